# Optimizing an MI355X kernel written in HIP

```python
import jax, jax.numpy as jnp
from jax import lax
import numpy as np

D_MODEL = 2048
BATCH = 4
SEQ = 4096
DEPTH = 1

MEM_LEN = 256
FOX_HEADS = 8
FOX_HEAD_DIM = 128
FOX_WIDTH = FOX_HEADS * FOX_HEAD_DIM
Q_BLOCK = 128
SG_GROUPS = 8
SG_GROUP_DIM = 128
SG_WIDTH = SG_GROUPS * SG_GROUP_DIM
SG_CHUNK = 128
X_HEADS = 4
X_HEAD_DIM = 128
X_WIDTH = X_HEADS * X_HEAD_DIM
N_EXPERTS = 32
TOP_K = 4
D_FF_EXPERT = D_MODEL
SWIGLU_LIMIT = 7.0
SWIGLU_ALPHA = 1.702
MOE_BLOCK = 256
RMS_EPS = 1e-6
LN_EPS = 1e-5
SPLITS = (FOX_WIDTH, 2 * FOX_WIDTH, 3 * FOX_WIDTH, 3 * FOX_WIDTH + FOX_HEADS,
          3 * FOX_WIDTH + FOX_HEADS + 2 * SG_WIDTH)
IN_COLS = 3 * FOX_WIDTH + FOX_HEADS + 2 * SG_WIDTH + 2 * D_MODEL

kernel_name = 'hybrid_fox_sgu_xattn_moe'


def rmsnorm(x, g):
    xf = x.astype(jnp.float32)
    y = xf * lax.rsqrt(jnp.mean(xf * xf, axis=-1, keepdims=True) + RMS_EPS)
    return (y * g.astype(jnp.float32)).astype(x.dtype)


def forgetting_attention(q, k, v, logf):
    B, S, H, Dh = q.shape
    nb = S // Q_BLOCK
    c = jnp.cumsum(logf, axis=1).transpose(0, 2, 1)
    qh = q.transpose(0, 2, 1, 3)
    kh = k.transpose(0, 2, 1, 3)
    vh = v.transpose(0, 2, 1, 3)
    q_blocks = qh.reshape(B, H, nb, Q_BLOCK, Dh).transpose(2, 0, 1, 3, 4)
    c_blocks = c.reshape(B, H, nb, Q_BLOCK).transpose(2, 0, 1, 3)
    starts = jnp.arange(nb, dtype=jnp.int32) * Q_BLOCK
    k_pos = jnp.arange(S, dtype=jnp.int32)
    scale = Dh ** -0.5

    def one_block(args):
        qb, cb, start = args
        s = jnp.einsum('bhqd,bhkd->bhqk', qb, kh, preferred_element_type=jnp.float32) * scale
        s = s + cb[..., None] - c[:, :, None, :]
        q_pos = start + jnp.arange(Q_BLOCK, dtype=jnp.int32)
        s = jnp.where(k_pos[None, :] <= q_pos[:, None], s, -jnp.inf)
        p = jax.nn.softmax(s, axis=-1)
        return jnp.einsum('bhqk,bhkd->bhqd', p.astype(vh.dtype), vh)

    out = lax.map(one_block, (q_blocks, c_blocks, starts))
    return out.transpose(1, 0, 3, 2, 4).reshape(B, S, H * Dh)


def spatial_gating(z, ln_g, ln_b, w_s, b_s):
    B, S, _ = z.shape
    u, v = jnp.split(z, 2, axis=-1)
    vf = v.astype(jnp.float32)
    mu = jnp.mean(vf, axis=-1, keepdims=True)
    var = jnp.mean(jnp.square(vf - mu), axis=-1, keepdims=True)
    v = ((vf - mu) * lax.rsqrt(var + LN_EPS) * ln_g.astype(jnp.float32)
         + ln_b.astype(jnp.float32)).astype(z.dtype)
    nc = S // SG_CHUNK
    v = v.reshape(B, nc, SG_CHUNK, SG_GROUPS, SG_GROUP_DIM)
    mask = jnp.tril(jnp.ones((SG_CHUNK, SG_CHUNK), dtype=bool))
    w = jnp.where(mask[None], w_s, jnp.zeros_like(w_s))
    mixed = jnp.einsum('gts,bnsgc->bntgc', w, v) + b_s.T[None, None, :, :, None]
    return u * mixed.reshape(B, S, SG_WIDTH)


def memory_cross_attention(h, hm, w_xq, w_xkv, w_xo):
    B, S, _ = h.shape
    M = hm.shape[1]
    q = (h @ w_xq).reshape(B, S, X_HEADS, X_HEAD_DIM)
    k, v = jnp.split(hm @ w_xkv, 2, axis=-1)
    k = k.reshape(B, M, X_HEADS, X_HEAD_DIM)
    v = v.reshape(B, M, X_HEADS, X_HEAD_DIM)
    s = jnp.einsum('bshd,bmhd->bhsm', q, k, preferred_element_type=jnp.float32) * (X_HEAD_DIM ** -0.5)
    p = jax.nn.softmax(s, axis=-1)
    o = jnp.einsum('bhsm,bmhd->bshd', p.astype(v.dtype), v).reshape(B, S, X_WIDTH)
    return o @ w_xo


def moe(h, w_router, b_router, w_gate_up, b_gate_up, w_down, b_down):
    B, S, D = h.shape
    N = B * S
    xt = h.reshape(N, D)
    logits = jnp.dot(xt, w_router, preferred_element_type=jnp.float32) + b_router.astype(jnp.float32)
    top_vals, top_idx = lax.top_k(logits, TOP_K)
    top_w = jax.nn.softmax(top_vals, axis=-1)
    A = N * TOP_K
    e_flat = top_idx.reshape(A)
    tok_flat = jnp.arange(A, dtype=jnp.int32) // TOP_K
    w_flat = top_w.reshape(A)
    order = jnp.argsort(e_flat)
    e_sorted = e_flat[order]
    tok_sorted = tok_flat[order]
    w_sorted = w_flat[order]
    counts = jnp.bincount(e_flat, length=N_EXPERTS)
    padded = ((counts + MOE_BLOCK - 1) // MOE_BLOCK) * MOE_BLOCK
    starts = jnp.cumsum(counts) - counts
    padded_ends = jnp.cumsum(padded)
    padded_starts = padded_ends - padded
    rank = jnp.arange(A, dtype=jnp.int32) - starts[e_sorted]
    dest = padded_starts[e_sorted] + rank
    n_blocks = -(-A // MOE_BLOCK) + N_EXPERTS
    P = n_blocks * MOE_BLOCK
    tok_buf = jnp.full((P,), N, jnp.int32).at[dest].set(tok_sorted)
    gate_buf = jnp.zeros((P,), jnp.float32).at[dest].set(w_sorted)
    block_start = jnp.arange(n_blocks, dtype=jnp.int32) * MOE_BLOCK
    block_expert = jnp.minimum(jnp.searchsorted(padded_ends, block_start, side='right'), N_EXPERTS - 1)
    x_pad = jnp.concatenate([xt, jnp.zeros((1, D), xt.dtype)], axis=0)

    def expert_block(args):
        tok, e = args
        xb = x_pad[tok]
        gu = xb @ w_gate_up[e] + b_gate_up[e]
        gate, up = jnp.split(gu, 2, axis=-1)
        gate = jnp.minimum(gate, SWIGLU_LIMIT)
        up = jnp.clip(up, -SWIGLU_LIMIT, SWIGLU_LIMIT)
        act = (up + 1) * gate * jax.nn.sigmoid(SWIGLU_ALPHA * gate)
        return act @ w_down[e] + b_down[e]

    y_buf = lax.map(expert_block, (tok_buf.reshape(n_blocks, MOE_BLOCK), block_expert))
    y_buf = y_buf.reshape(P, D)
    y_buf = y_buf * gate_buf[:, None].astype(y_buf.dtype)
    out = jnp.zeros((N + 1, D), y_buf.dtype).at[tok_buf].add(y_buf)[:N]
    return out.reshape(B, S, D)


def setup_inputs(seed: int = 0) -> dict:
    key = jax.random.key(seed)
    ks = jax.random.split(key, 28)
    f32 = jnp.float32
    nrm = lambda k, shape, s: jax.random.normal(k, shape, f32) * s
    D = D_MODEL
    return {
        'x': nrm(ks[0], (BATCH, SEQ, D), 1.0),
        'mem': nrm(ks[1], (BATCH, MEM_LEN, D), 1.0),
        'norm_mix_g': 1.0 + nrm(ks[2], (D,), 0.02),
        'w_in': nrm(ks[3], (D, IN_COLS), D ** -0.5),
        'b_forget': 3.0 + nrm(ks[4], (FOX_HEADS,), 0.1),
        'sg_ln_g': 1.0 + nrm(ks[5], (SG_WIDTH,), 0.02),
        'sg_ln_b': nrm(ks[6], (SG_WIDTH,), 0.02),
        'w_spatial': nrm(ks[7], (SG_GROUPS, SG_CHUNK, SG_CHUNK), SG_CHUNK ** -0.5),
        'b_spatial': 1.0 + nrm(ks[8], (SG_GROUPS, SG_CHUNK), 0.02),
        'w_branch_a': nrm(ks[9], (FOX_WIDTH, D), FOX_WIDTH ** -0.5),
        'w_branch_b': nrm(ks[10], (SG_WIDTH, D), SG_WIDTH ** -0.5),
        'w_out': nrm(ks[11], (D, D), D ** -0.5),
        'norm_x_g': 1.0 + nrm(ks[12], (D,), 0.02),
        'norm_mem_g': 1.0 + nrm(ks[13], (D,), 0.02),
        'w_xq': nrm(ks[14], (D, X_WIDTH), D ** -0.5),
        'w_xkv': nrm(ks[15], (D, 2 * X_WIDTH), D ** -0.5),
        'w_xo': nrm(ks[16], (X_WIDTH, D), X_WIDTH ** -0.5),
        'norm_ffn_g': 1.0 + nrm(ks[17], (D,), 0.02),
        'w_router': nrm(ks[18], (D, N_EXPERTS), D ** -0.5),
        'b_router': nrm(ks[19], (N_EXPERTS,), 0.01),
        'w_gate_up': nrm(ks[20], (N_EXPERTS, D, 2 * D_FF_EXPERT), D ** -0.5),
        'b_gate_up': nrm(ks[21], (N_EXPERTS, 2 * D_FF_EXPERT), 0.01),
        'w_down': nrm(ks[22], (N_EXPERTS, D_FF_EXPERT, D), D_FF_EXPERT ** -0.5),
        'b_down': nrm(ks[23], (N_EXPERTS, D), 0.01),
        'norm_final_g': 1.0 + nrm(ks[24], (D,), 0.02),
    }


def reference(x, mem, norm_mix_g, w_in, b_forget, sg_ln_g, sg_ln_b, w_spatial, b_spatial,
              w_branch_a, w_branch_b, w_out, norm_x_g, norm_mem_g, w_xq, w_xkv, w_xo,
              norm_ffn_g, w_router, b_router, w_gate_up, b_gate_up, w_down, b_down, norm_final_g):
    B, S, D = x.shape
    for _ in range(DEPTH):
        h = rmsnorm(x, norm_mix_g)
        proj = h @ w_in
        q, k, v, f_logit, z, gates = jnp.split(proj, SPLITS, axis=-1)
        logf = jax.nn.log_sigmoid(f_logit.astype(jnp.float32) + b_forget.astype(jnp.float32))
        y_a = forgetting_attention(q.reshape(B, S, FOX_HEADS, FOX_HEAD_DIM),
                                   k.reshape(B, S, FOX_HEADS, FOX_HEAD_DIM),
                                   v.reshape(B, S, FOX_HEADS, FOX_HEAD_DIM), logf) @ w_branch_a
        y_b = spatial_gating(jax.nn.gelu(z), sg_ln_g, sg_ln_b, w_spatial, b_spatial) @ w_branch_b
        g_a, g_b = jnp.split(gates, 2, axis=-1)
        merged = jax.nn.sigmoid(g_a) * y_a + jax.nn.sigmoid(g_b) * y_b
        x = x + merged @ w_out
        x = x + memory_cross_attention(rmsnorm(x, norm_x_g), rmsnorm(mem, norm_mem_g), w_xq, w_xkv, w_xo)
        x = x + moe(rmsnorm(x, norm_ffn_g), w_router, b_router, w_gate_up, b_gate_up, w_down, b_down)
    return rmsnorm(x, norm_final_g)
```

```cpp
#include <hip/hip_runtime.h>
#include <cstdio>
#include <cstdint>
#include <type_traits>

constexpr int DM = 2048, NB = 4, SEQ = 4096, NTOK = NB * SEQ, MEML = 256, NMEM = NB * MEML;
constexpr int FH = 8, FD = 128, FW = 1024, SGG = 8, SGD = 128, SGW = 1024, SGC = 128;
constexpr int XH = 4, XD = 128, XW = 512;
constexpr int NE = 32, TOPK = 4, DFF = 2048;
constexpr int INC = 3 * FW + FH + 2 * SGW + 2 * DM;
constexpr int C_Q = 0, C_K = 1024, C_V = 2048, C_F = 3072, C_Z = 3080, C_GA = 5128, C_GB = 7176;
constexpr float RMS_EPS = 1e-6f, LN_EPS = 1e-5f, SW_LIMIT = 7.0f, SW_ALPHA = 1.702f;
constexpr int MAXSLOT = NTOK * TOPK + NE * 256;

typedef unsigned short bf16;
__device__ __forceinline__ unsigned f2bf(float f) { unsigned u = __builtin_bit_cast(unsigned, f); return (u + 0x7fffu + ((u >> 16) & 1u)) >> 16; }
__device__ __forceinline__ float bf2f(bf16 h) { return __builtin_bit_cast(float, (unsigned)h << 16); }

constexpr size_t MiB = 1ull << 20;
constexpr size_t WS_CTL = 0;
constexpr size_t CTL_BYTES = 1 * MiB;
constexpr int CW_NRM = 12288;
constexpr int CW_CNT = 8192;
constexpr size_t WS_H0   = 16 * MiB;
constexpr size_t WS_HM   = WS_H0 + 64 * MiB;
constexpr size_t WS_LOGF = WS_HM + 4 * MiB;
constexpr size_t WS_CB   = WS_LOGF + 1 * MiB;
constexpr size_t WS_Q    = WS_CB + 1 * MiB;
constexpr size_t WS_K    = WS_Q + 32 * MiB;
constexpr size_t WS_V    = WS_K + 32 * MiB;
constexpr size_t WS_ZU   = WS_V + 32 * MiB;
constexpr size_t WS_ZV   = WS_ZU + 32 * MiB;
constexpr size_t WS_ZST  = WS_ZV + 32 * MiB;
constexpr size_t WS_GR   = WS_ZST + 2 * MiB;
constexpr size_t WS_GS   = WS_GR + 64 * MiB;
constexpr size_t WS_AS   = WS_GS + 64 * MiB;
constexpr size_t WS_MG   = WS_AS + 64 * MiB;
constexpr size_t WS_X1   = WS_MG + 64 * MiB;
constexpr size_t WS_X1B  = WS_X1 + 128 * MiB;
constexpr size_t WS_SS1  = WS_X1B + 64 * MiB;
constexpr size_t WS_QX   = WS_SS1 + 2 * MiB;
constexpr size_t WS_KX   = WS_QX + 16 * MiB;
constexpr size_t WS_VX   = WS_KX + 1 * MiB;
constexpr size_t WS_OX   = WS_VX + 1 * MiB;
constexpr size_t WS_X2   = WS_OX + 16 * MiB;
constexpr size_t WS_X2B  = WS_X2 + 128 * MiB;
constexpr size_t WS_SS2  = WS_X2B + 64 * MiB;
constexpr size_t WS_TOPE = WS_SS2 + 2 * MiB;
constexpr size_t WS_TOPR = WS_TOPE + 1 * MiB;
constexpr size_t WS_TOPW = WS_TOPR + 1 * MiB;
constexpr size_t WS_TOKL = WS_TOPW + 1 * MiB;
constexpr size_t WS_GWL  = WS_TOKL + 2 * MiB;
constexpr size_t WS_HB   = WS_GWL + 2 * MiB;
constexpr size_t WS_YB   = WS_HB + 288 * MiB;
constexpr size_t WS_TMP  = WS_YB + 288 * MiB;
constexpr size_t WS_END_NAIVE = WS_TMP + 640 * MiB;

__device__ __forceinline__ float gelu_tanh(float x) {
    const float u = 0.7978845608028654f * (x + 0.044715f * x * x * x);
    const float e = __expf(2.f * u);
    const float t = 1.f - 2.f / (e + 1.f);
    return 0.5f * x * (1.f + t);
}
__device__ __forceinline__ float sigmoidf_(float x) { return 1.f / (1.f + __expf(-x)); }
__device__ __forceinline__ float log_sigmoid(float x) { return fminf(x, 0.f) - log1pf(__expf(-fabsf(x))); }

#ifdef REFERENCE_PIPELINE
__device__ __forceinline__ float block_sum_256(float v, float* red) {
#pragma unroll
    for (int o = 32; o > 0; o >>= 1) v += __shfl_xor(v, o);
    __syncthreads();
    if ((threadIdx.x & 63) == 0) red[threadIdx.x >> 6] = v;
    __syncthreads();
    return red[0] + red[1] + red[2] + red[3];
}
__global__ __launch_bounds__(256) void n_rms_rows(const float* X, const float* g, bf16* OUT, const float* w_in, const float* b_forget, float* LOGF) {
    __shared__ float red[4];
    const int row = blockIdx.x, t = threadIdx.x;
    const float* x = X + (size_t)row * DM;
    float v[8]; float s = 0.f;
#pragma unroll
    for (int i = 0; i < 8; ++i) { v[i] = x[t + 256 * i]; s += v[i] * v[i]; }
    const float tot = block_sum_256(s, red);
    const float rstd = rsqrtf(tot * (1.f / DM) + RMS_EPS);
    float f[8];
#pragma unroll
    for (int j = 0; j < 8; ++j) f[j] = 0.f;
#pragma unroll
    for (int i = 0; i < 8; ++i) {
        const int k = t + 256 * i; const float h = v[i] * rstd * g[k];
        OUT[(size_t)row * DM + k] = (bf16)f2bf(h);
        if (LOGF) {
#pragma unroll
            for (int j = 0; j < 8; ++j) f[j] += h * w_in[(size_t)k * INC + C_F + j];
        }
    }
    if (LOGF) {
#pragma unroll
        for (int j = 0; j < 8; ++j) { const float tj = block_sum_256(f[j], red); if (t == 0) LOGF[(size_t)row * 8 + j] = log_sigmoid(tj + b_forget[j]); }
    }
}
__global__ __launch_bounds__(64) void n_cumsum(const float* LOGF, float* CB) {
    const int bh = blockIdx.x, b = bh / FH, h = bh % FH, lane = threadIdx.x;
    float loc = 0.f;
    for (int i = 0; i < 64; ++i) loc += LOGF[(size_t)(b * SEQ + lane * 64 + i) * 8 + h];
    float inc = loc;
#pragma unroll
    for (int o = 1; o < 64; o <<= 1) { const float n = __shfl_up(inc, o); if (lane >= o) inc += n; }
    float run = inc - loc;
    for (int i = 0; i < 64; ++i) { run += LOGF[(size_t)(b * SEQ + lane * 64 + i) * 8 + h]; CB[(size_t)bh * SEQ + lane * 64 + i] = -run * 11.313708498984761f; }
}

template <bool DUAL, class FA, class FB, class FA2, class FB2, class FE>
__global__ __launch_bounds__(256) void n_gemm(int M, int N, int K, int padarg, const int* Mdev, FA fa, FB fb, FA2 fa2, FB2 fb2, FE fe) {
    __shared__ float As[16][68], Bs[16][68], As2[DUAL ? 16 : 1][68], Bs2[DUAL ? 16 : 1][68];
    const int z = blockIdx.z, m0 = blockIdx.y * 64, n0 = blockIdx.x * 64, t = threadIdx.x, tx = t & 15, ty = t >> 4;
    const int Mr = Mdev ? Mdev[z] : M;
    if (m0 >= Mr) return;
    float acc[4][4], acc2[4][4];
#pragma unroll
    for (int i = 0; i < 4; ++i)
#pragma unroll
        for (int j = 0; j < 4; ++j) { acc[i][j] = 0.f; acc2[i][j] = 0.f; }
    for (int k0 = 0; k0 < K; k0 += 16) {
#pragma unroll
        for (int i = 0; i < 4; ++i) {
            const int idx = t + i * 256;
            { const int r = idx >> 4, c = idx & 15; const bool ok = (m0 + r) < Mr; As[c][r] = ok ? fa(z, m0 + r, k0 + c) : 0.f; if (DUAL) As2[c][r] = ok ? fa2(z, m0 + r, k0 + c) : 0.f; }
            { const int r = idx >> 6, c = idx & 63; const bool ok = (n0 + c) < N; Bs[r][c] = ok ? fb(z, k0 + r, n0 + c) : 0.f; if (DUAL) Bs2[r][c] = ok ? fb2(z, k0 + r, n0 + c) : 0.f; }
        }
        __syncthreads();
#pragma unroll
        for (int kk = 0; kk < 16; ++kk) {
            float a[4], b[4], a2[4], b2[4];
#pragma unroll
            for (int i = 0; i < 4; ++i) { a[i] = As[kk][ty * 4 + i]; b[i] = Bs[kk][tx * 4 + i]; if (DUAL) { a2[i] = As2[kk][ty * 4 + i]; b2[i] = Bs2[kk][tx * 4 + i]; } }
#pragma unroll
            for (int i = 0; i < 4; ++i)
#pragma unroll
                for (int j = 0; j < 4; ++j) { acc[i][j] += a[i] * b[j]; if (DUAL) acc2[i][j] += a2[i] * b2[j]; }
        }
        __syncthreads();
    }
#pragma unroll
    for (int i = 0; i < 4; ++i)
#pragma unroll
        for (int j = 0; j < 4; ++j) { const int m = m0 + ty * 4 + i, n = n0 + tx * 4 + j; if (m < Mr && n < N) fe(z, m, n, acc[i][j], acc2[i][j]); }
}
struct FNone { long pad; __device__ float operator()(int, int, int) const { return 0.f; } };
template <bool DUAL, class FA, class FB, class FA2, class FB2, class FE>
static void run_gemm(hipStream_t st, int Z, int M, int N, int K, const int* Mdev, FA fa, FB fb, FA2 fa2, FB2 fb2, FE fe) {
    dim3 grid((N + 63) / 64, (M + 63) / 64, Z);
    hipLaunchKernelGGL((n_gemm<DUAL, FA, FB, FA2, FB2, FE>), grid, dim3(256), 0, st, M, N, K, 0, Mdev, fa, fb, fa2, fb2, fe);
}
template <class FA, class FB, class FE>
static void run_gemm1(hipStream_t st, int Z, int M, int N, int K, const int* Mdev, FA fa, FB fb, FE fe) { run_gemm<false>(st, Z, M, N, K, Mdev, fa, fb, FNone{}, FNone{}, fe); }

struct ABf { const bf16* p; int ld, pad; __device__ float operator()(int, int m, int k) const { return bf2f(p[(size_t)m * ld + k]); } };
struct AF32 { const float* p; int ld, pad; __device__ float operator()(int, int m, int k) const { return p[(size_t)m * ld + k]; } };
struct BF32 { const float* p; int ld, pad; __device__ float operator()(int, int k, int n) const { return p[(size_t)k * ld + n]; } };
struct BF32G { const float* p; const float* g; int ld, pad; __device__ float operator()(int, int k, int n) const { return g[k] * p[(size_t)k * ld + n]; } };

struct EProj { bf16 *Q, *K, *V, *ZU, *ZV; float *TGA, *TGB;
    __device__ void operator()(int, int m, int n, float v, float) const {
        if (n < C_K) Q[(size_t)m * FW + n] = (bf16)f2bf(v);
        else if (n < C_V) K[(size_t)m * FW + n - C_K] = (bf16)f2bf(v);
        else if (n < C_F) V[(size_t)m * FW + n - C_V] = (bf16)f2bf(v);
        else if (n < C_Z) {}
        else if (n < C_Z + SGW) ZU[(size_t)m * SGW + n - C_Z] = (bf16)f2bf(gelu_tanh(v));
        else if (n < C_GA) ZV[(size_t)m * SGW + n - C_Z - SGW] = (bf16)f2bf(gelu_tanh(v));
        else if (n < C_GB) TGA[(size_t)m * DM + n - C_GA] = sigmoidf_(v);
        else TGB[(size_t)m * DM + n - C_GB] = sigmoidf_(v);
    } };
__global__ __launch_bounds__(256) void n_gates(const float* TGA, const float* TGB, bf16* GR, bf16* GS) {
    const size_t i = (size_t)blockIdx.x * 256 + threadIdx.x; const float a = TGA[i], b = TGB[i]; GR[i] = (bf16)f2bf(a / b); GS[i] = (bf16)f2bf(b);
}
__global__ __launch_bounds__(256) void n_zstat(const bf16* ZV, float* ZST) {
    __shared__ float red[4];
    const int row = blockIdx.x, t = threadIdx.x; float s = 0.f, q = 0.f;
    for (int i = 0; i < 4; ++i) { const float v = bf2f(ZV[(size_t)row * SGW + t + 256 * i]); s += v; q += v * v; }
    const float S = block_sum_256(s, red); const float Q = block_sum_256(q, red);
    if (t < 32) ZST[(size_t)row * 32 + t] = (t == 0) ? S : (t == 1) ? Q : 0.f;
}
struct AQh { const bf16* p; int ld, b, rows, pad; __device__ float operator()(int z, int m, int k) const { return bf2f(p[(size_t)(b * rows + m) * ld + z * 128 + k]); } };
struct BKh { const bf16* p; int ld, b, rows, pad; __device__ float operator()(int z, int k, int n) const { return bf2f(p[(size_t)(b * rows + n) * ld + z * 128 + k]); } };
struct BVh { const bf16* p; int ld, b, rows, pad; __device__ float operator()(int z, int k, int n) const { return bf2f(p[(size_t)(b * rows + k) * ld + z * 128 + n]); } };
struct ES { float* S; const float* CB; int b, ncol, causal, pad; __device__ void operator()(int z, int m, int n, float v, float) const {
        float s = v; if (CB) s += CB[(size_t)(b * FH + z) * SEQ + n]; s *= 0.08838834764831845f; if (causal && n > m) s = -INFINITY; S[((size_t)z * SEQ + m) * ncol + n] = s; } };
__global__ __launch_bounds__(256) void n_softmax_rows(float* S, int ncol) {
    __shared__ float red[4];
    float* r = S + (size_t)blockIdx.x * ncol; const int t = threadIdx.x;
    float mx = -INFINITY; for (int i = t; i < ncol; i += 256) mx = fmaxf(mx, r[i]);
#pragma unroll
    for (int o = 32; o > 0; o >>= 1) mx = fmaxf(mx, __shfl_xor(mx, o));
    __syncthreads(); if ((t & 63) == 0) red[t >> 6] = mx; __syncthreads();
    mx = fmaxf(fmaxf(red[0], red[1]), fmaxf(red[2], red[3]));
    float s = 0.f; for (int i = t; i < ncol; i += 256) { const float e = __expf(r[i] - mx); r[i] = e; s += e; }
    const float tot = block_sum_256(s, red); const float inv = 1.f / tot;
    for (int i = t; i < ncol; i += 256) r[i] *= inv;
}
struct AS3 { const float* S; int ncol, pad; __device__ float operator()(int z, int m, int k) const { return S[((size_t)z * SEQ + m) * ncol + k]; } };
struct EO { bf16* O; int ld, b, coff, pad; __device__ void operator()(int z, int m, int n, float v, float) const { O[(size_t)(b * SEQ + m) * ld + coff + z * 128 + n] = (bf16)f2bf(v); } };
__global__ __launch_bounds__(128) void n_spatial(const bf16* ZU, const bf16* ZV, const float* ZST, const float* ln_g, const float* ln_b, const float* w_s, const float* b_s, bf16* AS) {
    __shared__ float vn[128][129];
    const int chunk = blockIdx.x, g = blockIdx.y, c = threadIdx.x, t0 = chunk * SGC;
    for (int s = 0; s < 128; ++s) {
        const float* st = ZST + (size_t)(t0 + s) * 32; float S = 0.f, Q = 0.f;
        for (int i = 0; i < 16; ++i) { S += st[2 * i]; Q += st[2 * i + 1]; }
        const float mu = S * (1.f / SGW), var = fmaxf(Q * (1.f / SGW) - mu * mu, 0.f), rs = rsqrtf(var + LN_EPS);
        const float v = bf2f(ZV[(size_t)(t0 + s) * SGW + g * 128 + c]);
        vn[s][c] = (v - mu) * rs * ln_g[g * 128 + c] + ln_b[g * 128 + c];
    }
    __syncthreads();
    for (int t = 0; t < 128; ++t) {
        float a = 0.f; const float* w = w_s + ((size_t)g * 128 + t) * 128;
        for (int s = 0; s <= t; ++s) a += w[s] * vn[s][c];
        a += b_s[g * 128 + t];
        const float u = bf2f(ZU[(size_t)(t0 + t) * SGW + g * 128 + c]);
        AS[(size_t)(t0 + t) * DM + FW + g * 128 + c] = (bf16)f2bf(u * a);
    }
}
struct BWab { const float* wa; const float* wb; int second, pad; __device__ float operator()(int, int k, int n) const { return second ? wb[(size_t)k * DM + n] : wa[(size_t)k * DM + n]; } };
struct AAs { const bf16* p; int off, pad; __device__ float operator()(int, int m, int k) const { return bf2f(p[(size_t)m * DM + off + k]); } };
struct EMerge { const bf16 *GR, *GS; bf16* MG; __device__ void operator()(int, int m, int n, float v, float v2) const { const size_t i = (size_t)m * DM + n; MG[i] = (bf16)f2bf((v * bf2f(GR[i]) + v2) * bf2f(GS[i])); } };
struct EResid { const float* Xi; float* Xo; bf16* Xb; __device__ void operator()(int, int m, int n, float v, float) const { const size_t i = (size_t)m * DM + n; const float o = Xi[i] + v; Xo[i] = o; Xb[i] = (bf16)f2bf(o); } };
__global__ __launch_bounds__(256) void n_sumsq(const float* X, float* SS) {
    __shared__ float red[4];
    const int row = blockIdx.x, t = threadIdx.x; float q = 0.f;
    for (int i = 0; i < 8; ++i) { const float v = X[(size_t)row * DM + t + 256 * i]; q += v * v; }
    const float Q = block_sum_256(q, red);
    if (t < 32) SS[(size_t)row * 32 + t] = (t == 0) ? Q : 0.f;
}
__device__ __forceinline__ float rstd_from(const float* SS, int m) { float q = 0.f; for (int i = 0; i < 32; ++i) q += SS[(size_t)m * 32 + i]; return rsqrtf(q * (1.f / DM) + RMS_EPS); }
struct EQx { const float* SS; bf16* QX; __device__ void operator()(int, int m, int n, float v, float) const { QX[(size_t)m * XW + n] = (bf16)f2bf(v * rstd_from(SS, m)); } };
struct EKVx { bf16 *KX, *VX; __device__ void operator()(int, int m, int n, float v, float) const { if (n < XW) KX[(size_t)m * XW + n] = (bf16)f2bf(v); else VX[(size_t)m * XW + n - XW] = (bf16)f2bf(v); } };
struct ELogit { const float* SS; const float* br; float* LG; __device__ void operator()(int, int m, int n, float v, float) const { LG[(size_t)m * NE + n] = v * rstd_from(SS, m) + br[n]; } };
__global__ __launch_bounds__(256) void n_topk(const float* LG, int* TOPE, int* TOPR, float* TOPW, int* TOKL, float* GWL, unsigned* CNT, const float* SS, float* RS2) {
    const int t = blockIdx.x * 256 + threadIdx.x; if (t >= NTOK) return;
    RS2[t] = rstd_from(SS, t);
    float l[NE];
#pragma unroll
    for (int e = 0; e < NE; ++e) l[e] = LG[(size_t)t * NE + e];
    float tv[4]; int ti[4];
#pragma unroll
    for (int k = 0; k < 4; ++k) { float bv = -INFINITY; int bi = 0;
#pragma unroll
        for (int e = 0; e < NE; ++e) { if (l[e] > bv) { bv = l[e]; bi = e; } }
        tv[k] = bv; ti[k] = bi;
#pragma unroll
        for (int e = 0; e < NE; ++e) if (e == bi) l[e] = -INFINITY; }
    float s = 0.f, w[4];
#pragma unroll
    for (int k = 0; k < 4; ++k) { w[k] = __expf(tv[k] - tv[0]); s += w[k]; }
#pragma unroll
    for (int k = 0; k < 4; ++k) { const float wk = w[k] / s; const int e = ti[k]; const unsigned r = atomicAdd(&CNT[e], 1u);
        TOPE[t * 4 + k] = e; TOPR[t * 4 + k] = (int)r; TOPW[t * 4 + k] = wk; TOKL[(size_t)e * NTOK + r] = t; GWL[(size_t)e * NTOK + r] = wk; }
}
__device__ __forceinline__ int expert_base(const unsigned* CNT, int e) { int b = 0; for (int i = 0; i < e; ++i) b += ((int)CNT[i] + 255) & ~255; return b; }
struct AGath { const bf16* X; const int* TOKL; __device__ float operator()(int z, int m, int k) const { return bf2f(X[(size_t)TOKL[(size_t)z * NTOK + m] * DM + k]); } };
struct BGu { const float* w; const float* g; int up, pad; __device__ float operator()(int z, int k, int n) const { return g[k] * w[((size_t)z * DM + k) * (2 * DFF) + up * DFF + n]; } };
struct EAct { const float* SS; const int* TOKL; const float* bgu; const unsigned* CNT; bf16* HB;
    __device__ void operator()(int z, int m, int n, float v, float v2) const {
        const float rs = rstd_from(SS, TOKL[(size_t)z * NTOK + m]);
        float gate = v * rs + bgu[(size_t)z * 2 * DFF + n], up = v2 * rs + bgu[(size_t)z * 2 * DFF + DFF + n];
        gate = fminf(gate, SW_LIMIT); up = fminf(fmaxf(up, -SW_LIMIT), SW_LIMIT);
        const float act = (up + 1.f) * gate * sigmoidf_(SW_ALPHA * gate);
        HB[(size_t)(expert_base(CNT, z) + m) * DFF + n] = (bf16)f2bf(act); } };
struct AHb { const bf16* HB; const unsigned* CNT; __device__ float operator()(int z, int m, int k) const { return bf2f(HB[(size_t)(expert_base(CNT, z) + m) * DFF + k]); } };
struct BDn { const float* w; __device__ float operator()(int z, int k, int n) const { return w[((size_t)z * DFF + k) * DM + n]; } };
struct EDn { const float* bd; const float* GWL; const unsigned* CNT; bf16* YB; __device__ void operator()(int z, int m, int n, float v, float) const {
        YB[(size_t)(expert_base(CNT, z) + m) * DM + n] = (bf16)f2bf((v + bd[(size_t)z * DM + n]) * GWL[(size_t)z * NTOK + m]); } };
__global__ __launch_bounds__(256) void n_final(const float* X2, const bf16* YB, const int* TOPE, const int* TOPR, const unsigned* CNT, const float* g, float* OUT) {
    __shared__ float red[4];
    const int row = blockIdx.x, t = threadIdx.x;
    int slot[4];
#pragma unroll
    for (int k = 0; k < 4; ++k) slot[k] = expert_base(CNT, TOPE[row * 4 + k]) + TOPR[row * 4 + k];
    float v[8]; float q = 0.f;
#pragma unroll
    for (int i = 0; i < 8; ++i) { const int c = t + 256 * i; float a = X2[(size_t)row * DM + c];
#pragma unroll
        for (int k = 0; k < 4; ++k) a += bf2f(YB[(size_t)slot[k] * DM + c]);
        v[i] = a; q += a * a; }
    const float Q = block_sum_256(q, red); const float rs = rsqrtf(Q * (1.f / DM) + RMS_EPS);
#pragma unroll
    for (int i = 0; i < 8; ++i) { const int c = t + 256 * i; OUT[(size_t)row * DM + c] = v[i] * rs * g[c]; }
}

#endif
#define LAS __attribute__((address_space(3)))
#define GAS __attribute__((address_space(1)))
typedef short bf16x8 __attribute__((ext_vector_type(8)));
typedef float f32x4 __attribute__((ext_vector_type(4)));
typedef float f32x2 __attribute__((ext_vector_type(2)));
typedef unsigned u32x4 __attribute__((ext_vector_type(4)));
typedef unsigned u32x2 __attribute__((ext_vector_type(2)));

constexpr int NPROJ = 9216;
constexpr size_t WS_WP   = WS_END_NAIVE;
constexpr size_t WS_WAB  = WS_WP + 36 * MiB;
constexpr size_t WS_WO   = WS_WAB + 8 * MiB;
constexpr size_t WS_WXQ  = WS_WO + 8 * MiB;
constexpr size_t WS_WXKV = WS_WXQ + 2 * MiB;
constexpr size_t WS_WXO  = WS_WXKV + 4 * MiB;
constexpr size_t WS_WGU  = WS_WXO + 2 * MiB;
constexpr size_t WS_WD   = WS_WGU + 512 * MiB;
constexpr size_t WS_WRT  = WS_WD + 256 * MiB;
constexpr size_t WS_RS2  = WS_WRT + 1 * MiB;
constexpr size_t WS_RSL  = WS_RS2 + 1 * MiB;
constexpr size_t WS_X2Q  = WS_RSL + 2 * MiB;
constexpr size_t WS_H0Q  = WS_X2Q + 32 * MiB;
constexpr size_t WS_WPG  = WS_H0Q + 32 * MiB;
constexpr size_t WS_END  = WS_WPG + 8 * MiB;

constexpr int NWAVES = 8, NTHREADS = 512;
constexpr int LDS_STAGE = 131072;
constexpr int LDS_MISC = LDS_STAGE;
constexpr int LDS_TAB = LDS_STAGE + 256;
constexpr int LDS_BYTES = 147456;
constexpr int CW_BAR = 65536;

__device__ __forceinline__ unsigned cvt_pk_bf16(float lo, float hi) { unsigned r; asm volatile("v_cvt_pk_bf16_f32 %0, %1, %2" : "=v"(r) : "v"(lo), "v"(hi)); return r; }
constexpr float W8_SCALE = 64.f, W8_INV = 1.f / 64.f;
__device__ __forceinline__ unsigned pk4_fp8(float a, float b, float c, float d) {
    a = __builtin_amdgcn_fmed3f(a, -448.f, 448.f); b = __builtin_amdgcn_fmed3f(b, -448.f, 448.f); c = __builtin_amdgcn_fmed3f(c, -448.f, 448.f); d = __builtin_amdgcn_fmed3f(d, -448.f, 448.f);
    int w = 0; w = __builtin_amdgcn_cvt_pk_fp8_f32(a, b, w, false); w = __builtin_amdgcn_cvt_pk_fp8_f32(c, d, w, true); return (unsigned)w; }
__device__ __forceinline__ unsigned pk4_fp8_nc(float a, float b, float c, float d) {
    int w = 0; w = __builtin_amdgcn_cvt_pk_fp8_f32(a, b, w, false); w = __builtin_amdgcn_cvt_pk_fp8_f32(c, d, w, true); return (unsigned)w; }
__device__ __forceinline__ float fast_sigmoid(float x) { return __builtin_amdgcn_rcpf(1.f + __builtin_amdgcn_exp2f(-1.4426950408889634f * x)); }
__device__ __forceinline__ float fast_gelu_tanh(float x) { const float u2 = 1.5957691216057308f * (x + 0.044715f * x * x * x); return x * __builtin_amdgcn_rcpf(1.f + __builtin_amdgcn_exp2f(-1.4426950408889634f * u2)); }
__device__ __forceinline__ f32x2 gelu_tanh2(f32x2 x) { const f32x2 u = (x * x * 0.044715f + 1.0f) * x * (-1.4426950408889634f * 1.5957691216057308f);
    f32x2 e; e.x = __builtin_amdgcn_exp2f(u.x); e.y = __builtin_amdgcn_exp2f(u.y); const f32x2 d = e + 1.0f; f32x2 r; r.x = __builtin_amdgcn_rcpf(d.x); r.y = __builtin_amdgcn_rcpf(d.y); return x * r; }
__device__ __forceinline__ float wave_sum(float v) {
#pragma unroll
    for (int o = 1; o < 64; o <<= 1) v += __shfl_xor(v, o);
    return v;
}

#define XB_TMO      128
#define XB_XCNT(j)  (256  + 64 * (j))
#define XB_XSUB(j)  (1280 + 64 * (j))
#define XB_XGEN(j)  (2304 + 64 * (j))
#define XB_TOP      3328
#define XB_TOPGEN   3392
#define XCD_BAR_WORDS 3456
#define XB_SPIN_CAP (1u << 18)
__device__ __forceinline__ unsigned xb_ld(unsigned* p)              { return __hip_atomic_load(p, __ATOMIC_RELAXED, __HIP_MEMORY_SCOPE_AGENT); }
__device__ __forceinline__ unsigned xb_add(unsigned* p, unsigned v) { return __hip_atomic_fetch_add(p, v, __ATOMIC_RELAXED, __HIP_MEMORY_SCOPE_AGENT); }
__device__ __forceinline__ unsigned xb_xcc_id() { return (unsigned)__builtin_amdgcn_s_getreg((3 << 11) | 20) & 0xFu; }
#define XB_SPIN(cond, bar) do { unsigned _sp = 0; while (cond) { __builtin_amdgcn_s_sleep(1); \
    if ((++_sp & 255u) == 0u) { if (xb_ld(&(bar)[XB_TMO])) break; if (_sp > XB_SPIN_CAP) { atomicAdd(&(bar)[XB_TMO], 1u); break; } } } } while (0)
struct XcdBarrier { unsigned* bar; unsigned x; volatile LAS unsigned* st; };
__device__ __forceinline__ XcdBarrier xcd_barrier_post(unsigned* bar, volatile LAS unsigned* st) {
    XcdBarrier b; b.bar = bar; b.x = xb_xcc_id(); b.st = st;
    if (threadIdx.x == 0) (void)xb_add(&bar[XB_XCNT(b.x)], 1u);
    return b;
}
__device__ __forceinline__ void xcd_barrier_complete(unsigned* bar, unsigned x, unsigned& nloc, unsigned& nx) {
    const unsigned G = gridDim.x * gridDim.y * gridDim.z;
    unsigned sum, cnt, mine, sp = 0u;
    for (;;) {
        sum = 0u; cnt = 0u; mine = 0u;
#pragma unroll
        for (unsigned j = 0; j < 16; ++j) { const unsigned c = xb_ld(&bar[XB_XCNT(j)]); sum += c; cnt += (c > 0u) ? 1u : 0u; mine = (j == x) ? c : mine; }
        if (sum == G) break;
        __builtin_amdgcn_s_sleep(1);
        if ((++sp & 255u) == 0u) { if (xb_ld(&bar[XB_TMO])) break; if (sp > XB_SPIN_CAP) { atomicAdd(&bar[XB_TMO], 1u); break; } }
    }
    nloc = mine > 0u ? mine : 1u; nx = cnt > 0u ? cnt : 1u;
}
__device__ __forceinline__ void xcd_barrier(const XcdBarrier& b) {
    asm volatile("s_waitcnt vmcnt(0)" ::: "memory");
    __syncthreads();
    if (threadIdx.x == 0) {
        unsigned* bar = b.bar;
        __builtin_amdgcn_s_waitcnt(0);
        unsigned nloc = b.st[0], nx = b.st[1];
        if (nloc == 0u) { xcd_barrier_complete(bar, b.x, nloc, nx); b.st[0] = nloc; b.st[1] = nx; }
        const unsigned old = xb_add(&bar[XB_XSUB(b.x)], 1u);
        const unsigned gen = old / nloc;
        if (old + 1u == (gen + 1u) * nloc) {
            __builtin_amdgcn_fence(__ATOMIC_RELEASE, "agent");
            asm volatile("s_waitcnt vmcnt(0)" ::: "memory");
            const unsigned og = xb_add(&bar[XB_TOP], 1u);
            const unsigned tg = og / nx;
            if (og + 1u == (tg + 1u) * nx) xb_add(&bar[XB_TOPGEN], 1u);
            else XB_SPIN(xb_ld(&bar[XB_TOPGEN]) == tg, bar);
            __builtin_amdgcn_fence(__ATOMIC_ACQUIRE, "agent");
            xb_add(&bar[XB_XGEN(b.x)], 1u);
            asm volatile("s_waitcnt vmcnt(0)" ::: "memory");
        } else {
            XB_SPIN(xb_ld(&bar[XB_XGEN(b.x)]) == gen, bar);
            __builtin_amdgcn_fence(__ATOMIC_ACQUIRE, "agent");
            asm volatile("s_waitcnt vmcnt(0)" ::: "memory");
        }
    }
    __syncthreads();
}

namespace pg8 {
typedef int v4i_t __attribute__((ext_vector_type(4)));
typedef int v8i_t __attribute__((ext_vector_type(8)));
constexpr int BM = 256, BK = 64, HALF = 128, HTB = HALF * BK * 2, STAGE_BYTES = 8 * HTB;
__host__ __device__ __forceinline__ int lds_byte(int r, int c) { const int st = (r >> 4) * 2 + (c >> 5), rr = r & 15, cc = c & 31, ob = rr * 64 + cc * 2; return st * 1024 + (ob ^ (((ob >> 9) & 1) << 5)); }
__host__ __device__ __forceinline__ void stage_rc(int b, int& R, int& C) { const int st = b / 1024, sb = b % 1024, swz = sb ^ (((sb >> 9) & 1) << 5); R = (st >> 1) * 16 + swz / 64; C = (st & 1) * 32 + (swz % 64) / 2; }
__host__ __device__ __forceinline__ int perm32(int rho) { const int n = rho >> 4, i = rho & 15; return 8 * (i >> 2) + 4 * n + (i & 3); }

struct GUnit { const char* A; const char* B; int pm, pn, e, keep; };

template <bool GATHER, bool F8, class Epi, class Sched>
__device__ __forceinline__ void gemm_phase(LAS unsigned char* lds, const int nt, const unsigned lda, const unsigned ldb, const Sched& S, const Epi& E) {
    const int tid = threadIdx.x, wid = __builtin_amdgcn_readfirstlane(tid >> 6), lane = tid & 63, wr = wid >> 2, wc = wid & 3, fr = lane & 15, fq = lane >> 4;
    unsigned voffA[2], voffB[2]; int RA[2]; unsigned CA2[2];
#pragma unroll
    for (int i = 0; i < 2; ++i) { int R, C; stage_rc(tid * 16 + i * 8192, R, C); const int Rb = Epi::PERM ? ((R & ~31) + perm32(R & 31)) : R;
        RA[i] = R; CA2[i] = (unsigned)C * 2u; voffA[i] = (unsigned)R * lda + (unsigned)C * 2u; voffB[i] = (unsigned)Rb * ldb + (unsigned)C * 2u; }
    const size_t kstep = (size_t)(BK * 2);
    const size_t hA = GATHER ? 0 : (size_t)HALF * lda, hB = (size_t)HALF * ldb;
    const unsigned ldsw = (unsigned)wid * 1024u;
    const int aoff = lds_byte(wr * 64 + fr, fq * 8), boff = lds_byte(wc * 32 + fr, fq * 8);
    LAS unsigned char* const ldsB = lds + 4 * HTB;
#define PG8_SA(b, h) (((b) * 2 + (h)) * HTB)
#define PG8_SB(b, h) ((4 + (b) * 2 + (h)) * HTB)
#define PG8_STAGE(bufoff, gbase, voff) do { _Pragma("unroll") for (int _i = 0; _i < 2; ++_i) \
        __builtin_amdgcn_global_load_lds((const unsigned*)((const char*)(gbase) + (voff)[_i]), (LAS unsigned*)(lds + (bufoff) + ldsw + _i * 8192), 16, 0, 0); } while (0)
#define PG8_SBR(b, h) (((b) * 2 + (h)) * HTB)
#define PG8_LD8(base, off) __builtin_shufflevector(*(const LAS v4i_t*)((base) + (off)), *(const LAS v4i_t*)((base) + (off) + 1024), 0, 1, 2, 3, 4, 5, 6, 7)
#define PG8_LDA(dst, b, h) do { if constexpr (F8) { _Pragma("unroll") for (int m = 0; m < 4; ++m) dst##8[m] = PG8_LD8(lds, PG8_SA(b, h) + aoff + m * 2048); } \
        else { _Pragma("unroll") for (int m = 0; m < 4; ++m) _Pragma("unroll") for (int k = 0; k < 2; ++k) dst[m][k] = *(const LAS bf16x8*)(lds + PG8_SA(b, h) + aoff + m * 2048 + k * 1024); } } while (0)
#define PG8_LDB(dst, b, h) do { if constexpr (F8) { _Pragma("unroll") for (int n = 0; n < 2; ++n) dst##8[n] = PG8_LD8(ldsB, PG8_SBR(b, h) + boff + n * 2048); } \
        else { _Pragma("unroll") for (int n = 0; n < 2; ++n) _Pragma("unroll") for (int k = 0; k < 2; ++k) dst[n][k] = *(const LAS bf16x8*)(ldsB + PG8_SBR(b, h) + boff + n * 2048 + k * 1024); } } while (0)
#define PG8_MMA(ai, bj, At, Bt) do { __builtin_amdgcn_s_setprio(1); \
        if constexpr (F8) { _Pragma("unroll") for (int m = 0; m < 4; ++m) _Pragma("unroll") for (int n = 0; n < 2; ++n) \
            asm volatile("v_mfma_scale_f32_16x16x128_f8f6f4 %0, %1, %2, %0, %3, %3 op_sel_hi:[0,0,0]" : "+v"(acc[ai][bj][m][n]) : "v"(Bt##8[n]), "v"(At##8[m]), "v"(sc8)); } \
        else { _Pragma("unroll") for (int m = 0; m < 4; ++m) _Pragma("unroll") for (int n = 0; n < 2; ++n) _Pragma("unroll") for (int k = 0; k < 2; ++k) \
            acc[ai][bj][m][n] = __builtin_amdgcn_mfma_f32_16x16x32_bf16(Bt[n][k], At[m][k], acc[ai][bj][m][n], 0, 0, 0); } \
        __builtin_amdgcn_s_setprio(0); } while (0)
#define PG8_WAIT_V(n) asm volatile("s_waitcnt vmcnt(" #n ")" ::: "memory")
#define PG8_WAIT_L(n) asm volatile("s_waitcnt lgkmcnt(" #n ")" ::: "memory")
#define PG8_BAR __builtin_amdgcn_s_barrier()
#define PG8_SCHED __builtin_amdgcn_sched_barrier(0)
    GUnit cur, nxt; int ui = 0;
    if (!S.next(0, cur)) return;
    f32x4 acc[2][2][4][2];
#pragma unroll
    for (int a = 0; a < 2; ++a)
#pragma unroll
        for (int b = 0; b < 2; ++b)
#pragma unroll
            for (int m = 0; m < 4; ++m)
#pragma unroll
                for (int n = 0; n < 2; ++n) acc[a][b][m][n] = (f32x4){0.f, 0.f, 0.f, 0.f};
    bf16x8 At[4][2], B0[2][2], B1[2][2]; v8i_t At8[4], B08[2], B18[2];
    const int sc8 = 0x7f7f7f7f;
    const char* cA = cur.A; const char* cB = cur.B;
    unsigned vA0[2], vA1[2], vN0[2], vN1[2];
    if constexpr (GATHER) {
#pragma unroll
        for (int i = 0; i < 2; ++i) { vA0[i] = (unsigned)S.arow(cur, RA[i]) * lda + CA2[i]; vA1[i] = (unsigned)S.arow(cur, HALF + RA[i]) * lda + CA2[i]; }
        asm volatile("" : "+v"(vA0[0]), "+v"(vA0[1]), "+v"(vA1[0]), "+v"(vA1[1]));
    } else {
#pragma unroll
        for (int i = 0; i < 2; ++i) { vA0[i] = voffA[i]; vA1[i] = voffA[i]; }
    }
    PG8_STAGE(PG8_SB(0, 0), cB, voffB); PG8_STAGE(PG8_SB(0, 1), cB + hB, voffB); PG8_STAGE(PG8_SA(0, 0), cA, vA0); PG8_STAGE(PG8_SA(0, 1), cA + hA, vA1);
    if (wr == 1) PG8_BAR;
    PG8_WAIT_V(2); PG8_BAR;
    PG8_STAGE(PG8_SB(1, 0), cB + kstep, voffB); PG8_STAGE(PG8_SA(1, 0), cA + kstep, vA0); PG8_STAGE(PG8_SB(1, 1), cB + hB + kstep, voffB);
    PG8_WAIT_V(6); PG8_BAR;
    for (;;) {
        const bool has_next = S.next(ui + 1, nxt);
        const char* nA = has_next ? nxt.A : cA; const char* nB = has_next ? nxt.B : cB;
        if constexpr (GATHER) {
            if (has_next) {
#pragma unroll
                for (int i = 0; i < 2; ++i) { vN0[i] = (unsigned)S.arow(nxt, RA[i]) * lda + CA2[i]; vN1[i] = (unsigned)S.arow(nxt, HALF + RA[i]) * lda + CA2[i]; }
            } else {
#pragma unroll
                for (int i = 0; i < 2; ++i) { vN0[i] = vA0[i]; vN1[i] = vA1[i]; }
            }
            asm volatile("" : "+v"(vN0[0]), "+v"(vN0[1]), "+v"(vN1[0]), "+v"(vN1[1]));
        }
        for (int t = 0; t < nt; t += 2) {
            const bool last = (t == nt - 2);
            const char* a1 = cA + (size_t)(t + 1) * kstep;
            const char* a2 = last ? nA : cA + (size_t)(t + 2) * kstep; const char* b2 = last ? nB : cB + (size_t)(t + 2) * kstep;
            const char* a3 = a2 + kstep; const char* b3 = b2 + kstep;
            unsigned w0[2], w1[2];
            if constexpr (GATHER) {
#pragma unroll
                for (int i = 0; i < 2; ++i) { w0[i] = last ? vN0[i] : vA0[i]; w1[i] = last ? vN1[i] : vA1[i]; }
            } else {
#pragma unroll
                for (int i = 0; i < 2; ++i) { w0[i] = voffA[i]; w1[i] = voffA[i]; }
            }
            PG8_LDB(B0, 0, 0); PG8_LDB(B1, 0, 1); PG8_SCHED; PG8_LDA(At, 0, 0); PG8_STAGE(PG8_SA(1, 1), a1 + hA, vA1);
            PG8_WAIT_V(8); PG8_WAIT_L(0); PG8_BAR; PG8_MMA(0, 0, At, B0); PG8_MMA(0, 1, At, B1); PG8_BAR; PG8_SCHED;
            PG8_LDA(At, 0, 1); PG8_STAGE(PG8_SB(0, 0), b2, voffB); PG8_STAGE(PG8_SB(0, 1), b2 + hB, voffB); PG8_STAGE(PG8_SA(0, 0), a2, w0);
            PG8_WAIT_V(8); PG8_WAIT_L(0); PG8_BAR; PG8_MMA(1, 0, At, B0); PG8_MMA(1, 1, At, B1); PG8_BAR; PG8_SCHED;
            PG8_LDB(B0, 1, 0); PG8_LDB(B1, 1, 1); PG8_SCHED; PG8_LDA(At, 1, 0); PG8_STAGE(PG8_SA(0, 1), a2 + hA, w1);
            PG8_WAIT_V(8); PG8_WAIT_L(0); PG8_BAR; PG8_MMA(0, 0, At, B0); PG8_MMA(0, 1, At, B1); PG8_BAR; PG8_SCHED;
            PG8_LDA(At, 1, 1); PG8_STAGE(PG8_SB(1, 0), b3, voffB); PG8_STAGE(PG8_SB(1, 1), b3 + hB, voffB); PG8_STAGE(PG8_SA(1, 0), a3, w0);
            PG8_WAIT_V(8); PG8_WAIT_L(0); PG8_BAR; PG8_MMA(1, 0, At, B0); PG8_MMA(1, 1, At, B1); PG8_BAR; PG8_SCHED;
        }
        if (wr == 0) PG8_BAR;
        E(acc, cur, wr, wc, fr, fq);
        if (!has_next) break;
        if (!cur.keep) {
#pragma unroll
            for (int a = 0; a < 2; ++a)
#pragma unroll
                for (int b = 0; b < 2; ++b)
#pragma unroll
                    for (int m = 0; m < 4; ++m)
#pragma unroll
                        for (int n = 0; n < 2; ++n) acc[a][b][m][n] = (f32x4){0.f, 0.f, 0.f, 0.f};
        }
        cur = nxt; cA = nA; cB = nB; ++ui;
        if constexpr (GATHER) {
#pragma unroll
            for (int i = 0; i < 2; ++i) { vA0[i] = vN0[i]; vA1[i] = vN1[i]; }
        }
        if (wr == 1) PG8_BAR;
    }
    PG8_WAIT_V(0);
    PG8_BAR;
#undef PG8_SA
#undef PG8_SB
#undef PG8_STAGE
#undef PG8_LDA
#undef PG8_LDB
#undef PG8_MMA
#undef PG8_LD8
#undef PG8_SBR
#undef PG8_WAIT_V
#undef PG8_WAIT_L
#undef PG8_BAR
#undef PG8_SCHED
}

struct TileOrder {
    int nM, nN, nwg, G, c;
    __device__ void init(int nM_, int nN_, int G_, int c_) { nM = nM_; nN = nN_; nwg = nM * nN; G = G_; c = c_; }
    __device__ bool tile(int i, int& pm, int& pn) const { return tileL((long)i * G + c, pm, pn); }
    __device__ bool tileL(long L, int& pm, int& pn) const {
        if (L < 0 || L >= nwg) return false;
        int wgid = (int)L; { const int q = nwg / 8, r = nwg % 8, xcd = wgid % 8, off = wgid / 8; wgid = (xcd < r ? xcd * (q + 1) : r * (q + 1) + (xcd - r) * q) + off; }
        const int nig = 4 * nN, gid = wgid / nig, fm = gid * 4, gsz = (nM - fm) < 4 ? (nM - fm) : 4;
        pm = fm + ((wgid % nig) % gsz); pn = (wgid % nig) / gsz; return true;
    }
};
constexpr int P1_CO = 2, P1_NC = P1_CO * 32, P1_NG = 256 - P1_NC, P1_UG = 12, P1_UC = 0, P1_NBF = 20, P1_NF8 = 16;
static_assert(P1_NG * P1_UG + P1_NC * P1_UC == (NTOK / 256) * (NPROJ / 256) && (P1_NBF + P1_NF8) * 256 == NPROJ, "P1 unit deal");
struct ProjSched {
    TileOrder T; const char* A; const char* B; unsigned lda, ldb; int conv, idx;
    __device__ bool next(int i, GUnit& u) const { const long L = conv ? -1 : (long)i * P1_NG + idx; int pm, pn; if (!T.tileL(L, pm, pn)) return false;
        u.pm = pm; u.pn = pn; u.e = 0; u.keep = 0; u.A = A + (size_t)pm * 256 * lda; u.B = B + (size_t)pn * 256 * ldb; return true; }
    __device__ int arow(const GUnit&, int) const { return 0; }
};
struct PlainSched {
    TileOrder T; const char* A; const char* B; unsigned lda, ldb;
    __device__ bool next(int i, GUnit& u) const { int pm, pn; if (!T.tile(i, pm, pn)) return false; u.pm = pm; u.pn = pn; u.e = 0; u.keep = 0;
        u.A = A + (size_t)pm * 256 * lda; u.B = B + (size_t)pn * 256 * ldb; return true; }
    __device__ int arow(const GUnit&, int) const { return 0; }
};

struct EpiProj {
    static constexpr bool PERM = true;
    unsigned char* ws; int pn0; float gsc;
    __device__ __forceinline__ void operator()(f32x4 (&acc)[2][2][4][2], const GUnit& u, int wr, int wc, int fr, int fq) const {
        const int row0 = u.pm * BM + wr * 64 + fr, pn = u.pn + pn0;
        if (pn < 12) {
            static_assert(WS_K - WS_Q == WS_V - WS_K, "q|k|v spacing"); bf16* base = (bf16*)(ws + WS_Q + (size_t)(pn >> 2) * (WS_K - WS_Q)); const int col0 = (pn & 3) * 256 + wc * 32 + 8 * fq;
            float nmax[2] = {0.f, 0.f};
#pragma unroll
            for (int ai = 0; ai < 2; ++ai)
#pragma unroll
                for (int m = 0; m < 4; ++m) { bf16* rowp = base + (size_t)(row0 + ai * HALF + m * 16) * FW + col0;
#pragma unroll
                    for (int bj = 0; bj < 2; ++bj) { const f32x4 v0 = acc[ai][bj][m][0], v1 = acc[ai][bj][m][1];
                        if (pn < 8) { float q2 = (v0[0] * v0[0] + v0[1] * v0[1]) + (v0[2] * v0[2] + v0[3] * v0[3]) + (v1[0] * v1[0] + v1[1] * v1[1]) + (v1[2] * v1[2] + v1[3] * v1[3]);
                            q2 += __shfl_xor(q2, 16); q2 += __shfl_xor(q2, 32); nmax[bj] = fmaxf(nmax[bj], q2); }
                        u32x4 w; w.x = cvt_pk_bf16(v0[0], v0[1]); w.y = cvt_pk_bf16(v0[2], v0[3]); w.z = cvt_pk_bf16(v1[0], v1[1]); w.w = cvt_pk_bf16(v1[2], v1[3]);
                        *(u32x4*)(rowp + bj * HALF) = w; } }
            if (pn < 8) {
#pragma unroll
                for (int bj = 0; bj < 2; ++bj) { float v = nmax[bj]; v = fmaxf(v, __shfl_xor(v, 1)); v = fmaxf(v, __shfl_xor(v, 2)); v = fmaxf(v, __shfl_xor(v, 4)); v = fmaxf(v, __shfl_xor(v, 8));
                    if (fr == 0 && fq == 0) atomicMax((unsigned*)(ws + WS_CTL) + CW_NRM + (((pn >> 2) * 4 + (u.pm >> 4)) * 8 + (pn & 3) * 2 + bj) * 4 + wc, __float_as_uint(v)); }
            }
        } else if (pn < 20) {
            const bool isv = pn >= 16; bf16* base = (bf16*)(ws + WS_ZU + (size_t)(isv ? 1 : 0) * (WS_ZV - WS_ZU)); float* ZST = (float*)(ws + WS_ZST); const int col0 = ((pn - 12) & 3) * 256 + wc * 32 + 8 * fq;
#pragma unroll
            for (int ai = 0; ai < 2; ++ai)
#pragma unroll
                for (int m = 0; m < 4; ++m) { const int row = row0 + ai * HALF + m * 16; bf16* rowp = base + (size_t)row * SGW + col0; float s = 0.f, q = 0.f;
#pragma unroll
                    for (int bj = 0; bj < 2; ++bj) { f32x4 v0 = acc[ai][bj][m][0], v1 = acc[ai][bj][m][1];
                        { const f32x2 a = gelu_tanh2((f32x2){v0[0], v0[1]}), b = gelu_tanh2((f32x2){v0[2], v0[3]}), c = gelu_tanh2((f32x2){v1[0], v1[1]}), d = gelu_tanh2((f32x2){v1[2], v1[3]});
                          v0 = (f32x4){a.x, a.y, b.x, b.y}; v1 = (f32x4){c.x, c.y, d.x, d.y};
                          if (isv) { const f32x2 s2 = (a + b) + (c + d), q2 = (a * a + b * b) + (c * c + d * d); s += s2.x + s2.y; q += q2.x + q2.y; } }
                        u32x4 w; w.x = cvt_pk_bf16(v0[0], v0[1]); w.y = cvt_pk_bf16(v0[2], v0[3]); w.z = cvt_pk_bf16(v1[0], v1[1]); w.w = cvt_pk_bf16(v1[2], v1[3]);
                        *(u32x4*)(rowp + bj * HALF) = w; }
                    if (isv) { s += __shfl_xor(s, 16); s += __shfl_xor(s, 32); q += __shfl_xor(q, 16); q += __shfl_xor(q, 32);
                        if (fq == 0) *(f32x2*)(ZST + (size_t)row * 32 + ((pn - 16) * 4 + wc) * 2) = (f32x2){s, q}; } }
        } else {
            const int col0 = (pn - 20) * 128 + wc * 32 + 8 * fq; bf16* GR = (bf16*)(ws + WS_GR); bf16* GS = (bf16*)(ws + WS_GS);
#pragma unroll
            for (int ai = 0; ai < 2; ++ai)
#pragma unroll
                for (int m = 0; m < 4; ++m) { const size_t off = (size_t)(row0 + ai * HALF + m * 16) * DM + col0; float r[8], sb[8];
#pragma unroll
                    for (int n = 0; n < 2; ++n)
#pragma unroll
                        for (int p = 0; p < 2; ++p) { const f32x2 ya = (f32x2){acc[ai][0][m][n][2 * p], acc[ai][0][m][n][2 * p + 1]} * gsc, yb = (f32x2){acc[ai][1][m][n][2 * p], acc[ai][1][m][n][2 * p + 1]} * gsc;
                            f32x2 ea, eb; ea.x = __builtin_amdgcn_exp2f(ya.x); ea.y = __builtin_amdgcn_exp2f(ya.y); eb.x = __builtin_amdgcn_exp2f(yb.x); eb.y = __builtin_amdgcn_exp2f(yb.y);
                            const f32x2 da = ea + 1.0f, db = eb + 1.0f; f32x2 ra, rb; ra.x = __builtin_amdgcn_rcpf(da.x); ra.y = __builtin_amdgcn_rcpf(da.y); rb.x = __builtin_amdgcn_rcpf(db.x); rb.y = __builtin_amdgcn_rcpf(db.y);
                            const f32x2 rr = db * ra; sb[n * 4 + 2 * p] = rb.x; sb[n * 4 + 2 * p + 1] = rb.y; r[n * 4 + 2 * p] = rr.x; r[n * 4 + 2 * p + 1] = rr.y; }
                    u32x4 w; w.x = cvt_pk_bf16(r[0], r[1]); w.y = cvt_pk_bf16(r[2], r[3]); w.z = cvt_pk_bf16(r[4], r[5]); w.w = cvt_pk_bf16(r[6], r[7]);
                    *(u32x4*)(GR + off) = w;
                    w.x = cvt_pk_bf16(sb[0], sb[1]); w.y = cvt_pk_bf16(sb[2], sb[3]); w.z = cvt_pk_bf16(sb[4], sb[5]); w.w = cvt_pk_bf16(sb[6], sb[7]);
                    *(u32x4*)(GS + off) = w; }
        }
    }
};
struct MergeSched {
    TileOrder T; const char* A; const char* B; unsigned lda, ldb;
    __device__ bool next(int i, GUnit& u) const { int pm, pn; if (!T.tile(i >> 1, pm, pn)) return false; const int half = i & 1; u.pm = pm; u.pn = pn; u.e = 0; u.keep = half ^ 1;
        u.A = A + (size_t)pm * 256 * lda + half * (FW * 2); u.B = B + (size_t)pn * 256 * ldb + half * (FW * 2); return true; }
    __device__ int arow(const GUnit&, int) const { return 0; }
};
struct EpiMerge {
    static constexpr bool PERM = true;
    unsigned char* ws;
    __device__ __forceinline__ void operator()(f32x4 (&acc)[2][2][4][2], const GUnit& u, int wr, int wc, int fr, int fq) const {
        const int row0 = u.pm * BM + wr * 64 + fr, col0 = u.pn * 256 + wc * 32 + 8 * fq;
        const bf16* G = (const bf16*)(ws + (u.keep ? WS_GR : WS_GS)); bf16* MG = (bf16*)(ws + WS_MG);
#pragma unroll
        for (int ai = 0; ai < 2; ++ai) {
            u32x4 gv[4][2];
#pragma unroll
            for (int m = 0; m < 4; ++m)
#pragma unroll
                for (int bj = 0; bj < 2; ++bj) gv[m][bj] = *(const u32x4*)(G + (size_t)(row0 + ai * HALF + m * 16) * DM + col0 + bj * HALF);
#pragma unroll
            for (int m = 0; m < 4; ++m) { const size_t off = (size_t)(row0 + ai * HALF + m * 16) * DM + col0;
#pragma unroll
                for (int bj = 0; bj < 2; ++bj) { const u32x4 g = gv[m][bj];
                    f32x4 v0 = acc[ai][bj][m][0], v1 = acc[ai][bj][m][1];
                    v0[0] *= __builtin_bit_cast(float, g.x << 16); v0[1] *= __builtin_bit_cast(float, g.x & 0xffff0000u); v0[2] *= __builtin_bit_cast(float, g.y << 16); v0[3] *= __builtin_bit_cast(float, g.y & 0xffff0000u);
                    v1[0] *= __builtin_bit_cast(float, g.z << 16); v1[1] *= __builtin_bit_cast(float, g.z & 0xffff0000u); v1[2] *= __builtin_bit_cast(float, g.w << 16); v1[3] *= __builtin_bit_cast(float, g.w & 0xffff0000u);
                    if (u.keep) { acc[ai][bj][m][0] = v0; acc[ai][bj][m][1] = v1; }
                    else { u32x4 w; w.x = cvt_pk_bf16(v0[0], v0[1]); w.y = cvt_pk_bf16(v0[2], v0[3]); w.z = cvt_pk_bf16(v1[0], v1[1]); w.w = cvt_pk_bf16(v1[2], v1[3]); *(u32x4*)(MG + off + bj * HALF) = w; } } } }
    }
};
template <bool RB, bool WF>
struct EpiResid {
    static constexpr bool PERM = true;
    const void* Xi; float* Xo; bf16* Xb; float* SS; unsigned char* Xq;
    __device__ __forceinline__ void operator()(f32x4 (&acc)[2][2][4][2], const GUnit& u, int wr, int wc, int fr, int fq) const {
        const int row0 = u.pm * BM + wr * 64 + fr, col0 = u.pn * 256 + wc * 32 + 8 * fq;
        typedef typename std::conditional<RB, u32x4, f32x4>::type rv_t;
        constexpr int NV = RB ? 1 : 2, GB = 4;
#pragma unroll
        for (int g0 = 0; g0 < 8; g0 += GB) {
            rv_t xr[GB][2][NV];
#pragma unroll
            for (int gg = 0; gg < GB; ++gg) { const int gi = g0 + gg; const size_t offl = (size_t)(row0 + (gi >> 2) * HALF + (gi & 3) * 16) * DM + col0;
#pragma unroll
                for (int bj = 0; bj < 2; ++bj) {
                    if constexpr (RB) xr[gg][bj][0] = *(const u32x4*)((const bf16*)Xi + offl + bj * HALF);
                    else { xr[gg][bj][0] = *(const f32x4*)((const float*)Xi + offl + bj * HALF); xr[gg][bj][NV - 1] = *(const f32x4*)((const float*)Xi + offl + bj * HALF + 4); } } }
#pragma unroll
            for (int gg = 0; gg < GB; ++gg) { const int gi = g0 + gg, ai = gi >> 2, m = gi & 3; const int row = row0 + ai * HALF + m * 16; const size_t off = (size_t)row * DM + col0; float q = 0.f;
#pragma unroll
                for (int bj = 0; bj < 2; ++bj) { const size_t o = off + bj * HALF; f32x4 r0, r1;
                    if constexpr (RB) { const u32x4 r = xr[gg][bj][0];
                        r0 = (f32x4){__builtin_bit_cast(float, r.x << 16), __builtin_bit_cast(float, r.x & 0xffff0000u), __builtin_bit_cast(float, r.y << 16), __builtin_bit_cast(float, r.y & 0xffff0000u)};
                        r1 = (f32x4){__builtin_bit_cast(float, r.z << 16), __builtin_bit_cast(float, r.z & 0xffff0000u), __builtin_bit_cast(float, r.w << 16), __builtin_bit_cast(float, r.w & 0xffff0000u)}; }
                    else { r0 = xr[gg][bj][0]; r1 = xr[gg][bj][NV - 1]; }
                    const f32x4 v0 = r0 + acc[ai][bj][m][0], v1 = r1 + acc[ai][bj][m][1];
                    if constexpr (WF) { *(f32x4*)(Xo + o) = v0; *(f32x4*)(Xo + o + 4) = v1; }
                    q += ((v0[0] * v0[0] + v0[1] * v0[1]) + (v0[2] * v0[2] + v0[3] * v0[3])) + ((v1[0] * v1[0] + v1[1] * v1[1]) + (v1[2] * v1[2] + v1[3] * v1[3]));
                    if (Xb) { u32x4 w; w.x = cvt_pk_bf16(v0[0], v0[1]); w.y = cvt_pk_bf16(v0[2], v0[3]); w.z = cvt_pk_bf16(v1[0], v1[1]); w.w = cvt_pk_bf16(v1[2], v1[3]); *(u32x4*)(Xb + o) = w; }
                    if (Xq) { u32x2 w8; w8.x = pk4_fp8(v0[0], v0[1], v0[2], v0[3]); w8.y = pk4_fp8(v1[0], v1[1], v1[2], v1[3]); *(u32x2*)(Xq + o) = w8; } }
                q += __shfl_xor(q, 16); q += __shfl_xor(q, 32);
                if (fq == 0) SS[(size_t)row * 32 + u.pn * 4 + wc] = q; }
        }
    }
};
struct QkvSched {
    const char* X1B; const char* WXQ; const char* HM; const char* WXKV; int c;
    __device__ bool next(int i, GUnit& u) const { if (i > 0 || c >= 144) return false; u.keep = 0;
        if (c < 128) { u.e = 0; u.pm = c >> 1; u.pn = c & 1; u.A = X1B + (size_t)u.pm * 256 * (DM * 2); u.B = WXQ + (size_t)u.pn * 256 * (DM * 2); }
        else { const int j = c - 128; u.e = 1; u.pm = j >> 2; u.pn = j & 3; u.A = HM + (size_t)u.pm * 256 * (DM * 2); u.B = WXKV + (size_t)u.pn * 256 * (DM * 2); }
        return true; }
    __device__ int arow(const GUnit&, int) const { return 0; }
};
struct EpiQkv {
    static constexpr bool PERM = true;
    unsigned char* ws;
    __device__ __forceinline__ void operator()(f32x4 (&acc)[2][2][4][2], const GUnit& u, int wr, int wc, int fr, int fq) const {
        const int row0 = u.pm * BM + wr * 64 + fr; const float* SS = (const float*)(ws + WS_SS1);
        bf16* base = u.e ? (bf16*)(ws + WS_KX + (size_t)(u.pn >> 1) * (WS_VX - WS_KX)) + (u.pn & 1) * 256 : (bf16*)(ws + WS_QX) + u.pn * 256;
        float rsv[8];
#pragma unroll
        for (int gi = 0; gi < 8; ++gi) rsv[gi] = 1.f;
        if (!u.e) { f32x4 pp[8][2];
#pragma unroll
            for (int gi = 0; gi < 8; ++gi) { const int row = row0 + (gi >> 2) * HALF + (gi & 3) * 16; pp[gi][0] = *(const f32x4*)(SS + (size_t)row * 32 + fq * 8); pp[gi][1] = *(const f32x4*)(SS + (size_t)row * 32 + fq * 8 + 4); }
#pragma unroll
            for (int gi = 0; gi < 8; ++gi) { const f32x4 p0 = pp[gi][0], p1 = pp[gi][1];
                float q = ((p0[0] + p0[1]) + (p0[2] + p0[3])) + ((p1[0] + p1[1]) + (p1[2] + p1[3])); q += __shfl_xor(q, 16); q += __shfl_xor(q, 32); rsv[gi] = rsqrtf(q * (1.f / DM) + RMS_EPS); } }
#pragma unroll
        for (int ai = 0; ai < 2; ++ai)
#pragma unroll
            for (int m = 0; m < 4; ++m) { const int row = row0 + ai * HALF + m * 16; const float rs = rsv[ai * 4 + m];
                bf16* rowp = base + (size_t)row * XW + wc * 32 + 8 * fq;
#pragma unroll
                for (int bj = 0; bj < 2; ++bj) { const f32x4 v0 = acc[ai][bj][m][0] * rs, v1 = acc[ai][bj][m][1] * rs;
                    u32x4 w; w.x = cvt_pk_bf16(v0[0], v0[1]); w.y = cvt_pk_bf16(v0[2], v0[3]); w.z = cvt_pk_bf16(v1[0], v1[1]); w.w = cvt_pk_bf16(v1[2], v1[3]);
                    *(u32x4*)(rowp + bj * HALF) = w; } }
    }
};
struct MoeSched {
    const LAS int* tab; const char* A; const char* B; const int* TOKL; int G, c, npn; unsigned ldb; size_t erows;
    __device__ bool next(int i, GUnit& u) const {
        const int x = c & 7, j = c >> 3; const int T = npn == 16 ? i * 16 + 4 * (x >> 1) + (j & 3) : i * 32 + 4 * x + (j & 3); const int pnl = npn == 16 ? 8 * (x & 1) + (j >> 2) : (j >> 2);
        if (T >= tab[32]) return false;
        int e = 0;
#pragma unroll 1
        for (int j = 1; j < 32; ++j) e += (tab[j] <= T) ? 1 : 0;
        u.e = e; u.pm = T; u.pn = pnl; u.keep = 0; u.A = A; u.B = B + ((size_t)e * erows + (size_t)u.pn * 256) * ldb; return true; }
    __device__ int arow(const GUnit& u, int r) const { const int rank = (u.pm - tab[u.e]) * 256 + r; return rank < tab[40 + u.e] ? TOKL[(size_t)u.e * NTOK + rank] : 0; }
};
struct DownSched : MoeSched {
    unsigned lda;
    __device__ bool next(int i, GUnit& u) const { if (!MoeSched::next(i, u)) return false; u.A = A + (size_t)u.pm * 256 * lda; return true; }
};
struct EpiAct {
    static constexpr bool PERM = true;
    unsigned char* ws; const LAS int* tab; const float* bgu;
    __device__ __forceinline__ void operator()(f32x4 (&acc)[2][2][4][2], const GUnit& u, int wr, int wc, int fr, int fq) const {
        const int r0 = wr * 64 + fr, j0 = u.pn * 128 + wc * 32 + 8 * fq, rbase = (u.pm - tab[u.e]) * 256, cnt = tab[40 + u.e];
        const int* TOKL = (const int*)(ws + WS_TOKL) + (size_t)u.e * NTOK; const float* RS2 = (const float*)(ws + WS_RS2); unsigned char* HB = ws + WS_HB;
        const float* bg = bgu + (size_t)u.e * 2 * DFF + j0;
        const f32x4 bg0 = *(const f32x4*)bg, bg1 = *(const f32x4*)(bg + 4), bu0 = *(const f32x4*)(bg + DFF), bu1 = *(const f32x4*)(bg + DFF + 4);
        float rsv[8]; const float* RSL = (const float*)(ws + WS_RSL) + (size_t)u.e * NTOK;
#pragma unroll
        for (int gi = 0; gi < 8; ++gi) { const int rank = rbase + r0 + (gi >> 2) * HALF + (gi & 3) * 16; rsv[gi] = rank < cnt ? RSL[rank] : 0.f; }
#pragma unroll
        for (int ai = 0; ai < 2; ++ai)
#pragma unroll
            for (int m = 0; m < 4; ++m) { const int r = r0 + ai * HALF + m * 16; const float rs = rsv[ai * 4 + m] * W8_INV;
                float a[8];
#pragma unroll
                for (int n = 0; n < 2; ++n)
#pragma unroll
                    for (int p = 0; p < 2; ++p) { const f32x2 rs2 = (f32x2){rs, rs};
                        const f32x2 bg2 = n ? (f32x2){bg1[2 * p], bg1[2 * p + 1]} : (f32x2){bg0[2 * p], bg0[2 * p + 1]}, bu2 = n ? (f32x2){bu1[2 * p], bu1[2 * p + 1]} : (f32x2){bu0[2 * p], bu0[2 * p + 1]};
                        f32x2 g2 = (f32x2){acc[ai][0][m][n][2 * p], acc[ai][0][m][n][2 * p + 1]} * rs2 + bg2, u2 = (f32x2){acc[ai][1][m][n][2 * p], acc[ai][1][m][n][2 * p + 1]} * rs2 + bu2;
                        g2.x = fminf(g2.x, SW_LIMIT); g2.y = fminf(g2.y, SW_LIMIT); u2.x = __builtin_amdgcn_fmed3f(u2.x, -SW_LIMIT, SW_LIMIT); u2.y = __builtin_amdgcn_fmed3f(u2.y, -SW_LIMIT, SW_LIMIT);
                        const f32x2 y2 = g2 * (-1.4426950408889634f * SW_ALPHA); f32x2 e2; e2.x = __builtin_amdgcn_exp2f(y2.x); e2.y = __builtin_amdgcn_exp2f(y2.y);
                        const f32x2 d2 = e2 + 1.0f; f32x2 r2; r2.x = __builtin_amdgcn_rcpf(d2.x); r2.y = __builtin_amdgcn_rcpf(d2.y);
                        const f32x2 o2 = ((u2 + 1.0f) * g2) * r2; a[n * 4 + 2 * p] = o2.x; a[n * 4 + 2 * p + 1] = o2.y; }
                u32x2 w; w.x = pk4_fp8_nc(a[0], a[1], a[2], a[3]); w.y = pk4_fp8_nc(a[4], a[5], a[6], a[7]);
                *(u32x2*)(HB + (size_t)(u.pm * 256 + r) * DFF + j0) = w; }
    }
};
struct EpiDown {
    static constexpr bool PERM = true;
    unsigned char* ws; const LAS int* tab; const float* bd;
    __device__ __forceinline__ void operator()(f32x4 (&acc)[2][2][4][2], const GUnit& u, int wr, int wc, int fr, int fq) const {
        const int r0 = wr * 64 + fr, c0 = u.pn * 256 + wc * 32 + 8 * fq, rbase = (u.pm - tab[u.e]) * 256;
        const float* GWL = (const float*)(ws + WS_GWL) + (size_t)u.e * NTOK; unsigned char* YB = ws + WS_YB;
        const float* b = bd + (size_t)u.e * DM + c0;
        f32x4 bv[2][2];
#pragma unroll
        for (int bj = 0; bj < 2; ++bj) { bv[bj][0] = *(const f32x4*)(b + bj * HALF); bv[bj][1] = *(const f32x4*)(b + bj * HALF + 4); }
        float gwv[8];
#pragma unroll
        for (int gi = 0; gi < 8; ++gi) gwv[gi] = GWL[rbase + r0 + (gi >> 2) * HALF + (gi & 3) * 16];
#pragma unroll
        for (int ai = 0; ai < 2; ++ai)
#pragma unroll
            for (int m = 0; m < 4; ++m) { const int r = r0 + ai * HALF + m * 16; const float gw = gwv[ai * 4 + m];
#pragma unroll
                for (int bj = 0; bj < 2; ++bj) { const f32x4 v0 = (acc[ai][bj][m][0] * W8_INV + bv[bj][0]) * gw, v1 = (acc[ai][bj][m][1] * W8_INV + bv[bj][1]) * gw;
                    u32x2 w; w.x = pk4_fp8(v0[0], v0[1], v0[2], v0[3]); w.y = pk4_fp8(v1[0], v1[1], v1[2], v1[3]);
                    *(u32x2*)(YB + (size_t)(u.pm * 256 + r) * DM + c0 + bj * HALF) = w; } }
    }
};
}

struct KArgs { const float* in[25]; float* out; unsigned char* ws; int ph_lo, ph_hi, li, pad; };
struct Frame {
    LAS unsigned char* lds; volatile LAS unsigned* MISC; unsigned* ctl; unsigned char* ws;
    int tid, lane, wave, G, gw, NGW;
};

struct CvtDesc { const float* W; const float* g; bf16* dst0; size_t ldw, dld; int srccol, k0src, k0dst, f8; };
__device__ __forceinline__ void cvt_load(const CvtDesc& d, float (&v)[64], float& gv, int lane) {
    const float* rowp = d.W + (size_t)d.k0src * d.ldw;
    const unsigned col = (unsigned)d.srccol;
#pragma unroll
    for (int i = 0; i < 64; ++i) { v[i] = rowp[col]; rowp += d.ldw; }
    const float* gp = d.g ? d.g : d.W;
    const float gl = gp[d.k0src + lane]; gv = d.g ? gl : 1.f;
}
__device__ __forceinline__ void cvt_store(const CvtDesc& d, float (&v)[64], float gv, LAS unsigned char* tile, int lane) {
    if (d.f8) gv *= W8_SCALE;
#pragma unroll
    for (int i = 0; i < 64; ++i) v[i] *= __builtin_bit_cast(float, __builtin_amdgcn_readlane(__builtin_bit_cast(int, gv), i));
    if (d.f8) {
#pragma unroll
        for (int j = 0; j < 4; ++j) { u32x4 w; w.x = pk4_fp8(v[16 * j], v[16 * j + 1], v[16 * j + 2], v[16 * j + 3]); w.y = pk4_fp8(v[16 * j + 4], v[16 * j + 5], v[16 * j + 6], v[16 * j + 7]);
            w.z = pk4_fp8(v[16 * j + 8], v[16 * j + 9], v[16 * j + 10], v[16 * j + 11]); w.w = pk4_fp8(v[16 * j + 12], v[16 * j + 13], v[16 * j + 14], v[16 * j + 15]);
            *(LAS u32x4*)(tile + lane * 80 + j * 16) = w; }
        asm volatile("s_waitcnt lgkmcnt(0)" ::: "memory");
#pragma unroll
        for (int j = 0; j < 4; ++j) { const int r = 16 * j + (lane >> 2), c = lane & 3; const u32x4 w = *(const LAS u32x4*)(tile + r * 80 + c * 16);
            *(u32x4*)((unsigned char*)d.dst0 + (size_t)r * d.dld + d.k0dst + 16 * c) = w; }
        asm volatile("s_waitcnt lgkmcnt(0)" ::: "memory");
        return;
    }
#pragma unroll
    for (int j = 0; j < 8; ++j) { u32x4 w; w.x = cvt_pk_bf16(v[8 * j], v[8 * j + 1]); w.y = cvt_pk_bf16(v[8 * j + 2], v[8 * j + 3]); w.z = cvt_pk_bf16(v[8 * j + 4], v[8 * j + 5]); w.w = cvt_pk_bf16(v[8 * j + 6], v[8 * j + 7]);
        *(LAS u32x4*)(tile + lane * 144 + j * 16) = w; }
    asm volatile("s_waitcnt lgkmcnt(0)" ::: "memory");
#pragma unroll
    for (int j = 0; j < 8; ++j) { const int r = 8 * j + (lane >> 3), c = lane & 7; const u32x4 w = *(const LAS u32x4*)(tile + r * 144 + c * 16);
        *(u32x4*)(d.dst0 + (size_t)r * d.dld + d.k0dst + 8 * c) = w; }
    asm volatile("s_waitcnt lgkmcnt(0)" ::: "memory");
}
__device__ __forceinline__ int wp_srccol(int d) {
    if (d < 3072) return d;
    if (d < 5120) return d + 8;
    const int t = d - 5120, tile = t >> 8, r = t & 255, j = tile * 128 + (r & 127);
    return (r < 128 ? C_GA : C_GB) + j;
}
struct Cvt8Desc { const float* W; const float* g; unsigned char* dst; size_t ldw; int k0, col0a, col0b; };
__device__ __forceinline__ void cvt8_load(const Cvt8Desc& d, f32x4 (&v)[16], float& gv, int wave, int lane) {
    const float* rowp = d.W + (size_t)(d.k0 + 8 * wave) * d.ldw;
#pragma unroll
    for (int i = 0; i < 8; ++i) { v[2 * i] = __builtin_nontemporal_load((const f32x4*)(rowp + d.col0a)); v[2 * i + 1] = __builtin_nontemporal_load((const f32x4*)(rowp + d.col0b)); rowp += d.ldw; }
    const float* gp = d.g ? d.g : d.W; const float gl = gp[d.k0 + 8 * wave + (lane & 7)]; gv = d.g ? gl * W8_SCALE : W8_SCALE;
}
__device__ __forceinline__ void cvt8_pack(f32x4 (&v)[16], float gv, LAS unsigned char* lds, int sub, int wave, int lane) {
    float gs[8];
#pragma unroll
    for (int i = 0; i < 8; ++i) gs[i] = __builtin_bit_cast(float, __builtin_amdgcn_readlane(__builtin_bit_cast(int, gv), i));
#pragma unroll
    for (int hf = 0; hf < 2; ++hf) { u32x4 w[2];
#pragma unroll
        for (int j = 0; j < 4; ++j) { const unsigned lo = pk4_fp8(v[0 + hf][j] * gs[0], v[2 + hf][j] * gs[1], v[4 + hf][j] * gs[2], v[6 + hf][j] * gs[3]), hi = pk4_fp8(v[8 + hf][j] * gs[4], v[10 + hf][j] * gs[5], v[12 + hf][j] * gs[6], v[14 + hf][j] * gs[7]);
            if (j & 1) { w[j >> 1].z = lo; w[j >> 1].w = hi; } else { w[j >> 1].x = lo; w[j >> 1].y = hi; } }
        const int sw = 8 * sub + 2 * (wave >> 1);
        LAS unsigned char* p = lds + sub * 32768 + wave * 4096 + ((hf * 256 + 4 * lane) ^ (sw & 28)) * 8;
        *(LAS u32x4*)(p + 8 * (sw & 2)) = w[0]; *(LAS u32x4*)(p + 16 - 8 * (sw & 2)) = w[1]; }
}
__device__ __forceinline__ void cvt8_flush(unsigned char* dst, LAS unsigned char* lds, int tid) {
    asm volatile("s_waitcnt lgkmcnt(0)\n\ts_barrier" ::: "memory");
#pragma unroll 4
    for (int ps = 0; ps < 16; ++ps) { const int r = ps * 32 + (tid >> 4), p = tid & 15, j = p >> 2, pc = p & 3;
        const int rs = (r ^ (8 * j + 2 * pc)) * 8;
        const u32x2 a0 = *(const LAS u32x2*)(lds + j * 32768 + (2 * pc) * 4096 + rs), a1 = *(const LAS u32x2*)(lds + j * 32768 + (2 * pc + 1) * 4096 + rs);
        __builtin_nontemporal_store((u32x4){a0.x, a0.y, a1.x, a1.y}, (u32x4*)(dst + (size_t)r * DM + 16 * p)); }
    asm volatile("s_waitcnt lgkmcnt(0)\n\ts_barrier" ::: "memory");
}
constexpr int CVT8_SUPER = NE * 8 * 8 + NE * 8 * 4, CVT8_P1_SUPER = 1792;
__device__ __forceinline__ void cvt8_phase(const Frame& F, const KArgs& a, const int bit, const int nb, const int s_lo, const int s_hi) {
    unsigned char* ws = F.ws; const int lane = F.lane, wave = F.wave, tid = F.tid;
    constexpr int S_WGU = NE * 8 * 8;
    auto decode = [&](int s, int j) -> Cvt8Desc {
        Cvt8Desc D;
        if (s < S_WGU) { const int e = s / 64, rr = s % 64, kb4 = rr / 8, cb = rr % 8, kb = kb4 * 4 + j;
            const int da = 4 * lane, db = 256 + 4 * lane;
            D.W = a.in[20] + (size_t)e * DM * 2 * DFF; D.g = a.in[17]; D.ldw = 2 * DFF; D.k0 = kb * 64;
            D.col0a = ((da & 255) < 128 ? 0 : DFF) + (cb * 2 + (da >> 8)) * 128 + (da & 127); D.col0b = ((db & 255) < 128 ? 0 : DFF) + (cb * 2 + (db >> 8)) * 128 + (db & 127);
            D.dst = ws + WS_WGU + ((size_t)e * 2 * DFF + cb * 512) * DM + kb4 * 256; return D; }
        s -= S_WGU;
        { const int e = s / 32, rr = s % 32, kb4 = rr / 4, cb = rr % 4, kb = kb4 * 4 + j;
            D.W = a.in[22] + (size_t)e * DFF * DM; D.g = nullptr; D.ldw = DM; D.k0 = kb * 64; D.col0a = cb * 512 + 4 * lane; D.col0b = cb * 512 + 256 + 4 * lane;
            D.dst = ws + WS_WD + ((size_t)e * DM + cb * 512) * DFF + kb4 * 256; return D; }
    };
    f32x4 va[16], vb[16]; float ga = 1.f, gb = 1.f;
    int sidx = s_lo + bit;
    if (sidx < s_hi) { Cvt8Desc d0 = decode(sidx, 0); cvt8_load(d0, va, ga, wave, lane); }
    while (sidx < s_hi) {
        const int snext = sidx + nb; const bool more = snext < s_hi;
        { Cvt8Desc d1 = decode(sidx, 1); cvt8_load(d1, vb, gb, wave, lane); } cvt8_pack(va, ga, F.lds, 0, wave, lane);
        { Cvt8Desc d2 = decode(sidx, 2); cvt8_load(d2, va, ga, wave, lane); } cvt8_pack(vb, gb, F.lds, 1, wave, lane);
        { Cvt8Desc d3 = decode(sidx, 3); cvt8_load(d3, vb, gb, wave, lane); } cvt8_pack(va, ga, F.lds, 2, wave, lane);
        { Cvt8Desc dn = decode(more ? snext : sidx, 0); cvt8_load(dn, va, ga, wave, lane); } cvt8_pack(vb, gb, F.lds, 3, wave, lane);
        cvt8_flush(decode(sidx, 0).dst, F.lds, tid);
        sidx = snext;
    }
    asm volatile("s_waitcnt vmcnt(0)" ::: "memory"); __syncthreads();
}
template <int STAGE>
__device__ __forceinline__ void p0_prologue(const Frame& F, const KArgs& a, const int w0, const int nw) {
    unsigned char* ws = F.ws; const int lane = F.lane;
    constexpr int I_WP = (NPROJ / 64) * 32, I_WAB = 32 * 32, I_WO = 32 * 32, I_WXQ = 8 * 32, I_WXKV = 16 * 32, I_WXO = 32 * 8, I_WGU = NE * 64 * 32, I_WD = NE * 32 * 32;
    constexpr int NITEMS = I_WP + I_WAB + I_WO + I_WXQ + I_WXKV + I_WXO + I_WGU + I_WD;
    LAS float* wf = (LAS float*)F.lds;
    LAS unsigned char* tile = F.lds + F.wave * 9216;
    auto decode = [&](int it) -> CvtDesc {
        CvtDesc D; int r = it; D.g = nullptr; D.f8 = 0;
        if (r < I_WP) { const int kb = r / (NPROJ / 64), db = r % (NPROJ / 64), d = db * 64 + lane;
            D.W = a.in[3]; D.ldw = INC; D.srccol = wp_srccol(d); D.k0src = kb * 64; D.k0dst = kb * 64; D.dld = DM;
            if (db * 64 >= 5120) { D.f8 = 1; D.dst0 = (bf16*)(ws + WS_WPG + (size_t)(db * 64 - 5120) * DM); } else D.dst0 = (bf16*)(ws + WS_WP) + (size_t)db * 64 * DM;
            return D; } r -= I_WP;
        if (r < I_WAB) { const int kb = r / 32, db = r % 32, d = db * 64 + lane;
            D.W = kb < 16 ? a.in[9] : a.in[10]; D.ldw = DM; D.srccol = d; D.dst0 = (bf16*)(ws + WS_WAB) + (size_t)db * 64 * DM; D.dld = DM; D.k0src = (kb & 15) * 64; D.k0dst = kb * 64; return D; } r -= I_WAB;
        if (r < I_WO) { const int kb = r / 32, db = r % 32, d = db * 64 + lane;
            D.W = a.in[11]; D.ldw = DM; D.srccol = d; D.dst0 = (bf16*)(ws + WS_WO) + (size_t)db * 64 * DM; D.dld = DM; D.k0src = kb * 64; D.k0dst = kb * 64; return D; } r -= I_WO;
        if (r < I_WXQ) { const int kb = r / 8, db = r % 8, d = db * 64 + lane;
            D.W = a.in[14]; D.g = a.in[12]; D.ldw = XW; D.srccol = d; D.dst0 = (bf16*)(ws + WS_WXQ) + (size_t)db * 64 * DM; D.dld = DM; D.k0src = kb * 64; D.k0dst = kb * 64; return D; } r -= I_WXQ;
        if (r < I_WXKV) { const int kb = r / 16, db = r % 16, d = db * 64 + lane;
            D.W = a.in[15]; D.ldw = 2 * XW; D.srccol = d; D.dst0 = (bf16*)(ws + WS_WXKV) + (size_t)db * 64 * DM; D.dld = DM; D.k0src = kb * 64; D.k0dst = kb * 64; return D; } r -= I_WXKV;
        if (r < I_WXO) { const int kb = r / 32, db = r % 32, d = db * 64 + lane;
            D.W = a.in[16]; D.ldw = DM; D.srccol = d; D.dst0 = (bf16*)(ws + WS_WXO) + (size_t)db * 64 * XW; D.dld = XW; D.k0src = kb * 64; D.k0dst = kb * 64; return D; } r -= I_WXO;
        if (r < I_WGU) { const int e = r / (64 * 32), rr = r % (64 * 32), kb = rr / 64, db = rr % 64, d = db * 64 + lane;
            const int t256 = d >> 8, q = d & 255;
            D.W = a.in[20] + (size_t)e * DM * 2 * DFF; D.g = a.in[17]; D.ldw = 2 * DFF; D.srccol = (q < 128 ? 0 : DFF) + t256 * 128 + (q & 127); D.f8 = 1; D.dst0 = (bf16*)(ws + WS_WGU + ((size_t)e * 2 * DFF + db * 64) * DM); D.dld = DM; D.k0src = kb * 64; D.k0dst = kb * 64; return D; } r -= I_WGU;
        { const int e = r / (32 * 32), rr = r % (32 * 32), kb = rr / 32, db = rr % 32, d = db * 64 + lane;
            D.W = a.in[22] + (size_t)e * DFF * DM; D.ldw = DM; D.srccol = d; D.f8 = 1; D.dst0 = (bf16*)(ws + WS_WD + ((size_t)e * DM + db * 64) * DFF); D.dld = DFF; D.k0src = kb * 64; D.k0dst = kb * 64; return D; }
    };
    {
        float va[64], vb[64], ga = 1.f, gb = 1.f;
        constexpr int I_SMALL = I_WP + I_WAB + I_WO + I_WXQ + I_WXKV + I_WXO;
        const int IT_END = STAGE == 0 ? I_SMALL : NITEMS;
        int it = (STAGE == 0 ? 0 : I_SMALL) + w0;
        CvtDesc da = decode(it < IT_END ? it : 0), db_;
        cvt_load(da, va, ga, lane);
        while (it < IT_END) {
            const int it1 = it + nw, it2 = it + 2 * nw;
            db_ = decode(it1 < IT_END ? it1 : 0);
            cvt_load(db_, vb, gb, lane);
            cvt_store(da, va, ga, tile, lane);
            if (it1 >= IT_END) break;
            da = decode(it2 < IT_END ? it2 : 0);
            cvt_load(da, va, ga, lane);
            cvt_store(db_, vb, gb, tile, lane);
            it = it2;
        }
    }
    if constexpr (STAGE == 1) { asm volatile("s_waitcnt vmcnt(0)" ::: "memory"); __syncthreads(); return; }
    for (int i = F.gw * 64 + lane; i < DM * NE; i += F.NGW * 64) { const int k = i >> 5, e = i & 31; ((float*)(ws + WS_WRT))[(size_t)e * DM + k] = a.in[17][k] * a.in[18][i]; }
    __syncthreads();
    for (int i = F.tid; i < DM * 8; i += NTHREADS) wf[i] = a.in[3][(size_t)(i >> 3) * INC + C_F + (i & 7)];
    __syncthreads();
    for (int row = F.gw; row < NTOK + NMEM; row += F.NGW) {
        const bool ismem = row >= NTOK; const int r = ismem ? row - NTOK : row;
        const float* xr = (ismem ? a.in[1] : a.in[0]) + (size_t)r * DM; const float* g = ismem ? a.in[13] : a.in[2];
        bf16* orow = (bf16*)(ws + (ismem ? WS_HM : WS_H0)) + (size_t)r * DM;
        f32x4 v[8]; float s = 0.f;
#pragma unroll
        for (int j = 0; j < 8; ++j) { v[j] = ((const f32x4*)xr)[lane + 64 * j]; s += (v[j][0] * v[j][0] + v[j][1] * v[j][1]) + (v[j][2] * v[j][2] + v[j][3] * v[j][3]); }
        const float rstd = rsqrtf(wave_sum(s) * (1.f / DM) + RMS_EPS);
        float f[8];
#pragma unroll
        for (int j = 0; j < 8; ++j) f[j] = 0.f;
#pragma unroll
        for (int j = 0; j < 8; ++j) { const f32x4 gg = ((const f32x4*)g)[lane + 64 * j]; v[j] = v[j] * rstd * gg;
            u32x2 w; w.x = cvt_pk_bf16(v[j][0], v[j][1]); w.y = cvt_pk_bf16(v[j][2], v[j][3]); *(u32x2*)(orow + 4 * (lane + 64 * j)) = w;
            if (!ismem) { *(unsigned*)(ws + WS_H0Q + (size_t)r * DM + 4 * (lane + 64 * j)) = pk4_fp8(v[j][0], v[j][1], v[j][2], v[j][3]);
#pragma unroll
                for (int c = 0; c < 4; ++c) { const LAS f32x4* wk = (const LAS f32x4*)(wf + (4 * (lane + 64 * j) + c) * 8); const f32x4 w0 = wk[0], w1 = wk[1];
                    f[0] += v[j][c] * w0[0]; f[1] += v[j][c] * w0[1]; f[2] += v[j][c] * w0[2]; f[3] += v[j][c] * w0[3];
                    f[4] += v[j][c] * w1[0]; f[5] += v[j][c] * w1[1]; f[6] += v[j][c] * w1[2]; f[7] += v[j][c] * w1[3]; } } }
        if (!ismem) {
            float mine = 0.f;
#pragma unroll
            for (int j = 0; j < 8; ++j) { const float t = wave_sum(f[j]); if (lane == j) mine = t; }
            if (lane < 8) ((float*)(ws + WS_LOGF))[(size_t)r * 8 + lane] = log_sigmoid(mine + a.in[4][lane]);
        }
    }
}
__device__ __forceinline__ void cumsum_wave(const float* LOGF, float* CB, int bh, int lane) {
    const int b = bh / FH, h = bh % FH; float loc = 0.f;
    for (int i = 0; i < 64; ++i) loc += LOGF[(size_t)(b * SEQ + lane * 64 + i) * 8 + h];
    float inc = loc;
#pragma unroll
    for (int o = 1; o < 64; o <<= 1) { const float n = __shfl_up(inc, o); if (lane >= o) inc += n; }
    float run = inc - loc;
    for (int i = 0; i < 64; ++i) { run += LOGF[(size_t)(b * SEQ + lane * 64 + i) * 8 + h]; CB[(size_t)bh * SEQ + lane * 64 + i] = -run * 11.313708498984761f; }
}

namespace att {
constexpr int D = 128; constexpr float THR = 8.f; constexpr bool WSKIP = false;
constexpr float SCALE = 0.08838834764831845f;
constexpr int NW = 8, QBLK = 32, KVBLK = 64, QB = NW * QBLK;
constexpr int SHM_V = KVBLK * D * 2, SHM_K = KVBLK * D * 2;
constexpr int LDS_BYTES = 2 * SHM_V + 2 * SHM_K + NW * 64 * 4;
constexpr int BIAS_OFF = LDS_BYTES;

typedef short s16x4 __attribute__((ext_vector_type(4)));
typedef float f32x16 __attribute__((ext_vector_type(16)));
template <class A, class Bt> struct same_t { static constexpr bool v = false; };
template <class A> struct same_t<A, A> { static constexpr bool v = true; };

#define KSWZ(row, colB) ((row) * 256 + ((colB) ^ (((row) & 7) << 4)))
#define SBAR() __builtin_amdgcn_sched_barrier(0)
__device__ __forceinline__ int v_st(int k, int c) { const int kk = (k & ~0xC) | ((k & 4) << 1) | ((k & 8) >> 1); return ((kk >> 3) * 4 + (c >> 5)) * 512 + ((kk & 7) * 32 + (c & 31)) * 2; }
__device__ __forceinline__ int v_rd_base(int lane) { return ((lane & 3) << 3) | (((lane >> 2) & 3) << 6) | (((lane >> 4) & 1) << 5) | (((lane >> 5) & 1) << 8); }
constexpr int v_rd_off(int d0, int ks, int half) { return d0 * 512 + ks * 4096 + half * 2048; }
__device__ __forceinline__ int crow(int r, int hi) { return (r & 3) + 8 * (r >> 2) + 4 * hi; }
__device__ __forceinline__ unsigned cvtpk(float lo, float hi) {
    unsigned r; asm volatile("v_cvt_pk_bf16_f32 %0, %1, %2" : "=v"(r) : "v"(lo), "v"(hi)); return r;
}
__device__ __forceinline__ bf16x8 pack8(f32x4 a, f32x4 b) {
    u32x4 w = {cvtpk(a[0], a[1]), cvtpk(a[2], a[3]), cvtpk(b[0], b[1]), cvtpk(b[2], b[3])};
    return *reinterpret_cast<bf16x8*>(&w);
}
template <class T> __device__ __forceinline__ bf16x8 load8(const T* p) {
    if constexpr (same_t<T, float>::v) { return pack8(*(const f32x4*)p, *(const f32x4*)(p + 4)); }
    else { return *reinterpret_cast<const bf16x8*>(p); }
}
__device__ __forceinline__ void mask_tile(f32x16& p0, f32x16& p1, int dq, unsigned W) {
    const float NEG = -__builtin_inff();
#pragma unroll
    for (int r = 0; r < 16; ++r) {
        const int c = (r & 3) + 8 * (r >> 2);
        if ((unsigned)(dq - c) >= W) p0[r] = NEG;
        if ((unsigned)(dq - c - 32) >= W) p1[r] = NEG;
    }
}
__device__ __forceinline__ void partialSM(f32x16& p0, f32x16& p1, float& m_reg, float& mn, float& alpha) {
    float pmax = p0[0]; for (int r = 1; r < 16; ++r) pmax = fmaxf(pmax, p0[r]); for (int r = 0; r < 16; ++r) pmax = fmaxf(pmax, p1[r]);
    { auto rr = __builtin_amdgcn_permlane32_swap(__float_as_uint(pmax), __float_as_uint(pmax), false, false);
      pmax = fmaxf(__uint_as_float(rr[0]), __uint_as_float(rr[1])); }
    constexpr float C2 = 1.4426950408889634f * SCALE;
    if (__builtin_expect(__all((pmax - m_reg) * SCALE <= THR), 1)) { mn = m_reg; alpha = 1.f; }
    else { mn = fmaxf(m_reg, pmax); alpha = __builtin_amdgcn_exp2f((m_reg - mn) * C2); m_reg = mn; }
    const float mnL = -mn * C2;
    for (int r = 0; r < 16; ++r) p0[r] = fmaf(p0[r], C2, mnL); for (int r = 0; r < 16; ++r) p1[r] = fmaf(p1[r], C2, mnL);
    for (int r = 0; r < 16; ++r) p0[r] = __builtin_amdgcn_exp2f(p0[r]);
}
__device__ __forceinline__ void finishSM(f32x16& p0, f32x16& p1, float alpha, float& l_reg, bf16x8& pa0, bf16x8& pa1, bf16x8& pa2, bf16x8& pa3) {
    for (int r = 0; r < 16; ++r) p1[r] = __builtin_amdgcn_exp2f(p1[r]);
    float ps = 0; for (int r = 0; r < 16; ++r) ps += p0[r]; for (int r = 0; r < 16; ++r) ps += p1[r];
    { auto rr = __builtin_amdgcn_permlane32_swap(__float_as_uint(ps), __float_as_uint(ps), false, false);
      ps = __uint_as_float(rr[0]) + __uint_as_float(rr[1]); }
    l_reg = l_reg * alpha + ps;
#define PK4(P, B_, OUT) do { unsigned a0 = cvtpk(P[B_+0], P[B_+1]), a1 = cvtpk(P[B_+2], P[B_+3]);                          \
        unsigned b0 = cvtpk(P[B_+4], P[B_+5]), b1 = cvtpk(P[B_+6], P[B_+7]);                                             \
        auto r0 = __builtin_amdgcn_permlane32_swap(a0, b0, false, false); auto r1 = __builtin_amdgcn_permlane32_swap(a1, b1, false, false); \
        u32x4 w = {r0[0], r1[0], r0[1], r1[1]}; OUT = *reinterpret_cast<bf16x8*>(&w); } while (0)
    PK4(p0, 0, pa0); PK4(p0, 8, pa1); PK4(p1, 0, pa2); PK4(p1, 8, pa3);
#undef PK4
}
template <int KB, bool SK, bool BIAS>
__device__ __forceinline__ void qkt(f32x16& p0, f32x16& p1, const char* K_lds, int r32, int hi, const bf16x8* qr, bool act, const float* bl) {
    if (SK && !act) { const float NEG = -__builtin_inff();
#pragma unroll
        for (int r = 0; r < 16; ++r) { p0[r] = NEG; p1[r] = NEG; } return; }
    if constexpr (BIAS) {
#pragma unroll
        for (int g_ = 0; g_ < 4; ++g_) { const f32x4 t0 = *(const f32x4*)(bl + 8 * g_), t1 = *(const f32x4*)(bl + 32 + 8 * g_);
            p0[4 * g_] = t0[0]; p0[4 * g_ + 1] = t0[1]; p0[4 * g_ + 2] = t0[2]; p0[4 * g_ + 3] = t0[3]; p1[4 * g_] = t1[0]; p1[4 * g_ + 1] = t1[1]; p1[4 * g_ + 2] = t1[2]; p1[4 * g_ + 3] = t1[3]; }
    } else { p0 = f32x16{}; p1 = f32x16{}; }
    const char* kb[4];
#pragma unroll
    for (int dd = 0; dd < 4; ++dd) kb[dd] = K_lds + KB * SHM_K + KSWZ(r32, (dd * 16 + hi * 8) * 2);
#pragma unroll
    for (int d0 = 0; d0 < 8; ++d0) { const char* a = kb[d0 & 3] + (d0 >> 2) * 128;
        bf16x8 b0 = *reinterpret_cast<const bf16x8*>(a);
        bf16x8 b1 = *reinterpret_cast<const bf16x8*>(a + 32 * 256);
        p0 = __builtin_amdgcn_mfma_f32_32x32x16_bf16(b0, qr[d0], p0, 0, 0, 0);
        p1 = __builtin_amdgcn_mfma_f32_32x32x16_bf16(b1, qr[d0], p1, 0, 0, 0); }
}
template <int VB, bool SK>
__device__ __forceinline__ void pv_tile(f32x16* o, int vb0, bf16x8 pa0, bf16x8 pa1, bf16x8 pa2, bf16x8 pa3, bool act) {
    if (SK && !act) return;
#define TRRD(dst, off) asm volatile("ds_read_b64_tr_b16 %0, %1 offset:%2" : "=&v"(dst) : "v"(vb0), "i"(off) : "memory")
#define PV_D0(d0) do { s16x4 l0, l1, l2, l3, h0, h1, h2, h3; constexpr int b_ = VB * SHM_V + v_rd_off(d0, 0, 0);     \
        TRRD(l0, b_); TRRD(h0, b_ + 2048); TRRD(l1, b_ + 4096); TRRD(h1, b_ + 6144); TRRD(l2, b_ + 8192); TRRD(h2, b_ + 10240); TRRD(l3, b_ + 12288); TRRD(h3, b_ + 14336); \
        asm volatile("s_waitcnt lgkmcnt(0)" ::: "memory"); SBAR();                 \
        o[d0] = __builtin_amdgcn_mfma_f32_32x32x16_bf16(pa0, (bf16x8){l0[0], l0[1], l0[2], l0[3], h0[0], h0[1], h0[2], h0[3]}, o[d0], 0, 0, 0);   \
        o[d0] = __builtin_amdgcn_mfma_f32_32x32x16_bf16(pa1, (bf16x8){l1[0], l1[1], l1[2], l1[3], h1[0], h1[1], h1[2], h1[3]}, o[d0], 0, 0, 0);   \
        o[d0] = __builtin_amdgcn_mfma_f32_32x32x16_bf16(pa2, (bf16x8){l2[0], l2[1], l2[2], l2[3], h2[0], h2[1], h2[2], h2[3]}, o[d0], 0, 0, 0);   \
        o[d0] = __builtin_amdgcn_mfma_f32_32x32x16_bf16(pa3, (bf16x8){l3[0], l3[1], l3[2], l3[3], h3[0], h3[1], h3[2], h3[3]}, o[d0], 0, 0, 0); } while (0)
    PV_D0(0); PV_D0(1); PV_D0(2); PV_D0(3);
#undef PV_D0
#undef TRRD
}

template <class TIn, class TOut> struct BlockRef { const TIn* Q; const TIn* K; const TIn* V; TOut* O; int P0; };
template <class TIn> struct Seam {
    bf16x8 qr[8];
    bf16x8 st_v0, st_v1, st_k0, st_k1; f32x4 sf0, sf1, sf2, sf3;
    f32x4 tq[16];
};
__device__ __forceinline__ int swa_jlo(int P0, int W) { const int lowk = P0 - W + 1; return lowk > 0 ? lowk / KVBLK : 0; }
#define ROW(p, k0, rr) (((p) + (size_t)(k0) * KS) + (unsigned)((rr) * KS + sc))
#define VMW() asm volatile("s_waitcnt vmcnt(0)" ::: "memory")
#define VMWN(n) asm volatile("s_waitcnt vmcnt(%0)" :: "i"(n) : "memory")
#define SLOAD_H(Kp, Vp, k0) do { S.st_v0 = load8<TIn>(ROW(Vp, k0, sr)); S.st_v1 = load8<TIn>(ROW(Vp, k0, 32 + sr));              \
                         S.st_k0 = load8<TIn>(ROW(Kp, k0, sr)); S.st_k1 = load8<TIn>(ROW(Kp, k0, 32 + sr)); } while (0)
#define SWRITE_HK(bf) do { *(bf16x8*)(K_lds + (bf) * SHM_K + kws) = S.st_k0; *(bf16x8*)(K_lds + (bf) * SHM_K + kws + 32 * 256) = S.st_k1; } while (0)
#define SWRITE_HV(bf) do { *(bf16x8*)(V_lds + (bf) * SHM_V + vst0) = S.st_v0; *(bf16x8*)(V_lds + (bf) * SHM_V + vst1) = S.st_v1; } while (0)
#define SWRITE_H(bf) do { SWRITE_HV(bf); SWRITE_HK(bf); } while (0)
#define SLOAD_F(p, k0) do { S.sf0 = *(const f32x4*)ROW(p, k0, sr); S.sf1 = *(const f32x4*)(ROW(p, k0, sr) + 4);                \
                            S.sf2 = *(const f32x4*)ROW(p, k0, 32 + sr); S.sf3 = *(const f32x4*)(ROW(p, k0, 32 + sr) + 4); } while (0)
#define SWRITE_KF(bf) do { *(bf16x8*)(K_lds + (bf) * SHM_K + kws) = pack8(S.sf0, S.sf1); *(bf16x8*)(K_lds + (bf) * SHM_K + kws + 32 * 256) = pack8(S.sf2, S.sf3); } while (0)
#define SWRITE_VF(bf) do { *(bf16x8*)(V_lds + (bf) * SHM_V + vst0) = pack8(S.sf0, S.sf1); *(bf16x8*)(V_lds + (bf) * SHM_V + vst1) = pack8(S.sf2, S.sf3); } while (0)
template <class TIn, class TOut, int QS, int KS, int OS, bool BIAS>
__device__ __forceinline__ void causal_swa_prime(const BlockRef<TIn, TOut>& cur, int W, char* lds, Seam<TIn>& S) {
    constexpr bool F32 = same_t<TIn, float>::v;
    const int tid = threadIdx.x, wid = __builtin_amdgcn_readfirstlane(tid >> 6), lane = tid & 63, r32 = lane & 31, hi = lane >> 5;
    const int sr = tid >> 4, sc = (tid & 15) * 8, kws = KSWZ(sr, sc * 2); char* K_lds = lds + 2 * SHM_V;
    const int kb0 = swa_jlo(cur.P0, W) * KVBLK;
    for (int d0 = 0; d0 < 8; ++d0) S.qr[d0] = load8<TIn>(cur.Q + (size_t)(wid * QBLK + r32) * QS + d0 * 16 + hi * 8);
    if constexpr (F32) { SLOAD_F((const float*)cur.K, kb0); VMW(); SWRITE_KF(0); SBAR(); SLOAD_F((const float*)cur.V, kb0); }
    else { SLOAD_H(cur.K, cur.V, kb0); VMW(); SWRITE_HK(0); }
    __syncthreads();
}
template <class TIn, class TOut, int QS, int KS, int OS, bool BIAS, bool PREF = true>
__device__ __forceinline__ void causal_swa_block(const BlockRef<TIn, TOut>& cur, const BlockRef<TIn, TOut>& nxt, int skv, int W, char* lds, Seam<TIn>& S) {
    constexpr bool F32 = same_t<TIn, float>::v;
    const int tid = threadIdx.x, wid = __builtin_amdgcn_readfirstlane(tid >> 6), lane = tid & 63, r32 = lane & 31, hi = lane >> 5;
    const int j_lo = swa_jlo(cur.P0, W);
    int j_hi = (cur.P0 + QB - 1) / KVBLK + 1; if (j_hi > skv / KVBLK) j_hi = skv / KVBLK;
    const int NT = j_hi - j_lo;
    const int kbn = swa_jlo(nxt.P0, W) * KVBLK;
    const int qlo = cur.P0 + wid * QBLK, qm = qlo + r32 - 4 * hi;
    char* V_lds = lds; char* K_lds = lds + 2 * SHM_V;
    float* ws = (float*)(lds + 2 * SHM_V + 2 * SHM_K) + wid * 64; float* li_l = ws, * al_l = ws + 32;
    float m_reg = BIAS ? ((const float*)(lds + BIAS_OFF))[cur.P0 + wid * QBLK + r32] : -1e30f, l_reg = 0; f32x16 o[4] = {};
    const int sr = tid >> 4, sc = (tid & 15) * 8, vst0 = v_st(sr, sc), vst1 = v_st(32 + sr, sc), kws = KSWZ(sr, sc * 2);
    const int vb0 = (int)(uintptr_t)V_lds + v_rd_base(lane);
    const TIn* Kh = cur.K; const TIn* Vh = cur.V;
    const float* bias0 = (const float*)(lds + BIAS_OFF) + 4 * hi;
#define RESC(a) do { if (__any((a) < 1.f)) { if (hi == 0) al_l[r32] = (a); asm volatile("s_waitcnt lgkmcnt(0)" ::: "memory");              \
                     for (int d_ = 0; d_ < 4; ++d_) for (int r = 0; r < 16; ++r) o[d_][r] *= al_l[crow(r, hi)]; } } while (0)
#define KBASE(t) ((j_lo + (t)) * KVBLK)
#define BL(t) (bias0 + KBASE(t))
#define ACT(t) (KBASE(t) <= qlo + QBLK - 1 && KBASE(t) + KVBLK - 1 >= qlo - W + 1)
#define MASKT(P0_, P1_, t) do { const int kb_ = KBASE(t); if ((!SK || ACT(t)) && (kb_ + KVBLK - 1 > qlo || kb_ <= qlo + QBLK - 1 - W)) mask_tile(P0_, P1_, qm - kb_, (unsigned)W); } while (0)
    constexpr int NQL = F32 ? 16 : 8;
    constexpr bool SK = WSKIP && !F32;
#define SEAM_K0() do { VMWN(NQL); if constexpr (F32) { SWRITE_KF(0); SBAR(); SLOAD_F((const float*)nxt.V, kbn); } else { SWRITE_HK(0); } SBAR(); } while (0)
    f32x16 pA0, pA1, pB0, pB1; float mnA, mnB, alA, alB; bf16x8 pa0, pa1, pa2, pa3;
    if constexpr (F32) { VMW(); SWRITE_VF(0); SBAR(); } else { SWRITE_HV(0); SBAR(); }
    if (NT > 1) { if constexpr (F32) SLOAD_F((const float*)Kh, KBASE(1)); else SLOAD_H(Kh, Vh, KBASE(1)); }
    SBAR(); qkt<0, SK, BIAS>(pA0, pA1, K_lds, r32, hi, S.qr, ACT(0), BL(0));
    if constexpr (F32) { if (NT > 1) { VMW(); SWRITE_KF(1); SBAR(); SLOAD_F((const float*)Vh, KBASE(1)); } }
    MASKT(pA0, pA1, 0); partialSM(pA0, pA1, m_reg, mnA, alA);
    if (NT > 1) { VMW(); if constexpr (F32) { SWRITE_VF(1); SBAR(); if (NT > 2) SLOAD_F((const float*)Kh, KBASE(2)); } else SWRITE_H(1); }
    __syncthreads();
#define HALF_STEP(PX0, PX1, mnX, alX, PY0, PY1, alY, t, KB, VB, SB) do {                                                      \
        SBAR(); qkt<KB, SK, BIAS>(PX0, PX1, K_lds, r32, hi, S.qr, ACT(t), BL(t));                                             \
        finishSM(PY0, PY1, alY, l_reg, pa0, pa1, pa2, pa3); SBAR();                                                           \
        if ((t) + 1 < NT) { if constexpr (F32) { VMW(); SWRITE_KF(SB); SBAR(); SLOAD_F((const float*)Vh, KBASE((t) + 1)); }  \
                            else { SLOAD_H(Kh, Vh, KBASE((t) + 1)); } SBAR(); }                                               \
        pv_tile<VB, SK>(o, vb0, pa0, pa1, pa2, pa3, ACT((t) - 1)); MASKT(PX0, PX1, (t)); partialSM(PX0, PX1, m_reg, mnX, alX);                                        \
        __syncthreads();                                                                                                      \
        if ((t) + 1 < NT) { VMW(); if constexpr (F32) { SWRITE_VF(SB); SBAR(); if ((t) + 2 < NT) SLOAD_F((const float*)Kh, KBASE((t) + 2)); } \
                            else { SWRITE_H(SB); } }                                                                          \
        RESC(alX); __syncthreads(); } while (0)
    for (int t = 1; t + 1 < NT; t += 2) {
        HALF_STEP(pB0, pB1, mnB, alB, pA0, pA1, alA, t, 1, 0, 0);
        HALF_STEP(pA0, pA1, mnA, alA, pB0, pB1, alB, t + 1, 0, 1, 1);
    }
    const bool even = (NT & 1) == 0;
    if (even) { SBAR(); qkt<1, SK, BIAS>(pB0, pB1, K_lds, r32, hi, S.qr, ACT(NT - 1), BL(NT - 1)); SBAR(); }
#define QROW(e) (nxt.Q + (size_t)(wid * QBLK + r32) * QS + ((e) >> 1) * 16 + hi * 8 + ((e) & 1) * 4)
    if constexpr (F32) { SLOAD_F((const float*)nxt.K, kbn); SBAR();
#pragma unroll
        for (int e = 0; e < 8; ++e) S.tq[e] = *(const f32x4*)QROW(e); }
    else if constexpr (PREF) { SLOAD_H(nxt.K, nxt.V, kbn); SBAR();
#pragma unroll
        for (int d0 = 0; d0 < 8; ++d0) S.qr[d0] = load8<TIn>(nxt.Q + (size_t)(wid * QBLK + r32) * QS + d0 * 16 + hi * 8); }
    SBAR();
    finishSM(pA0, pA1, alA, l_reg, pa0, pa1, pa2, pa3); SBAR();
    if constexpr (F32) {
#pragma unroll
        for (int e = 8; e < 16; ++e) S.tq[e] = *(const f32x4*)QROW(e); SBAR(); }
#undef QROW
    pv_tile<0, SK>(o, vb0, pa0, pa1, pa2, pa3, ACT(even ? NT - 2 : NT - 1));
    if (even) { MASKT(pB0, pB1, NT - 1); partialSM(pB0, pB1, m_reg, mnB, alB); __syncthreads(); RESC(alB);
        finishSM(pB0, pB1, alB, l_reg, pa0, pa1, pa2, pa3); SBAR(); pv_tile<1, SK>(o, vb0, pa0, pa1, pa2, pa3, ACT(NT - 1)); }
    SBAR(); if constexpr (PREF) SEAM_K0();
    if (hi == 0) li_l[r32] = l_reg; asm volatile("s_waitcnt lgkmcnt(0)" ::: "memory");
    float rli[16];
#pragma unroll
    for (int r = 0; r < 16; ++r) rli[r] = __builtin_amdgcn_rcpf(li_l[crow(r, hi)]);
    TOut* Ow = cur.O + (size_t)(wid * QBLK) * OS;
#pragma unroll
    for (int r = 0; r < 16; ++r) { const int orow = crow(r, hi);
#pragma unroll
        for (int d0 = 0; d0 < 4; ++d0) { const float v = o[d0][r] * rli[r];
            if constexpr (same_t<TOut, float>::v) { Ow[(size_t)orow * OS + d0 * 32 + r32] = v; }
            else { const float vn = __shfl_xor(v, 1);
                   if ((r32 & 1) == 0) *(unsigned*)(Ow + (size_t)orow * OS + d0 * 32 + r32) = cvtpk(v, vn); } } }
    if constexpr (F32) {
#pragma unroll
        for (int d0 = 0; d0 < 8; ++d0) S.qr[d0] = pack8(S.tq[2 * d0], S.tq[2 * d0 + 1]); }
    __syncthreads();
#undef RESC
#undef KBASE
#undef BL
#undef ACT
#undef MASKT
#undef SEAM_K0
#undef HALF_STEP
}
#undef ROW
#undef VMW
#undef VMWN
#undef SLOAD_H
#undef SWRITE_HK
#undef SWRITE_HV
#undef SWRITE_H
#undef SLOAD_F
#undef SWRITE_KF
#undef SWRITE_VF

#undef KSWZ
#undef SBAR
}
__device__ __forceinline__ void sg_phase(const Frame& F, const KArgs& a, const int u_first, const int u_count) {
    unsigned char* ws = F.ws; const int tid = F.tid, lane = F.lane, w = F.wave, tl = lane & 15, kq = lane >> 4;
    LAS f32x2* st = (LAS f32x2*)F.lds;
    LAS unsigned short* vt = (LAS unsigned short*)(F.lds + 1024);
    const bf16* ZU = (const bf16*)(ws + WS_ZU); const bf16* ZV = (const bf16*)(ws + WS_ZV); const float* ZST = (const float*)(ws + WS_ZST); bf16* AS = (bf16*)(ws + WS_AS);
    const float* ln_g = a.in[5]; const float* ln_b = a.in[6]; const float* w_sp = a.in[7]; const float* b_sp = a.in[8];
    for (int uu = 0; uu < u_count; ++uu) { const int u = u_first + uu;
        const int chunk = u >> 3, g = u & 7, t0 = chunk * SGC;
        if (tid < 128) { const f32x4* p = (const f32x4*)(ZST + (size_t)(t0 + tid) * 32); float S = 0.f, Q = 0.f;
#pragma unroll
            for (int i = 0; i < 8; ++i) { const f32x4 v = p[i]; S += v[0] + v[2]; Q += v[1] + v[3]; }
            const float mu = S * (1.f / SGW), var = fmaxf(Q * (1.f / SGW) - mu * mu, 0.f); st[tid] = (f32x2){mu, rsqrtf(var + LN_EPS)}; }
        __syncthreads();
        { const int s = tid >> 2, c0 = (tid & 3) * 32; const f32x2 ms = st[s]; const bf16* src = ZV + (size_t)(t0 + s) * SGW + g * 128 + c0;
#pragma unroll
            for (int q = 0; q < 4; ++q) { const u32x4 raw = ((const u32x4*)src)[q]; const unsigned rw[4] = {raw.x, raw.y, raw.z, raw.w};
                const f32x4 g0 = *(const f32x4*)(ln_g + g * 128 + c0 + 8 * q), g1 = *(const f32x4*)(ln_g + g * 128 + c0 + 8 * q + 4), b0 = *(const f32x4*)(ln_b + g * 128 + c0 + 8 * q), b1 = *(const f32x4*)(ln_b + g * 128 + c0 + 8 * q + 4);
#pragma unroll
                for (int i = 0; i < 8; ++i) { const unsigned wd = rw[i >> 1]; const float v = __builtin_bit_cast(float, (i & 1) ? (wd & 0xffff0000u) : (wd << 16));
                    const float gg = (i < 4) ? g0[i & 3] : g1[i & 3], bb = (i < 4) ? b0[i & 3] : b1[i & 3];
                    vt[(c0 + 8 * q + i) * 136 + s] = (unsigned short)f2bf((v - ms[0]) * ms[1] * gg + bb); } } }
        __syncthreads();
        f32x4 acc[8];
#pragma unroll
        for (int j = 0; j < 8; ++j) acc[j] = (f32x4){0.f, 0.f, 0.f, 0.f};
        const int t = 16 * w + tl;
        f32x4 wraw[4][2];
#pragma unroll
        for (int ks = 0; ks < 4; ++ks) { const float* wp = w_sp + ((size_t)(g * 128 + t) * 128 + 32 * ks + 8 * kq); if (ks <= (w >> 1)) { wraw[ks][0] = *(const f32x4*)wp; wraw[ks][1] = *(const f32x4*)(wp + 4); } else { wraw[ks][0] = (f32x4){0.f, 0.f, 0.f, 0.f}; wraw[ks][1] = wraw[ks][0]; } }
        u32x2 uraw[8];
#pragma unroll
        for (int j = 0; j < 8; ++j) uraw[j] = *(const u32x2*)(ZU + (size_t)(t0 + t) * SGW + g * 128 + 16 * j + 4 * kq);
        const float bs = b_sp[g * 128 + t];
#pragma unroll
        for (int ks = 0; ks < 4; ++ks) { if (ks > (w >> 1)) continue;
            const f32x4 w0 = wraw[ks][0], w1 = wraw[ks][1];
            float wv[8] = {w0[0], w0[1], w0[2], w0[3], w1[0], w1[1], w1[2], w1[3]};
#pragma unroll
            for (int i = 0; i < 8; ++i) if (32 * ks + 8 * kq + i > t) wv[i] = 0.f;
            u32x4 pk; pk.x = cvt_pk_bf16(wv[0], wv[1]); pk.y = cvt_pk_bf16(wv[2], wv[3]); pk.z = cvt_pk_bf16(wv[4], wv[5]); pk.w = cvt_pk_bf16(wv[6], wv[7]);
            const bf16x8 wf = __builtin_bit_cast(bf16x8, pk);
#pragma unroll
            for (int j = 0; j < 8; ++j) { const bf16x8 vf = *(const LAS bf16x8*)(vt + (16 * j + tl) * 136 + 32 * ks + 8 * kq);
                acc[j] = __builtin_amdgcn_mfma_f32_16x16x32_bf16(vf, wf, acc[j], 0, 0, 0); }
        }
#pragma unroll
        for (int j = 0; j < 8; ++j) { const int ch = 16 * j + 4 * kq; const u32x2 uu = uraw[j];
            const float o0 = __builtin_bit_cast(float, uu.x << 16) * (acc[j][0] + bs), o1 = __builtin_bit_cast(float, uu.x & 0xffff0000u) * (acc[j][1] + bs);
            const float o2 = __builtin_bit_cast(float, uu.y << 16) * (acc[j][2] + bs), o3 = __builtin_bit_cast(float, uu.y & 0xffff0000u) * (acc[j][3] + bs);
            u32x2 o; o.x = cvt_pk_bf16(o0, o1); o.y = cvt_pk_bf16(o2, o3); *(u32x2*)(AS + (size_t)(t0 + t) * DM + FW + g * 128 + ch) = o; }
        __syncthreads();
    }
}
__device__ __forceinline__ void fox_phase(const Frame& F, char* lds, int& sg_first, int& sg_count) {
    sg_first = blockIdx.x * 4; sg_count = 4;
    typedef unsigned short T;
    unsigned char* ws = F.ws; const int G = F.G, c = blockIdx.x, vcu = (G % 8 == 0) ? (c % 8) * (G / 8) + c / 8 : c;
    const T* Qb = (const T*)(ws + WS_Q); const T* Kb = (const T*)(ws + WS_K); const T* Vb = (const T*)(ws + WS_V); T* Ob = (T*)(ws + WS_AS); const float* CB = (const float*)(ws + WS_CB);
    if (vcu < NB * FH * 8) {
        const int L = vcu; const int bh = L >> 3, x = L & 7, b = bh / FH, h = bh % FH;
        __syncthreads();
        { const f32x4* src = (const f32x4*)(CB + (size_t)bh * SEQ); f32x4* dst = (f32x4*)(lds + att::BIAS_OFF); dst[F.tid] = src[F.tid]; dst[F.tid + 512] = src[F.tid + 512]; }
        __syncthreads();
        int Wwin = SEQ;
        { const unsigned* NRM = F.ctl + CW_NRM; float q2 = 0.f, k2 = 0.f;
#pragma unroll
            for (int i = 0; i < 4; ++i) { q2 += __uint_as_float(__hip_atomic_load(NRM + ((0 * 4 + b) * 8 + h) * 4 + i, __ATOMIC_RELAXED, __HIP_MEMORY_SCOPE_AGENT)); k2 += __uint_as_float(__hip_atomic_load(NRM + ((1 * 4 + b) * 8 + h) * 4 + i, __ATOMIC_RELAXED, __HIP_MEMORY_SCOPE_AGENT)); }
            const float Bnd = sqrtf(q2 * k2) * 0.08838834764831845f * 1.02f;
            const float need = -(2.f * Bnd + 30.f) * 11.313708498984761f;
            const float* bl = (const float*)(lds + att::BIAS_OFF); float* red = (float*)(lds + att::BIAS_OFF + SEQ * 4);
            int lo = 1, hi = SEQ / 64;
            while (lo < hi) { const int mid = (lo + hi) >> 1, Wc = mid * 64; float mx = -3.0e38f;
                for (int t = Wc + F.tid; t < SEQ; t += NTHREADS) mx = fmaxf(mx, bl[t - Wc] - bl[t]);
#pragma unroll
                for (int o = 1; o < 64; o <<= 1) mx = fmaxf(mx, __shfl_xor(mx, o));
                __syncthreads(); if (F.lane == 0) red[F.wave] = mx; __syncthreads();
                float m8 = red[0];
#pragma unroll
                for (int i = 1; i < 8; ++i) m8 = fmaxf(m8, red[i]);
                if (m8 <= need) hi = mid; else lo = mid + 1; }
            Wwin = __builtin_amdgcn_readfirstlane(lo * 64); __syncthreads(); }
        att::BlockRef<T, T> cur, nxt;
        cur.K = Kb + (size_t)b * SEQ * FW + h * FD; cur.V = Vb + (size_t)b * SEQ * FW + h * FD; nxt = cur;
        cur.Q = Qb + ((size_t)b * SEQ + x * 256) * FW + h * FD; cur.O = Ob + ((size_t)b * SEQ + x * 256) * DM + h * FD; cur.P0 = x * 256;
        nxt.Q = Qb + ((size_t)b * SEQ + (15 - x) * 256) * FW + h * FD; nxt.O = Ob + ((size_t)b * SEQ + (15 - x) * 256) * DM + h * FD; nxt.P0 = (15 - x) * 256;
        att::Seam<T> S;
        att::causal_swa_prime<T, T, FW, FW, DM, true>(cur, Wwin, lds, S);
        att::causal_swa_block<T, T, FW, FW, DM, true>(cur, nxt, SEQ, Wwin, lds, S);
        att::causal_swa_block<T, T, FW, FW, DM, true, false>(nxt, nxt, SEQ, Wwin, lds, S);
        { const int wt = Wwin / 64 + 4; int load[8], cnt[8];
#pragma unroll
          for (int i = 0; i < 8; ++i) { const int f0 = 4 * (i + 1), f1 = 4 * (16 - i); load[i] = (f0 < wt ? f0 : wt) + (f1 < wt ? f1 : wt); cnt[i] = 0; }
          for (int k = 0; k < 32; ++k) { int bi = 0, bv = load[0];
#pragma unroll
              for (int i = 1; i < 8; ++i) if (load[i] < bv) { bv = load[i]; bi = i; }
#pragma unroll
              for (int i = 0; i < 8; ++i) if (i == bi) { load[i] += 4; cnt[i] += 1; } }
          int first = 0, mine = 0;
#pragma unroll
          for (int i = 0; i < 8; ++i) { if (i < x) first += cnt[i]; if (i == x) mine = cnt[i]; }
          sg_first = bh * 32 + first; sg_count = mine; }
    }
}
__device__ __forceinline__ void xattn_phase(const Frame& F, char* lds) {
    typedef unsigned short T;
    unsigned char* ws = F.ws;
    const T* Qb = (const T*)(ws + WS_QX); const T* Kb = (const T*)(ws + WS_KX); const T* Vb = (const T*)(ws + WS_VX); T* Ob = (T*)(ws + WS_OX);
    for (int L = blockIdx.x; L < NB * XH * 16; L += F.G) {
        const int b = L >> 6, h = (L >> 4) & 3, qb = L & 15;
        att::BlockRef<T, T> cur;
        cur.K = Kb + (size_t)b * MEML * XW + h * XD; cur.V = Vb + (size_t)b * MEML * XW + h * XD;
        cur.Q = Qb + ((size_t)b * SEQ + qb * 256) * XW + h * XD; cur.O = Ob + ((size_t)b * SEQ + qb * 256) * XW + h * XD; cur.P0 = MEML;
        att::Seam<T> S;
        att::causal_swa_prime<T, T, XW, XW, XW, false>(cur, 1 << 20, lds, S);
        att::causal_swa_block<T, T, XW, XW, XW, false, false>(cur, cur, MEML, 1 << 20, lds, S);
    }
}
__device__ __forceinline__ void moe_tables(const Frame& F) {
    LAS int* tab = (LAS int*)(F.lds + LDS_TAB);
    __syncthreads();
    if (F.tid == 0) { const unsigned* CNT = F.ctl + CW_CNT; int p = 0;
        for (int e = 0; e < NE; ++e) { const int c = (int)__hip_atomic_load(CNT + e, __ATOMIC_RELAXED, __HIP_MEMORY_SCOPE_AGENT); tab[e] = p; tab[40 + e] = c; p += (c + 255) >> 8; }
        tab[32] = p; }
    __syncthreads();
}
typedef float f32x16 __attribute__((ext_vector_type(16)));
__device__ __forceinline__ void p8_router(const Frame& F, const KArgs& a) {
    unsigned char* ws = F.ws; const int tid = F.tid, lane = F.lane, wave = F.wave, tl = lane & 31, hi = lane >> 5, grp = wave >> 2, kq = wave & 3;
    const float* X2 = (const float*)(ws + WS_X2); const float* WRT = (const float*)(ws + WS_WRT);
    constexpr int PITCH = 132;
    LAS float* xs = (LAS float*)F.lds;
    LAS float* wsm = xs + 2 * 64 * PITCH;
    LAS float* red = wsm + 2 * 32 * PITCH;
    LAS unsigned* lcnt = (LAS unsigned*)(F.lds + LDS_TAB + 512);
    for (int tp = blockIdx.x; tp < NTOK / 64; tp += F.G) {
        const int tok0 = tp * 64;
        f32x4 xa[4], wa[2], xb[4], wb[2];
#define P8_LOAD(X, W, c) do { _Pragma("unroll") for (int i = 0; i < 4; ++i) { const int p = tid + 512 * i; X[i] = *(const f32x4*)(X2 + (size_t)(tok0 + (p >> 5)) * DM + (c) * 128 + (p & 31) * 4); } \
        _Pragma("unroll") for (int i = 0; i < 2; ++i) { const int p = tid + 512 * i; W[i] = *(const f32x4*)(WRT + (size_t)(p >> 5) * DM + (c) * 128 + (p & 31) * 4); } } while (0)
#define P8_WRITE(X, W, b) do { _Pragma("unroll") for (int i = 0; i < 4; ++i) { const int p = tid + 512 * i; *(LAS f32x4*)(xs + ((b) * 64 + (p >> 5)) * PITCH + (p & 31) * 4) = X[i]; } \
        _Pragma("unroll") for (int i = 0; i < 2; ++i) { const int p = tid + 512 * i; *(LAS f32x4*)(wsm + ((b) * 32 + (p >> 5)) * PITCH + (p & 31) * 4) = W[i]; } } while (0)
#define P8_COMPUTE(b) do { const LAS float* xp = xs + ((b) * 64 + grp * 32 + tl) * PITCH + kq * 32 + 4 * hi; const LAS float* wp = wsm + ((b) * 32 + tl) * PITCH + kq * 32 + 4 * hi; \
        _Pragma("unroll") for (int s4 = 0; s4 < 4; ++s4) { const f32x4 xv = *(const LAS f32x4*)(xp + 8 * s4), wv = *(const LAS f32x4*)(wp + 8 * s4); \
            ss += (xv[0] * xv[0] + xv[1] * xv[1]) + (xv[2] * xv[2] + xv[3] * xv[3]); \
            _Pragma("unroll") for (int i = 0; i < 4; ++i) d = __builtin_amdgcn_mfma_f32_32x32x2f32(wv[i], xv[i], d, 0, 0, 0); } } while (0)
        __syncthreads();
        P8_LOAD(xa, wa, 0); P8_WRITE(xa, wa, 0); P8_LOAD(xa, wa, 1);
        f32x16 d = {}; float ss = 0.f;
        for (int c = 0; c < 16; c += 2) {
            if (c + 2 < 16) P8_LOAD(xb, wb, c + 2);
            asm volatile("s_waitcnt lgkmcnt(0)\n\ts_barrier" ::: "memory");
            P8_COMPUTE(0);
            P8_WRITE(xa, wa, 1);
            if (c + 3 < 16) P8_LOAD(xa, wa, c + 3);
            asm volatile("s_waitcnt lgkmcnt(0)\n\ts_barrier" ::: "memory");
            P8_COMPUTE(1);
            if (c + 2 < 16) P8_WRITE(xb, wb, 0);
        }
#undef P8_COMPUTE
#undef P8_LOAD
#undef P8_WRITE
        const int tok = tok0 + grp * 32 + tl;
        if (kq != 0) { LAS float* r = red + ((grp * 3 + (kq - 1)) * 17) * 64 + lane;
#pragma unroll
            for (int i = 0; i < 16; ++i) r[i * 64] = d[i];
            r[16 * 64] = ss; }
        __syncthreads();
        float wgt[4] = {0.f, 0.f, 0.f, 0.f}; int fe[4] = {0, 0, 0, 0}; unsigned lr[4] = {0u, 0u, 0u, 0u}; float rstd_t = 0.f;
        if (kq == 0) {
#pragma unroll
            for (int w = 0; w < 3; ++w) { const LAS float* r = red + ((grp * 3 + w) * 17) * 64 + lane;
#pragma unroll
                for (int i = 0; i < 16; ++i) d[i] += r[i * 64];
                ss += r[16 * 64]; }
            ss += __shfl_xor(ss, 32);
            const float rstd = rsqrtf(ss * (1.f / DM) + RMS_EPS);
            float l[16];
#pragma unroll
            for (int r = 0; r < 16; ++r) { const int e = (r & 3) + 8 * (r >> 2) + 4 * hi; l[r] = d[r] * rstd + a.in[19][e]; }
            float tv[8]; int ti[8];
#pragma unroll
            for (int k = 0; k < 4; ++k) { float bv = -INFINITY; int bi = 0;
#pragma unroll
                for (int r = 0; r < 16; ++r) { const int e = (r & 3) + 8 * (r >> 2) + 4 * hi; if (l[r] > bv || (l[r] == bv && e < bi)) { bv = l[r]; bi = e; } }
                tv[k] = bv; ti[k] = bi;
#pragma unroll
                for (int r = 0; r < 16; ++r) { const int e = (r & 3) + 8 * (r >> 2) + 4 * hi; if (e == bi) l[r] = -INFINITY; } }
#pragma unroll
            for (int k = 0; k < 4; ++k) { tv[4 + k] = __shfl_xor(tv[k], 32); ti[4 + k] = __shfl_xor(ti[k], 32); }
            float fv[4]; int fi[4];
#pragma unroll
            for (int k = 0; k < 4; ++k) { float bv = -INFINITY; int bi = 1 << 30;
#pragma unroll
                for (int j = 0; j < 8; ++j) if (tv[j] > bv || (tv[j] == bv && ti[j] < bi)) { bv = tv[j]; bi = ti[j]; }
                fv[k] = bv; fi[k] = bi;
#pragma unroll
                for (int j = 0; j < 8; ++j) if (ti[j] == bi) tv[j] = -INFINITY; }
            if (hi == 0) {
                float w[4], sm = 0.f;
#pragma unroll
                for (int k = 0; k < 4; ++k) { w[k] = __expf(fv[k] - fv[0]); sm += w[k]; }
                const float inv = 1.f / sm; rstd_t = rstd;
#pragma unroll
                for (int k = 0; k < 4; ++k) { fe[k] = fi[k]; wgt[k] = w[k] * inv; lr[k] = __hip_atomic_fetch_add(lcnt + fi[k], 1u, __ATOMIC_RELAXED, __HIP_MEMORY_SCOPE_WORKGROUP); }
            }
        }
        __syncthreads();
        if (tid < 32) { const unsigned cN = lcnt[tid]; lcnt[32 + tid] = cN ? atomicAdd(F.ctl + CW_CNT + tid, cN) : 0u; lcnt[tid] = 0u; }
        __syncthreads();
        if (kq == 0 && hi == 0) {
            ((float*)(ws + WS_RS2))[tok] = rstd_t;
#pragma unroll
            for (int k = 0; k < 4; ++k) { const int e = fe[k]; const float wk = wgt[k]; const unsigned rk = lcnt[32 + e] + lr[k];
                ((int*)(ws + WS_TOPE))[tok * 4 + k] = e; ((int*)(ws + WS_TOPR))[tok * 4 + k] = (int)rk; ((float*)(ws + WS_TOPW))[tok * 4 + k] = wk;
                ((int*)(ws + WS_TOKL))[(size_t)e * NTOK + rk] = tok; ((float*)(ws + WS_GWL))[(size_t)e * NTOK + rk] = wk; ((float*)(ws + WS_RSL))[(size_t)e * NTOK + rk] = rstd_t; }
        }
    }
}
__device__ __forceinline__ void p12_final(const Frame& F, const KArgs& a) {
    unsigned char* ws = F.ws; const int lane = F.lane; const LAS int* tab = (const LAS int*)(F.lds + LDS_TAB);
    const float* X2 = (const float*)(ws + WS_X2); const unsigned char* YB = ws + WS_YB; const int* TOPE = (const int*)(ws + WS_TOPE); const int* TOPR = (const int*)(ws + WS_TOPR);
    for (int row = F.gw; row < NTOK; row += F.NGW) {
        size_t so[4];
#pragma unroll
        for (int k = 0; k < 4; ++k) { const int e = TOPE[row * 4 + k], r = TOPR[row * 4 + k]; so[k] = (size_t)(tab[e] * 256 + r) * DM; }
        f32x4 v[8]; float q = 0.f;
#pragma unroll
        for (int j = 0; j < 8; ++j) { const int c = 4 * (lane + 64 * j); v[j] = *(const f32x4*)(X2 + (size_t)row * DM + c);
#pragma unroll
            for (int k = 0; k < 4; ++k) { const int y = *(const int*)(YB + so[k] + c);
                v[j][0] += __builtin_amdgcn_cvt_f32_fp8(y, 0); v[j][1] += __builtin_amdgcn_cvt_f32_fp8(y, 1); v[j][2] += __builtin_amdgcn_cvt_f32_fp8(y, 2); v[j][3] += __builtin_amdgcn_cvt_f32_fp8(y, 3); }
            q += (v[j][0] * v[j][0] + v[j][1] * v[j][1]) + (v[j][2] * v[j][2] + v[j][3] * v[j][3]); }
        const float rs = rsqrtf(wave_sum(q) * (1.f / DM) + RMS_EPS);
#pragma unroll
        for (int j = 0; j < 8; ++j) { const int c = 4 * (lane + 64 * j); const f32x4 g = *(const f32x4*)(a.in[24] + c); *(f32x4*)(a.out + (size_t)row * DM + c) = v[j] * rs * g; }
    }
}
__global__ void __launch_bounds__(NTHREADS, 2) mega_fwd(KArgs args) {
    extern __shared__ __attribute__((aligned(16))) unsigned char lds_raw[];
    Frame F;
    F.lds = (LAS unsigned char*)lds_raw; F.MISC = (volatile LAS unsigned*)(F.lds + LDS_MISC);
    F.tid = threadIdx.x; F.lane = F.tid & 63; F.wave = __builtin_amdgcn_readfirstlane(F.tid >> 6);
    F.G = gridDim.x; F.gw = blockIdx.x * NWAVES + F.wave; F.NGW = F.G * NWAVES;
    F.ws = args.ws; F.ctl = (unsigned*)(args.ws + WS_CTL);
    unsigned char* ws = args.ws;
    for (int u = F.tid; u < (LDS_BYTES - LDS_MISC) / 4; u += NTHREADS) ((LAS unsigned*)(F.lds + LDS_MISC))[u] = 0u;
    __syncthreads();
    XcdBarrier bar = xcd_barrier_post(F.ctl + CW_BAR + args.li * XCD_BAR_WORDS, F.MISC + 8);
    const int lo = args.ph_lo, hi = args.ph_hi;
#define IN(k) (lo <= (k) && (k) < hi)
#define BOTH(k) (IN(k) && IN((k) + 1))
    if (IN(0)) { p0_prologue<0>(F, args, F.gw, F.NGW); if (BOTH(0)) xcd_barrier(bar); }
    if (IN(1)) {
        if (blockIdx.x < NB * FH && F.wave == 0) cumsum_wave((const float*)(ws + WS_LOGF), (float*)(ws + WS_CB), blockIdx.x, F.lane);
        const int bx = blockIdx.x, oct = bx >> 3, conv = (oct & 7) < pg8::P1_CO ? 1 : 0;
        const int idx = (conv ? ((oct >> 3) * pg8::P1_CO + (oct & 7)) : ((oct >> 3) * (8 - pg8::P1_CO) + (oct & 7) - pg8::P1_CO)) * 8 + (bx & 7);
        if (conv) cvt8_phase(F, args, idx, pg8::P1_NC, 0, CVT8_P1_SUPER);
        {
            pg8::ProjSched S; S.T.init(NTOK / 256, pg8::P1_NBF, pg8::P1_NG, idx); S.A = (const char*)(ws + WS_H0); S.B = (const char*)(ws + WS_WP); S.lda = DM * 2; S.ldb = DM * 2; S.conv = conv; S.idx = idx;
            pg8::EpiProj E{ws, 0, -1.4426950408889634f};
            pg8::gemm_phase<false, false>(F.lds, DM / 64, DM * 2, DM * 2, S, E); }
        {
            constexpr int OFS = (pg8::P1_NG - ((NTOK / 256) * pg8::P1_NBF) % pg8::P1_NG) % pg8::P1_NG;
            pg8::ProjSched S; S.T.init(NTOK / 256, pg8::P1_NF8, pg8::P1_NG, (idx + OFS) % pg8::P1_NG); S.A = (const char*)(ws + WS_H0Q); S.B = (const char*)(ws + WS_WPG); S.lda = DM; S.ldb = DM; S.conv = conv; S.idx = (idx + OFS) % pg8::P1_NG;
            pg8::EpiProj E{ws, pg8::P1_NBF, -1.4426950408889634f * W8_INV};
            pg8::gemm_phase<false, true>(F.lds, DM / 128, DM, DM, S, E); }
        if (BOTH(1)) xcd_barrier(bar);
    }
    if (IN(2)) { int sg_first, sg_count; fox_phase(F, (char*)lds_raw, sg_first, sg_count); sg_phase(F, args, sg_first, sg_count); if (BOTH(2)) xcd_barrier(bar); }
    if (IN(3)) {
        pg8::MergeSched S; S.T.init(NTOK / 256, DM / 256, F.G, (int)blockIdx.x); S.A = (const char*)(ws + WS_AS); S.B = (const char*)(ws + WS_WAB); S.lda = DM * 2; S.ldb = DM * 2;
        pg8::EpiMerge E{ws};
        pg8::gemm_phase<false, false>(F.lds, FW / 64, DM * 2, DM * 2, S, E);
        if (BOTH(3)) xcd_barrier(bar);
    }
    if (IN(4)) {
        pg8::PlainSched S; S.T.init(NTOK / 256, DM / 256, F.G, (int)blockIdx.x); S.A = (const char*)(ws + WS_MG); S.B = (const char*)(ws + WS_WO); S.lda = DM * 2; S.ldb = DM * 2;
        pg8::EpiResid<false, false> E{args.in[0], nullptr, (bf16*)(ws + WS_X1B), (float*)(ws + WS_SS1), nullptr};
        pg8::gemm_phase<false, false>(F.lds, DM / 64, DM * 2, DM * 2, S, E);
        if (BOTH(4)) xcd_barrier(bar);
    }
    if (IN(5)) {
        if (blockIdx.x >= 144) cvt8_phase(F, args, (int)blockIdx.x - 144, 112, CVT8_P1_SUPER, CVT8_SUPER);
        pg8::QkvSched S{(const char*)(ws + WS_X1B), (const char*)(ws + WS_WXQ), (const char*)(ws + WS_HM), (const char*)(ws + WS_WXKV), (int)blockIdx.x};
        pg8::EpiQkv E{ws};
        pg8::gemm_phase<false, false>(F.lds, DM / 64, DM * 2, DM * 2, S, E);
        if (BOTH(5)) xcd_barrier(bar);
    }
    if (IN(6)) { xattn_phase(F, (char*)lds_raw); if (BOTH(6)) xcd_barrier(bar); }
    if (IN(7)) {
        pg8::PlainSched S; S.T.init(NTOK / 256, DM / 256, F.G, (int)blockIdx.x); S.A = (const char*)(ws + WS_OX); S.B = (const char*)(ws + WS_WXO); S.lda = XW * 2; S.ldb = XW * 2;
        pg8::EpiResid<true, true> E{(const void*)(ws + WS_X1B), (float*)(ws + WS_X2), nullptr, (float*)(ws + WS_SS2), ws + WS_X2Q};
        pg8::gemm_phase<false, false>(F.lds, XW / 64, XW * 2, XW * 2, S, E);
        if (BOTH(7)) xcd_barrier(bar);
    }
    if (IN(8)) { p8_router(F, args); if (BOTH(8)) xcd_barrier(bar); }
    if (IN(10)) {
        moe_tables(F);
        pg8::MoeSched S{(const LAS int*)(F.lds + LDS_TAB), (const char*)(ws + WS_X2Q), (const char*)(ws + WS_WGU), (const int*)(ws + WS_TOKL), F.G, (int)blockIdx.x, 16, (unsigned)DM, (size_t)(2 * DFF)};
        pg8::EpiAct E{ws, (const LAS int*)(F.lds + LDS_TAB), args.in[21]};
        pg8::gemm_phase<true, true>(F.lds, DM / 128, DM, DM, S, E);
        if (BOTH(10)) xcd_barrier(bar);
    }
    if (IN(11)) {
        moe_tables(F);
        pg8::DownSched S{{(const LAS int*)(F.lds + LDS_TAB), (const char*)(ws + WS_HB), (const char*)(ws + WS_WD), (const int*)(ws + WS_TOKL), F.G, (int)blockIdx.x, 8, (unsigned)DFF, (size_t)DM}, (unsigned)DFF};
        pg8::EpiDown E{ws, (const LAS int*)(F.lds + LDS_TAB), args.in[23]};
        pg8::gemm_phase<false, true>(F.lds, DFF / 128, DFF, DFF, S, E);
        if (BOTH(11)) xcd_barrier(bar);
    }
    if (IN(12)) { moe_tables(F); p12_final(F, args); }
#undef IN
#undef BOTH
}
#ifndef PROBE_PHASE
#define PROBE_PHASE -1
#endif
static int g_grid = 0;
static void mega_launch(hipStream_t st, void* const* d_in, void* d_out, void* d_ws, int lo, int hi, int li) {
    if (g_grid == 0) {
        int dev = 0, cus = 0;
        if (hipGetDevice(&dev) != hipSuccess || hipDeviceGetAttribute(&cus, hipDeviceAttributeMultiprocessorCount, dev) != hipSuccess || cus <= 0) cus = 256;
        if (hipFuncSetAttribute((const void*)mega_fwd, hipFuncAttributeMaxDynamicSharedMemorySize, LDS_BYTES) != hipSuccess) fprintf(stderr, "hipFuncSetAttribute failed\n");
        int per_cu = 0;
        if (hipOccupancyMaxActiveBlocksPerMultiprocessor(&per_cu, (const void*)mega_fwd, NTHREADS, LDS_BYTES) != hipSuccess || per_cu < 1) fprintf(stderr, "occupancy query: %d\n", per_cu);
        (void)hipGetLastError();
        g_grid = cus;
        if (cus != 256) fprintf(stderr, "kernel_launch: built for 256 CUs, device reports %d\n", cus);
    }
    KArgs a{};
    for (int i = 0; i < 25; ++i) a.in[i] = (const float*)d_in[i];
    a.out = (float*)d_out; a.ws = (unsigned char*)d_ws; a.ph_lo = lo; a.ph_hi = hi; a.li = li; a.pad = 0;
    hipLaunchKernelGGL(mega_fwd, dim3(g_grid), dim3(NTHREADS), LDS_BYTES, st, a);
}
extern "C" void kernel_launch(void* const* d_in, const int* in_sizes, int n_in, void* d_out, int out_size, void* d_ws, size_t ws_size, hipStream_t st) {
    if (n_in != 25 || ws_size < WS_END) { fprintf(stderr, "kernel_launch: unexpected n_in %d / ws %zu\n", n_in, ws_size); return; }
    (void)in_sizes; (void)out_size;
    char* ws = (char*)d_ws;
    (void)hipMemsetAsync(ws + WS_CTL, 0, CTL_BYTES, st);
    mega_launch(st, d_in, d_out, d_ws, 0, 13, 0);
#if PROBE_PHASE >= 0
    mega_launch(st, d_in, d_out, d_ws, PROBE_PHASE, PROBE_PHASE + 1, 1);
#endif
}
```

```cpp
#include <hip/hip_runtime.h>
#include <cstdio>
#include <cstdint>
#include <type_traits>

constexpr int DM = 2048, NB = 4, SEQ = 4096, NTOK = NB * SEQ, MEML = 256, NMEM = NB * MEML;
constexpr int FH = 8, FD = 128, FW = 1024, SGG = 8, SGD = 128, SGW = 1024, SGC = 128;
constexpr int XH = 4, XD = 128, XW = 512;
constexpr int NE = 32, TOPK = 4, DFF = 2048;
constexpr int INC = 3 * FW + FH + 2 * SGW + 2 * DM;
constexpr int C_Q = 0, C_K = 1024, C_V = 2048, C_F = 3072, C_Z = 3080, C_GA = 5128, C_GB = 7176;
constexpr float RMS_EPS = 1e-6f, LN_EPS = 1e-5f, SW_LIMIT = 7.0f, SW_ALPHA = 1.702f;
constexpr int MAXSLOT = NTOK * TOPK + NE * 256;

typedef unsigned short bf16;
__device__ __forceinline__ unsigned f2bf(float f) { unsigned u = __builtin_bit_cast(unsigned, f); return (u + 0x7fffu + ((u >> 16) & 1u)) >> 16; }
__device__ __forceinline__ float bf2f(bf16 h) { return __builtin_bit_cast(float, (unsigned)h << 16); }

constexpr size_t MiB = 1ull << 20;
constexpr size_t WS_CTL = 0;
constexpr size_t CTL_BYTES = 1 * MiB;
constexpr int CW_NRM = 12288;
constexpr int CW_CNT = 8192;
constexpr size_t WS_H0   = 16 * MiB;
constexpr size_t WS_HM   = WS_H0 + 64 * MiB;
constexpr size_t WS_LOGF = WS_HM + 4 * MiB;
constexpr size_t WS_CB   = WS_LOGF + 1 * MiB;
constexpr size_t WS_Q    = WS_CB + 1 * MiB;
constexpr size_t WS_K    = WS_Q + 32 * MiB;
constexpr size_t WS_V    = WS_K + 32 * MiB;
constexpr size_t WS_ZU   = WS_V + 32 * MiB;
constexpr size_t WS_ZV   = WS_ZU + 32 * MiB;
constexpr size_t WS_ZST  = WS_ZV + 32 * MiB;
constexpr size_t WS_GR   = WS_ZST + 2 * MiB;
constexpr size_t WS_GS   = WS_GR + 64 * MiB;
constexpr size_t WS_AS   = WS_GS + 64 * MiB;
constexpr size_t WS_MG   = WS_AS + 64 * MiB;
constexpr size_t WS_X1   = WS_MG + 64 * MiB;
constexpr size_t WS_X1B  = WS_X1 + 128 * MiB;
constexpr size_t WS_SS1  = WS_X1B + 64 * MiB;
constexpr size_t WS_QX   = WS_SS1 + 2 * MiB;
constexpr size_t WS_KX   = WS_QX + 16 * MiB;
constexpr size_t WS_VX   = WS_KX + 1 * MiB;
constexpr size_t WS_OX   = WS_VX + 1 * MiB;
constexpr size_t WS_X2   = WS_OX + 16 * MiB;
constexpr size_t WS_X2B  = WS_X2 + 128 * MiB;
constexpr size_t WS_SS2  = WS_X2B + 64 * MiB;
constexpr size_t WS_TOPE = WS_SS2 + 2 * MiB;
constexpr size_t WS_TOPR = WS_TOPE + 1 * MiB;
constexpr size_t WS_TOPW = WS_TOPR + 1 * MiB;
constexpr size_t WS_TOKL = WS_TOPW + 1 * MiB;
constexpr size_t WS_GWL  = WS_TOKL + 2 * MiB;
constexpr size_t WS_HB   = WS_GWL + 2 * MiB;
constexpr size_t WS_YB   = WS_HB + 288 * MiB;
constexpr size_t WS_TMP  = WS_YB + 288 * MiB;
constexpr size_t WS_END_NAIVE = WS_TMP + 640 * MiB;

__device__ __forceinline__ float gelu_tanh(float x) {
    const float u = 0.7978845608028654f * (x + 0.044715f * x * x * x);
    const float e = __expf(2.f * u);
    const float t = 1.f - 2.f / (e + 1.f);
    return 0.5f * x * (1.f + t);
}
__device__ __forceinline__ float sigmoidf_(float x) { return 1.f / (1.f + __expf(-x)); }
__device__ __forceinline__ float log_sigmoid(float x) { return fminf(x, 0.f) - log1pf(__expf(-fabsf(x))); }

#ifdef REFERENCE_PIPELINE
__device__ __forceinline__ float block_sum_256(float v, float* red) {
#pragma unroll
    for (int o = 32; o > 0; o >>= 1) v += __shfl_xor(v, o);
    __syncthreads();
    if ((threadIdx.x & 63) == 0) red[threadIdx.x >> 6] = v;
    __syncthreads();
    return red[0] + red[1] + red[2] + red[3];
}
__global__ __launch_bounds__(256) void n_rms_rows(const float* X, const float* g, bf16* OUT, const float* w_in, const float* b_forget, float* LOGF) {
    __shared__ float red[4];
    const int row = blockIdx.x, t = threadIdx.x;
    const float* x = X + (size_t)row * DM;
    float v[8]; float s = 0.f;
#pragma unroll
    for (int i = 0; i < 8; ++i) { v[i] = x[t + 256 * i]; s += v[i] * v[i]; }
    const float tot = block_sum_256(s, red);
    const float rstd = rsqrtf(tot * (1.f / DM) + RMS_EPS);
    float f[8];
#pragma unroll
    for (int j = 0; j < 8; ++j) f[j] = 0.f;
#pragma unroll
    for (int i = 0; i < 8; ++i) {
        const int k = t + 256 * i; const float h = v[i] * rstd * g[k];
        OUT[(size_t)row * DM + k] = (bf16)f2bf(h);
        if (LOGF) {
#pragma unroll
            for (int j = 0; j < 8; ++j) f[j] += h * w_in[(size_t)k * INC + C_F + j];
        }
    }
    if (LOGF) {
#pragma unroll
        for (int j = 0; j < 8; ++j) { const float tj = block_sum_256(f[j], red); if (t == 0) LOGF[(size_t)row * 8 + j] = log_sigmoid(tj + b_forget[j]); }
    }
}
__global__ __launch_bounds__(64) void n_cumsum(const float* LOGF, float* CB) {
    const int bh = blockIdx.x, b = bh / FH, h = bh % FH, lane = threadIdx.x;
    float loc = 0.f;
    for (int i = 0; i < 64; ++i) loc += LOGF[(size_t)(b * SEQ + lane * 64 + i) * 8 + h];
    float inc = loc;
#pragma unroll
    for (int o = 1; o < 64; o <<= 1) { const float n = __shfl_up(inc, o); if (lane >= o) inc += n; }
    float run = inc - loc;
    for (int i = 0; i < 64; ++i) { run += LOGF[(size_t)(b * SEQ + lane * 64 + i) * 8 + h]; CB[(size_t)bh * SEQ + lane * 64 + i] = -run * 11.313708498984761f; }
}

template <bool DUAL, class FA, class FB, class FA2, class FB2, class FE>
__global__ __launch_bounds__(256) void n_gemm(int M, int N, int K, int padarg, const int* Mdev, FA fa, FB fb, FA2 fa2, FB2 fb2, FE fe) {
    __shared__ float As[16][68], Bs[16][68], As2[DUAL ? 16 : 1][68], Bs2[DUAL ? 16 : 1][68];
    const int z = blockIdx.z, m0 = blockIdx.y * 64, n0 = blockIdx.x * 64, t = threadIdx.x, tx = t & 15, ty = t >> 4;
    const int Mr = Mdev ? Mdev[z] : M;
    if (m0 >= Mr) return;
    float acc[4][4], acc2[4][4];
#pragma unroll
    for (int i = 0; i < 4; ++i)
#pragma unroll
        for (int j = 0; j < 4; ++j) { acc[i][j] = 0.f; acc2[i][j] = 0.f; }
    for (int k0 = 0; k0 < K; k0 += 16) {
#pragma unroll
        for (int i = 0; i < 4; ++i) {
            const int idx = t + i * 256;
            { const int r = idx >> 4, c = idx & 15; const bool ok = (m0 + r) < Mr; As[c][r] = ok ? fa(z, m0 + r, k0 + c) : 0.f; if (DUAL) As2[c][r] = ok ? fa2(z, m0 + r, k0 + c) : 0.f; }
            { const int r = idx >> 6, c = idx & 63; const bool ok = (n0 + c) < N; Bs[r][c] = ok ? fb(z, k0 + r, n0 + c) : 0.f; if (DUAL) Bs2[r][c] = ok ? fb2(z, k0 + r, n0 + c) : 0.f; }
        }
        __syncthreads();
#pragma unroll
        for (int kk = 0; kk < 16; ++kk) {
            float a[4], b[4], a2[4], b2[4];
#pragma unroll
            for (int i = 0; i < 4; ++i) { a[i] = As[kk][ty * 4 + i]; b[i] = Bs[kk][tx * 4 + i]; if (DUAL) { a2[i] = As2[kk][ty * 4 + i]; b2[i] = Bs2[kk][tx * 4 + i]; } }
#pragma unroll
            for (int i = 0; i < 4; ++i)
#pragma unroll
                for (int j = 0; j < 4; ++j) { acc[i][j] += a[i] * b[j]; if (DUAL) acc2[i][j] += a2[i] * b2[j]; }
        }
        __syncthreads();
    }
#pragma unroll
    for (int i = 0; i < 4; ++i)
#pragma unroll
        for (int j = 0; j < 4; ++j) { const int m = m0 + ty * 4 + i, n = n0 + tx * 4 + j; if (m < Mr && n < N) fe(z, m, n, acc[i][j], acc2[i][j]); }
}
struct FNone { long pad; __device__ float operator()(int, int, int) const { return 0.f; } };
template <bool DUAL, class FA, class FB, class FA2, class FB2, class FE>
static void run_gemm(hipStream_t st, int Z, int M, int N, int K, const int* Mdev, FA fa, FB fb, FA2 fa2, FB2 fb2, FE fe) {
    dim3 grid((N + 63) / 64, (M + 63) / 64, Z);
    hipLaunchKernelGGL((n_gemm<DUAL, FA, FB, FA2, FB2, FE>), grid, dim3(256), 0, st, M, N, K, 0, Mdev, fa, fb, fa2, fb2, fe);
}
template <class FA, class FB, class FE>
static void run_gemm1(hipStream_t st, int Z, int M, int N, int K, const int* Mdev, FA fa, FB fb, FE fe) { run_gemm<false>(st, Z, M, N, K, Mdev, fa, fb, FNone{}, FNone{}, fe); }

struct ABf { const bf16* p; int ld, pad; __device__ float operator()(int, int m, int k) const { return bf2f(p[(size_t)m * ld + k]); } };
struct AF32 { const float* p; int ld, pad; __device__ float operator()(int, int m, int k) const { return p[(size_t)m * ld + k]; } };
struct BF32 { const float* p; int ld, pad; __device__ float operator()(int, int k, int n) const { return p[(size_t)k * ld + n]; } };
struct BF32G { const float* p; const float* g; int ld, pad; __device__ float operator()(int, int k, int n) const { return g[k] * p[(size_t)k * ld + n]; } };

struct EProj { bf16 *Q, *K, *V, *ZU, *ZV; float *TGA, *TGB;
    __device__ void operator()(int, int m, int n, float v, float) const {
        if (n < C_K) Q[(size_t)m * FW + n] = (bf16)f2bf(v);
        else if (n < C_V) K[(size_t)m * FW + n - C_K] = (bf16)f2bf(v);
        else if (n < C_F) V[(size_t)m * FW + n - C_V] = (bf16)f2bf(v);
        else if (n < C_Z) {}
        else if (n < C_Z + SGW) ZU[(size_t)m * SGW + n - C_Z] = (bf16)f2bf(gelu_tanh(v));
        else if (n < C_GA) ZV[(size_t)m * SGW + n - C_Z - SGW] = (bf16)f2bf(gelu_tanh(v));
        else if (n < C_GB) TGA[(size_t)m * DM + n - C_GA] = sigmoidf_(v);
        else TGB[(size_t)m * DM + n - C_GB] = sigmoidf_(v);
    } };
__global__ __launch_bounds__(256) void n_gates(const float* TGA, const float* TGB, bf16* GR, bf16* GS) {
    const size_t i = (size_t)blockIdx.x * 256 + threadIdx.x; const float a = TGA[i], b = TGB[i]; GR[i] = (bf16)f2bf(a / b); GS[i] = (bf16)f2bf(b);
}
__global__ __launch_bounds__(256) void n_zstat(const bf16* ZV, float* ZST) {
    __shared__ float red[4];
    const int row = blockIdx.x, t = threadIdx.x; float s = 0.f, q = 0.f;
    for (int i = 0; i < 4; ++i) { const float v = bf2f(ZV[(size_t)row * SGW + t + 256 * i]); s += v; q += v * v; }
    const float S = block_sum_256(s, red); const float Q = block_sum_256(q, red);
    if (t < 32) ZST[(size_t)row * 32 + t] = (t == 0) ? S : (t == 1) ? Q : 0.f;
}
struct AQh { const bf16* p; int ld, b, rows, pad; __device__ float operator()(int z, int m, int k) const { return bf2f(p[(size_t)(b * rows + m) * ld + z * 128 + k]); } };
struct BKh { const bf16* p; int ld, b, rows, pad; __device__ float operator()(int z, int k, int n) const { return bf2f(p[(size_t)(b * rows + n) * ld + z * 128 + k]); } };
struct BVh { const bf16* p; int ld, b, rows, pad; __device__ float operator()(int z, int k, int n) const { return bf2f(p[(size_t)(b * rows + k) * ld + z * 128 + n]); } };
struct ES { float* S; const float* CB; int b, ncol, causal, pad; __device__ void operator()(int z, int m, int n, float v, float) const {
        float s = v; if (CB) s += CB[(size_t)(b * FH + z) * SEQ + n]; s *= 0.08838834764831845f; if (causal && n > m) s = -INFINITY; S[((size_t)z * SEQ + m) * ncol + n] = s; } };
__global__ __launch_bounds__(256) void n_softmax_rows(float* S, int ncol) {
    __shared__ float red[4];
    float* r = S + (size_t)blockIdx.x * ncol; const int t = threadIdx.x;
    float mx = -INFINITY; for (int i = t; i < ncol; i += 256) mx = fmaxf(mx, r[i]);
#pragma unroll
    for (int o = 32; o > 0; o >>= 1) mx = fmaxf(mx, __shfl_xor(mx, o));
    __syncthreads(); if ((t & 63) == 0) red[t >> 6] = mx; __syncthreads();
    mx = fmaxf(fmaxf(red[0], red[1]), fmaxf(red[2], red[3]));
    float s = 0.f; for (int i = t; i < ncol; i += 256) { const float e = __expf(r[i] - mx); r[i] = e; s += e; }
    const float tot = block_sum_256(s, red); const float inv = 1.f / tot;
    for (int i = t; i < ncol; i += 256) r[i] *= inv;
}
struct AS3 { const float* S; int ncol, pad; __device__ float operator()(int z, int m, int k) const { return S[((size_t)z * SEQ + m) * ncol + k]; } };
struct EO { bf16* O; int ld, b, coff, pad; __device__ void operator()(int z, int m, int n, float v, float) const { O[(size_t)(b * SEQ + m) * ld + coff + z * 128 + n] = (bf16)f2bf(v); } };
__global__ __launch_bounds__(128) void n_spatial(const bf16* ZU, const bf16* ZV, const float* ZST, const float* ln_g, const float* ln_b, const float* w_s, const float* b_s, bf16* AS) {
    __shared__ float vn[128][129];
    const int chunk = blockIdx.x, g = blockIdx.y, c = threadIdx.x, t0 = chunk * SGC;
    for (int s = 0; s < 128; ++s) {
        const float* st = ZST + (size_t)(t0 + s) * 32; float S = 0.f, Q = 0.f;
        for (int i = 0; i < 16; ++i) { S += st[2 * i]; Q += st[2 * i + 1]; }
        const float mu = S * (1.f / SGW), var = fmaxf(Q * (1.f / SGW) - mu * mu, 0.f), rs = rsqrtf(var + LN_EPS);
        const float v = bf2f(ZV[(size_t)(t0 + s) * SGW + g * 128 + c]);
        vn[s][c] = (v - mu) * rs * ln_g[g * 128 + c] + ln_b[g * 128 + c];
    }
    __syncthreads();
    for (int t = 0; t < 128; ++t) {
        float a = 0.f; const float* w = w_s + ((size_t)g * 128 + t) * 128;
        for (int s = 0; s <= t; ++s) a += w[s] * vn[s][c];
        a += b_s[g * 128 + t];
        const float u = bf2f(ZU[(size_t)(t0 + t) * SGW + g * 128 + c]);
        AS[(size_t)(t0 + t) * DM + FW + g * 128 + c] = (bf16)f2bf(u * a);
    }
}
struct BWab { const float* wa; const float* wb; int second, pad; __device__ float operator()(int, int k, int n) const { return second ? wb[(size_t)k * DM + n] : wa[(size_t)k * DM + n]; } };
struct AAs { const bf16* p; int off, pad; __device__ float operator()(int, int m, int k) const { return bf2f(p[(size_t)m * DM + off + k]); } };
struct EMerge { const bf16 *GR, *GS; bf16* MG; __device__ void operator()(int, int m, int n, float v, float v2) const { const size_t i = (size_t)m * DM + n; MG[i] = (bf16)f2bf((v * bf2f(GR[i]) + v2) * bf2f(GS[i])); } };
struct EResid { const float* Xi; float* Xo; bf16* Xb; __device__ void operator()(int, int m, int n, float v, float) const { const size_t i = (size_t)m * DM + n; const float o = Xi[i] + v; Xo[i] = o; Xb[i] = (bf16)f2bf(o); } };
__global__ __launch_bounds__(256) void n_sumsq(const float* X, float* SS) {
    __shared__ float red[4];
    const int row = blockIdx.x, t = threadIdx.x; float q = 0.f;
    for (int i = 0; i < 8; ++i) { const float v = X[(size_t)row * DM + t + 256 * i]; q += v * v; }
    const float Q = block_sum_256(q, red);
    if (t < 32) SS[(size_t)row * 32 + t] = (t == 0) ? Q : 0.f;
}
__device__ __forceinline__ float rstd_from(const float* SS, int m) { float q = 0.f; for (int i = 0; i < 32; ++i) q += SS[(size_t)m * 32 + i]; return rsqrtf(q * (1.f / DM) + RMS_EPS); }
struct EQx { const float* SS; bf16* QX; __device__ void operator()(int, int m, int n, float v, float) const { QX[(size_t)m * XW + n] = (bf16)f2bf(v * rstd_from(SS, m)); } };
struct EKVx { bf16 *KX, *VX; __device__ void operator()(int, int m, int n, float v, float) const { if (n < XW) KX[(size_t)m * XW + n] = (bf16)f2bf(v); else VX[(size_t)m * XW + n - XW] = (bf16)f2bf(v); } };
struct ELogit { const float* SS; const float* br; float* LG; __device__ void operator()(int, int m, int n, float v, float) const { LG[(size_t)m * NE + n] = v * rstd_from(SS, m) + br[n]; } };
__global__ __launch_bounds__(256) void n_topk(const float* LG, int* TOPE, int* TOPR, float* TOPW, int* TOKL, float* GWL, unsigned* CNT, const float* SS, float* RS2) {
    const int t = blockIdx.x * 256 + threadIdx.x; if (t >= NTOK) return;
    RS2[t] = rstd_from(SS, t);
    float l[NE];
#pragma unroll
    for (int e = 0; e < NE; ++e) l[e] = LG[(size_t)t * NE + e];
    float tv[4]; int ti[4];
#pragma unroll
    for (int k = 0; k < 4; ++k) { float bv = -INFINITY; int bi = 0;
#pragma unroll
        for (int e = 0; e < NE; ++e) { if (l[e] > bv) { bv = l[e]; bi = e; } }
        tv[k] = bv; ti[k] = bi;
#pragma unroll
        for (int e = 0; e < NE; ++e) if (e == bi) l[e] = -INFINITY; }
    float s = 0.f, w[4];
#pragma unroll
    for (int k = 0; k < 4; ++k) { w[k] = __expf(tv[k] - tv[0]); s += w[k]; }
#pragma unroll
    for (int k = 0; k < 4; ++k) { const float wk = w[k] / s; const int e = ti[k]; const unsigned r = atomicAdd(&CNT[e], 1u);
        TOPE[t * 4 + k] = e; TOPR[t * 4 + k] = (int)r; TOPW[t * 4 + k] = wk; TOKL[(size_t)e * NTOK + r] = t; GWL[(size_t)e * NTOK + r] = wk; }
}
__device__ __forceinline__ int expert_base(const unsigned* CNT, int e) { int b = 0; for (int i = 0; i < e; ++i) b += ((int)CNT[i] + 255) & ~255; return b; }
struct AGath { const bf16* X; const int* TOKL; __device__ float operator()(int z, int m, int k) const { return bf2f(X[(size_t)TOKL[(size_t)z * NTOK + m] * DM + k]); } };
struct BGu { const float* w; const float* g; int up, pad; __device__ float operator()(int z, int k, int n) const { return g[k] * w[((size_t)z * DM + k) * (2 * DFF) + up * DFF + n]; } };
struct EAct { const float* SS; const int* TOKL; const float* bgu; const unsigned* CNT; bf16* HB;
    __device__ void operator()(int z, int m, int n, float v, float v2) const {
        const float rs = rstd_from(SS, TOKL[(size_t)z * NTOK + m]);
        float gate = v * rs + bgu[(size_t)z * 2 * DFF + n], up = v2 * rs + bgu[(size_t)z * 2 * DFF + DFF + n];
        gate = fminf(gate, SW_LIMIT); up = fminf(fmaxf(up, -SW_LIMIT), SW_LIMIT);
        const float act = (up + 1.f) * gate * sigmoidf_(SW_ALPHA * gate);
        HB[(size_t)(expert_base(CNT, z) + m) * DFF + n] = (bf16)f2bf(act); } };
struct AHb { const bf16* HB; const unsigned* CNT; __device__ float operator()(int z, int m, int k) const { return bf2f(HB[(size_t)(expert_base(CNT, z) + m) * DFF + k]); } };
struct BDn { const float* w; __device__ float operator()(int z, int k, int n) const { return w[((size_t)z * DFF + k) * DM + n]; } };
struct EDn { const float* bd; const float* GWL; const unsigned* CNT; bf16* YB; __device__ void operator()(int z, int m, int n, float v, float) const {
        YB[(size_t)(expert_base(CNT, z) + m) * DM + n] = (bf16)f2bf((v + bd[(size_t)z * DM + n]) * GWL[(size_t)z * NTOK + m]); } };
__global__ __launch_bounds__(256) void n_final(const float* X2, const bf16* YB, const int* TOPE, const int* TOPR, const unsigned* CNT, const float* g, float* OUT) {
    __shared__ float red[4];
    const int row = blockIdx.x, t = threadIdx.x;
    int slot[4];
#pragma unroll
    for (int k = 0; k < 4; ++k) slot[k] = expert_base(CNT, TOPE[row * 4 + k]) + TOPR[row * 4 + k];
    float v[8]; float q = 0.f;
#pragma unroll
    for (int i = 0; i < 8; ++i) { const int c = t + 256 * i; float a = X2[(size_t)row * DM + c];
#pragma unroll
        for (int k = 0; k < 4; ++k) a += bf2f(YB[(size_t)slot[k] * DM + c]);
        v[i] = a; q += a * a; }
    const float Q = block_sum_256(q, red); const float rs = rsqrtf(Q * (1.f / DM) + RMS_EPS);
#pragma unroll
    for (int i = 0; i < 8; ++i) { const int c = t + 256 * i; OUT[(size_t)row * DM + c] = v[i] * rs * g[c]; }
}

#endif
#define LAS __attribute__((address_space(3)))
#define GAS __attribute__((address_space(1)))
typedef short bf16x8 __attribute__((ext_vector_type(8)));
typedef float f32x4 __attribute__((ext_vector_type(4)));
typedef float f32x2 __attribute__((ext_vector_type(2)));
typedef unsigned u32x4 __attribute__((ext_vector_type(4)));
typedef unsigned u32x2 __attribute__((ext_vector_type(2)));

constexpr int NPROJ = 9216;
constexpr size_t WS_WP   = WS_END_NAIVE;
constexpr size_t WS_WAB  = WS_WP + 36 * MiB;
constexpr size_t WS_WO   = WS_WAB + 8 * MiB;
constexpr size_t WS_WXQ  = WS_WO + 8 * MiB;
constexpr size_t WS_WXKV = WS_WXQ + 2 * MiB;
constexpr size_t WS_WXO  = WS_WXKV + 4 * MiB;
constexpr size_t WS_WGU  = WS_WXO + 2 * MiB;
constexpr size_t WS_WD   = WS_WGU + 512 * MiB;
constexpr size_t WS_WRT  = WS_WD + 256 * MiB;
constexpr size_t WS_RS2  = WS_WRT + 1 * MiB;
constexpr size_t WS_RSL  = WS_RS2 + 1 * MiB;
constexpr size_t WS_X2Q  = WS_RSL + 2 * MiB;
constexpr size_t WS_H0Q  = WS_X2Q + 32 * MiB;
constexpr size_t WS_WPG  = WS_H0Q + 32 * MiB;
constexpr size_t WS_END  = WS_WPG + 8 * MiB;

constexpr int NWAVES = 8, NTHREADS = 512;
constexpr int LDS_STAGE = 131072;
constexpr int LDS_MISC = LDS_STAGE;
constexpr int LDS_TAB = LDS_STAGE + 256;
constexpr int LDS_BYTES = 147456;
constexpr int CW_BAR = 65536;

__device__ __forceinline__ unsigned cvt_pk_bf16(float lo, float hi) { unsigned r; asm volatile("v_cvt_pk_bf16_f32 %0, %1, %2" : "=v"(r) : "v"(lo), "v"(hi)); return r; }
constexpr float W8_SCALE = 64.f, W8_INV = 1.f / 64.f;
__device__ __forceinline__ unsigned pk4_fp8(float a, float b, float c, float d) {
    a = __builtin_amdgcn_fmed3f(a, -448.f, 448.f); b = __builtin_amdgcn_fmed3f(b, -448.f, 448.f); c = __builtin_amdgcn_fmed3f(c, -448.f, 448.f); d = __builtin_amdgcn_fmed3f(d, -448.f, 448.f);
    int w = 0; w = __builtin_amdgcn_cvt_pk_fp8_f32(a, b, w, false); w = __builtin_amdgcn_cvt_pk_fp8_f32(c, d, w, true); return (unsigned)w; }
__device__ __forceinline__ unsigned pk4_fp8_nc(float a, float b, float c, float d) {
    int w = 0; w = __builtin_amdgcn_cvt_pk_fp8_f32(a, b, w, false); w = __builtin_amdgcn_cvt_pk_fp8_f32(c, d, w, true); return (unsigned)w; }
__device__ __forceinline__ float fast_sigmoid(float x) { return __builtin_amdgcn_rcpf(1.f + __builtin_amdgcn_exp2f(-1.4426950408889634f * x)); }
__device__ __forceinline__ float fast_gelu_tanh(float x) { const float u2 = 1.5957691216057308f * (x + 0.044715f * x * x * x); return x * __builtin_amdgcn_rcpf(1.f + __builtin_amdgcn_exp2f(-1.4426950408889634f * u2)); }
__device__ __forceinline__ f32x2 gelu_tanh2(f32x2 x) { const f32x2 u = (x * x * 0.044715f + 1.0f) * x * (-1.4426950408889634f * 1.5957691216057308f);
    f32x2 e; e.x = __builtin_amdgcn_exp2f(u.x); e.y = __builtin_amdgcn_exp2f(u.y); const f32x2 d = e + 1.0f; f32x2 r; r.x = __builtin_amdgcn_rcpf(d.x); r.y = __builtin_amdgcn_rcpf(d.y); return x * r; }
__device__ __forceinline__ float wave_sum(float v) {
#pragma unroll
    for (int o = 1; o < 64; o <<= 1) v += __shfl_xor(v, o);
    return v;
}

#define XB_TMO      128
#define XB_XCNT(j)  (256  + 64 * (j))
#define XB_XSUB(j)  (1280 + 64 * (j))
#define XB_XGEN(j)  (2304 + 64 * (j))
#define XB_TOP      3328
#define XB_TOPGEN   3392
#define XCD_BAR_WORDS 3456
#define XB_SPIN_CAP (1u << 18)
__device__ __forceinline__ unsigned xb_ld(unsigned* p)              { return __hip_atomic_load(p, __ATOMIC_RELAXED, __HIP_MEMORY_SCOPE_AGENT); }
__device__ __forceinline__ unsigned xb_add(unsigned* p, unsigned v) { return __hip_atomic_fetch_add(p, v, __ATOMIC_RELAXED, __HIP_MEMORY_SCOPE_AGENT); }
__device__ __forceinline__ unsigned xb_xcc_id() { return (unsigned)__builtin_amdgcn_s_getreg((3 << 11) | 20) & 0xFu; }
#define XB_SPIN(cond, bar) do { unsigned _sp = 0; while (cond) { __builtin_amdgcn_s_sleep(1); \
    if ((++_sp & 255u) == 0u) { if (xb_ld(&(bar)[XB_TMO])) break; if (_sp > XB_SPIN_CAP) { atomicAdd(&(bar)[XB_TMO], 1u); break; } } } } while (0)
struct XcdBarrier { unsigned* bar; unsigned x; volatile LAS unsigned* st; };
__device__ __forceinline__ XcdBarrier xcd_barrier_post(unsigned* bar, volatile LAS unsigned* st) {
    XcdBarrier b; b.bar = bar; b.x = xb_xcc_id(); b.st = st;
    if (threadIdx.x == 0) (void)xb_add(&bar[XB_XCNT(b.x)], 1u);
    return b;
}
__device__ __forceinline__ void xcd_barrier_complete(unsigned* bar, unsigned x, unsigned& nloc, unsigned& nx) {
    const unsigned G = gridDim.x * gridDim.y * gridDim.z;
    unsigned sum, cnt, mine, sp = 0u;
    for (;;) {
        sum = 0u; cnt = 0u; mine = 0u;
#pragma unroll
        for (unsigned j = 0; j < 16; ++j) { const unsigned c = xb_ld(&bar[XB_XCNT(j)]); sum += c; cnt += (c > 0u) ? 1u : 0u; mine = (j == x) ? c : mine; }
        if (sum == G) break;
        __builtin_amdgcn_s_sleep(1);
        if ((++sp & 255u) == 0u) { if (xb_ld(&bar[XB_TMO])) break; if (sp > XB_SPIN_CAP) { atomicAdd(&bar[XB_TMO], 1u); break; } }
    }
    nloc = mine > 0u ? mine : 1u; nx = cnt > 0u ? cnt : 1u;
}
__device__ __forceinline__ void xcd_barrier(const XcdBarrier& b) {
    asm volatile("s_waitcnt vmcnt(0)" ::: "memory");
    __syncthreads();
    if (threadIdx.x == 0) {
        unsigned* bar = b.bar;
        __builtin_amdgcn_s_waitcnt(0);
        unsigned nloc = b.st[0], nx = b.st[1];
        if (nloc == 0u) { xcd_barrier_complete(bar, b.x, nloc, nx); b.st[0] = nloc; b.st[1] = nx; }
        const unsigned old = xb_add(&bar[XB_XSUB(b.x)], 1u);
        const unsigned gen = old / nloc;
        if (old + 1u == (gen + 1u) * nloc) {
            __builtin_amdgcn_fence(__ATOMIC_RELEASE, "agent");
            asm volatile("s_waitcnt vmcnt(0)" ::: "memory");
            const unsigned og = xb_add(&bar[XB_TOP], 1u);
            const unsigned tg = og / nx;
            if (og + 1u == (tg + 1u) * nx) xb_add(&bar[XB_TOPGEN], 1u);
            else XB_SPIN(xb_ld(&bar[XB_TOPGEN]) == tg, bar);
            __builtin_amdgcn_fence(__ATOMIC_ACQUIRE, "agent");
            xb_add(&bar[XB_XGEN(b.x)], 1u);
            asm volatile("s_waitcnt vmcnt(0)" ::: "memory");
        } else {
            XB_SPIN(xb_ld(&bar[XB_XGEN(b.x)]) == gen, bar);
            __builtin_amdgcn_fence(__ATOMIC_ACQUIRE, "agent");
            asm volatile("s_waitcnt vmcnt(0)" ::: "memory");
        }
    }
    __syncthreads();
}

namespace pg8 {
typedef int v4i_t __attribute__((ext_vector_type(4)));
typedef int v8i_t __attribute__((ext_vector_type(8)));
constexpr int BM = 256, BK = 64, HALF = 128, HTB = HALF * BK * 2, STAGE_BYTES = 8 * HTB;
__host__ __device__ __forceinline__ int lds_byte(int r, int c) { const int st = (r >> 4) * 2 + (c >> 5), rr = r & 15, cc = c & 31, ob = rr * 64 + cc * 2; return st * 1024 + (ob ^ (((ob >> 9) & 1) << 5)); }
__host__ __device__ __forceinline__ void stage_rc(int b, int& R, int& C) { const int st = b / 1024, sb = b % 1024, swz = sb ^ (((sb >> 9) & 1) << 5); R = (st >> 1) * 16 + swz / 64; C = (st & 1) * 32 + (swz % 64) / 2; }
__host__ __device__ __forceinline__ int perm32(int rho) { const int n = rho >> 4, i = rho & 15; return 8 * (i >> 2) + 4 * n + (i & 3); }

struct GUnit { const char* A; const char* B; int pm, pn, e, keep; };

template <bool GATHER, bool F8, class Epi, class Sched>
__device__ __forceinline__ void gemm_phase(LAS unsigned char* lds, const int nt, const unsigned lda, const unsigned ldb, const Sched& S, const Epi& E) {
    const int tid = threadIdx.x, wid = __builtin_amdgcn_readfirstlane(tid >> 6), lane = tid & 63, wr = wid >> 2, wc = wid & 3, fr = lane & 15, fq = lane >> 4;
    unsigned voffA[2], voffB[2]; int RA[2]; unsigned CA2[2];
#pragma unroll
    for (int i = 0; i < 2; ++i) { int R, C; stage_rc(tid * 16 + i * 8192, R, C); const int Rb = Epi::PERM ? ((R & ~31) + perm32(R & 31)) : R;
        RA[i] = R; CA2[i] = (unsigned)C * 2u; voffA[i] = (unsigned)R * lda + (unsigned)C * 2u; voffB[i] = (unsigned)Rb * ldb + (unsigned)C * 2u; }
    const size_t kstep = (size_t)(BK * 2);
    const size_t hA = GATHER ? 0 : (size_t)HALF * lda, hB = (size_t)HALF * ldb;
    const unsigned ldsw = (unsigned)wid * 1024u;
    const int aoff = lds_byte(wr * 64 + fr, fq * 8), boff = lds_byte(wc * 32 + fr, fq * 8);
    LAS unsigned char* const ldsB = lds + 4 * HTB;
#define PG8_SA(b, h) (((b) * 2 + (h)) * HTB)
#define PG8_SB(b, h) ((4 + (b) * 2 + (h)) * HTB)
#define PG8_STAGE(bufoff, gbase, voff) do { _Pragma("unroll") for (int _i = 0; _i < 2; ++_i) \
        __builtin_amdgcn_global_load_lds((const unsigned*)((const char*)(gbase) + (voff)[_i]), (LAS unsigned*)(lds + (bufoff) + ldsw + _i * 8192), 16, 0, 0); } while (0)
#define PG8_SBR(b, h) (((b) * 2 + (h)) * HTB)
#define PG8_LD8(base, off) __builtin_shufflevector(*(const LAS v4i_t*)((base) + (off)), *(const LAS v4i_t*)((base) + (off) + 1024), 0, 1, 2, 3, 4, 5, 6, 7)
#define PG8_LDA(dst, b, h) do { if constexpr (F8) { _Pragma("unroll") for (int m = 0; m < 4; ++m) dst##8[m] = PG8_LD8(lds, PG8_SA(b, h) + aoff + m * 2048); } \
        else { _Pragma("unroll") for (int m = 0; m < 4; ++m) _Pragma("unroll") for (int k = 0; k < 2; ++k) dst[m][k] = *(const LAS bf16x8*)(lds + PG8_SA(b, h) + aoff + m * 2048 + k * 1024); } } while (0)
#define PG8_LDB(dst, b, h) do { if constexpr (F8) { _Pragma("unroll") for (int n = 0; n < 2; ++n) dst##8[n] = PG8_LD8(ldsB, PG8_SBR(b, h) + boff + n * 2048); } \
        else { _Pragma("unroll") for (int n = 0; n < 2; ++n) _Pragma("unroll") for (int k = 0; k < 2; ++k) dst[n][k] = *(const LAS bf16x8*)(ldsB + PG8_SBR(b, h) + boff + n * 2048 + k * 1024); } } while (0)
#define PG8_MMA(ai, bj, At, Bt) do { __builtin_amdgcn_s_setprio(1); \
        if constexpr (F8) { _Pragma("unroll") for (int m = 0; m < 4; ++m) _Pragma("unroll") for (int n = 0; n < 2; ++n) \
            asm volatile("v_mfma_scale_f32_16x16x128_f8f6f4 %0, %1, %2, %0, %3, %3 op_sel_hi:[0,0,0]" : "+v"(acc[ai][bj][m][n]) : "v"(Bt##8[n]), "v"(At##8[m]), "v"(sc8)); } \
        else { _Pragma("unroll") for (int m = 0; m < 4; ++m) _Pragma("unroll") for (int n = 0; n < 2; ++n) _Pragma("unroll") for (int k = 0; k < 2; ++k) \
            acc[ai][bj][m][n] = __builtin_amdgcn_mfma_f32_16x16x32_bf16(Bt[n][k], At[m][k], acc[ai][bj][m][n], 0, 0, 0); } \
        __builtin_amdgcn_s_setprio(0); } while (0)
#define PG8_WAIT_V(n) asm volatile("s_waitcnt vmcnt(" #n ")" ::: "memory")
#define PG8_WAIT_L(n) asm volatile("s_waitcnt lgkmcnt(" #n ")" ::: "memory")
#define PG8_BAR __builtin_amdgcn_s_barrier()
#define PG8_SCHED __builtin_amdgcn_sched_barrier(0)
    GUnit cur, nxt; int ui = 0;
    if (!S.next(0, cur)) return;
    f32x4 acc[2][2][4][2];
#pragma unroll
    for (int a = 0; a < 2; ++a)
#pragma unroll
        for (int b = 0; b < 2; ++b)
#pragma unroll
            for (int m = 0; m < 4; ++m)
#pragma unroll
                for (int n = 0; n < 2; ++n) acc[a][b][m][n] = (f32x4){0.f, 0.f, 0.f, 0.f};
    bf16x8 At[4][2], B0[2][2], B1[2][2]; v8i_t At8[4], B08[2], B18[2];
    const int sc8 = 0x7f7f7f7f;
    const char* cA = cur.A; const char* cB = cur.B;
    unsigned vA0[2], vA1[2], vN0[2], vN1[2];
    if constexpr (GATHER) {
#pragma unroll
        for (int i = 0; i < 2; ++i) { vA0[i] = (unsigned)S.arow(cur, RA[i]) * lda + CA2[i]; vA1[i] = (unsigned)S.arow(cur, HALF + RA[i]) * lda + CA2[i]; }
        asm volatile("" : "+v"(vA0[0]), "+v"(vA0[1]), "+v"(vA1[0]), "+v"(vA1[1]));
    } else {
#pragma unroll
        for (int i = 0; i < 2; ++i) { vA0[i] = voffA[i]; vA1[i] = voffA[i]; }
    }
    PG8_STAGE(PG8_SB(0, 0), cB, voffB); PG8_STAGE(PG8_SB(0, 1), cB + hB, voffB); PG8_STAGE(PG8_SA(0, 0), cA, vA0); PG8_STAGE(PG8_SA(0, 1), cA + hA, vA1);
    if (wr == 1) PG8_BAR;
    PG8_WAIT_V(2); PG8_BAR;
    PG8_STAGE(PG8_SB(1, 0), cB + kstep, voffB); PG8_STAGE(PG8_SA(1, 0), cA + kstep, vA0); PG8_STAGE(PG8_SB(1, 1), cB + hB + kstep, voffB);
    PG8_WAIT_V(6); PG8_BAR;
    for (;;) {
        const bool has_next = S.next(ui + 1, nxt);
        const char* nA = has_next ? nxt.A : cA; const char* nB = has_next ? nxt.B : cB;
        if constexpr (GATHER) {
            if (has_next) {
#pragma unroll
                for (int i = 0; i < 2; ++i) { vN0[i] = (unsigned)S.arow(nxt, RA[i]) * lda + CA2[i]; vN1[i] = (unsigned)S.arow(nxt, HALF + RA[i]) * lda + CA2[i]; }
            } else {
#pragma unroll
                for (int i = 0; i < 2; ++i) { vN0[i] = vA0[i]; vN1[i] = vA1[i]; }
            }
            asm volatile("" : "+v"(vN0[0]), "+v"(vN0[1]), "+v"(vN1[0]), "+v"(vN1[1]));
        }
        for (int t = 0; t < nt; t += 2) {
            const bool last = (t == nt - 2);
            const char* a1 = cA + (size_t)(t + 1) * kstep;
            const char* a2 = last ? nA : cA + (size_t)(t + 2) * kstep; const char* b2 = last ? nB : cB + (size_t)(t + 2) * kstep;
            const char* a3 = a2 + kstep; const char* b3 = b2 + kstep;
            unsigned w0[2], w1[2];
            if constexpr (GATHER) {
#pragma unroll
                for (int i = 0; i < 2; ++i) { w0[i] = last ? vN0[i] : vA0[i]; w1[i] = last ? vN1[i] : vA1[i]; }
            } else {
#pragma unroll
                for (int i = 0; i < 2; ++i) { w0[i] = voffA[i]; w1[i] = voffA[i]; }
            }
            PG8_LDB(B0, 0, 0); PG8_LDB(B1, 0, 1); PG8_SCHED; PG8_LDA(At, 0, 0); PG8_STAGE(PG8_SA(1, 1), a1 + hA, vA1);
            PG8_WAIT_V(8); PG8_WAIT_L(0); PG8_BAR; PG8_MMA(0, 0, At, B0); PG8_MMA(0, 1, At, B1); PG8_BAR; PG8_SCHED;
            PG8_LDA(At, 0, 1); PG8_STAGE(PG8_SB(0, 0), b2, voffB); PG8_STAGE(PG8_SB(0, 1), b2 + hB, voffB); PG8_STAGE(PG8_SA(0, 0), a2, w0);
            PG8_WAIT_V(8); PG8_WAIT_L(0); PG8_BAR; PG8_MMA(1, 0, At, B0); PG8_MMA(1, 1, At, B1); PG8_BAR; PG8_SCHED;
            PG8_LDB(B0, 1, 0); PG8_LDB(B1, 1, 1); PG8_SCHED; PG8_LDA(At, 1, 0); PG8_STAGE(PG8_SA(0, 1), a2 + hA, w1);
            PG8_WAIT_V(8); PG8_WAIT_L(0); PG8_BAR; PG8_MMA(0, 0, At, B0); PG8_MMA(0, 1, At, B1); PG8_BAR; PG8_SCHED;
            PG8_LDA(At, 1, 1); PG8_STAGE(PG8_SB(1, 0), b3, voffB); PG8_STAGE(PG8_SB(1, 1), b3 + hB, voffB); PG8_STAGE(PG8_SA(1, 0), a3, w0);
            PG8_WAIT_V(8); PG8_WAIT_L(0); PG8_BAR; PG8_MMA(1, 0, At, B0); PG8_MMA(1, 1, At, B1); PG8_BAR; PG8_SCHED;
        }
        if (wr == 0) PG8_BAR;
        E(acc, cur, wr, wc, fr, fq);
        if (!has_next) break;
        if (!cur.keep) {
#pragma unroll
            for (int a = 0; a < 2; ++a)
#pragma unroll
                for (int b = 0; b < 2; ++b)
#pragma unroll
                    for (int m = 0; m < 4; ++m)
#pragma unroll
                        for (int n = 0; n < 2; ++n) acc[a][b][m][n] = (f32x4){0.f, 0.f, 0.f, 0.f};
        }
        cur = nxt; cA = nA; cB = nB; ++ui;
        if constexpr (GATHER) {
#pragma unroll
            for (int i = 0; i < 2; ++i) { vA0[i] = vN0[i]; vA1[i] = vN1[i]; }
        }
        if (wr == 1) PG8_BAR;
    }
    PG8_WAIT_V(0);
    PG8_BAR;
#undef PG8_SA
#undef PG8_SB
#undef PG8_STAGE
#undef PG8_LDA
#undef PG8_LDB
#undef PG8_MMA
#undef PG8_LD8
#undef PG8_SBR
#undef PG8_WAIT_V
#undef PG8_WAIT_L
#undef PG8_BAR
#undef PG8_SCHED
}

struct TileOrder {
    int nM, nN, nwg, G, c;
    __device__ void init(int nM_, int nN_, int G_, int c_) { nM = nM_; nN = nN_; nwg = nM * nN; G = G_; c = c_; }
    __device__ bool tile(int i, int& pm, int& pn) const { return tileL((long)i * G + c, pm, pn); }
    __device__ bool tileL(long L, int& pm, int& pn) const {
        if (L < 0 || L >= nwg) return false;
        int wgid = (int)L; { const int q = nwg / 8, r = nwg % 8, xcd = wgid % 8, off = wgid / 8; wgid = (xcd < r ? xcd * (q + 1) : r * (q + 1) + (xcd - r) * q) + off; }
        const int nig = 4 * nN, gid = wgid / nig, fm = gid * 4, gsz = (nM - fm) < 4 ? (nM - fm) : 4;
        pm = fm + ((wgid % nig) % gsz); pn = (wgid % nig) / gsz; return true;
    }
};
constexpr int P1_CO = 2, P1_NC = P1_CO * 32, P1_NG = 256 - P1_NC, P1_UG = 12, P1_UC = 0, P1_NBF = 20, P1_NF8 = 16;
static_assert(P1_NG * P1_UG + P1_NC * P1_UC == (NTOK / 256) * (NPROJ / 256) && (P1_NBF + P1_NF8) * 256 == NPROJ, "P1 unit deal");
struct ProjSched {
    TileOrder T; const char* A; const char* B; unsigned lda, ldb; int conv, idx;
    __device__ bool next(int i, GUnit& u) const { const long L = conv ? -1 : (long)i * P1_NG + idx; int pm, pn; if (!T.tileL(L, pm, pn)) return false;
        u.pm = pm; u.pn = pn; u.e = 0; u.keep = 0; u.A = A + (size_t)pm * 256 * lda; u.B = B + (size_t)pn * 256 * ldb; return true; }
    __device__ int arow(const GUnit&, int) const { return 0; }
};
struct PlainSched {
    TileOrder T; const char* A; const char* B; unsigned lda, ldb;
    __device__ bool next(int i, GUnit& u) const { int pm, pn; if (!T.tile(i, pm, pn)) return false; u.pm = pm; u.pn = pn; u.e = 0; u.keep = 0;
        u.A = A + (size_t)pm * 256 * lda; u.B = B + (size_t)pn * 256 * ldb; return true; }
    __device__ int arow(const GUnit&, int) const { return 0; }
};

struct EpiProj {
    static constexpr bool PERM = true;
    unsigned char* ws; int pn0; float gsc;
    __device__ __forceinline__ void operator()(f32x4 (&acc)[2][2][4][2], const GUnit& u, int wr, int wc, int fr, int fq) const {
        const int row0 = u.pm * BM + wr * 64 + fr, pn = u.pn + pn0;
        if (pn < 12) {
            static_assert(WS_K - WS_Q == WS_V - WS_K, "q|k|v spacing"); bf16* base = (bf16*)(ws + WS_Q + (size_t)(pn >> 2) * (WS_K - WS_Q)); const int col0 = (pn & 3) * 256 + wc * 32 + 8 * fq;
            float nmax[2] = {0.f, 0.f};
#pragma unroll
            for (int ai = 0; ai < 2; ++ai)
#pragma unroll
                for (int m = 0; m < 4; ++m) { bf16* rowp = base + (size_t)(row0 + ai * HALF + m * 16) * FW + col0;
#pragma unroll
                    for (int bj = 0; bj < 2; ++bj) { const f32x4 v0 = acc[ai][bj][m][0], v1 = acc[ai][bj][m][1];
                        if (pn < 8) { float q2 = (v0[0] * v0[0] + v0[1] * v0[1]) + (v0[2] * v0[2] + v0[3] * v0[3]) + (v1[0] * v1[0] + v1[1] * v1[1]) + (v1[2] * v1[2] + v1[3] * v1[3]);
                            q2 += __shfl_xor(q2, 16); q2 += __shfl_xor(q2, 32); nmax[bj] = fmaxf(nmax[bj], q2); }
                        u32x4 w; w.x = cvt_pk_bf16(v0[0], v0[1]); w.y = cvt_pk_bf16(v0[2], v0[3]); w.z = cvt_pk_bf16(v1[0], v1[1]); w.w = cvt_pk_bf16(v1[2], v1[3]);
                        *(u32x4*)(rowp + bj * HALF) = w; } }
            if (pn < 8) {
#pragma unroll
                for (int bj = 0; bj < 2; ++bj) { float v = nmax[bj]; v = fmaxf(v, __shfl_xor(v, 1)); v = fmaxf(v, __shfl_xor(v, 2)); v = fmaxf(v, __shfl_xor(v, 4)); v = fmaxf(v, __shfl_xor(v, 8));
                    if (fr == 0 && fq == 0) atomicMax((unsigned*)(ws + WS_CTL) + CW_NRM + (((pn >> 2) * 4 + (u.pm >> 4)) * 8 + (pn & 3) * 2 + bj) * 4 + wc, __float_as_uint(v)); }
            }
        } else if (pn < 20) {
            const bool isv = pn >= 16; bf16* base = (bf16*)(ws + WS_ZU + (size_t)(isv ? 1 : 0) * (WS_ZV - WS_ZU)); float* ZST = (float*)(ws + WS_ZST); const int col0 = ((pn - 12) & 3) * 256 + wc * 32 + 8 * fq;
#pragma unroll
            for (int ai = 0; ai < 2; ++ai)
#pragma unroll
                for (int m = 0; m < 4; ++m) { const int row = row0 + ai * HALF + m * 16; bf16* rowp = base + (size_t)row * SGW + col0; float s = 0.f, q = 0.f;
#pragma unroll
                    for (int bj = 0; bj < 2; ++bj) { f32x4 v0 = acc[ai][bj][m][0], v1 = acc[ai][bj][m][1];
                        { const f32x2 a = gelu_tanh2((f32x2){v0[0], v0[1]}), b = gelu_tanh2((f32x2){v0[2], v0[3]}), c = gelu_tanh2((f32x2){v1[0], v1[1]}), d = gelu_tanh2((f32x2){v1[2], v1[3]});
                          v0 = (f32x4){a.x, a.y, b.x, b.y}; v1 = (f32x4){c.x, c.y, d.x, d.y};
                          if (isv) { const f32x2 s2 = (a + b) + (c + d), q2 = (a * a + b * b) + (c * c + d * d); s += s2.x + s2.y; q += q2.x + q2.y; } }
                        u32x4 w; w.x = cvt_pk_bf16(v0[0], v0[1]); w.y = cvt_pk_bf16(v0[2], v0[3]); w.z = cvt_pk_bf16(v1[0], v1[1]); w.w = cvt_pk_bf16(v1[2], v1[3]);
                        *(u32x4*)(rowp + bj * HALF) = w; }
                    if (isv) { s += __shfl_xor(s, 16); s += __shfl_xor(s, 32); q += __shfl_xor(q, 16); q += __shfl_xor(q, 32);
                        if (fq == 0) *(f32x2*)(ZST + (size_t)row * 32 + ((pn - 16) * 4 + wc) * 2) = (f32x2){s, q}; } }
        } else {
            const int col0 = (pn - 20) * 128 + wc * 32 + 8 * fq; bf16* GR = (bf16*)(ws + WS_GR); bf16* GS = (bf16*)(ws + WS_GS);
#pragma unroll
            for (int ai = 0; ai < 2; ++ai)
#pragma unroll
                for (int m = 0; m < 4; ++m) { const size_t off = (size_t)(row0 + ai * HALF + m * 16) * DM + col0; float r[8], sb[8];
#pragma unroll
                    for (int n = 0; n < 2; ++n)
#pragma unroll
                        for (int p = 0; p < 2; ++p) { const f32x2 ya = (f32x2){acc[ai][0][m][n][2 * p], acc[ai][0][m][n][2 * p + 1]} * gsc, yb = (f32x2){acc[ai][1][m][n][2 * p], acc[ai][1][m][n][2 * p + 1]} * gsc;
                            f32x2 ea, eb; ea.x = __builtin_amdgcn_exp2f(ya.x); ea.y = __builtin_amdgcn_exp2f(ya.y); eb.x = __builtin_amdgcn_exp2f(yb.x); eb.y = __builtin_amdgcn_exp2f(yb.y);
                            const f32x2 da = ea + 1.0f, db = eb + 1.0f; f32x2 ra, rb; ra.x = __builtin_amdgcn_rcpf(da.x); ra.y = __builtin_amdgcn_rcpf(da.y); rb.x = __builtin_amdgcn_rcpf(db.x); rb.y = __builtin_amdgcn_rcpf(db.y);
                            const f32x2 rr = db * ra; sb[n * 4 + 2 * p] = rb.x; sb[n * 4 + 2 * p + 1] = rb.y; r[n * 4 + 2 * p] = rr.x; r[n * 4 + 2 * p + 1] = rr.y; }
                    u32x4 w; w.x = cvt_pk_bf16(r[0], r[1]); w.y = cvt_pk_bf16(r[2], r[3]); w.z = cvt_pk_bf16(r[4], r[5]); w.w = cvt_pk_bf16(r[6], r[7]);
                    *(u32x4*)(GR + off) = w;
                    w.x = cvt_pk_bf16(sb[0], sb[1]); w.y = cvt_pk_bf16(sb[2], sb[3]); w.z = cvt_pk_bf16(sb[4], sb[5]); w.w = cvt_pk_bf16(sb[6], sb[7]);
                    *(u32x4*)(GS + off) = w; }
        }
    }
};
struct MergeSched {
    TileOrder T; const char* A; const char* B; unsigned lda, ldb;
    __device__ bool next(int i, GUnit& u) const { int pm, pn; if (!T.tile(i >> 1, pm, pn)) return false; const int half = i & 1; u.pm = pm; u.pn = pn; u.e = 0; u.keep = half ^ 1;
        u.A = A + (size_t)pm * 256 * lda + half * (FW * 2); u.B = B + (size_t)pn * 256 * ldb + half * (FW * 2); return true; }
    __device__ int arow(const GUnit&, int) const { return 0; }
};
struct EpiMerge {
    static constexpr bool PERM = true;
    unsigned char* ws;
    __device__ __forceinline__ void operator()(f32x4 (&acc)[2][2][4][2], const GUnit& u, int wr, int wc, int fr, int fq) const {
        const int row0 = u.pm * BM + wr * 64 + fr, col0 = u.pn * 256 + wc * 32 + 8 * fq;
        const bf16* G = (const bf16*)(ws + (u.keep ? WS_GR : WS_GS)); bf16* MG = (bf16*)(ws + WS_MG);
#pragma unroll
        for (int ai = 0; ai < 2; ++ai) {
            u32x4 gv[4][2];
#pragma unroll
            for (int m = 0; m < 4; ++m)
#pragma unroll
                for (int bj = 0; bj < 2; ++bj) gv[m][bj] = *(const u32x4*)(G + (size_t)(row0 + ai * HALF + m * 16) * DM + col0 + bj * HALF);
#pragma unroll
            for (int m = 0; m < 4; ++m) { const size_t off = (size_t)(row0 + ai * HALF + m * 16) * DM + col0;
#pragma unroll
                for (int bj = 0; bj < 2; ++bj) { const u32x4 g = gv[m][bj];
                    f32x4 v0 = acc[ai][bj][m][0], v1 = acc[ai][bj][m][1];
                    v0[0] *= __builtin_bit_cast(float, g.x << 16); v0[1] *= __builtin_bit_cast(float, g.x & 0xffff0000u); v0[2] *= __builtin_bit_cast(float, g.y << 16); v0[3] *= __builtin_bit_cast(float, g.y & 0xffff0000u);
                    v1[0] *= __builtin_bit_cast(float, g.z << 16); v1[1] *= __builtin_bit_cast(float, g.z & 0xffff0000u); v1[2] *= __builtin_bit_cast(float, g.w << 16); v1[3] *= __builtin_bit_cast(float, g.w & 0xffff0000u);
                    if (u.keep) { acc[ai][bj][m][0] = v0; acc[ai][bj][m][1] = v1; }
                    else { u32x4 w; w.x = cvt_pk_bf16(v0[0], v0[1]); w.y = cvt_pk_bf16(v0[2], v0[3]); w.z = cvt_pk_bf16(v1[0], v1[1]); w.w = cvt_pk_bf16(v1[2], v1[3]); *(u32x4*)(MG + off + bj * HALF) = w; } } } }
    }
};
template <bool RB, bool WF>
struct EpiResid {
    static constexpr bool PERM = true;
    const void* Xi; float* Xo; bf16* Xb; float* SS; unsigned char* Xq;
    __device__ __forceinline__ void operator()(f32x4 (&acc)[2][2][4][2], const GUnit& u, int wr, int wc, int fr, int fq) const {
        const int row0 = u.pm * BM + wr * 64 + fr, col0 = u.pn * 256 + wc * 32 + 8 * fq;
        typedef typename std::conditional<RB, u32x4, f32x4>::type rv_t;
        constexpr int NV = RB ? 1 : 2, GB = 4;
#pragma unroll
        for (int g0 = 0; g0 < 8; g0 += GB) {
            rv_t xr[GB][2][NV];
#pragma unroll
            for (int gg = 0; gg < GB; ++gg) { const int gi = g0 + gg; const size_t offl = (size_t)(row0 + (gi >> 2) * HALF + (gi & 3) * 16) * DM + col0;
#pragma unroll
                for (int bj = 0; bj < 2; ++bj) {
                    if constexpr (RB) xr[gg][bj][0] = *(const u32x4*)((const bf16*)Xi + offl + bj * HALF);
                    else { xr[gg][bj][0] = *(const f32x4*)((const float*)Xi + offl + bj * HALF); xr[gg][bj][NV - 1] = *(const f32x4*)((const float*)Xi + offl + bj * HALF + 4); } } }
#pragma unroll
            for (int gg = 0; gg < GB; ++gg) { const int gi = g0 + gg, ai = gi >> 2, m = gi & 3; const int row = row0 + ai * HALF + m * 16; const size_t off = (size_t)row * DM + col0; float q = 0.f;
#pragma unroll
                for (int bj = 0; bj < 2; ++bj) { const size_t o = off + bj * HALF; f32x4 r0, r1;
                    if constexpr (RB) { const u32x4 r = xr[gg][bj][0];
                        r0 = (f32x4){__builtin_bit_cast(float, r.x << 16), __builtin_bit_cast(float, r.x & 0xffff0000u), __builtin_bit_cast(float, r.y << 16), __builtin_bit_cast(float, r.y & 0xffff0000u)};
                        r1 = (f32x4){__builtin_bit_cast(float, r.z << 16), __builtin_bit_cast(float, r.z & 0xffff0000u), __builtin_bit_cast(float, r.w << 16), __builtin_bit_cast(float, r.w & 0xffff0000u)}; }
                    else { r0 = xr[gg][bj][0]; r1 = xr[gg][bj][NV - 1]; }
                    const f32x4 v0 = r0 + acc[ai][bj][m][0], v1 = r1 + acc[ai][bj][m][1];
                    if constexpr (WF) { *(f32x4*)(Xo + o) = v0; *(f32x4*)(Xo + o + 4) = v1; }
                    q += ((v0[0] * v0[0] + v0[1] * v0[1]) + (v0[2] * v0[2] + v0[3] * v0[3])) + ((v1[0] * v1[0] + v1[1] * v1[1]) + (v1[2] * v1[2] + v1[3] * v1[3]));
                    if (Xb) { u32x4 w; w.x = cvt_pk_bf16(v0[0], v0[1]); w.y = cvt_pk_bf16(v0[2], v0[3]); w.z = cvt_pk_bf16(v1[0], v1[1]); w.w = cvt_pk_bf16(v1[2], v1[3]); *(u32x4*)(Xb + o) = w; }
                    if (Xq) { u32x2 w8; w8.x = pk4_fp8(v0[0], v0[1], v0[2], v0[3]); w8.y = pk4_fp8(v1[0], v1[1], v1[2], v1[3]); *(u32x2*)(Xq + o) = w8; } }
                q += __shfl_xor(q, 16); q += __shfl_xor(q, 32);
                if (fq == 0) SS[(size_t)row * 32 + u.pn * 4 + wc] = q; }
        }
    }
};
struct QkvSched {
    const char* X1B; const char* WXQ; const char* HM; const char* WXKV; int c;
    __device__ bool next(int i, GUnit& u) const { if (i > 0 || c >= 144) return false; u.keep = 0;
        if (c < 128) { u.e = 0; u.pm = c >> 1; u.pn = c & 1; u.A = X1B + (size_t)u.pm * 256 * (DM * 2); u.B = WXQ + (size_t)u.pn * 256 * (DM * 2); }
        else { const int j = c - 128; u.e = 1; u.pm = j >> 2; u.pn = j & 3; u.A = HM + (size_t)u.pm * 256 * (DM * 2); u.B = WXKV + (size_t)u.pn * 256 * (DM * 2); }
        return true; }
    __device__ int arow(const GUnit&, int) const { return 0; }
};
struct EpiQkv {
    static constexpr bool PERM = true;
    unsigned char* ws;
    __device__ __forceinline__ void operator()(f32x4 (&acc)[2][2][4][2], const GUnit& u, int wr, int wc, int fr, int fq) const {
        const int row0 = u.pm * BM + wr * 64 + fr; const float* SS = (const float*)(ws + WS_SS1);
        bf16* base = u.e ? (bf16*)(ws + WS_KX + (size_t)(u.pn >> 1) * (WS_VX - WS_KX)) + (u.pn & 1) * 256 : (bf16*)(ws + WS_QX) + u.pn * 256;
        float rsv[8];
#pragma unroll
        for (int gi = 0; gi < 8; ++gi) rsv[gi] = 1.f;
        if (!u.e) { f32x4 pp[8][2];
#pragma unroll
            for (int gi = 0; gi < 8; ++gi) { const int row = row0 + (gi >> 2) * HALF + (gi & 3) * 16; pp[gi][0] = *(const f32x4*)(SS + (size_t)row * 32 + fq * 8); pp[gi][1] = *(const f32x4*)(SS + (size_t)row * 32 + fq * 8 + 4); }
#pragma unroll
            for (int gi = 0; gi < 8; ++gi) { const f32x4 p0 = pp[gi][0], p1 = pp[gi][1];
                float q = ((p0[0] + p0[1]) + (p0[2] + p0[3])) + ((p1[0] + p1[1]) + (p1[2] + p1[3])); q += __shfl_xor(q, 16); q += __shfl_xor(q, 32); rsv[gi] = rsqrtf(q * (1.f / DM) + RMS_EPS); } }
#pragma unroll
        for (int ai = 0; ai < 2; ++ai)
#pragma unroll
            for (int m = 0; m < 4; ++m) { const int row = row0 + ai * HALF + m * 16; const float rs = rsv[ai * 4 + m];
                bf16* rowp = base + (size_t)row * XW + wc * 32 + 8 * fq;
#pragma unroll
                for (int bj = 0; bj < 2; ++bj) { const f32x4 v0 = acc[ai][bj][m][0] * rs, v1 = acc[ai][bj][m][1] * rs;
                    u32x4 w; w.x = cvt_pk_bf16(v0[0], v0[1]); w.y = cvt_pk_bf16(v0[2], v0[3]); w.z = cvt_pk_bf16(v1[0], v1[1]); w.w = cvt_pk_bf16(v1[2], v1[3]);
                    *(u32x4*)(rowp + bj * HALF) = w; } }
    }
};
struct MoeSched {
    const LAS int* tab; const char* A; const char* B; const int* TOKL; int G, c, npn; unsigned ldb; size_t erows;
    __device__ bool next(int i, GUnit& u) const {
        const int x = c & 7, j = c >> 3; const int T = npn == 16 ? i * 16 + 4 * (x >> 1) + (j & 3) : i * 32 + 4 * x + (j & 3); const int pnl = npn == 16 ? 8 * (x & 1) + (j >> 2) : (j >> 2);
        if (T >= tab[32]) return false;
        int e = 0;
#pragma unroll 1
        for (int j = 1; j < 32; ++j) e += (tab[j] <= T) ? 1 : 0;
        u.e = e; u.pm = T; u.pn = pnl; u.keep = 0; u.A = A; u.B = B + ((size_t)e * erows + (size_t)u.pn * 256) * ldb; return true; }
    __device__ int arow(const GUnit& u, int r) const { const int rank = (u.pm - tab[u.e]) * 256 + r; return rank < tab[40 + u.e] ? TOKL[(size_t)u.e * NTOK + rank] : 0; }
};
struct DownSched : MoeSched {
    unsigned lda;
    __device__ bool next(int i, GUnit& u) const { if (!MoeSched::next(i, u)) return false; u.A = A + (size_t)u.pm * 256 * lda; return true; }
};
struct EpiAct {
    static constexpr bool PERM = true;
    unsigned char* ws; const LAS int* tab; const float* bgu;
    __device__ __forceinline__ void operator()(f32x4 (&acc)[2][2][4][2], const GUnit& u, int wr, int wc, int fr, int fq) const {
        const int r0 = wr * 64 + fr, j0 = u.pn * 128 + wc * 32 + 8 * fq, rbase = (u.pm - tab[u.e]) * 256, cnt = tab[40 + u.e];
        const int* TOKL = (const int*)(ws + WS_TOKL) + (size_t)u.e * NTOK; const float* RS2 = (const float*)(ws + WS_RS2); unsigned char* HB = ws + WS_HB;
        const float* bg = bgu + (size_t)u.e * 2 * DFF + j0;
        const f32x4 bg0 = *(const f32x4*)bg, bg1 = *(const f32x4*)(bg + 4), bu0 = *(const f32x4*)(bg + DFF), bu1 = *(const f32x4*)(bg + DFF + 4);
        float rsv[8]; const float* RSL = (const float*)(ws + WS_RSL) + (size_t)u.e * NTOK;
#pragma unroll
        for (int gi = 0; gi < 8; ++gi) { const int rank = rbase + r0 + (gi >> 2) * HALF + (gi & 3) * 16; rsv[gi] = rank < cnt ? RSL[rank] : 0.f; }
#pragma unroll
        for (int ai = 0; ai < 2; ++ai)
#pragma unroll
            for (int m = 0; m < 4; ++m) { const int r = r0 + ai * HALF + m * 16; const float rs = rsv[ai * 4 + m] * W8_INV;
                float a[8];
#pragma unroll
                for (int n = 0; n < 2; ++n)
#pragma unroll
                    for (int p = 0; p < 2; ++p) { const f32x2 rs2 = (f32x2){rs, rs};
                        const f32x2 bg2 = n ? (f32x2){bg1[2 * p], bg1[2 * p + 1]} : (f32x2){bg0[2 * p], bg0[2 * p + 1]}, bu2 = n ? (f32x2){bu1[2 * p], bu1[2 * p + 1]} : (f32x2){bu0[2 * p], bu0[2 * p + 1]};
                        f32x2 g2 = (f32x2){acc[ai][0][m][n][2 * p], acc[ai][0][m][n][2 * p + 1]} * rs2 + bg2, u2 = (f32x2){acc[ai][1][m][n][2 * p], acc[ai][1][m][n][2 * p + 1]} * rs2 + bu2;
                        g2.x = fminf(g2.x, SW_LIMIT); g2.y = fminf(g2.y, SW_LIMIT); u2.x = __builtin_amdgcn_fmed3f(u2.x, -SW_LIMIT, SW_LIMIT); u2.y = __builtin_amdgcn_fmed3f(u2.y, -SW_LIMIT, SW_LIMIT);
                        const f32x2 y2 = g2 * (-1.4426950408889634f * SW_ALPHA); f32x2 e2; e2.x = __builtin_amdgcn_exp2f(y2.x); e2.y = __builtin_amdgcn_exp2f(y2.y);
                        const f32x2 d2 = e2 + 1.0f; f32x2 r2; r2.x = __builtin_amdgcn_rcpf(d2.x); r2.y = __builtin_amdgcn_rcpf(d2.y);
                        const f32x2 o2 = ((u2 + 1.0f) * g2) * r2; a[n * 4 + 2 * p] = o2.x; a[n * 4 + 2 * p + 1] = o2.y; }
                u32x2 w; w.x = pk4_fp8_nc(a[0], a[1], a[2], a[3]); w.y = pk4_fp8_nc(a[4], a[5], a[6], a[7]);
                *(u32x2*)(HB + (size_t)(u.pm * 256 + r) * DFF + j0) = w; }
    }
};
struct EpiDown {
    static constexpr bool PERM = true;
    unsigned char* ws; const LAS int* tab; const float* bd;
    __device__ __forceinline__ void operator()(f32x4 (&acc)[2][2][4][2], const GUnit& u, int wr, int wc, int fr, int fq) const {
        const int r0 = wr * 64 + fr, c0 = u.pn * 256 + wc * 32 + 8 * fq, rbase = (u.pm - tab[u.e]) * 256;
        const float* GWL = (const float*)(ws + WS_GWL) + (size_t)u.e * NTOK; unsigned char* YB = ws + WS_YB;
        const float* b = bd + (size_t)u.e * DM + c0;
        f32x4 bv[2][2];
#pragma unroll
        for (int bj = 0; bj < 2; ++bj) { bv[bj][0] = *(const f32x4*)(b + bj * HALF); bv[bj][1] = *(const f32x4*)(b + bj * HALF + 4); }
        float gwv[8];
#pragma unroll
        for (int gi = 0; gi < 8; ++gi) gwv[gi] = GWL[rbase + r0 + (gi >> 2) * HALF + (gi & 3) * 16];
#pragma unroll
        for (int ai = 0; ai < 2; ++ai)
#pragma unroll
            for (int m = 0; m < 4; ++m) { const int r = r0 + ai * HALF + m * 16; const float gw = gwv[ai * 4 + m];
#pragma unroll
                for (int bj = 0; bj < 2; ++bj) { const f32x4 v0 = (acc[ai][bj][m][0] * W8_INV + bv[bj][0]) * gw, v1 = (acc[ai][bj][m][1] * W8_INV + bv[bj][1]) * gw;
                    u32x2 w; w.x = pk4_fp8(v0[0], v0[1], v0[2], v0[3]); w.y = pk4_fp8(v1[0], v1[1], v1[2], v1[3]);
                    *(u32x2*)(YB + (size_t)(u.pm * 256 + r) * DM + c0 + bj * HALF) = w; } }
    }
};
}

struct KArgs { const float* in[25]; float* out; unsigned char* ws; int ph_lo, ph_hi, li, pad; };
struct Frame {
    LAS unsigned char* lds; volatile LAS unsigned* MISC; unsigned* ctl; unsigned char* ws;
    int tid, lane, wave, G, gw, NGW;
};

struct CvtDesc { const float* W; const float* g; bf16* dst0; size_t ldw, dld; int srccol, k0src, k0dst, f8; };
__device__ __forceinline__ void cvt_load(const CvtDesc& d, float (&v)[64], float& gv, int lane) {
    const float* rowp = d.W + (size_t)d.k0src * d.ldw;
    const unsigned col = (unsigned)d.srccol;
#pragma unroll
    for (int i = 0; i < 64; ++i) { v[i] = rowp[col]; rowp += d.ldw; }
    const float* gp = d.g ? d.g : d.W;
    const float gl = gp[d.k0src + lane]; gv = d.g ? gl : 1.f;
}
__device__ __forceinline__ void cvt_store(const CvtDesc& d, float (&v)[64], float gv, LAS unsigned char* tile, int lane) {
    if (d.f8) gv *= W8_SCALE;
#pragma unroll
    for (int i = 0; i < 64; ++i) v[i] *= __builtin_bit_cast(float, __builtin_amdgcn_readlane(__builtin_bit_cast(int, gv), i));
    if (d.f8) {
#pragma unroll
        for (int j = 0; j < 4; ++j) { u32x4 w; w.x = pk4_fp8(v[16 * j], v[16 * j + 1], v[16 * j + 2], v[16 * j + 3]); w.y = pk4_fp8(v[16 * j + 4], v[16 * j + 5], v[16 * j + 6], v[16 * j + 7]);
            w.z = pk4_fp8(v[16 * j + 8], v[16 * j + 9], v[16 * j + 10], v[16 * j + 11]); w.w = pk4_fp8(v[16 * j + 12], v[16 * j + 13], v[16 * j + 14], v[16 * j + 15]);
            *(LAS u32x4*)(tile + lane * 80 + j * 16) = w; }
        asm volatile("s_waitcnt lgkmcnt(0)" ::: "memory");
#pragma unroll
        for (int j = 0; j < 4; ++j) { const int r = 16 * j + (lane >> 2), c = lane & 3; const u32x4 w = *(const LAS u32x4*)(tile + r * 80 + c * 16);
            *(u32x4*)((unsigned char*)d.dst0 + (size_t)r * d.dld + d.k0dst + 16 * c) = w; }
        asm volatile("s_waitcnt lgkmcnt(0)" ::: "memory");
        return;
    }
#pragma unroll
    for (int j = 0; j < 8; ++j) { u32x4 w; w.x = cvt_pk_bf16(v[8 * j], v[8 * j + 1]); w.y = cvt_pk_bf16(v[8 * j + 2], v[8 * j + 3]); w.z = cvt_pk_bf16(v[8 * j + 4], v[8 * j + 5]); w.w = cvt_pk_bf16(v[8 * j + 6], v[8 * j + 7]);
        *(LAS u32x4*)(tile + lane * 144 + j * 16) = w; }
    asm volatile("s_waitcnt lgkmcnt(0)" ::: "memory");
#pragma unroll
    for (int j = 0; j < 8; ++j) { const int r = 8 * j + (lane >> 3), c = lane & 7; const u32x4 w = *(const LAS u32x4*)(tile + r * 144 + c * 16);
        *(u32x4*)(d.dst0 + (size_t)r * d.dld + d.k0dst + 8 * c) = w; }
    asm volatile("s_waitcnt lgkmcnt(0)" ::: "memory");
}
__device__ __forceinline__ int wp_srccol(int d) {
    if (d < 3072) return d;
    if (d < 5120) return d + 8;
    const int t = d - 5120, tile = t >> 8, r = t & 255, j = tile * 128 + (r & 127);
    return (r < 128 ? C_GA : C_GB) + j;
}
struct Cvt8Desc { const float* W; const float* g; unsigned char* dst; size_t ldw; int k0, col0a, col0b; };
__device__ __forceinline__ void cvt8_load(const Cvt8Desc& d, f32x4 (&v)[16], float& gv, int wave, int lane) {
    const float* rowp = d.W + (size_t)(d.k0 + 8 * wave) * d.ldw;
#pragma unroll
    for (int i = 0; i < 8; ++i) { v[2 * i] = __builtin_nontemporal_load((const f32x4*)(rowp + d.col0a)); v[2 * i + 1] = __builtin_nontemporal_load((const f32x4*)(rowp + d.col0b)); rowp += d.ldw; }
    const float* gp = d.g ? d.g : d.W; const float gl = gp[d.k0 + 8 * wave + (lane & 7)]; gv = d.g ? gl * W8_SCALE : W8_SCALE;
}
__device__ __forceinline__ void cvt8_pack(f32x4 (&v)[16], float gv, LAS unsigned char* lds, int sub, int wave, int lane) {
    float gs[8];
#pragma unroll
    for (int i = 0; i < 8; ++i) gs[i] = __builtin_bit_cast(float, __builtin_amdgcn_readlane(__builtin_bit_cast(int, gv), i));
#pragma unroll
    for (int hf = 0; hf < 2; ++hf) { u32x4 w[2];
#pragma unroll
        for (int j = 0; j < 4; ++j) { const unsigned lo = pk4_fp8(v[0 + hf][j] * gs[0], v[2 + hf][j] * gs[1], v[4 + hf][j] * gs[2], v[6 + hf][j] * gs[3]), hi = pk4_fp8(v[8 + hf][j] * gs[4], v[10 + hf][j] * gs[5], v[12 + hf][j] * gs[6], v[14 + hf][j] * gs[7]);
            if (j & 1) { w[j >> 1].z = lo; w[j >> 1].w = hi; } else { w[j >> 1].x = lo; w[j >> 1].y = hi; } }
        const int sw = 8 * sub + 2 * (wave >> 1);
        LAS unsigned char* p = lds + sub * 32768 + wave * 4096 + ((hf * 256 + 4 * lane) ^ (sw & 28)) * 8;
        *(LAS u32x4*)(p + 8 * (sw & 2)) = w[0]; *(LAS u32x4*)(p + 16 - 8 * (sw & 2)) = w[1]; }
}
__device__ __forceinline__ void cvt8_flush(unsigned char* dst, LAS unsigned char* lds, int tid) {
    asm volatile("s_waitcnt lgkmcnt(0)\n\ts_barrier" ::: "memory");
#pragma unroll 4
    for (int ps = 0; ps < 16; ++ps) { const int r = ps * 32 + (tid >> 4), p = tid & 15, j = p >> 2, pc = p & 3;
        const int rs = (r ^ (8 * j + 2 * pc)) * 8;
        const u32x2 a0 = *(const LAS u32x2*)(lds + j * 32768 + (2 * pc) * 4096 + rs), a1 = *(const LAS u32x2*)(lds + j * 32768 + (2 * pc + 1) * 4096 + rs);
        __builtin_nontemporal_store((u32x4){a0.x, a0.y, a1.x, a1.y}, (u32x4*)(dst + (size_t)r * DM + 16 * p)); }
    asm volatile("s_waitcnt lgkmcnt(0)\n\ts_barrier" ::: "memory");
}
constexpr int CVT8_SUPER = NE * 8 * 8 + NE * 8 * 4, CVT8_P1_SUPER = 1840;
__device__ __forceinline__ void cvt8_phase(const Frame& F, const KArgs& a, const int bit, const int nb, const int s_lo, const int s_hi) {
    unsigned char* ws = F.ws; const int lane = F.lane, wave = F.wave, tid = F.tid;
    constexpr int S_WGU = NE * 8 * 8;
    auto decode = [&](int s, int j) -> Cvt8Desc {
        Cvt8Desc D;
        if (s < S_WGU) { const int e = s / 64, rr = s % 64, kb4 = rr / 8, cb = rr % 8, kb = kb4 * 4 + j;
            const int da = 4 * lane, db = 256 + 4 * lane;
            D.W = a.in[20] + (size_t)e * DM * 2 * DFF; D.g = a.in[17]; D.ldw = 2 * DFF; D.k0 = kb * 64;
            D.col0a = ((da & 255) < 128 ? 0 : DFF) + (cb * 2 + (da >> 8)) * 128 + (da & 127); D.col0b = ((db & 255) < 128 ? 0 : DFF) + (cb * 2 + (db >> 8)) * 128 + (db & 127);
            D.dst = ws + WS_WGU + ((size_t)e * 2 * DFF + cb * 512) * DM + kb4 * 256; return D; }
        s -= S_WGU;
        { const int e = s / 32, rr = s % 32, kb4 = rr / 4, cb = rr % 4, kb = kb4 * 4 + j;
            D.W = a.in[22] + (size_t)e * DFF * DM; D.g = nullptr; D.ldw = DM; D.k0 = kb * 64; D.col0a = cb * 512 + 4 * lane; D.col0b = cb * 512 + 256 + 4 * lane;
            D.dst = ws + WS_WD + ((size_t)e * DM + cb * 512) * DFF + kb4 * 256; return D; }
    };
    f32x4 va[16], vb[16]; float ga = 1.f, gb = 1.f;
    int sidx = s_lo + bit;
    if (sidx < s_hi) { Cvt8Desc d0 = decode(sidx, 0); cvt8_load(d0, va, ga, wave, lane); }
    while (sidx < s_hi) {
        const int snext = sidx + nb; const bool more = snext < s_hi;
        { Cvt8Desc d1 = decode(sidx, 1); cvt8_load(d1, vb, gb, wave, lane); } cvt8_pack(va, ga, F.lds, 0, wave, lane);
        { Cvt8Desc d2 = decode(sidx, 2); cvt8_load(d2, va, ga, wave, lane); } cvt8_pack(vb, gb, F.lds, 1, wave, lane);
        { Cvt8Desc d3 = decode(sidx, 3); cvt8_load(d3, vb, gb, wave, lane); } cvt8_pack(va, ga, F.lds, 2, wave, lane);
        { Cvt8Desc dn = decode(more ? snext : sidx, 0); cvt8_load(dn, va, ga, wave, lane); } cvt8_pack(vb, gb, F.lds, 3, wave, lane);
        cvt8_flush(decode(sidx, 0).dst, F.lds, tid);
        sidx = snext;
    }
    asm volatile("s_waitcnt vmcnt(0)" ::: "memory"); __syncthreads();
}
template <int STAGE>
__device__ __forceinline__ void p0_prologue(const Frame& F, const KArgs& a, const int w0, const int nw) {
    unsigned char* ws = F.ws; const int lane = F.lane;
    constexpr int I_WP = (NPROJ / 64) * 32, I_WAB = 32 * 32, I_WO = 32 * 32, I_WXQ = 8 * 32, I_WXKV = 16 * 32, I_WXO = 32 * 8, I_WGU = NE * 64 * 32, I_WD = NE * 32 * 32;
    constexpr int NITEMS = I_WP + I_WAB + I_WO + I_WXQ + I_WXKV + I_WXO + I_WGU + I_WD;
    LAS float* wf = (LAS float*)F.lds;
    LAS unsigned char* tile = F.lds + F.wave * 9216;
    auto decode = [&](int it) -> CvtDesc {
        CvtDesc D; int r = it; D.g = nullptr; D.f8 = 0;
        if (r < I_WP) { const int kb = r / (NPROJ / 64), db = r % (NPROJ / 64), d = db * 64 + lane;
            D.W = a.in[3]; D.ldw = INC; D.srccol = wp_srccol(d); D.k0src = kb * 64; D.k0dst = kb * 64; D.dld = DM;
            if (db * 64 >= 5120) { D.f8 = 1; D.dst0 = (bf16*)(ws + WS_WPG + (size_t)(db * 64 - 5120) * DM); } else D.dst0 = (bf16*)(ws + WS_WP) + (size_t)db * 64 * DM;
            return D; } r -= I_WP;
        if (r < I_WAB) { const int kb = r / 32, db = r % 32, d = db * 64 + lane;
            D.W = kb < 16 ? a.in[9] : a.in[10]; D.ldw = DM; D.srccol = d; D.dst0 = (bf16*)(ws + WS_WAB) + (size_t)db * 64 * DM; D.dld = DM; D.k0src = (kb & 15) * 64; D.k0dst = kb * 64; return D; } r -= I_WAB;
        if (r < I_WO) { const int kb = r / 32, db = r % 32, d = db * 64 + lane;
            D.W = a.in[11]; D.ldw = DM; D.srccol = d; D.dst0 = (bf16*)(ws + WS_WO) + (size_t)db * 64 * DM; D.dld = DM; D.k0src = kb * 64; D.k0dst = kb * 64; return D; } r -= I_WO;
        if (r < I_WXQ) { const int kb = r / 8, db = r % 8, d = db * 64 + lane;
            D.W = a.in[14]; D.g = a.in[12]; D.ldw = XW; D.srccol = d; D.dst0 = (bf16*)(ws + WS_WXQ) + (size_t)db * 64 * DM; D.dld = DM; D.k0src = kb * 64; D.k0dst = kb * 64; return D; } r -= I_WXQ;
        if (r < I_WXKV) { const int kb = r / 16, db = r % 16, d = db * 64 + lane;
            D.W = a.in[15]; D.ldw = 2 * XW; D.srccol = d; D.dst0 = (bf16*)(ws + WS_WXKV) + (size_t)db * 64 * DM; D.dld = DM; D.k0src = kb * 64; D.k0dst = kb * 64; return D; } r -= I_WXKV;
        if (r < I_WXO) { const int kb = r / 32, db = r % 32, d = db * 64 + lane;
            D.W = a.in[16]; D.ldw = DM; D.srccol = d; D.dst0 = (bf16*)(ws + WS_WXO) + (size_t)db * 64 * XW; D.dld = XW; D.k0src = kb * 64; D.k0dst = kb * 64; return D; } r -= I_WXO;
        if (r < I_WGU) { const int e = r / (64 * 32), rr = r % (64 * 32), kb = rr / 64, db = rr % 64, d = db * 64 + lane;
            const int t256 = d >> 8, q = d & 255;
            D.W = a.in[20] + (size_t)e * DM * 2 * DFF; D.g = a.in[17]; D.ldw = 2 * DFF; D.srccol = (q < 128 ? 0 : DFF) + t256 * 128 + (q & 127); D.f8 = 1; D.dst0 = (bf16*)(ws + WS_WGU + ((size_t)e * 2 * DFF + db * 64) * DM); D.dld = DM; D.k0src = kb * 64; D.k0dst = kb * 64; return D; } r -= I_WGU;
        { const int e = r / (32 * 32), rr = r % (32 * 32), kb = rr / 32, db = rr % 32, d = db * 64 + lane;
            D.W = a.in[22] + (size_t)e * DFF * DM; D.ldw = DM; D.srccol = d; D.f8 = 1; D.dst0 = (bf16*)(ws + WS_WD + ((size_t)e * DM + db * 64) * DFF); D.dld = DFF; D.k0src = kb * 64; D.k0dst = kb * 64; return D; }
    };
    {
        float va[64], vb[64], ga = 1.f, gb = 1.f;
        constexpr int I_SMALL = I_WP + I_WAB + I_WO + I_WXQ + I_WXKV + I_WXO;
        const int IT_END = STAGE == 0 ? I_SMALL : NITEMS;
        int it = (STAGE == 0 ? 0 : I_SMALL) + w0;
        CvtDesc da = decode(it < IT_END ? it : 0), db_;
        cvt_load(da, va, ga, lane);
        while (it < IT_END) {
            const int it1 = it + nw, it2 = it + 2 * nw;
            db_ = decode(it1 < IT_END ? it1 : 0);
            cvt_load(db_, vb, gb, lane);
            cvt_store(da, va, ga, tile, lane);
            if (it1 >= IT_END) break;
            da = decode(it2 < IT_END ? it2 : 0);
            cvt_load(da, va, ga, lane);
            cvt_store(db_, vb, gb, tile, lane);
            it = it2;
        }
    }
    if constexpr (STAGE == 1) { asm volatile("s_waitcnt vmcnt(0)" ::: "memory"); __syncthreads(); return; }
    for (int i = F.gw * 64 + lane; i < DM * NE; i += F.NGW * 64) { const int k = i >> 5, e = i & 31; ((float*)(ws + WS_WRT))[(size_t)e * DM + k] = a.in[17][k] * a.in[18][i]; }
    __syncthreads();
    for (int i = F.tid; i < DM * 8; i += NTHREADS) wf[i] = a.in[3][(size_t)(i >> 3) * INC + C_F + (i & 7)];
    __syncthreads();
    for (int row = F.gw; row < NTOK + NMEM; row += F.NGW) {
        const bool ismem = row >= NTOK; const int r = ismem ? row - NTOK : row;
        const float* xr = (ismem ? a.in[1] : a.in[0]) + (size_t)r * DM; const float* g = ismem ? a.in[13] : a.in[2];
        bf16* orow = (bf16*)(ws + (ismem ? WS_HM : WS_H0)) + (size_t)r * DM;
        f32x4 v[8]; float s = 0.f;
#pragma unroll
        for (int j = 0; j < 8; ++j) { v[j] = ((const f32x4*)xr)[lane + 64 * j]; s += (v[j][0] * v[j][0] + v[j][1] * v[j][1]) + (v[j][2] * v[j][2] + v[j][3] * v[j][3]); }
        const float rstd = rsqrtf(wave_sum(s) * (1.f / DM) + RMS_EPS);
        float f[8];
#pragma unroll
        for (int j = 0; j < 8; ++j) f[j] = 0.f;
#pragma unroll
        for (int j = 0; j < 8; ++j) { const f32x4 gg = ((const f32x4*)g)[lane + 64 * j]; v[j] = v[j] * rstd * gg;
            u32x2 w; w.x = cvt_pk_bf16(v[j][0], v[j][1]); w.y = cvt_pk_bf16(v[j][2], v[j][3]); *(u32x2*)(orow + 4 * (lane + 64 * j)) = w;
            if (!ismem) { *(unsigned*)(ws + WS_H0Q + (size_t)r * DM + 4 * (lane + 64 * j)) = pk4_fp8(v[j][0], v[j][1], v[j][2], v[j][3]);
#pragma unroll
                for (int c = 0; c < 4; ++c) { const LAS f32x4* wk = (const LAS f32x4*)(wf + (4 * (lane + 64 * j) + c) * 8); const f32x4 w0 = wk[0], w1 = wk[1];
                    f[0] += v[j][c] * w0[0]; f[1] += v[j][c] * w0[1]; f[2] += v[j][c] * w0[2]; f[3] += v[j][c] * w0[3];
                    f[4] += v[j][c] * w1[0]; f[5] += v[j][c] * w1[1]; f[6] += v[j][c] * w1[2]; f[7] += v[j][c] * w1[3]; } } }
        if (!ismem) {
            float mine = 0.f;
#pragma unroll
            for (int j = 0; j < 8; ++j) { const float t = wave_sum(f[j]); if (lane == j) mine = t; }
            if (lane < 8) ((float*)(ws + WS_LOGF))[(size_t)r * 8 + lane] = log_sigmoid(mine + a.in[4][lane]);
        }
    }
}
__device__ __forceinline__ void cumsum_wave(const float* LOGF, float* CB, int bh, int lane) {
    const int b = bh / FH, h = bh % FH; float loc = 0.f;
    for (int i = 0; i < 64; ++i) loc += LOGF[(size_t)(b * SEQ + lane * 64 + i) * 8 + h];
    float inc = loc;
#pragma unroll
    for (int o = 1; o < 64; o <<= 1) { const float n = __shfl_up(inc, o); if (lane >= o) inc += n; }
    float run = inc - loc;
    for (int i = 0; i < 64; ++i) { run += LOGF[(size_t)(b * SEQ + lane * 64 + i) * 8 + h]; CB[(size_t)bh * SEQ + lane * 64 + i] = -run * 11.313708498984761f; }
}

namespace att {
constexpr int D = 128; constexpr float THR = 8.f; constexpr bool WSKIP = false;
constexpr float SCALE = 0.08838834764831845f;
constexpr int NW = 8, QBLK = 32, KVBLK = 64, QB = NW * QBLK;
constexpr int SHM_V = KVBLK * D * 2, SHM_K = KVBLK * D * 2;
constexpr int LDS_BYTES = 2 * SHM_V + 2 * SHM_K + NW * 64 * 4;
constexpr int BIAS_OFF = LDS_BYTES;

typedef short s16x4 __attribute__((ext_vector_type(4)));
typedef float f32x16 __attribute__((ext_vector_type(16)));
template <class A, class Bt> struct same_t { static constexpr bool v = false; };
template <class A> struct same_t<A, A> { static constexpr bool v = true; };

#define KSWZ(row, colB) ((row) * 256 + ((colB) ^ (((row) & 7) << 4)))
#define SBAR() __builtin_amdgcn_sched_barrier(0)
__device__ __forceinline__ int v_st(int k, int c) { const int kk = (k & ~0xC) | ((k & 4) << 1) | ((k & 8) >> 1); return ((kk >> 3) * 4 + (c >> 5)) * 512 + ((kk & 7) * 32 + (c & 31)) * 2; }
__device__ __forceinline__ int v_rd_base(int lane) { return ((lane & 3) << 3) | (((lane >> 2) & 3) << 6) | (((lane >> 4) & 1) << 5) | (((lane >> 5) & 1) << 8); }
constexpr int v_rd_off(int d0, int ks, int half) { return d0 * 512 + ks * 4096 + half * 2048; }
__device__ __forceinline__ int crow(int r, int hi) { return (r & 3) + 8 * (r >> 2) + 4 * hi; }
__device__ __forceinline__ unsigned cvtpk(float lo, float hi) {
    unsigned r; asm volatile("v_cvt_pk_bf16_f32 %0, %1, %2" : "=v"(r) : "v"(lo), "v"(hi)); return r;
}
__device__ __forceinline__ bf16x8 pack8(f32x4 a, f32x4 b) {
    u32x4 w = {cvtpk(a[0], a[1]), cvtpk(a[2], a[3]), cvtpk(b[0], b[1]), cvtpk(b[2], b[3])};
    return *reinterpret_cast<bf16x8*>(&w);
}
template <class T> __device__ __forceinline__ bf16x8 load8(const T* p) {
    if constexpr (same_t<T, float>::v) { return pack8(*(const f32x4*)p, *(const f32x4*)(p + 4)); }
    else { return *reinterpret_cast<const bf16x8*>(p); }
}
__device__ __forceinline__ void mask_tile(f32x16& p0, f32x16& p1, int dq, unsigned W) {
    const float NEG = -__builtin_inff();
#pragma unroll
    for (int r = 0; r < 16; ++r) {
        const int c = (r & 3) + 8 * (r >> 2);
        if ((unsigned)(dq - c) >= W) p0[r] = NEG;
        if ((unsigned)(dq - c - 32) >= W) p1[r] = NEG;
    }
}
__device__ __forceinline__ void partialSM(f32x16& p0, f32x16& p1, float& m_reg, float& mn, float& alpha) {
    float pmax = p0[0]; for (int r = 1; r < 16; ++r) pmax = fmaxf(pmax, p0[r]); for (int r = 0; r < 16; ++r) pmax = fmaxf(pmax, p1[r]);
    { auto rr = __builtin_amdgcn_permlane32_swap(__float_as_uint(pmax), __float_as_uint(pmax), false, false);
      pmax = fmaxf(__uint_as_float(rr[0]), __uint_as_float(rr[1])); }
    constexpr float C2 = 1.4426950408889634f * SCALE;
    if (__builtin_expect(__all((pmax - m_reg) * SCALE <= THR), 1)) { mn = m_reg; alpha = 1.f; }
    else { mn = fmaxf(m_reg, pmax); alpha = __builtin_amdgcn_exp2f((m_reg - mn) * C2); m_reg = mn; }
    const float mnL = -mn * C2;
    for (int r = 0; r < 16; ++r) p0[r] = fmaf(p0[r], C2, mnL); for (int r = 0; r < 16; ++r) p1[r] = fmaf(p1[r], C2, mnL);
    for (int r = 0; r < 16; ++r) p0[r] = __builtin_amdgcn_exp2f(p0[r]);
}
__device__ __forceinline__ void finishSM(f32x16& p0, f32x16& p1, float alpha, float& l_reg, bf16x8& pa0, bf16x8& pa1, bf16x8& pa2, bf16x8& pa3) {
    for (int r = 0; r < 16; ++r) p1[r] = __builtin_amdgcn_exp2f(p1[r]);
    float ps = 0; for (int r = 0; r < 16; ++r) ps += p0[r]; for (int r = 0; r < 16; ++r) ps += p1[r];
    { auto rr = __builtin_amdgcn_permlane32_swap(__float_as_uint(ps), __float_as_uint(ps), false, false);
      ps = __uint_as_float(rr[0]) + __uint_as_float(rr[1]); }
    l_reg = l_reg * alpha + ps;
#define PK4(P, B_, OUT) do { unsigned a0 = cvtpk(P[B_+0], P[B_+1]), a1 = cvtpk(P[B_+2], P[B_+3]);                          \
        unsigned b0 = cvtpk(P[B_+4], P[B_+5]), b1 = cvtpk(P[B_+6], P[B_+7]);                                             \
        auto r0 = __builtin_amdgcn_permlane32_swap(a0, b0, false, false); auto r1 = __builtin_amdgcn_permlane32_swap(a1, b1, false, false); \
        u32x4 w = {r0[0], r1[0], r0[1], r1[1]}; OUT = *reinterpret_cast<bf16x8*>(&w); } while (0)
    PK4(p0, 0, pa0); PK4(p0, 8, pa1); PK4(p1, 0, pa2); PK4(p1, 8, pa3);
#undef PK4
}
template <int KB, bool SK, bool BIAS>
__device__ __forceinline__ void qkt(f32x16& p0, f32x16& p1, const char* K_lds, int r32, int hi, const bf16x8* qr, bool act, const float* bl) {
    if (SK && !act) { const float NEG = -__builtin_inff();
#pragma unroll
        for (int r = 0; r < 16; ++r) { p0[r] = NEG; p1[r] = NEG; } return; }
    if constexpr (BIAS) {
#pragma unroll
        for (int g_ = 0; g_ < 4; ++g_) { const f32x4 t0 = *(const f32x4*)(bl + 8 * g_), t1 = *(const f32x4*)(bl + 32 + 8 * g_);
            p0[4 * g_] = t0[0]; p0[4 * g_ + 1] = t0[1]; p0[4 * g_ + 2] = t0[2]; p0[4 * g_ + 3] = t0[3]; p1[4 * g_] = t1[0]; p1[4 * g_ + 1] = t1[1]; p1[4 * g_ + 2] = t1[2]; p1[4 * g_ + 3] = t1[3]; }
    } else { p0 = f32x16{}; p1 = f32x16{}; }
    const char* kb[4];
#pragma unroll
    for (int dd = 0; dd < 4; ++dd) kb[dd] = K_lds + KB * SHM_K + KSWZ(r32, (dd * 16 + hi * 8) * 2);
#pragma unroll
    for (int d0 = 0; d0 < 8; ++d0) { const char* a = kb[d0 & 3] + (d0 >> 2) * 128;
        bf16x8 b0 = *reinterpret_cast<const bf16x8*>(a);
        bf16x8 b1 = *reinterpret_cast<const bf16x8*>(a + 32 * 256);
        p0 = __builtin_amdgcn_mfma_f32_32x32x16_bf16(b0, qr[d0], p0, 0, 0, 0);
        p1 = __builtin_amdgcn_mfma_f32_32x32x16_bf16(b1, qr[d0], p1, 0, 0, 0); }
}
template <int VB, bool SK>
__device__ __forceinline__ void pv_tile(f32x16* o, int vb0, bf16x8 pa0, bf16x8 pa1, bf16x8 pa2, bf16x8 pa3, bool act) {
    if (SK && !act) return;
#define TRRD(dst, off) asm volatile("ds_read_b64_tr_b16 %0, %1 offset:%2" : "=&v"(dst) : "v"(vb0), "i"(off) : "memory")
#define PV_D0(d0) do { s16x4 l0, l1, l2, l3, h0, h1, h2, h3; constexpr int b_ = VB * SHM_V + v_rd_off(d0, 0, 0);     \
        TRRD(l0, b_); TRRD(h0, b_ + 2048); TRRD(l1, b_ + 4096); TRRD(h1, b_ + 6144); TRRD(l2, b_ + 8192); TRRD(h2, b_ + 10240); TRRD(l3, b_ + 12288); TRRD(h3, b_ + 14336); \
        asm volatile("s_waitcnt lgkmcnt(0)" ::: "memory"); SBAR();                 \
        o[d0] = __builtin_amdgcn_mfma_f32_32x32x16_bf16(pa0, (bf16x8){l0[0], l0[1], l0[2], l0[3], h0[0], h0[1], h0[2], h0[3]}, o[d0], 0, 0, 0);   \
        o[d0] = __builtin_amdgcn_mfma_f32_32x32x16_bf16(pa1, (bf16x8){l1[0], l1[1], l1[2], l1[3], h1[0], h1[1], h1[2], h1[3]}, o[d0], 0, 0, 0);   \
        o[d0] = __builtin_amdgcn_mfma_f32_32x32x16_bf16(pa2, (bf16x8){l2[0], l2[1], l2[2], l2[3], h2[0], h2[1], h2[2], h2[3]}, o[d0], 0, 0, 0);   \
        o[d0] = __builtin_amdgcn_mfma_f32_32x32x16_bf16(pa3, (bf16x8){l3[0], l3[1], l3[2], l3[3], h3[0], h3[1], h3[2], h3[3]}, o[d0], 0, 0, 0); } while (0)
    PV_D0(0); PV_D0(1); PV_D0(2); PV_D0(3);
#undef PV_D0
#undef TRRD
}

template <class TIn, class TOut> struct BlockRef { const TIn* Q; const TIn* K; const TIn* V; TOut* O; int P0; };
template <class TIn> struct Seam {
    bf16x8 qr[8];
    bf16x8 st_v0, st_v1, st_k0, st_k1; f32x4 sf0, sf1, sf2, sf3;
    f32x4 tq[16];
};
__device__ __forceinline__ int swa_jlo(int P0, int W) { const int lowk = P0 - W + 1; return lowk > 0 ? lowk / KVBLK : 0; }
#define ROW(p, k0, rr) (((p) + (size_t)(k0) * KS) + (unsigned)((rr) * KS + sc))
#define VMW() asm volatile("s_waitcnt vmcnt(0)" ::: "memory")
#define VMWN(n) asm volatile("s_waitcnt vmcnt(%0)" :: "i"(n) : "memory")
#define SLOAD_H(Kp, Vp, k0) do { S.st_v0 = load8<TIn>(ROW(Vp, k0, sr)); S.st_v1 = load8<TIn>(ROW(Vp, k0, 32 + sr));              \
                         S.st_k0 = load8<TIn>(ROW(Kp, k0, sr)); S.st_k1 = load8<TIn>(ROW(Kp, k0, 32 + sr)); } while (0)
#define SWRITE_HK(bf) do { *(bf16x8*)(K_lds + (bf) * SHM_K + kws) = S.st_k0; *(bf16x8*)(K_lds + (bf) * SHM_K + kws + 32 * 256) = S.st_k1; } while (0)
#define SWRITE_HV(bf) do { *(bf16x8*)(V_lds + (bf) * SHM_V + vst0) = S.st_v0; *(bf16x8*)(V_lds + (bf) * SHM_V + vst1) = S.st_v1; } while (0)
#define SWRITE_H(bf) do { SWRITE_HV(bf); SWRITE_HK(bf); } while (0)
#define SLOAD_F(p, k0) do { S.sf0 = *(const f32x4*)ROW(p, k0, sr); S.sf1 = *(const f32x4*)(ROW(p, k0, sr) + 4);                \
                            S.sf2 = *(const f32x4*)ROW(p, k0, 32 + sr); S.sf3 = *(const f32x4*)(ROW(p, k0, 32 + sr) + 4); } while (0)
#define SWRITE_KF(bf) do { *(bf16x8*)(K_lds + (bf) * SHM_K + kws) = pack8(S.sf0, S.sf1); *(bf16x8*)(K_lds + (bf) * SHM_K + kws + 32 * 256) = pack8(S.sf2, S.sf3); } while (0)
#define SWRITE_VF(bf) do { *(bf16x8*)(V_lds + (bf) * SHM_V + vst0) = pack8(S.sf0, S.sf1); *(bf16x8*)(V_lds + (bf) * SHM_V + vst1) = pack8(S.sf2, S.sf3); } while (0)
template <class TIn, class TOut, int QS, int KS, int OS, bool BIAS>
__device__ __forceinline__ void causal_swa_prime(const BlockRef<TIn, TOut>& cur, int W, char* lds, Seam<TIn>& S) {
    constexpr bool F32 = same_t<TIn, float>::v;
    const int tid = threadIdx.x, wid = __builtin_amdgcn_readfirstlane(tid >> 6), lane = tid & 63, r32 = lane & 31, hi = lane >> 5;
    const int sr = tid >> 4, sc = (tid & 15) * 8, kws = KSWZ(sr, sc * 2); char* K_lds = lds + 2 * SHM_V;
    const int kb0 = swa_jlo(cur.P0, W) * KVBLK;
    for (int d0 = 0; d0 < 8; ++d0) S.qr[d0] = load8<TIn>(cur.Q + (size_t)(wid * QBLK + r32) * QS + d0 * 16 + hi * 8);
    if constexpr (F32) { SLOAD_F((const float*)cur.K, kb0); VMW(); SWRITE_KF(0); SBAR(); SLOAD_F((const float*)cur.V, kb0); }
    else { SLOAD_H(cur.K, cur.V, kb0); VMW(); SWRITE_HK(0); }
    __syncthreads();
}
template <class TIn, class TOut, int QS, int KS, int OS, bool BIAS, bool PREF = true>
__device__ __forceinline__ void causal_swa_block(const BlockRef<TIn, TOut>& cur, const BlockRef<TIn, TOut>& nxt, int skv, int W, char* lds, Seam<TIn>& S) {
    constexpr bool F32 = same_t<TIn, float>::v;
    const int tid = threadIdx.x, wid = __builtin_amdgcn_readfirstlane(tid >> 6), lane = tid & 63, r32 = lane & 31, hi = lane >> 5;
    const int j_lo = swa_jlo(cur.P0, W);
    int j_hi = (cur.P0 + QB - 1) / KVBLK + 1; if (j_hi > skv / KVBLK) j_hi = skv / KVBLK;
    const int NT = j_hi - j_lo;
    const int kbn = swa_jlo(nxt.P0, W) * KVBLK;
    const int qlo = cur.P0 + wid * QBLK, qm = qlo + r32 - 4 * hi;
    char* V_lds = lds; char* K_lds = lds + 2 * SHM_V;
    float* ws = (float*)(lds + 2 * SHM_V + 2 * SHM_K) + wid * 64; float* li_l = ws, * al_l = ws + 32;
    float m_reg = BIAS ? ((const float*)(lds + BIAS_OFF))[cur.P0 + wid * QBLK + r32] : -1e30f, l_reg = 0; f32x16 o[4] = {};
    const int sr = tid >> 4, sc = (tid & 15) * 8, vst0 = v_st(sr, sc), vst1 = v_st(32 + sr, sc), kws = KSWZ(sr, sc * 2);
    const int vb0 = (int)(uintptr_t)V_lds + v_rd_base(lane);
    const TIn* Kh = cur.K; const TIn* Vh = cur.V;
    const float* bias0 = (const float*)(lds + BIAS_OFF) + 4 * hi;
#define RESC(a) do { if (__any((a) < 1.f)) { if (hi == 0) al_l[r32] = (a); asm volatile("s_waitcnt lgkmcnt(0)" ::: "memory");              \
                     for (int d_ = 0; d_ < 4; ++d_) for (int r = 0; r < 16; ++r) o[d_][r] *= al_l[crow(r, hi)]; } } while (0)
#define KBASE(t) ((j_lo + (t)) * KVBLK)
#define BL(t) (bias0 + KBASE(t))
#define ACT(t) (KBASE(t) <= qlo + QBLK - 1 && KBASE(t) + KVBLK - 1 >= qlo - W + 1)
#define MASKT(P0_, P1_, t) do { const int kb_ = KBASE(t); if ((!SK || ACT(t)) && (kb_ + KVBLK - 1 > qlo || kb_ <= qlo + QBLK - 1 - W)) mask_tile(P0_, P1_, qm - kb_, (unsigned)W); } while (0)
    constexpr int NQL = F32 ? 16 : 8;
    constexpr bool SK = WSKIP && !F32;
#define SEAM_K0() do { VMWN(NQL); if constexpr (F32) { SWRITE_KF(0); SBAR(); SLOAD_F((const float*)nxt.V, kbn); } else { SWRITE_HK(0); } SBAR(); } while (0)
    f32x16 pA0, pA1, pB0, pB1; float mnA, mnB, alA, alB; bf16x8 pa0, pa1, pa2, pa3;
    if constexpr (F32) { VMW(); SWRITE_VF(0); SBAR(); } else { SWRITE_HV(0); SBAR(); }
    if (NT > 1) { if constexpr (F32) SLOAD_F((const float*)Kh, KBASE(1)); else SLOAD_H(Kh, Vh, KBASE(1)); }
    SBAR(); qkt<0, SK, BIAS>(pA0, pA1, K_lds, r32, hi, S.qr, ACT(0), BL(0));
    if constexpr (F32) { if (NT > 1) { VMW(); SWRITE_KF(1); SBAR(); SLOAD_F((const float*)Vh, KBASE(1)); } }
    MASKT(pA0, pA1, 0); partialSM(pA0, pA1, m_reg, mnA, alA);
    if (NT > 1) { VMW(); if constexpr (F32) { SWRITE_VF(1); SBAR(); if (NT > 2) SLOAD_F((const float*)Kh, KBASE(2)); } else SWRITE_H(1); }
    __syncthreads();
#define HALF_STEP(PX0, PX1, mnX, alX, PY0, PY1, alY, t, KB, VB, SB) do {                                                      \
        SBAR(); qkt<KB, SK, BIAS>(PX0, PX1, K_lds, r32, hi, S.qr, ACT(t), BL(t));                                             \
        finishSM(PY0, PY1, alY, l_reg, pa0, pa1, pa2, pa3); SBAR();                                                           \
        if ((t) + 1 < NT) { if constexpr (F32) { VMW(); SWRITE_KF(SB); SBAR(); SLOAD_F((const float*)Vh, KBASE((t) + 1)); }  \
                            else { SLOAD_H(Kh, Vh, KBASE((t) + 1)); } SBAR(); }                                               \
        pv_tile<VB, SK>(o, vb0, pa0, pa1, pa2, pa3, ACT((t) - 1)); MASKT(PX0, PX1, (t)); partialSM(PX0, PX1, m_reg, mnX, alX);                                        \
        __syncthreads();                                                                                                      \
        if ((t) + 1 < NT) { VMW(); if constexpr (F32) { SWRITE_VF(SB); SBAR(); if ((t) + 2 < NT) SLOAD_F((const float*)Kh, KBASE((t) + 2)); } \
                            else { SWRITE_H(SB); } }                                                                          \
        RESC(alX); __syncthreads(); } while (0)
    for (int t = 1; t + 1 < NT; t += 2) {
        HALF_STEP(pB0, pB1, mnB, alB, pA0, pA1, alA, t, 1, 0, 0);
        HALF_STEP(pA0, pA1, mnA, alA, pB0, pB1, alB, t + 1, 0, 1, 1);
    }
    const bool even = (NT & 1) == 0;
    if (even) { SBAR(); qkt<1, SK, BIAS>(pB0, pB1, K_lds, r32, hi, S.qr, ACT(NT - 1), BL(NT - 1)); SBAR(); }
#define QROW(e) (nxt.Q + (size_t)(wid * QBLK + r32) * QS + ((e) >> 1) * 16 + hi * 8 + ((e) & 1) * 4)
    if constexpr (F32) { SLOAD_F((const float*)nxt.K, kbn); SBAR();
#pragma unroll
        for (int e = 0; e < 8; ++e) S.tq[e] = *(const f32x4*)QROW(e); }
    else if constexpr (PREF) { SLOAD_H(nxt.K, nxt.V, kbn); SBAR();
#pragma unroll
        for (int d0 = 0; d0 < 8; ++d0) S.qr[d0] = load8<TIn>(nxt.Q + (size_t)(wid * QBLK + r32) * QS + d0 * 16 + hi * 8); }
    SBAR();
    finishSM(pA0, pA1, alA, l_reg, pa0, pa1, pa2, pa3); SBAR();
    if constexpr (F32) {
#pragma unroll
        for (int e = 8; e < 16; ++e) S.tq[e] = *(const f32x4*)QROW(e); SBAR(); }
#undef QROW
    pv_tile<0, SK>(o, vb0, pa0, pa1, pa2, pa3, ACT(even ? NT - 2 : NT - 1));
    if (even) { MASKT(pB0, pB1, NT - 1); partialSM(pB0, pB1, m_reg, mnB, alB); __syncthreads(); RESC(alB);
        finishSM(pB0, pB1, alB, l_reg, pa0, pa1, pa2, pa3); SBAR(); pv_tile<1, SK>(o, vb0, pa0, pa1, pa2, pa3, ACT(NT - 1)); }
    SBAR(); if constexpr (PREF) SEAM_K0();
    if (hi == 0) li_l[r32] = l_reg; asm volatile("s_waitcnt lgkmcnt(0)" ::: "memory");
    float rli[16];
#pragma unroll
    for (int r = 0; r < 16; ++r) rli[r] = __builtin_amdgcn_rcpf(li_l[crow(r, hi)]);
    TOut* Ow = cur.O + (size_t)(wid * QBLK) * OS;
#pragma unroll
    for (int r = 0; r < 16; ++r) { const int orow = crow(r, hi);
#pragma unroll
        for (int d0 = 0; d0 < 4; ++d0) { const float v = o[d0][r] * rli[r];
            if constexpr (same_t<TOut, float>::v) { Ow[(size_t)orow * OS + d0 * 32 + r32] = v; }
            else { const float vn = __shfl_xor(v, 1);
                   if ((r32 & 1) == 0) *(unsigned*)(Ow + (size_t)orow * OS + d0 * 32 + r32) = cvtpk(v, vn); } } }
    if constexpr (F32) {
#pragma unroll
        for (int d0 = 0; d0 < 8; ++d0) S.qr[d0] = pack8(S.tq[2 * d0], S.tq[2 * d0 + 1]); }
    __syncthreads();
#undef RESC
#undef KBASE
#undef BL
#undef ACT
#undef MASKT
#undef SEAM_K0
#undef HALF_STEP
}
#undef ROW
#undef VMW
#undef VMWN
#undef SLOAD_H
#undef SWRITE_HK
#undef SWRITE_HV
#undef SWRITE_H
#undef SLOAD_F
#undef SWRITE_KF
#undef SWRITE_VF

#undef KSWZ
#undef SBAR
}
__device__ __forceinline__ void sg_phase(const Frame& F, const KArgs& a, const int u_first, const int u_count) {
    unsigned char* ws = F.ws; const int tid = F.tid, lane = F.lane, w = F.wave, tl = lane & 15, kq = lane >> 4;
    LAS f32x2* st = (LAS f32x2*)F.lds;
    LAS unsigned short* vt = (LAS unsigned short*)(F.lds + 1024);
    const bf16* ZU = (const bf16*)(ws + WS_ZU); const bf16* ZV = (const bf16*)(ws + WS_ZV); const float* ZST = (const float*)(ws + WS_ZST); bf16* AS = (bf16*)(ws + WS_AS);
    const float* ln_g = a.in[5]; const float* ln_b = a.in[6]; const float* w_sp = a.in[7]; const float* b_sp = a.in[8];
    for (int uu = 0; uu < u_count; ++uu) { const int u = u_first + uu;
        const int chunk = u >> 3, g = u & 7, t0 = chunk * SGC;
        if (tid < 128) { const f32x4* p = (const f32x4*)(ZST + (size_t)(t0 + tid) * 32); float S = 0.f, Q = 0.f;
#pragma unroll
            for (int i = 0; i < 8; ++i) { const f32x4 v = p[i]; S += v[0] + v[2]; Q += v[1] + v[3]; }
            const float mu = S * (1.f / SGW), var = fmaxf(Q * (1.f / SGW) - mu * mu, 0.f); st[tid] = (f32x2){mu, rsqrtf(var + LN_EPS)}; }
        __syncthreads();
        { const int s = tid >> 2, c0 = (tid & 3) * 32; const f32x2 ms = st[s]; const bf16* src = ZV + (size_t)(t0 + s) * SGW + g * 128 + c0;
#pragma unroll
            for (int q = 0; q < 4; ++q) { const u32x4 raw = ((const u32x4*)src)[q]; const unsigned rw[4] = {raw.x, raw.y, raw.z, raw.w};
                const f32x4 g0 = *(const f32x4*)(ln_g + g * 128 + c0 + 8 * q), g1 = *(const f32x4*)(ln_g + g * 128 + c0 + 8 * q + 4), b0 = *(const f32x4*)(ln_b + g * 128 + c0 + 8 * q), b1 = *(const f32x4*)(ln_b + g * 128 + c0 + 8 * q + 4);
#pragma unroll
                for (int i = 0; i < 8; ++i) { const unsigned wd = rw[i >> 1]; const float v = __builtin_bit_cast(float, (i & 1) ? (wd & 0xffff0000u) : (wd << 16));
                    const float gg = (i < 4) ? g0[i & 3] : g1[i & 3], bb = (i < 4) ? b0[i & 3] : b1[i & 3];
                    vt[(c0 + 8 * q + i) * 136 + s] = (unsigned short)f2bf((v - ms[0]) * ms[1] * gg + bb); } } }
        __syncthreads();
        f32x4 acc[8];
#pragma unroll
        for (int j = 0; j < 8; ++j) acc[j] = (f32x4){0.f, 0.f, 0.f, 0.f};
        const int t = 16 * w + tl;
        f32x4 wraw[4][2];
#pragma unroll
        for (int ks = 0; ks < 4; ++ks) { const float* wp = w_sp + ((size_t)(g * 128 + t) * 128 + 32 * ks + 8 * kq); if (ks <= (w >> 1)) { wraw[ks][0] = *(const f32x4*)wp; wraw[ks][1] = *(const f32x4*)(wp + 4); } else { wraw[ks][0] = (f32x4){0.f, 0.f, 0.f, 0.f}; wraw[ks][1] = wraw[ks][0]; } }
        u32x2 uraw[8];
#pragma unroll
        for (int j = 0; j < 8; ++j) uraw[j] = *(const u32x2*)(ZU + (size_t)(t0 + t) * SGW + g * 128 + 16 * j + 4 * kq);
        const float bs = b_sp[g * 128 + t];
#pragma unroll
        for (int ks = 0; ks < 4; ++ks) { if (ks > (w >> 1)) continue;
            const f32x4 w0 = wraw[ks][0], w1 = wraw[ks][1];
            float wv[8] = {w0[0], w0[1], w0[2], w0[3], w1[0], w1[1], w1[2], w1[3]};
#pragma unroll
            for (int i = 0; i < 8; ++i) if (32 * ks + 8 * kq + i > t) wv[i] = 0.f;
            u32x4 pk; pk.x = cvt_pk_bf16(wv[0], wv[1]); pk.y = cvt_pk_bf16(wv[2], wv[3]); pk.z = cvt_pk_bf16(wv[4], wv[5]); pk.w = cvt_pk_bf16(wv[6], wv[7]);
            const bf16x8 wf = __builtin_bit_cast(bf16x8, pk);
#pragma unroll
            for (int j = 0; j < 8; ++j) { const bf16x8 vf = *(const LAS bf16x8*)(vt + (16 * j + tl) * 136 + 32 * ks + 8 * kq);
                acc[j] = __builtin_amdgcn_mfma_f32_16x16x32_bf16(vf, wf, acc[j], 0, 0, 0); }
        }
#pragma unroll
        for (int j = 0; j < 8; ++j) { const int ch = 16 * j + 4 * kq; const u32x2 uu = uraw[j];
            const float o0 = __builtin_bit_cast(float, uu.x << 16) * (acc[j][0] + bs), o1 = __builtin_bit_cast(float, uu.x & 0xffff0000u) * (acc[j][1] + bs);
            const float o2 = __builtin_bit_cast(float, uu.y << 16) * (acc[j][2] + bs), o3 = __builtin_bit_cast(float, uu.y & 0xffff0000u) * (acc[j][3] + bs);
            u32x2 o; o.x = cvt_pk_bf16(o0, o1); o.y = cvt_pk_bf16(o2, o3); *(u32x2*)(AS + (size_t)(t0 + t) * DM + FW + g * 128 + ch) = o; }
        __syncthreads();
    }
}
__device__ __forceinline__ void fox_phase(const Frame& F, char* lds, int& sg_first, int& sg_count) {
    sg_first = blockIdx.x * 4; sg_count = 4;
    typedef unsigned short T;
    unsigned char* ws = F.ws; const int G = F.G, c = blockIdx.x, vcu = (G % 8 == 0) ? (c % 8) * (G / 8) + c / 8 : c;
    const T* Qb = (const T*)(ws + WS_Q); const T* Kb = (const T*)(ws + WS_K); const T* Vb = (const T*)(ws + WS_V); T* Ob = (T*)(ws + WS_AS); const float* CB = (const float*)(ws + WS_CB);
    if (vcu < NB * FH * 8) {
        const int L = vcu; const int bh = L >> 3, x = L & 7, b = bh / FH, h = bh % FH;
        __syncthreads();
        { const f32x4* src = (const f32x4*)(CB + (size_t)bh * SEQ); f32x4* dst = (f32x4*)(lds + att::BIAS_OFF); dst[F.tid] = src[F.tid]; dst[F.tid + 512] = src[F.tid + 512]; }
        __syncthreads();
        int Wwin = SEQ;
        { const unsigned* NRM = F.ctl + CW_NRM; float q2 = 0.f, k2 = 0.f;
#pragma unroll
            for (int i = 0; i < 4; ++i) { q2 += __uint_as_float(__hip_atomic_load(NRM + ((0 * 4 + b) * 8 + h) * 4 + i, __ATOMIC_RELAXED, __HIP_MEMORY_SCOPE_AGENT)); k2 += __uint_as_float(__hip_atomic_load(NRM + ((1 * 4 + b) * 8 + h) * 4 + i, __ATOMIC_RELAXED, __HIP_MEMORY_SCOPE_AGENT)); }
            const float Bnd = sqrtf(q2 * k2) * 0.08838834764831845f * 1.02f;
            const float need = -(2.f * Bnd + 30.f) * 11.313708498984761f;
            const float* bl = (const float*)(lds + att::BIAS_OFF); float* red = (float*)(lds + att::BIAS_OFF + SEQ * 4);
            int lo = 1, hi = SEQ / 64;
            while (lo < hi) { const int mid = (lo + hi) >> 1, Wc = mid * 64; float mx = -3.0e38f;
                for (int t = Wc + F.tid; t < SEQ; t += NTHREADS) mx = fmaxf(mx, bl[t - Wc] - bl[t]);
#pragma unroll
                for (int o = 1; o < 64; o <<= 1) mx = fmaxf(mx, __shfl_xor(mx, o));
                __syncthreads(); if (F.lane == 0) red[F.wave] = mx; __syncthreads();
                float m8 = red[0];
#pragma unroll
                for (int i = 1; i < 8; ++i) m8 = fmaxf(m8, red[i]);
                if (m8 <= need) hi = mid; else lo = mid + 1; }
            Wwin = __builtin_amdgcn_readfirstlane(lo * 64); __syncthreads(); }
        att::BlockRef<T, T> cur, nxt;
        cur.K = Kb + (size_t)b * SEQ * FW + h * FD; cur.V = Vb + (size_t)b * SEQ * FW + h * FD; nxt = cur;
        cur.Q = Qb + ((size_t)b * SEQ + x * 256) * FW + h * FD; cur.O = Ob + ((size_t)b * SEQ + x * 256) * DM + h * FD; cur.P0 = x * 256;
        nxt.Q = Qb + ((size_t)b * SEQ + (15 - x) * 256) * FW + h * FD; nxt.O = Ob + ((size_t)b * SEQ + (15 - x) * 256) * DM + h * FD; nxt.P0 = (15 - x) * 256;
        att::Seam<T> S;
        att::causal_swa_prime<T, T, FW, FW, DM, true>(cur, Wwin, lds, S);
        att::causal_swa_block<T, T, FW, FW, DM, true>(cur, nxt, SEQ, Wwin, lds, S);
        att::causal_swa_block<T, T, FW, FW, DM, true, false>(nxt, nxt, SEQ, Wwin, lds, S);
        { const int wt = Wwin / 64 + 4; int load[8], cnt[8];
#pragma unroll
          for (int i = 0; i < 8; ++i) { const int f0 = 4 * (i + 1), f1 = 4 * (16 - i); load[i] = (f0 < wt ? f0 : wt) + (f1 < wt ? f1 : wt); cnt[i] = 0; }
          for (int k = 0; k < 32; ++k) { int bi = 0, bv = load[0];
#pragma unroll
              for (int i = 1; i < 8; ++i) if (load[i] < bv) { bv = load[i]; bi = i; }
#pragma unroll
              for (int i = 0; i < 8; ++i) if (i == bi) { load[i] += 4; cnt[i] += 1; } }
          int first = 0, mine = 0;
#pragma unroll
          for (int i = 0; i < 8; ++i) { if (i < x) first += cnt[i]; if (i == x) mine = cnt[i]; }
          sg_first = bh * 32 + first; sg_count = mine; }
    }
}
__device__ __forceinline__ void xattn_phase(const Frame& F, char* lds) {
    typedef unsigned short T;
    unsigned char* ws = F.ws;
    const T* Qb = (const T*)(ws + WS_QX); const T* Kb = (const T*)(ws + WS_KX); const T* Vb = (const T*)(ws + WS_VX); T* Ob = (T*)(ws + WS_OX);
    for (int L = blockIdx.x; L < NB * XH * 16; L += F.G) {
        const int b = L >> 6, h = (L >> 4) & 3, qb = L & 15;
        att::BlockRef<T, T> cur;
        cur.K = Kb + (size_t)b * MEML * XW + h * XD; cur.V = Vb + (size_t)b * MEML * XW + h * XD;
        cur.Q = Qb + ((size_t)b * SEQ + qb * 256) * XW + h * XD; cur.O = Ob + ((size_t)b * SEQ + qb * 256) * XW + h * XD; cur.P0 = MEML;
        att::Seam<T> S;
        att::causal_swa_prime<T, T, XW, XW, XW, false>(cur, 1 << 20, lds, S);
        att::causal_swa_block<T, T, XW, XW, XW, false, false>(cur, cur, MEML, 1 << 20, lds, S);
    }
}
__device__ __forceinline__ void moe_tables(const Frame& F) {
    LAS int* tab = (LAS int*)(F.lds + LDS_TAB);
    __syncthreads();
    if (F.tid == 0) { const unsigned* CNT = F.ctl + CW_CNT; int p = 0;
        for (int e = 0; e < NE; ++e) { const int c = (int)__hip_atomic_load(CNT + e, __ATOMIC_RELAXED, __HIP_MEMORY_SCOPE_AGENT); tab[e] = p; tab[40 + e] = c; p += (c + 255) >> 8; }
        tab[32] = p; }
    __syncthreads();
}
typedef float f32x16 __attribute__((ext_vector_type(16)));
__device__ __forceinline__ void p8_router(const Frame& F, const KArgs& a) {
    unsigned char* ws = F.ws; const int tid = F.tid, lane = F.lane, wave = F.wave, tl = lane & 31, hi = lane >> 5, grp = wave >> 2, kq = wave & 3;
    const float* X2 = (const float*)(ws + WS_X2); const float* WRT = (const float*)(ws + WS_WRT);
    constexpr int PITCH = 132;
    LAS float* xs = (LAS float*)F.lds;
    LAS float* wsm = xs + 2 * 64 * PITCH;
    LAS float* red = wsm + 2 * 32 * PITCH;
    LAS unsigned* lcnt = (LAS unsigned*)(F.lds + LDS_TAB + 512);
    for (int tp = blockIdx.x; tp < NTOK / 64; tp += F.G) {
        const int tok0 = tp * 64;
        f32x4 xa[4], wa[2], xb[4], wb[2];
#define P8_LOAD(X, W, c) do { _Pragma("unroll") for (int i = 0; i < 4; ++i) { const int p = tid + 512 * i; X[i] = *(const f32x4*)(X2 + (size_t)(tok0 + (p >> 5)) * DM + (c) * 128 + (p & 31) * 4); } \
        _Pragma("unroll") for (int i = 0; i < 2; ++i) { const int p = tid + 512 * i; W[i] = *(const f32x4*)(WRT + (size_t)(p >> 5) * DM + (c) * 128 + (p & 31) * 4); } } while (0)
#define P8_WRITE(X, W, b) do { _Pragma("unroll") for (int i = 0; i < 4; ++i) { const int p = tid + 512 * i; *(LAS f32x4*)(xs + ((b) * 64 + (p >> 5)) * PITCH + (p & 31) * 4) = X[i]; } \
        _Pragma("unroll") for (int i = 0; i < 2; ++i) { const int p = tid + 512 * i; *(LAS f32x4*)(wsm + ((b) * 32 + (p >> 5)) * PITCH + (p & 31) * 4) = W[i]; } } while (0)
#define P8_COMPUTE(b) do { const LAS float* xp = xs + ((b) * 64 + grp * 32 + tl) * PITCH + kq * 32 + 4 * hi; const LAS float* wp = wsm + ((b) * 32 + tl) * PITCH + kq * 32 + 4 * hi; \
        _Pragma("unroll") for (int s4 = 0; s4 < 4; ++s4) { const f32x4 xv = *(const LAS f32x4*)(xp + 8 * s4), wv = *(const LAS f32x4*)(wp + 8 * s4); \
            ss += (xv[0] * xv[0] + xv[1] * xv[1]) + (xv[2] * xv[2] + xv[3] * xv[3]); \
            _Pragma("unroll") for (int i = 0; i < 4; ++i) d = __builtin_amdgcn_mfma_f32_32x32x2f32(wv[i], xv[i], d, 0, 0, 0); } } while (0)
        __syncthreads();
        P8_LOAD(xa, wa, 0); P8_WRITE(xa, wa, 0); P8_LOAD(xa, wa, 1);
        f32x16 d = {}; float ss = 0.f;
        for (int c = 0; c < 16; c += 2) {
            if (c + 2 < 16) P8_LOAD(xb, wb, c + 2);
            asm volatile("s_waitcnt lgkmcnt(0)\n\ts_barrier" ::: "memory");
            P8_COMPUTE(0);
            P8_WRITE(xa, wa, 1);
            if (c + 3 < 16) P8_LOAD(xa, wa, c + 3);
            asm volatile("s_waitcnt lgkmcnt(0)\n\ts_barrier" ::: "memory");
            P8_COMPUTE(1);
            if (c + 2 < 16) P8_WRITE(xb, wb, 0);
        }
#undef P8_COMPUTE
#undef P8_LOAD
#undef P8_WRITE
        const int tok = tok0 + grp * 32 + tl;
        if (kq != 0) { LAS float* r = red + ((grp * 3 + (kq - 1)) * 17) * 64 + lane;
#pragma unroll
            for (int i = 0; i < 16; ++i) r[i * 64] = d[i];
            r[16 * 64] = ss; }
        __syncthreads();
        float wgt[4] = {0.f, 0.f, 0.f, 0.f}; int fe[4] = {0, 0, 0, 0}; unsigned lr[4] = {0u, 0u, 0u, 0u}; float rstd_t = 0.f;
        if (kq == 0) {
#pragma unroll
            for (int w = 0; w < 3; ++w) { const LAS float* r = red + ((grp * 3 + w) * 17) * 64 + lane;
#pragma unroll
                for (int i = 0; i < 16; ++i) d[i] += r[i * 64];
                ss += r[16 * 64]; }
            ss += __shfl_xor(ss, 32);
            const float rstd = rsqrtf(ss * (1.f / DM) + RMS_EPS);
            float l[16];
#pragma unroll
            for (int r = 0; r < 16; ++r) { const int e = (r & 3) + 8 * (r >> 2) + 4 * hi; l[r] = d[r] * rstd + a.in[19][e]; }
            float tv[8]; int ti[8];
#pragma unroll
            for (int k = 0; k < 4; ++k) { float bv = -INFINITY; int bi = 0;
#pragma unroll
                for (int r = 0; r < 16; ++r) { const int e = (r & 3) + 8 * (r >> 2) + 4 * hi; if (l[r] > bv || (l[r] == bv && e < bi)) { bv = l[r]; bi = e; } }
                tv[k] = bv; ti[k] = bi;
#pragma unroll
                for (int r = 0; r < 16; ++r) { const int e = (r & 3) + 8 * (r >> 2) + 4 * hi; if (e == bi) l[r] = -INFINITY; } }
#pragma unroll
            for (int k = 0; k < 4; ++k) { tv[4 + k] = __shfl_xor(tv[k], 32); ti[4 + k] = __shfl_xor(ti[k], 32); }
            float fv[4]; int fi[4];
#pragma unroll
            for (int k = 0; k < 4; ++k) { float bv = -INFINITY; int bi = 1 << 30;
#pragma unroll
                for (int j = 0; j < 8; ++j) if (tv[j] > bv || (tv[j] == bv && ti[j] < bi)) { bv = tv[j]; bi = ti[j]; }
                fv[k] = bv; fi[k] = bi;
#pragma unroll
                for (int j = 0; j < 8; ++j) if (ti[j] == bi) tv[j] = -INFINITY; }
            if (hi == 0) {
                float w[4], sm = 0.f;
#pragma unroll
                for (int k = 0; k < 4; ++k) { w[k] = __expf(fv[k] - fv[0]); sm += w[k]; }
                const float inv = 1.f / sm; rstd_t = rstd;
#pragma unroll
                for (int k = 0; k < 4; ++k) { fe[k] = fi[k]; wgt[k] = w[k] * inv; lr[k] = __hip_atomic_fetch_add(lcnt + fi[k], 1u, __ATOMIC_RELAXED, __HIP_MEMORY_SCOPE_WORKGROUP); }
            }
        }
        __syncthreads();
        if (tid < 32) { const unsigned cN = lcnt[tid]; lcnt[32 + tid] = cN ? atomicAdd(F.ctl + CW_CNT + tid, cN) : 0u; lcnt[tid] = 0u; }
        __syncthreads();
        if (kq == 0 && hi == 0) {
            ((float*)(ws + WS_RS2))[tok] = rstd_t;
#pragma unroll
            for (int k = 0; k < 4; ++k) { const int e = fe[k]; const float wk = wgt[k]; const unsigned rk = lcnt[32 + e] + lr[k];
                ((int*)(ws + WS_TOPE))[tok * 4 + k] = e; ((int*)(ws + WS_TOPR))[tok * 4 + k] = (int)rk; ((float*)(ws + WS_TOPW))[tok * 4 + k] = wk;
                ((int*)(ws + WS_TOKL))[(size_t)e * NTOK + rk] = tok; ((float*)(ws + WS_GWL))[(size_t)e * NTOK + rk] = wk; ((float*)(ws + WS_RSL))[(size_t)e * NTOK + rk] = rstd_t; }
        }
    }
}
__device__ __forceinline__ void p12_final(const Frame& F, const KArgs& a) {
    unsigned char* ws = F.ws; const int lane = F.lane; const LAS int* tab = (const LAS int*)(F.lds + LDS_TAB);
    const float* X2 = (const float*)(ws + WS_X2); const unsigned char* YB = ws + WS_YB; const int* TOPE = (const int*)(ws + WS_TOPE); const int* TOPR = (const int*)(ws + WS_TOPR);
    for (int row = F.gw; row < NTOK; row += F.NGW) {
        size_t so[4];
#pragma unroll
        for (int k = 0; k < 4; ++k) { const int e = TOPE[row * 4 + k], r = TOPR[row * 4 + k]; so[k] = (size_t)(tab[e] * 256 + r) * DM; }
        f32x4 v[8]; float q = 0.f;
#pragma unroll
        for (int j = 0; j < 8; ++j) { const int c = 4 * (lane + 64 * j); v[j] = *(const f32x4*)(X2 + (size_t)row * DM + c);
#pragma unroll
            for (int k = 0; k < 4; ++k) { const int y = *(const int*)(YB + so[k] + c);
                v[j][0] += __builtin_amdgcn_cvt_f32_fp8(y, 0); v[j][1] += __builtin_amdgcn_cvt_f32_fp8(y, 1); v[j][2] += __builtin_amdgcn_cvt_f32_fp8(y, 2); v[j][3] += __builtin_amdgcn_cvt_f32_fp8(y, 3); }
            q += (v[j][0] * v[j][0] + v[j][1] * v[j][1]) + (v[j][2] * v[j][2] + v[j][3] * v[j][3]); }
        const float rs = rsqrtf(wave_sum(q) * (1.f / DM) + RMS_EPS);
#pragma unroll
        for (int j = 0; j < 8; ++j) { const int c = 4 * (lane + 64 * j); const f32x4 g = *(const f32x4*)(a.in[24] + c); *(f32x4*)(a.out + (size_t)row * DM + c) = v[j] * rs * g; }
    }
}
__global__ void __launch_bounds__(NTHREADS, 2) mega_fwd(KArgs args) {
    extern __shared__ __attribute__((aligned(16))) unsigned char lds_raw[];
    Frame F;
    F.lds = (LAS unsigned char*)lds_raw; F.MISC = (volatile LAS unsigned*)(F.lds + LDS_MISC);
    F.tid = threadIdx.x; F.lane = F.tid & 63; F.wave = __builtin_amdgcn_readfirstlane(F.tid >> 6);
    F.G = gridDim.x; F.gw = blockIdx.x * NWAVES + F.wave; F.NGW = F.G * NWAVES;
    F.ws = args.ws; F.ctl = (unsigned*)(args.ws + WS_CTL);
    unsigned char* ws = args.ws;
    for (int u = F.tid; u < (LDS_BYTES - LDS_MISC) / 4; u += NTHREADS) ((LAS unsigned*)(F.lds + LDS_MISC))[u] = 0u;
    __syncthreads();
    XcdBarrier bar = xcd_barrier_post(F.ctl + CW_BAR + args.li * XCD_BAR_WORDS, F.MISC + 8);
    const int lo = args.ph_lo, hi = args.ph_hi;
#define IN(k) (lo <= (k) && (k) < hi)
#define BOTH(k) (IN(k) && IN((k) + 1))
    if (IN(0)) { p0_prologue<0>(F, args, F.gw, F.NGW); if (BOTH(0)) xcd_barrier(bar); }
    if (IN(1)) {
        if (blockIdx.x < NB * FH && F.wave == 0) cumsum_wave((const float*)(ws + WS_LOGF), (float*)(ws + WS_CB), blockIdx.x, F.lane);
        const int bx = blockIdx.x, oct = bx >> 3, conv = (oct & 7) < pg8::P1_CO ? 1 : 0;
        const int idx = (conv ? ((oct >> 3) * pg8::P1_CO + (oct & 7)) : ((oct >> 3) * (8 - pg8::P1_CO) + (oct & 7) - pg8::P1_CO)) * 8 + (bx & 7);
        if (conv) cvt8_phase(F, args, idx, pg8::P1_NC, 0, CVT8_P1_SUPER);
        {
            pg8::ProjSched S; S.T.init(NTOK / 256, pg8::P1_NBF, pg8::P1_NG, idx); S.A = (const char*)(ws + WS_H0); S.B = (const char*)(ws + WS_WP); S.lda = DM * 2; S.ldb = DM * 2; S.conv = conv; S.idx = idx;
            pg8::EpiProj E{ws, 0, -1.4426950408889634f};
            pg8::gemm_phase<false, false>(F.lds, DM / 64, DM * 2, DM * 2, S, E); }
        {
            constexpr int OFS = (pg8::P1_NG - ((NTOK / 256) * pg8::P1_NBF) % pg8::P1_NG) % pg8::P1_NG;
            pg8::ProjSched S; S.T.init(NTOK / 256, pg8::P1_NF8, pg8::P1_NG, (idx + OFS) % pg8::P1_NG); S.A = (const char*)(ws + WS_H0Q); S.B = (const char*)(ws + WS_WPG); S.lda = DM; S.ldb = DM; S.conv = conv; S.idx = (idx + OFS) % pg8::P1_NG;
            pg8::EpiProj E{ws, pg8::P1_NBF, -1.4426950408889634f * W8_INV};
            pg8::gemm_phase<false, true>(F.lds, DM / 128, DM, DM, S, E); }
        if (BOTH(1)) xcd_barrier(bar);
    }
    if (IN(2)) { int sg_first, sg_count; fox_phase(F, (char*)lds_raw, sg_first, sg_count); sg_phase(F, args, sg_first, sg_count); if (BOTH(2)) xcd_barrier(bar); }
    if (IN(3)) {
        pg8::MergeSched S; S.T.init(NTOK / 256, DM / 256, F.G, (int)blockIdx.x); S.A = (const char*)(ws + WS_AS); S.B = (const char*)(ws + WS_WAB); S.lda = DM * 2; S.ldb = DM * 2;
        pg8::EpiMerge E{ws};
        pg8::gemm_phase<false, false>(F.lds, FW / 64, DM * 2, DM * 2, S, E);
        if (BOTH(3)) xcd_barrier(bar);
    }
    if (IN(4)) {
        pg8::PlainSched S; S.T.init(NTOK / 256, DM / 256, F.G, (int)blockIdx.x); S.A = (const char*)(ws + WS_MG); S.B = (const char*)(ws + WS_WO); S.lda = DM * 2; S.ldb = DM * 2;
        pg8::EpiResid<false, false> E{args.in[0], nullptr, (bf16*)(ws + WS_X1B), (float*)(ws + WS_SS1), nullptr};
        pg8::gemm_phase<false, false>(F.lds, DM / 64, DM * 2, DM * 2, S, E);
        if (BOTH(4)) xcd_barrier(bar);
    }
    if (IN(5)) {
        if (blockIdx.x >= 144) cvt8_phase(F, args, (int)blockIdx.x - 144, 112, CVT8_P1_SUPER, CVT8_SUPER);
        pg8::QkvSched S{(const char*)(ws + WS_X1B), (const char*)(ws + WS_WXQ), (const char*)(ws + WS_HM), (const char*)(ws + WS_WXKV), (int)blockIdx.x};
        pg8::EpiQkv E{ws};
        pg8::gemm_phase<false, false>(F.lds, DM / 64, DM * 2, DM * 2, S, E);
        if (BOTH(5)) xcd_barrier(bar);
    }
    if (IN(6)) { xattn_phase(F, (char*)lds_raw); if (BOTH(6)) xcd_barrier(bar); }
    if (IN(7)) {
        pg8::PlainSched S; S.T.init(NTOK / 256, DM / 256, F.G, (int)blockIdx.x); S.A = (const char*)(ws + WS_OX); S.B = (const char*)(ws + WS_WXO); S.lda = XW * 2; S.ldb = XW * 2;
        pg8::EpiResid<true, true> E{(const void*)(ws + WS_X1B), (float*)(ws + WS_X2), nullptr, (float*)(ws + WS_SS2), ws + WS_X2Q};
        pg8::gemm_phase<false, false>(F.lds, XW / 64, XW * 2, XW * 2, S, E);
        if (BOTH(7)) xcd_barrier(bar);
    }
    if (IN(8)) { p8_router(F, args); if (BOTH(8)) xcd_barrier(bar); }
    if (IN(10)) {
        moe_tables(F);
        pg8::MoeSched S{(const LAS int*)(F.lds + LDS_TAB), (const char*)(ws + WS_X2Q), (const char*)(ws + WS_WGU), (const int*)(ws + WS_TOKL), F.G, (int)blockIdx.x, 16, (unsigned)DM, (size_t)(2 * DFF)};
        pg8::EpiAct E{ws, (const LAS int*)(F.lds + LDS_TAB), args.in[21]};
        pg8::gemm_phase<true, true>(F.lds, DM / 128, DM, DM, S, E);
        if (BOTH(10)) xcd_barrier(bar);
    }
    if (IN(11)) {
        moe_tables(F);
        pg8::DownSched S{{(const LAS int*)(F.lds + LDS_TAB), (const char*)(ws + WS_HB), (const char*)(ws + WS_WD), (const int*)(ws + WS_TOKL), F.G, (int)blockIdx.x, 8, (unsigned)DFF, (size_t)DM}, (unsigned)DFF};
        pg8::EpiDown E{ws, (const LAS int*)(F.lds + LDS_TAB), args.in[23]};
        pg8::gemm_phase<false, true>(F.lds, DFF / 128, DFF, DFF, S, E);
        if (BOTH(11)) xcd_barrier(bar);
    }
    if (IN(12)) { moe_tables(F); p12_final(F, args); }
#undef IN
#undef BOTH
}
#ifndef PROBE_PHASE
#define PROBE_PHASE -1
#endif
static int g_grid = 0;
static void mega_launch(hipStream_t st, void* const* d_in, void* d_out, void* d_ws, int lo, int hi, int li) {
    if (g_grid == 0) {
        int dev = 0, cus = 0;
        if (hipGetDevice(&dev) != hipSuccess || hipDeviceGetAttribute(&cus, hipDeviceAttributeMultiprocessorCount, dev) != hipSuccess || cus <= 0) cus = 256;
        if (hipFuncSetAttribute((const void*)mega_fwd, hipFuncAttributeMaxDynamicSharedMemorySize, LDS_BYTES) != hipSuccess) fprintf(stderr, "hipFuncSetAttribute failed\n");
        int per_cu = 0;
        if (hipOccupancyMaxActiveBlocksPerMultiprocessor(&per_cu, (const void*)mega_fwd, NTHREADS, LDS_BYTES) != hipSuccess || per_cu < 1) fprintf(stderr, "occupancy query: %d\n", per_cu);
        (void)hipGetLastError();
        g_grid = cus;
        if (cus != 256) fprintf(stderr, "kernel_launch: built for 256 CUs, device reports %d\n", cus);
    }
    KArgs a{};
    for (int i = 0; i < 25; ++i) a.in[i] = (const float*)d_in[i];
    a.out = (float*)d_out; a.ws = (unsigned char*)d_ws; a.ph_lo = lo; a.ph_hi = hi; a.li = li; a.pad = 0;
    hipLaunchKernelGGL(mega_fwd, dim3(g_grid), dim3(NTHREADS), LDS_BYTES, st, a);
}
extern "C" void kernel_launch(void* const* d_in, const int* in_sizes, int n_in, void* d_out, int out_size, void* d_ws, size_t ws_size, hipStream_t st) {
    if (n_in != 25 || ws_size < WS_END) { fprintf(stderr, "kernel_launch: unexpected n_in %d / ws %zu\n", n_in, ws_size); return; }
    (void)in_sizes; (void)out_size;
    char* ws = (char*)d_ws;
    (void)hipMemsetAsync(ws + WS_CTL, 0, CTL_BYTES, st);
    mega_launch(st, d_in, d_out, d_ws, 0, 13, 0);
#if PROBE_PHASE >= 0
    mega_launch(st, d_in, d_out, d_ws, PROBE_PHASE, PROBE_PHASE + 1, 1);
#endif
}
```

```cpp
#include <hip/hip_runtime.h>
#include <cstdio>
#include <cstdint>
#include <type_traits>

constexpr int DM = 2048, NB = 4, SEQ = 4096, NTOK = NB * SEQ, MEML = 256, NMEM = NB * MEML;
constexpr int FH = 8, FD = 128, FW = 1024, SGG = 8, SGD = 128, SGW = 1024, SGC = 128;
constexpr int XH = 4, XD = 128, XW = 512;
constexpr int NE = 32, TOPK = 4, DFF = 2048;
constexpr int INC = 3 * FW + FH + 2 * SGW + 2 * DM;
constexpr int C_Q = 0, C_K = 1024, C_V = 2048, C_F = 3072, C_Z = 3080, C_GA = 5128, C_GB = 7176;
constexpr float RMS_EPS = 1e-6f, LN_EPS = 1e-5f, SW_LIMIT = 7.0f, SW_ALPHA = 1.702f;
constexpr int MAXSLOT = NTOK * TOPK + NE * 256;

typedef unsigned short bf16;
__device__ __forceinline__ unsigned f2bf(float f) { unsigned u = __builtin_bit_cast(unsigned, f); return (u + 0x7fffu + ((u >> 16) & 1u)) >> 16; }
__device__ __forceinline__ float bf2f(bf16 h) { return __builtin_bit_cast(float, (unsigned)h << 16); }

constexpr size_t MiB = 1ull << 20;
constexpr size_t WS_CTL = 0;
constexpr size_t CTL_BYTES = 1 * MiB;
constexpr int CW_NRM = 12288;
constexpr int CW_CNT = 8192;
constexpr size_t WS_H0   = 16 * MiB;
constexpr size_t WS_HM   = WS_H0 + 64 * MiB;
constexpr size_t WS_LOGF = WS_HM + 4 * MiB;
constexpr size_t WS_CB   = WS_LOGF + 1 * MiB;
constexpr size_t WS_Q    = WS_CB + 1 * MiB;
constexpr size_t WS_K    = WS_Q + 32 * MiB;
constexpr size_t WS_V    = WS_K + 32 * MiB;
constexpr size_t WS_ZU   = WS_V + 32 * MiB;
constexpr size_t WS_ZV   = WS_ZU + 32 * MiB;
constexpr size_t WS_ZST  = WS_ZV + 32 * MiB;
constexpr size_t WS_GR   = WS_ZST + 2 * MiB;
constexpr size_t WS_GS   = WS_GR + 64 * MiB;
constexpr size_t WS_AS   = WS_GS + 64 * MiB;
constexpr size_t WS_MG   = WS_AS + 64 * MiB;
constexpr size_t WS_X1   = WS_MG + 64 * MiB;
constexpr size_t WS_X1B  = WS_X1 + 128 * MiB;
constexpr size_t WS_SS1  = WS_X1B + 64 * MiB;
constexpr size_t WS_QX   = WS_SS1 + 2 * MiB;
constexpr size_t WS_KX   = WS_QX + 16 * MiB;
constexpr size_t WS_VX   = WS_KX + 1 * MiB;
constexpr size_t WS_OX   = WS_VX + 1 * MiB;
constexpr size_t WS_X2   = WS_OX + 16 * MiB;
constexpr size_t WS_X2B  = WS_X2 + 128 * MiB;
constexpr size_t WS_SS2  = WS_X2B + 64 * MiB;
constexpr size_t WS_TOPE = WS_SS2 + 2 * MiB;
constexpr size_t WS_TOPR = WS_TOPE + 1 * MiB;
constexpr size_t WS_TOPW = WS_TOPR + 1 * MiB;
constexpr size_t WS_TOKL = WS_TOPW + 1 * MiB;
constexpr size_t WS_GWL  = WS_TOKL + 2 * MiB;
constexpr size_t WS_HB   = WS_GWL + 2 * MiB;
constexpr size_t WS_YB   = WS_HB + 288 * MiB;
constexpr size_t WS_TMP  = WS_YB + 288 * MiB;
constexpr size_t WS_END_NAIVE = WS_TMP + 640 * MiB;

__device__ __forceinline__ float gelu_tanh(float x) {
    const float u = 0.7978845608028654f * (x + 0.044715f * x * x * x);
    const float e = __expf(2.f * u);
    const float t = 1.f - 2.f / (e + 1.f);
    return 0.5f * x * (1.f + t);
}
__device__ __forceinline__ float sigmoidf_(float x) { return 1.f / (1.f + __expf(-x)); }
__device__ __forceinline__ float log_sigmoid(float x) { return fminf(x, 0.f) - log1pf(__expf(-fabsf(x))); }

#ifdef REFERENCE_PIPELINE
__device__ __forceinline__ float block_sum_256(float v, float* red) {
#pragma unroll
    for (int o = 32; o > 0; o >>= 1) v += __shfl_xor(v, o);
    __syncthreads();
    if ((threadIdx.x & 63) == 0) red[threadIdx.x >> 6] = v;
    __syncthreads();
    return red[0] + red[1] + red[2] + red[3];
}
__global__ __launch_bounds__(256) void n_rms_rows(const float* X, const float* g, bf16* OUT, const float* w_in, const float* b_forget, float* LOGF) {
    __shared__ float red[4];
    const int row = blockIdx.x, t = threadIdx.x;
    const float* x = X + (size_t)row * DM;
    float v[8]; float s = 0.f;
#pragma unroll
    for (int i = 0; i < 8; ++i) { v[i] = x[t + 256 * i]; s += v[i] * v[i]; }
    const float tot = block_sum_256(s, red);
    const float rstd = rsqrtf(tot * (1.f / DM) + RMS_EPS);
    float f[8];
#pragma unroll
    for (int j = 0; j < 8; ++j) f[j] = 0.f;
#pragma unroll
    for (int i = 0; i < 8; ++i) {
        const int k = t + 256 * i; const float h = v[i] * rstd * g[k];
        OUT[(size_t)row * DM + k] = (bf16)f2bf(h);
        if (LOGF) {
#pragma unroll
            for (int j = 0; j < 8; ++j) f[j] += h * w_in[(size_t)k * INC + C_F + j];
        }
    }
    if (LOGF) {
#pragma unroll
        for (int j = 0; j < 8; ++j) { const float tj = block_sum_256(f[j], red); if (t == 0) LOGF[(size_t)row * 8 + j] = log_sigmoid(tj + b_forget[j]); }
    }
}
__global__ __launch_bounds__(64) void n_cumsum(const float* LOGF, float* CB) {
    const int bh = blockIdx.x, b = bh / FH, h = bh % FH, lane = threadIdx.x;
    float loc = 0.f;
    for (int i = 0; i < 64; ++i) loc += LOGF[(size_t)(b * SEQ + lane * 64 + i) * 8 + h];
    float inc = loc;
#pragma unroll
    for (int o = 1; o < 64; o <<= 1) { const float n = __shfl_up(inc, o); if (lane >= o) inc += n; }
    float run = inc - loc;
    for (int i = 0; i < 64; ++i) { run += LOGF[(size_t)(b * SEQ + lane * 64 + i) * 8 + h]; CB[(size_t)bh * SEQ + lane * 64 + i] = -run * 11.313708498984761f; }
}

template <bool DUAL, class FA, class FB, class FA2, class FB2, class FE>
__global__ __launch_bounds__(256) void n_gemm(int M, int N, int K, int padarg, const int* Mdev, FA fa, FB fb, FA2 fa2, FB2 fb2, FE fe) {
    __shared__ float As[16][68], Bs[16][68], As2[DUAL ? 16 : 1][68], Bs2[DUAL ? 16 : 1][68];
    const int z = blockIdx.z, m0 = blockIdx.y * 64, n0 = blockIdx.x * 64, t = threadIdx.x, tx = t & 15, ty = t >> 4;
    const int Mr = Mdev ? Mdev[z] : M;
    if (m0 >= Mr) return;
    float acc[4][4], acc2[4][4];
#pragma unroll
    for (int i = 0; i < 4; ++i)
#pragma unroll
        for (int j = 0; j < 4; ++j) { acc[i][j] = 0.f; acc2[i][j] = 0.f; }
    for (int k0 = 0; k0 < K; k0 += 16) {
#pragma unroll
        for (int i = 0; i < 4; ++i) {
            const int idx = t + i * 256;
            { const int r = idx >> 4, c = idx & 15; const bool ok = (m0 + r) < Mr; As[c][r] = ok ? fa(z, m0 + r, k0 + c) : 0.f; if (DUAL) As2[c][r] = ok ? fa2(z, m0 + r, k0 + c) : 0.f; }
            { const int r = idx >> 6, c = idx & 63; const bool ok = (n0 + c) < N; Bs[r][c] = ok ? fb(z, k0 + r, n0 + c) : 0.f; if (DUAL) Bs2[r][c] = ok ? fb2(z, k0 + r, n0 + c) : 0.f; }
        }
        __syncthreads();
#pragma unroll
        for (int kk = 0; kk < 16; ++kk) {
            float a[4], b[4], a2[4], b2[4];
#pragma unroll
            for (int i = 0; i < 4; ++i) { a[i] = As[kk][ty * 4 + i]; b[i] = Bs[kk][tx * 4 + i]; if (DUAL) { a2[i] = As2[kk][ty * 4 + i]; b2[i] = Bs2[kk][tx * 4 + i]; } }
#pragma unroll
            for (int i = 0; i < 4; ++i)
#pragma unroll
                for (int j = 0; j < 4; ++j) { acc[i][j] += a[i] * b[j]; if (DUAL) acc2[i][j] += a2[i] * b2[j]; }
        }
        __syncthreads();
    }
#pragma unroll
    for (int i = 0; i < 4; ++i)
#pragma unroll
        for (int j = 0; j < 4; ++j) { const int m = m0 + ty * 4 + i, n = n0 + tx * 4 + j; if (m < Mr && n < N) fe(z, m, n, acc[i][j], acc2[i][j]); }
}
struct FNone { long pad; __device__ float operator()(int, int, int) const { return 0.f; } };
template <bool DUAL, class FA, class FB, class FA2, class FB2, class FE>
static void run_gemm(hipStream_t st, int Z, int M, int N, int K, const int* Mdev, FA fa, FB fb, FA2 fa2, FB2 fb2, FE fe) {
    dim3 grid((N + 63) / 64, (M + 63) / 64, Z);
    hipLaunchKernelGGL((n_gemm<DUAL, FA, FB, FA2, FB2, FE>), grid, dim3(256), 0, st, M, N, K, 0, Mdev, fa, fb, fa2, fb2, fe);
}
template <class FA, class FB, class FE>
static void run_gemm1(hipStream_t st, int Z, int M, int N, int K, const int* Mdev, FA fa, FB fb, FE fe) { run_gemm<false>(st, Z, M, N, K, Mdev, fa, fb, FNone{}, FNone{}, fe); }

struct ABf { const bf16* p; int ld, pad; __device__ float operator()(int, int m, int k) const { return bf2f(p[(size_t)m * ld + k]); } };
struct AF32 { const float* p; int ld, pad; __device__ float operator()(int, int m, int k) const { return p[(size_t)m * ld + k]; } };
struct BF32 { const float* p; int ld, pad; __device__ float operator()(int, int k, int n) const { return p[(size_t)k * ld + n]; } };
struct BF32G { const float* p; const float* g; int ld, pad; __device__ float operator()(int, int k, int n) const { return g[k] * p[(size_t)k * ld + n]; } };

struct EProj { bf16 *Q, *K, *V, *ZU, *ZV; float *TGA, *TGB;
    __device__ void operator()(int, int m, int n, float v, float) const {
        if (n < C_K) Q[(size_t)m * FW + n] = (bf16)f2bf(v);
        else if (n < C_V) K[(size_t)m * FW + n - C_K] = (bf16)f2bf(v);
        else if (n < C_F) V[(size_t)m * FW + n - C_V] = (bf16)f2bf(v);
        else if (n < C_Z) {}
        else if (n < C_Z + SGW) ZU[(size_t)m * SGW + n - C_Z] = (bf16)f2bf(gelu_tanh(v));
        else if (n < C_GA) ZV[(size_t)m * SGW + n - C_Z - SGW] = (bf16)f2bf(gelu_tanh(v));
        else if (n < C_GB) TGA[(size_t)m * DM + n - C_GA] = sigmoidf_(v);
        else TGB[(size_t)m * DM + n - C_GB] = sigmoidf_(v);
    } };
__global__ __launch_bounds__(256) void n_gates(const float* TGA, const float* TGB, bf16* GR, bf16* GS) {
    const size_t i = (size_t)blockIdx.x * 256 + threadIdx.x; const float a = TGA[i], b = TGB[i]; GR[i] = (bf16)f2bf(a / b); GS[i] = (bf16)f2bf(b);
}
__global__ __launch_bounds__(256) void n_zstat(const bf16* ZV, float* ZST) {
    __shared__ float red[4];
    const int row = blockIdx.x, t = threadIdx.x; float s = 0.f, q = 0.f;
    for (int i = 0; i < 4; ++i) { const float v = bf2f(ZV[(size_t)row * SGW + t + 256 * i]); s += v; q += v * v; }
    const float S = block_sum_256(s, red); const float Q = block_sum_256(q, red);
    if (t < 32) ZST[(size_t)row * 32 + t] = (t == 0) ? S : (t == 1) ? Q : 0.f;
}
struct AQh { const bf16* p; int ld, b, rows, pad; __device__ float operator()(int z, int m, int k) const { return bf2f(p[(size_t)(b * rows + m) * ld + z * 128 + k]); } };
struct BKh { const bf16* p; int ld, b, rows, pad; __device__ float operator()(int z, int k, int n) const { return bf2f(p[(size_t)(b * rows + n) * ld + z * 128 + k]); } };
struct BVh { const bf16* p; int ld, b, rows, pad; __device__ float operator()(int z, int k, int n) const { return bf2f(p[(size_t)(b * rows + k) * ld + z * 128 + n]); } };
struct ES { float* S; const float* CB; int b, ncol, causal, pad; __device__ void operator()(int z, int m, int n, float v, float) const {
        float s = v; if (CB) s += CB[(size_t)(b * FH + z) * SEQ + n]; s *= 0.08838834764831845f; if (causal && n > m) s = -INFINITY; S[((size_t)z * SEQ + m) * ncol + n] = s; } };
__global__ __launch_bounds__(256) void n_softmax_rows(float* S, int ncol) {
    __shared__ float red[4];
    float* r = S + (size_t)blockIdx.x * ncol; const int t = threadIdx.x;
    float mx = -INFINITY; for (int i = t; i < ncol; i += 256) mx = fmaxf(mx, r[i]);
#pragma unroll
    for (int o = 32; o > 0; o >>= 1) mx = fmaxf(mx, __shfl_xor(mx, o));
    __syncthreads(); if ((t & 63) == 0) red[t >> 6] = mx; __syncthreads();
    mx = fmaxf(fmaxf(red[0], red[1]), fmaxf(red[2], red[3]));
    float s = 0.f; for (int i = t; i < ncol; i += 256) { const float e = __expf(r[i] - mx); r[i] = e; s += e; }
    const float tot = block_sum_256(s, red); const float inv = 1.f / tot;
    for (int i = t; i < ncol; i += 256) r[i] *= inv;
}
struct AS3 { const float* S; int ncol, pad; __device__ float operator()(int z, int m, int k) const { return S[((size_t)z * SEQ + m) * ncol + k]; } };
struct EO { bf16* O; int ld, b, coff, pad; __device__ void operator()(int z, int m, int n, float v, float) const { O[(size_t)(b * SEQ + m) * ld + coff + z * 128 + n] = (bf16)f2bf(v); } };
__global__ __launch_bounds__(128) void n_spatial(const bf16* ZU, const bf16* ZV, const float* ZST, const float* ln_g, const float* ln_b, const float* w_s, const float* b_s, bf16* AS) {
    __shared__ float vn[128][129];
    const int chunk = blockIdx.x, g = blockIdx.y, c = threadIdx.x, t0 = chunk * SGC;
    for (int s = 0; s < 128; ++s) {
        const float* st = ZST + (size_t)(t0 + s) * 32; float S = 0.f, Q = 0.f;
        for (int i = 0; i < 16; ++i) { S += st[2 * i]; Q += st[2 * i + 1]; }
        const float mu = S * (1.f / SGW), var = fmaxf(Q * (1.f / SGW) - mu * mu, 0.f), rs = rsqrtf(var + LN_EPS);
        const float v = bf2f(ZV[(size_t)(t0 + s) * SGW + g * 128 + c]);
        vn[s][c] = (v - mu) * rs * ln_g[g * 128 + c] + ln_b[g * 128 + c];
    }
    __syncthreads();
    for (int t = 0; t < 128; ++t) {
        float a = 0.f; const float* w = w_s + ((size_t)g * 128 + t) * 128;
        for (int s = 0; s <= t; ++s) a += w[s] * vn[s][c];
        a += b_s[g * 128 + t];
        const float u = bf2f(ZU[(size_t)(t0 + t) * SGW + g * 128 + c]);
        AS[(size_t)(t0 + t) * DM + FW + g * 128 + c] = (bf16)f2bf(u * a);
    }
}
struct BWab { const float* wa; const float* wb; int second, pad; __device__ float operator()(int, int k, int n) const { return second ? wb[(size_t)k * DM + n] : wa[(size_t)k * DM + n]; } };
struct AAs { const bf16* p; int off, pad; __device__ float operator()(int, int m, int k) const { return bf2f(p[(size_t)m * DM + off + k]); } };
struct EMerge { const bf16 *GR, *GS; bf16* MG; __device__ void operator()(int, int m, int n, float v, float v2) const { const size_t i = (size_t)m * DM + n; MG[i] = (bf16)f2bf((v * bf2f(GR[i]) + v2) * bf2f(GS[i])); } };
struct EResid { const float* Xi; float* Xo; bf16* Xb; __device__ void operator()(int, int m, int n, float v, float) const { const size_t i = (size_t)m * DM + n; const float o = Xi[i] + v; Xo[i] = o; Xb[i] = (bf16)f2bf(o); } };
__global__ __launch_bounds__(256) void n_sumsq(const float* X, float* SS) {
    __shared__ float red[4];
    const int row = blockIdx.x, t = threadIdx.x; float q = 0.f;
    for (int i = 0; i < 8; ++i) { const float v = X[(size_t)row * DM + t + 256 * i]; q += v * v; }
    const float Q = block_sum_256(q, red);
    if (t < 32) SS[(size_t)row * 32 + t] = (t == 0) ? Q : 0.f;
}
__device__ __forceinline__ float rstd_from(const float* SS, int m) { float q = 0.f; for (int i = 0; i < 32; ++i) q += SS[(size_t)m * 32 + i]; return rsqrtf(q * (1.f / DM) + RMS_EPS); }
struct EQx { const float* SS; bf16* QX; __device__ void operator()(int, int m, int n, float v, float) const { QX[(size_t)m * XW + n] = (bf16)f2bf(v * rstd_from(SS, m)); } };
struct EKVx { bf16 *KX, *VX; __device__ void operator()(int, int m, int n, float v, float) const { if (n < XW) KX[(size_t)m * XW + n] = (bf16)f2bf(v); else VX[(size_t)m * XW + n - XW] = (bf16)f2bf(v); } };
struct ELogit { const float* SS; const float* br; float* LG; __device__ void operator()(int, int m, int n, float v, float) const { LG[(size_t)m * NE + n] = v * rstd_from(SS, m) + br[n]; } };
__global__ __launch_bounds__(256) void n_topk(const float* LG, int* TOPE, int* TOPR, float* TOPW, int* TOKL, float* GWL, unsigned* CNT, const float* SS, float* RS2) {
    const int t = blockIdx.x * 256 + threadIdx.x; if (t >= NTOK) return;
    RS2[t] = rstd_from(SS, t);
    float l[NE];
#pragma unroll
    for (int e = 0; e < NE; ++e) l[e] = LG[(size_t)t * NE + e];
    float tv[4]; int ti[4];
#pragma unroll
    for (int k = 0; k < 4; ++k) { float bv = -INFINITY; int bi = 0;
#pragma unroll
        for (int e = 0; e < NE; ++e) { if (l[e] > bv) { bv = l[e]; bi = e; } }
        tv[k] = bv; ti[k] = bi;
#pragma unroll
        for (int e = 0; e < NE; ++e) if (e == bi) l[e] = -INFINITY; }
    float s = 0.f, w[4];
#pragma unroll
    for (int k = 0; k < 4; ++k) { w[k] = __expf(tv[k] - tv[0]); s += w[k]; }
#pragma unroll
    for (int k = 0; k < 4; ++k) { const float wk = w[k] / s; const int e = ti[k]; const unsigned r = atomicAdd(&CNT[e], 1u);
        TOPE[t * 4 + k] = e; TOPR[t * 4 + k] = (int)r; TOPW[t * 4 + k] = wk; TOKL[(size_t)e * NTOK + r] = t; GWL[(size_t)e * NTOK + r] = wk; }
}
__device__ __forceinline__ int expert_base(const unsigned* CNT, int e) { int b = 0; for (int i = 0; i < e; ++i) b += ((int)CNT[i] + 255) & ~255; return b; }
struct AGath { const bf16* X; const int* TOKL; __device__ float operator()(int z, int m, int k) const { return bf2f(X[(size_t)TOKL[(size_t)z * NTOK + m] * DM + k]); } };
struct BGu { const float* w; const float* g; int up, pad; __device__ float operator()(int z, int k, int n) const { return g[k] * w[((size_t)z * DM + k) * (2 * DFF) + up * DFF + n]; } };
struct EAct { const float* SS; const int* TOKL; const float* bgu; const unsigned* CNT; bf16* HB;
    __device__ void operator()(int z, int m, int n, float v, float v2) const {
        const float rs = rstd_from(SS, TOKL[(size_t)z * NTOK + m]);
        float gate = v * rs + bgu[(size_t)z * 2 * DFF + n], up = v2 * rs + bgu[(size_t)z * 2 * DFF + DFF + n];
        gate = fminf(gate, SW_LIMIT); up = fminf(fmaxf(up, -SW_LIMIT), SW_LIMIT);
        const float act = (up + 1.f) * gate * sigmoidf_(SW_ALPHA * gate);
        HB[(size_t)(expert_base(CNT, z) + m) * DFF + n] = (bf16)f2bf(act); } };
struct AHb { const bf16* HB; const unsigned* CNT; __device__ float operator()(int z, int m, int k) const { return bf2f(HB[(size_t)(expert_base(CNT, z) + m) * DFF + k]); } };
struct BDn { const float* w; __device__ float operator()(int z, int k, int n) const { return w[((size_t)z * DFF + k) * DM + n]; } };
struct EDn { const float* bd; const float* GWL; const unsigned* CNT; bf16* YB; __device__ void operator()(int z, int m, int n, float v, float) const {
        YB[(size_t)(expert_base(CNT, z) + m) * DM + n] = (bf16)f2bf((v + bd[(size_t)z * DM + n]) * GWL[(size_t)z * NTOK + m]); } };
__global__ __launch_bounds__(256) void n_final(const float* X2, const bf16* YB, const int* TOPE, const int* TOPR, const unsigned* CNT, const float* g, float* OUT) {
    __shared__ float red[4];
    const int row = blockIdx.x, t = threadIdx.x;
    int slot[4];
#pragma unroll
    for (int k = 0; k < 4; ++k) slot[k] = expert_base(CNT, TOPE[row * 4 + k]) + TOPR[row * 4 + k];
    float v[8]; float q = 0.f;
#pragma unroll
    for (int i = 0; i < 8; ++i) { const int c = t + 256 * i; float a = X2[(size_t)row * DM + c];
#pragma unroll
        for (int k = 0; k < 4; ++k) a += bf2f(YB[(size_t)slot[k] * DM + c]);
        v[i] = a; q += a * a; }
    const float Q = block_sum_256(q, red); const float rs = rsqrtf(Q * (1.f / DM) + RMS_EPS);
#pragma unroll
    for (int i = 0; i < 8; ++i) { const int c = t + 256 * i; OUT[(size_t)row * DM + c] = v[i] * rs * g[c]; }
}

#endif
#define LAS __attribute__((address_space(3)))
#define GAS __attribute__((address_space(1)))
typedef short bf16x8 __attribute__((ext_vector_type(8)));
typedef float f32x4 __attribute__((ext_vector_type(4)));
typedef float f32x2 __attribute__((ext_vector_type(2)));
typedef unsigned u32x4 __attribute__((ext_vector_type(4)));
typedef unsigned u32x2 __attribute__((ext_vector_type(2)));

constexpr int NPROJ = 9216;
constexpr size_t WS_WP   = WS_END_NAIVE;
constexpr size_t WS_WAB  = WS_WP + 36 * MiB;
constexpr size_t WS_WO   = WS_WAB + 8 * MiB;
constexpr size_t WS_WXQ  = WS_WO + 8 * MiB;
constexpr size_t WS_WXKV = WS_WXQ + 2 * MiB;
constexpr size_t WS_WXO  = WS_WXKV + 4 * MiB;
constexpr size_t WS_WGU  = WS_WXO + 2 * MiB;
constexpr size_t WS_WD   = WS_WGU + 512 * MiB;
constexpr size_t WS_WRT  = WS_WD + 256 * MiB;
constexpr size_t WS_RS2  = WS_WRT + 1 * MiB;
constexpr size_t WS_RSL  = WS_RS2 + 1 * MiB;
constexpr size_t WS_X2Q  = WS_RSL + 2 * MiB;
constexpr size_t WS_H0Q  = WS_X2Q + 32 * MiB;
constexpr size_t WS_WPG  = WS_H0Q + 32 * MiB;
constexpr size_t WS_END  = WS_WPG + 8 * MiB;

constexpr int NWAVES = 8, NTHREADS = 512;
constexpr int LDS_STAGE = 131072;
constexpr int LDS_MISC = LDS_STAGE;
constexpr int LDS_TAB = LDS_STAGE + 256;
constexpr int LDS_BYTES = 147456;
constexpr int CW_BAR = 65536;

__device__ __forceinline__ unsigned cvt_pk_bf16(float lo, float hi) { unsigned r; asm volatile("v_cvt_pk_bf16_f32 %0, %1, %2" : "=v"(r) : "v"(lo), "v"(hi)); return r; }
constexpr float W8_SCALE = 64.f, W8_INV = 1.f / 64.f;
__device__ __forceinline__ unsigned pk4_fp8(float a, float b, float c, float d) {
    a = __builtin_amdgcn_fmed3f(a, -448.f, 448.f); b = __builtin_amdgcn_fmed3f(b, -448.f, 448.f); c = __builtin_amdgcn_fmed3f(c, -448.f, 448.f); d = __builtin_amdgcn_fmed3f(d, -448.f, 448.f);
    int w = 0; w = __builtin_amdgcn_cvt_pk_fp8_f32(a, b, w, false); w = __builtin_amdgcn_cvt_pk_fp8_f32(c, d, w, true); return (unsigned)w; }
__device__ __forceinline__ unsigned pk4_fp8_nc(float a, float b, float c, float d) {
    int w = 0; w = __builtin_amdgcn_cvt_pk_fp8_f32(a, b, w, false); w = __builtin_amdgcn_cvt_pk_fp8_f32(c, d, w, true); return (unsigned)w; }
__device__ __forceinline__ float fast_sigmoid(float x) { return __builtin_amdgcn_rcpf(1.f + __builtin_amdgcn_exp2f(-1.4426950408889634f * x)); }
__device__ __forceinline__ float fast_gelu_tanh(float x) { const float u2 = 1.5957691216057308f * (x + 0.044715f * x * x * x); return x * __builtin_amdgcn_rcpf(1.f + __builtin_amdgcn_exp2f(-1.4426950408889634f * u2)); }
__device__ __forceinline__ f32x2 gelu_tanh2(f32x2 x) { const f32x2 u = (x * x * 0.044715f + 1.0f) * x * (-1.4426950408889634f * 1.5957691216057308f);
    f32x2 e; e.x = __builtin_amdgcn_exp2f(u.x); e.y = __builtin_amdgcn_exp2f(u.y); const f32x2 d = e + 1.0f; f32x2 r; r.x = __builtin_amdgcn_rcpf(d.x); r.y = __builtin_amdgcn_rcpf(d.y); return x * r; }
__device__ __forceinline__ float wave_sum(float v) {
#pragma unroll
    for (int o = 1; o < 64; o <<= 1) v += __shfl_xor(v, o);
    return v;
}

#define XB_TMO      128
#define XB_XCNT(j)  (256  + 64 * (j))
#define XB_XSUB(j)  (1280 + 64 * (j))
#define XB_XGEN(j)  (2304 + 64 * (j))
#define XB_TOP      3328
#define XB_TOPGEN   3392
#define XCD_BAR_WORDS 3456
#define XB_SPIN_CAP (1u << 18)
__device__ __forceinline__ unsigned xb_ld(unsigned* p)              { return __hip_atomic_load(p, __ATOMIC_RELAXED, __HIP_MEMORY_SCOPE_AGENT); }
__device__ __forceinline__ unsigned xb_add(unsigned* p, unsigned v) { return __hip_atomic_fetch_add(p, v, __ATOMIC_RELAXED, __HIP_MEMORY_SCOPE_AGENT); }
__device__ __forceinline__ unsigned xb_xcc_id() { return (unsigned)__builtin_amdgcn_s_getreg((3 << 11) | 20) & 0xFu; }
#define XB_SPIN(cond, bar) do { unsigned _sp = 0; while (cond) { __builtin_amdgcn_s_sleep(1); \
    if ((++_sp & 255u) == 0u) { if (xb_ld(&(bar)[XB_TMO])) break; if (_sp > XB_SPIN_CAP) { atomicAdd(&(bar)[XB_TMO], 1u); break; } } } } while (0)
struct XcdBarrier { unsigned* bar; unsigned x; volatile LAS unsigned* st; };
__device__ __forceinline__ XcdBarrier xcd_barrier_post(unsigned* bar, volatile LAS unsigned* st) {
    XcdBarrier b; b.bar = bar; b.x = xb_xcc_id(); b.st = st;
    if (threadIdx.x == 0) (void)xb_add(&bar[XB_XCNT(b.x)], 1u);
    return b;
}
__device__ __forceinline__ void xcd_barrier_complete(unsigned* bar, unsigned x, unsigned& nloc, unsigned& nx) {
    const unsigned G = gridDim.x * gridDim.y * gridDim.z;
    unsigned sum, cnt, mine, sp = 0u;
    for (;;) {
        sum = 0u; cnt = 0u; mine = 0u;
#pragma unroll
        for (unsigned j = 0; j < 16; ++j) { const unsigned c = xb_ld(&bar[XB_XCNT(j)]); sum += c; cnt += (c > 0u) ? 1u : 0u; mine = (j == x) ? c : mine; }
        if (sum == G) break;
        __builtin_amdgcn_s_sleep(1);
        if ((++sp & 255u) == 0u) { if (xb_ld(&bar[XB_TMO])) break; if (sp > XB_SPIN_CAP) { atomicAdd(&bar[XB_TMO], 1u); break; } }
    }
    nloc = mine > 0u ? mine : 1u; nx = cnt > 0u ? cnt : 1u;
}
__device__ __forceinline__ void xcd_barrier(const XcdBarrier& b) {
    asm volatile("s_waitcnt vmcnt(0)" ::: "memory");
    __syncthreads();
    if (threadIdx.x == 0) {
        unsigned* bar = b.bar;
        __builtin_amdgcn_s_waitcnt(0);
        unsigned nloc = b.st[0], nx = b.st[1];
        if (nloc == 0u) { xcd_barrier_complete(bar, b.x, nloc, nx); b.st[0] = nloc; b.st[1] = nx; }
        const unsigned old = xb_add(&bar[XB_XSUB(b.x)], 1u);
        const unsigned gen = old / nloc;
        if (old + 1u == (gen + 1u) * nloc) {
            __builtin_amdgcn_fence(__ATOMIC_RELEASE, "agent");
            asm volatile("s_waitcnt vmcnt(0)" ::: "memory");
            const unsigned og = xb_add(&bar[XB_TOP], 1u);
            const unsigned tg = og / nx;
            if (og + 1u == (tg + 1u) * nx) xb_add(&bar[XB_TOPGEN], 1u);
            else XB_SPIN(xb_ld(&bar[XB_TOPGEN]) == tg, bar);
            __builtin_amdgcn_fence(__ATOMIC_ACQUIRE, "agent");
            xb_add(&bar[XB_XGEN(b.x)], 1u);
            asm volatile("s_waitcnt vmcnt(0)" ::: "memory");
        } else {
            XB_SPIN(xb_ld(&bar[XB_XGEN(b.x)]) == gen, bar);
            __builtin_amdgcn_fence(__ATOMIC_ACQUIRE, "agent");
            asm volatile("s_waitcnt vmcnt(0)" ::: "memory");
        }
    }
    __syncthreads();
}

namespace pg8 {
typedef int v4i_t __attribute__((ext_vector_type(4)));
typedef int v8i_t __attribute__((ext_vector_type(8)));
constexpr int BM = 256, BK = 64, HALF = 128, HTB = HALF * BK * 2, STAGE_BYTES = 8 * HTB;
__host__ __device__ __forceinline__ int lds_byte(int r, int c) { const int st = (r >> 4) * 2 + (c >> 5), rr = r & 15, cc = c & 31, ob = rr * 64 + cc * 2; return st * 1024 + (ob ^ (((ob >> 9) & 1) << 5)); }
__host__ __device__ __forceinline__ void stage_rc(int b, int& R, int& C) { const int st = b / 1024, sb = b % 1024, swz = sb ^ (((sb >> 9) & 1) << 5); R = (st >> 1) * 16 + swz / 64; C = (st & 1) * 32 + (swz % 64) / 2; }
__host__ __device__ __forceinline__ int perm32(int rho) { const int n = rho >> 4, i = rho & 15; return 8 * (i >> 2) + 4 * n + (i & 3); }

struct GUnit { const char* A; const char* B; int pm, pn, e, keep; };

template <bool GATHER, bool F8, class Epi, class Sched>
__device__ __forceinline__ void gemm_phase(LAS unsigned char* lds, const int nt, const unsigned lda, const unsigned ldb, const Sched& S, const Epi& E) {
    const int tid = threadIdx.x, wid = __builtin_amdgcn_readfirstlane(tid >> 6), lane = tid & 63, wr = wid >> 2, wc = wid & 3, fr = lane & 15, fq = lane >> 4;
    unsigned voffA[2], voffB[2]; int RA[2]; unsigned CA2[2];
#pragma unroll
    for (int i = 0; i < 2; ++i) { int R, C; stage_rc(tid * 16 + i * 8192, R, C); const int Rb = Epi::PERM ? ((R & ~31) + perm32(R & 31)) : R;
        RA[i] = R; CA2[i] = (unsigned)C * 2u; voffA[i] = (unsigned)R * lda + (unsigned)C * 2u; voffB[i] = (unsigned)Rb * ldb + (unsigned)C * 2u; }
    const size_t kstep = (size_t)(BK * 2);
    const size_t hA = GATHER ? 0 : (size_t)HALF * lda, hB = (size_t)HALF * ldb;
    const unsigned ldsw = (unsigned)wid * 1024u;
    const int aoff = lds_byte(wr * 64 + fr, fq * 8), boff = lds_byte(wc * 32 + fr, fq * 8);
    LAS unsigned char* const ldsB = lds + 4 * HTB;
#define PG8_SA(b, h) (((b) * 2 + (h)) * HTB)
#define PG8_SB(b, h) ((4 + (b) * 2 + (h)) * HTB)
#define PG8_STAGE(bufoff, gbase, voff) do { _Pragma("unroll") for (int _i = 0; _i < 2; ++_i) \
        __builtin_amdgcn_global_load_lds((const unsigned*)((const char*)(gbase) + (voff)[_i]), (LAS unsigned*)(lds + (bufoff) + ldsw + _i * 8192), 16, 0, 0); } while (0)
#define PG8_SBR(b, h) (((b) * 2 + (h)) * HTB)
#define PG8_LD8(base, off) __builtin_shufflevector(*(const LAS v4i_t*)((base) + (off)), *(const LAS v4i_t*)((base) + (off) + 1024), 0, 1, 2, 3, 4, 5, 6, 7)
#define PG8_LDA(dst, b, h) do { if constexpr (F8) { _Pragma("unroll") for (int m = 0; m < 4; ++m) dst##8[m] = PG8_LD8(lds, PG8_SA(b, h) + aoff + m * 2048); } \
        else { _Pragma("unroll") for (int m = 0; m < 4; ++m) _Pragma("unroll") for (int k = 0; k < 2; ++k) dst[m][k] = *(const LAS bf16x8*)(lds + PG8_SA(b, h) + aoff + m * 2048 + k * 1024); } } while (0)
#define PG8_LDB(dst, b, h) do { if constexpr (F8) { _Pragma("unroll") for (int n = 0; n < 2; ++n) dst##8[n] = PG8_LD8(ldsB, PG8_SBR(b, h) + boff + n * 2048); } \
        else { _Pragma("unroll") for (int n = 0; n < 2; ++n) _Pragma("unroll") for (int k = 0; k < 2; ++k) dst[n][k] = *(const LAS bf16x8*)(ldsB + PG8_SBR(b, h) + boff + n * 2048 + k * 1024); } } while (0)
#define PG8_MMA(ai, bj, At, Bt) do { __builtin_amdgcn_s_setprio(1); \
        if constexpr (F8) { _Pragma("unroll") for (int m = 0; m < 4; ++m) _Pragma("unroll") for (int n = 0; n < 2; ++n) \
            asm volatile("v_mfma_scale_f32_16x16x128_f8f6f4 %0, %1, %2, %0, %3, %3 op_sel_hi:[0,0,0]" : "+v"(acc[ai][bj][m][n]) : "v"(Bt##8[n]), "v"(At##8[m]), "v"(sc8)); } \
        else { _Pragma("unroll") for (int m = 0; m < 4; ++m) _Pragma("unroll") for (int n = 0; n < 2; ++n) _Pragma("unroll") for (int k = 0; k < 2; ++k) \
            acc[ai][bj][m][n] = __builtin_amdgcn_mfma_f32_16x16x32_bf16(Bt[n][k], At[m][k], acc[ai][bj][m][n], 0, 0, 0); } \
        __builtin_amdgcn_s_setprio(0); } while (0)
#define PG8_WAIT_V(n) asm volatile("s_waitcnt vmcnt(" #n ")" ::: "memory")
#define PG8_WAIT_L(n) asm volatile("s_waitcnt lgkmcnt(" #n ")" ::: "memory")
#define PG8_BAR __builtin_amdgcn_s_barrier()
#define PG8_SCHED __builtin_amdgcn_sched_barrier(0)
    GUnit cur, nxt; int ui = 0;
    if (!S.next(0, cur)) return;
    f32x4 acc[2][2][4][2];
#pragma unroll
    for (int a = 0; a < 2; ++a)
#pragma unroll
        for (int b = 0; b < 2; ++b)
#pragma unroll
            for (int m = 0; m < 4; ++m)
#pragma unroll
                for (int n = 0; n < 2; ++n) acc[a][b][m][n] = (f32x4){0.f, 0.f, 0.f, 0.f};
    bf16x8 At[4][2], B0[2][2], B1[2][2]; v8i_t At8[4], B08[2], B18[2];
    const int sc8 = 0x7f7f7f7f;
    const char* cA = cur.A; const char* cB = cur.B;
    unsigned vA0[2], vA1[2], vN0[2], vN1[2];
    if constexpr (GATHER) {
#pragma unroll
        for (int i = 0; i < 2; ++i) { vA0[i] = (unsigned)S.arow(cur, RA[i]) * lda + CA2[i]; vA1[i] = (unsigned)S.arow(cur, HALF + RA[i]) * lda + CA2[i]; }
        asm volatile("" : "+v"(vA0[0]), "+v"(vA0[1]), "+v"(vA1[0]), "+v"(vA1[1]));
    } else {
#pragma unroll
        for (int i = 0; i < 2; ++i) { vA0[i] = voffA[i]; vA1[i] = voffA[i]; }
    }
    PG8_STAGE(PG8_SB(0, 0), cB, voffB); PG8_STAGE(PG8_SB(0, 1), cB + hB, voffB); PG8_STAGE(PG8_SA(0, 0), cA, vA0); PG8_STAGE(PG8_SA(0, 1), cA + hA, vA1);
    if (wr == 1) PG8_BAR;
    PG8_WAIT_V(2); PG8_BAR;
    PG8_STAGE(PG8_SB(1, 0), cB + kstep, voffB); PG8_STAGE(PG8_SA(1, 0), cA + kstep, vA0); PG8_STAGE(PG8_SB(1, 1), cB + hB + kstep, voffB);
    PG8_WAIT_V(6); PG8_BAR;
    for (;;) {
        const bool has_next = S.next(ui + 1, nxt);
        const char* nA = has_next ? nxt.A : cA; const char* nB = has_next ? nxt.B : cB;
        if constexpr (GATHER) {
            if (has_next) {
#pragma unroll
                for (int i = 0; i < 2; ++i) { vN0[i] = (unsigned)S.arow(nxt, RA[i]) * lda + CA2[i]; vN1[i] = (unsigned)S.arow(nxt, HALF + RA[i]) * lda + CA2[i]; }
            } else {
#pragma unroll
                for (int i = 0; i < 2; ++i) { vN0[i] = vA0[i]; vN1[i] = vA1[i]; }
            }
            asm volatile("" : "+v"(vN0[0]), "+v"(vN0[1]), "+v"(vN1[0]), "+v"(vN1[1]));
        }
        for (int t = 0; t < nt; t += 2) {
            const bool last = (t == nt - 2);
            const char* a1 = cA + (size_t)(t + 1) * kstep;
            const char* a2 = last ? nA : cA + (size_t)(t + 2) * kstep; const char* b2 = last ? nB : cB + (size_t)(t + 2) * kstep;
            const char* a3 = a2 + kstep; const char* b3 = b2 + kstep;
            unsigned w0[2], w1[2];
            if constexpr (GATHER) {
#pragma unroll
                for (int i = 0; i < 2; ++i) { w0[i] = last ? vN0[i] : vA0[i]; w1[i] = last ? vN1[i] : vA1[i]; }
            } else {
#pragma unroll
                for (int i = 0; i < 2; ++i) { w0[i] = voffA[i]; w1[i] = voffA[i]; }
            }
            PG8_LDB(B0, 0, 0); PG8_LDB(B1, 0, 1); PG8_SCHED; PG8_LDA(At, 0, 0); PG8_STAGE(PG8_SA(1, 1), a1 + hA, vA1);
            PG8_WAIT_V(8); PG8_WAIT_L(0); PG8_BAR; PG8_MMA(0, 0, At, B0); PG8_MMA(0, 1, At, B1); PG8_BAR; PG8_SCHED;
            PG8_LDA(At, 0, 1); PG8_STAGE(PG8_SB(0, 0), b2, voffB); PG8_STAGE(PG8_SB(0, 1), b2 + hB, voffB); PG8_STAGE(PG8_SA(0, 0), a2, w0);
            PG8_WAIT_V(8); PG8_WAIT_L(0); PG8_BAR; PG8_MMA(1, 0, At, B0); PG8_MMA(1, 1, At, B1); PG8_BAR; PG8_SCHED;
            PG8_LDB(B0, 1, 0); PG8_LDB(B1, 1, 1); PG8_SCHED; PG8_LDA(At, 1, 0); PG8_STAGE(PG8_SA(0, 1), a2 + hA, w1);
            PG8_WAIT_V(8); PG8_WAIT_L(0); PG8_BAR; PG8_MMA(0, 0, At, B0); PG8_MMA(0, 1, At, B1); PG8_BAR; PG8_SCHED;
            PG8_LDA(At, 1, 1); PG8_STAGE(PG8_SB(1, 0), b3, voffB); PG8_STAGE(PG8_SB(1, 1), b3 + hB, voffB); PG8_STAGE(PG8_SA(1, 0), a3, w0);
            PG8_WAIT_V(8); PG8_WAIT_L(0); PG8_BAR; PG8_MMA(1, 0, At, B0); PG8_MMA(1, 1, At, B1); PG8_BAR; PG8_SCHED;
        }
        if (wr == 0) PG8_BAR;
        E(acc, cur, wr, wc, fr, fq);
        if (!has_next) break;
        if (!cur.keep) {
#pragma unroll
            for (int a = 0; a < 2; ++a)
#pragma unroll
                for (int b = 0; b < 2; ++b)
#pragma unroll
                    for (int m = 0; m < 4; ++m)
#pragma unroll
                        for (int n = 0; n < 2; ++n) acc[a][b][m][n] = (f32x4){0.f, 0.f, 0.f, 0.f};
        }
        cur = nxt; cA = nA; cB = nB; ++ui;
        if constexpr (GATHER) {
#pragma unroll
            for (int i = 0; i < 2; ++i) { vA0[i] = vN0[i]; vA1[i] = vN1[i]; }
        }
        if (wr == 1) PG8_BAR;
    }
    PG8_WAIT_V(0);
    PG8_BAR;
#undef PG8_SA
#undef PG8_SB
#undef PG8_STAGE
#undef PG8_LDA
#undef PG8_LDB
#undef PG8_MMA
#undef PG8_LD8
#undef PG8_SBR
#undef PG8_WAIT_V
#undef PG8_WAIT_L
#undef PG8_BAR
#undef PG8_SCHED
}

struct TileOrder {
    int nM, nN, nwg, G, c;
    __device__ void init(int nM_, int nN_, int G_, int c_) { nM = nM_; nN = nN_; nwg = nM * nN; G = G_; c = c_; }
    __device__ bool tile(int i, int& pm, int& pn) const { return tileL((long)i * G + c, pm, pn); }
    __device__ bool tileL(long L, int& pm, int& pn) const {
        if (L < 0 || L >= nwg) return false;
        int wgid = (int)L; { const int q = nwg / 8, r = nwg % 8, xcd = wgid % 8, off = wgid / 8; wgid = (xcd < r ? xcd * (q + 1) : r * (q + 1) + (xcd - r) * q) + off; }
        const int nig = 4 * nN, gid = wgid / nig, fm = gid * 4, gsz = (nM - fm) < 4 ? (nM - fm) : 4;
        pm = fm + ((wgid % nig) % gsz); pn = (wgid % nig) / gsz; return true;
    }
};
constexpr int P1_CO = 2, P1_NC = P1_CO * 32, P1_NG = 256 - P1_NC, P1_UG = 12, P1_UC = 0, P1_NBF = 20, P1_NF8 = 16;
static_assert(P1_NG * P1_UG + P1_NC * P1_UC == (NTOK / 256) * (NPROJ / 256) && (P1_NBF + P1_NF8) * 256 == NPROJ, "P1 unit deal");
struct ProjSched {
    TileOrder T; const char* A; const char* B; unsigned lda, ldb; int conv, idx;
    __device__ bool next(int i, GUnit& u) const { const long L = conv ? -1 : (long)i * P1_NG + idx; int pm, pn; if (!T.tileL(L, pm, pn)) return false;
        u.pm = pm; u.pn = pn; u.e = 0; u.keep = 0; u.A = A + (size_t)pm * 256 * lda; u.B = B + (size_t)pn * 256 * ldb; return true; }
    __device__ int arow(const GUnit&, int) const { return 0; }
};
struct PlainSched {
    TileOrder T; const char* A; const char* B; unsigned lda, ldb;
    __device__ bool next(int i, GUnit& u) const { int pm, pn; if (!T.tile(i, pm, pn)) return false; u.pm = pm; u.pn = pn; u.e = 0; u.keep = 0;
        u.A = A + (size_t)pm * 256 * lda; u.B = B + (size_t)pn * 256 * ldb; return true; }
    __device__ int arow(const GUnit&, int) const { return 0; }
};

struct EpiProj {
    static constexpr bool PERM = true;
    unsigned char* ws; int pn0; float gsc;
    __device__ __forceinline__ void operator()(f32x4 (&acc)[2][2][4][2], const GUnit& u, int wr, int wc, int fr, int fq) const {
        const int row0 = u.pm * BM + wr * 64 + fr, pn = u.pn + pn0;
        if (pn < 12) {
            static_assert(WS_K - WS_Q == WS_V - WS_K, "q|k|v spacing"); bf16* base = (bf16*)(ws + WS_Q + (size_t)(pn >> 2) * (WS_K - WS_Q)); const int col0 = (pn & 3) * 256 + wc * 32 + 8 * fq;
            float nmax[2] = {0.f, 0.f};
#pragma unroll
            for (int ai = 0; ai < 2; ++ai)
#pragma unroll
                for (int m = 0; m < 4; ++m) { bf16* rowp = base + (size_t)(row0 + ai * HALF + m * 16) * FW + col0;
#pragma unroll
                    for (int bj = 0; bj < 2; ++bj) { const f32x4 v0 = acc[ai][bj][m][0], v1 = acc[ai][bj][m][1];
                        if (pn < 8) { float q2 = (v0[0] * v0[0] + v0[1] * v0[1]) + (v0[2] * v0[2] + v0[3] * v0[3]) + (v1[0] * v1[0] + v1[1] * v1[1]) + (v1[2] * v1[2] + v1[3] * v1[3]);
                            q2 += __shfl_xor(q2, 16); q2 += __shfl_xor(q2, 32); nmax[bj] = fmaxf(nmax[bj], q2); }
                        u32x4 w; w.x = cvt_pk_bf16(v0[0], v0[1]); w.y = cvt_pk_bf16(v0[2], v0[3]); w.z = cvt_pk_bf16(v1[0], v1[1]); w.w = cvt_pk_bf16(v1[2], v1[3]);
                        *(u32x4*)(rowp + bj * HALF) = w; } }
            if (pn < 8) {
#pragma unroll
                for (int bj = 0; bj < 2; ++bj) { float v = nmax[bj]; v = fmaxf(v, __shfl_xor(v, 1)); v = fmaxf(v, __shfl_xor(v, 2)); v = fmaxf(v, __shfl_xor(v, 4)); v = fmaxf(v, __shfl_xor(v, 8));
                    if (fr == 0 && fq == 0) atomicMax((unsigned*)(ws + WS_CTL) + CW_NRM + (((pn >> 2) * 4 + (u.pm >> 4)) * 8 + (pn & 3) * 2 + bj) * 4 + wc, __float_as_uint(v)); }
            }
        } else if (pn < 20) {
            const bool isv = pn >= 16; bf16* base = (bf16*)(ws + WS_ZU + (size_t)(isv ? 1 : 0) * (WS_ZV - WS_ZU)); float* ZST = (float*)(ws + WS_ZST); const int col0 = ((pn - 12) & 3) * 256 + wc * 32 + 8 * fq;
#pragma unroll
            for (int ai = 0; ai < 2; ++ai)
#pragma unroll
                for (int m = 0; m < 4; ++m) { const int row = row0 + ai * HALF + m * 16; bf16* rowp = base + (size_t)row * SGW + col0; float s = 0.f, q = 0.f;
#pragma unroll
                    for (int bj = 0; bj < 2; ++bj) { f32x4 v0 = acc[ai][bj][m][0], v1 = acc[ai][bj][m][1];
                        { const f32x2 a = gelu_tanh2((f32x2){v0[0], v0[1]}), b = gelu_tanh2((f32x2){v0[2], v0[3]}), c = gelu_tanh2((f32x2){v1[0], v1[1]}), d = gelu_tanh2((f32x2){v1[2], v1[3]});
                          v0 = (f32x4){a.x, a.y, b.x, b.y}; v1 = (f32x4){c.x, c.y, d.x, d.y};
                          if (isv) { const f32x2 s2 = (a + b) + (c + d), q2 = (a * a + b * b) + (c * c + d * d); s += s2.x + s2.y; q += q2.x + q2.y; } }
                        u32x4 w; w.x = cvt_pk_bf16(v0[0], v0[1]); w.y = cvt_pk_bf16(v0[2], v0[3]); w.z = cvt_pk_bf16(v1[0], v1[1]); w.w = cvt_pk_bf16(v1[2], v1[3]);
                        *(u32x4*)(rowp + bj * HALF) = w; }
                    if (isv) { s += __shfl_xor(s, 16); s += __shfl_xor(s, 32); q += __shfl_xor(q, 16); q += __shfl_xor(q, 32);
                        if (fq == 0) *(f32x2*)(ZST + (size_t)row * 32 + ((pn - 16) * 4 + wc) * 2) = (f32x2){s, q}; } }
        } else {
            const int col0 = (pn - 20) * 128 + wc * 32 + 8 * fq; bf16* GR = (bf16*)(ws + WS_GR); bf16* GS = (bf16*)(ws + WS_GS);
#pragma unroll
            for (int ai = 0; ai < 2; ++ai)
#pragma unroll
                for (int m = 0; m < 4; ++m) { const size_t off = (size_t)(row0 + ai * HALF + m * 16) * DM + col0; float r[8], sb[8];
#pragma unroll
                    for (int n = 0; n < 2; ++n)
#pragma unroll
                        for (int p = 0; p < 2; ++p) { const f32x2 ya = (f32x2){acc[ai][0][m][n][2 * p], acc[ai][0][m][n][2 * p + 1]} * gsc, yb = (f32x2){acc[ai][1][m][n][2 * p], acc[ai][1][m][n][2 * p + 1]} * gsc;
                            f32x2 ea, eb; ea.x = __builtin_amdgcn_exp2f(ya.x); ea.y = __builtin_amdgcn_exp2f(ya.y); eb.x = __builtin_amdgcn_exp2f(yb.x); eb.y = __builtin_amdgcn_exp2f(yb.y);
                            const f32x2 da = ea + 1.0f, db = eb + 1.0f; f32x2 ra, rb; ra.x = __builtin_amdgcn_rcpf(da.x); ra.y = __builtin_amdgcn_rcpf(da.y); rb.x = __builtin_amdgcn_rcpf(db.x); rb.y = __builtin_amdgcn_rcpf(db.y);
                            const f32x2 rr = db * ra; sb[n * 4 + 2 * p] = rb.x; sb[n * 4 + 2 * p + 1] = rb.y; r[n * 4 + 2 * p] = rr.x; r[n * 4 + 2 * p + 1] = rr.y; }
                    u32x4 w; w.x = cvt_pk_bf16(r[0], r[1]); w.y = cvt_pk_bf16(r[2], r[3]); w.z = cvt_pk_bf16(r[4], r[5]); w.w = cvt_pk_bf16(r[6], r[7]);
                    *(u32x4*)(GR + off) = w;
                    w.x = cvt_pk_bf16(sb[0], sb[1]); w.y = cvt_pk_bf16(sb[2], sb[3]); w.z = cvt_pk_bf16(sb[4], sb[5]); w.w = cvt_pk_bf16(sb[6], sb[7]);
                    *(u32x4*)(GS + off) = w; }
        }
    }
};
struct MergeSched {
    TileOrder T; const char* A; const char* B; unsigned lda, ldb;
    __device__ bool next(int i, GUnit& u) const { int pm, pn; if (!T.tile(i >> 1, pm, pn)) return false; const int half = i & 1; u.pm = pm; u.pn = pn; u.e = 0; u.keep = half ^ 1;
        u.A = A + (size_t)pm * 256 * lda + half * (FW * 2); u.B = B + (size_t)pn * 256 * ldb + half * (FW * 2); return true; }
    __device__ int arow(const GUnit&, int) const { return 0; }
};
struct EpiMerge {
    static constexpr bool PERM = true;
    unsigned char* ws;
    __device__ __forceinline__ void operator()(f32x4 (&acc)[2][2][4][2], const GUnit& u, int wr, int wc, int fr, int fq) const {
        const int row0 = u.pm * BM + wr * 64 + fr, col0 = u.pn * 256 + wc * 32 + 8 * fq;
        const bf16* G = (const bf16*)(ws + (u.keep ? WS_GR : WS_GS)); bf16* MG = (bf16*)(ws + WS_MG);
#pragma unroll
        for (int ai = 0; ai < 2; ++ai) {
            u32x4 gv[4][2];
#pragma unroll
            for (int m = 0; m < 4; ++m)
#pragma unroll
                for (int bj = 0; bj < 2; ++bj) gv[m][bj] = *(const u32x4*)(G + (size_t)(row0 + ai * HALF + m * 16) * DM + col0 + bj * HALF);
#pragma unroll
            for (int m = 0; m < 4; ++m) { const size_t off = (size_t)(row0 + ai * HALF + m * 16) * DM + col0;
#pragma unroll
                for (int bj = 0; bj < 2; ++bj) { const u32x4 g = gv[m][bj];
                    f32x4 v0 = acc[ai][bj][m][0], v1 = acc[ai][bj][m][1];
                    v0[0] *= __builtin_bit_cast(float, g.x << 16); v0[1] *= __builtin_bit_cast(float, g.x & 0xffff0000u); v0[2] *= __builtin_bit_cast(float, g.y << 16); v0[3] *= __builtin_bit_cast(float, g.y & 0xffff0000u);
                    v1[0] *= __builtin_bit_cast(float, g.z << 16); v1[1] *= __builtin_bit_cast(float, g.z & 0xffff0000u); v1[2] *= __builtin_bit_cast(float, g.w << 16); v1[3] *= __builtin_bit_cast(float, g.w & 0xffff0000u);
                    if (u.keep) { acc[ai][bj][m][0] = v0; acc[ai][bj][m][1] = v1; }
                    else { u32x4 w; w.x = cvt_pk_bf16(v0[0], v0[1]); w.y = cvt_pk_bf16(v0[2], v0[3]); w.z = cvt_pk_bf16(v1[0], v1[1]); w.w = cvt_pk_bf16(v1[2], v1[3]); *(u32x4*)(MG + off + bj * HALF) = w; } } } }
    }
};
template <bool RB, bool WF>
struct EpiResid {
    static constexpr bool PERM = true;
    const void* Xi; float* Xo; bf16* Xb; float* SS; unsigned char* Xq;
    __device__ __forceinline__ void operator()(f32x4 (&acc)[2][2][4][2], const GUnit& u, int wr, int wc, int fr, int fq) const {
        const int row0 = u.pm * BM + wr * 64 + fr, col0 = u.pn * 256 + wc * 32 + 8 * fq;
        typedef typename std::conditional<RB, u32x4, f32x4>::type rv_t;
        constexpr int NV = RB ? 1 : 2, GB = 4;
#pragma unroll
        for (int g0 = 0; g0 < 8; g0 += GB) {
            rv_t xr[GB][2][NV];
#pragma unroll
            for (int gg = 0; gg < GB; ++gg) { const int gi = g0 + gg; const size_t offl = (size_t)(row0 + (gi >> 2) * HALF + (gi & 3) * 16) * DM + col0;
#pragma unroll
                for (int bj = 0; bj < 2; ++bj) {
                    if constexpr (RB) xr[gg][bj][0] = *(const u32x4*)((const bf16*)Xi + offl + bj * HALF);
                    else { xr[gg][bj][0] = *(const f32x4*)((const float*)Xi + offl + bj * HALF); xr[gg][bj][NV - 1] = *(const f32x4*)((const float*)Xi + offl + bj * HALF + 4); } } }
#pragma unroll
            for (int gg = 0; gg < GB; ++gg) { const int gi = g0 + gg, ai = gi >> 2, m = gi & 3; const int row = row0 + ai * HALF + m * 16; const size_t off = (size_t)row * DM + col0; float q = 0.f;
#pragma unroll
                for (int bj = 0; bj < 2; ++bj) { const size_t o = off + bj * HALF; f32x4 r0, r1;
                    if constexpr (RB) { const u32x4 r = xr[gg][bj][0];
                        r0 = (f32x4){__builtin_bit_cast(float, r.x << 16), __builtin_bit_cast(float, r.x & 0xffff0000u), __builtin_bit_cast(float, r.y << 16), __builtin_bit_cast(float, r.y & 0xffff0000u)};
                        r1 = (f32x4){__builtin_bit_cast(float, r.z << 16), __builtin_bit_cast(float, r.z & 0xffff0000u), __builtin_bit_cast(float, r.w << 16), __builtin_bit_cast(float, r.w & 0xffff0000u)}; }
                    else { r0 = xr[gg][bj][0]; r1 = xr[gg][bj][NV - 1]; }
                    const f32x4 v0 = r0 + acc[ai][bj][m][0], v1 = r1 + acc[ai][bj][m][1];
                    if constexpr (WF) { *(f32x4*)(Xo + o) = v0; *(f32x4*)(Xo + o + 4) = v1; }
                    q += ((v0[0] * v0[0] + v0[1] * v0[1]) + (v0[2] * v0[2] + v0[3] * v0[3])) + ((v1[0] * v1[0] + v1[1] * v1[1]) + (v1[2] * v1[2] + v1[3] * v1[3]));
                    if (Xb) { u32x4 w; w.x = cvt_pk_bf16(v0[0], v0[1]); w.y = cvt_pk_bf16(v0[2], v0[3]); w.z = cvt_pk_bf16(v1[0], v1[1]); w.w = cvt_pk_bf16(v1[2], v1[3]); *(u32x4*)(Xb + o) = w; }
                    if (Xq) { u32x2 w8; w8.x = pk4_fp8(v0[0], v0[1], v0[2], v0[3]); w8.y = pk4_fp8(v1[0], v1[1], v1[2], v1[3]); *(u32x2*)(Xq + o) = w8; } }
                q += __shfl_xor(q, 16); q += __shfl_xor(q, 32);
                if (fq == 0) SS[(size_t)row * 32 + u.pn * 4 + wc] = q; }
        }
    }
};
struct QkvSched {
    const char* X1B; const char* WXQ; const char* HM; const char* WXKV; int c;
    __device__ bool next(int i, GUnit& u) const { if (i > 0 || c >= 144) return false; u.keep = 0;
        if (c < 128) { u.e = 0; u.pm = c >> 1; u.pn = c & 1; u.A = X1B + (size_t)u.pm * 256 * (DM * 2); u.B = WXQ + (size_t)u.pn * 256 * (DM * 2); }
        else { const int j = c - 128; u.e = 1; u.pm = j >> 2; u.pn = j & 3; u.A = HM + (size_t)u.pm * 256 * (DM * 2); u.B = WXKV + (size_t)u.pn * 256 * (DM * 2); }
        return true; }
    __device__ int arow(const GUnit&, int) const { return 0; }
};
struct EpiQkv {
    static constexpr bool PERM = true;
    unsigned char* ws;
    __device__ __forceinline__ void operator()(f32x4 (&acc)[2][2][4][2], const GUnit& u, int wr, int wc, int fr, int fq) const {
        const int row0 = u.pm * BM + wr * 64 + fr; const float* SS = (const float*)(ws + WS_SS1);
        bf16* base = u.e ? (bf16*)(ws + WS_KX + (size_t)(u.pn >> 1) * (WS_VX - WS_KX)) + (u.pn & 1) * 256 : (bf16*)(ws + WS_QX) + u.pn * 256;
        float rsv[8];
#pragma unroll
        for (int gi = 0; gi < 8; ++gi) rsv[gi] = 1.f;
        if (!u.e) { f32x4 pp[8][2];
#pragma unroll
            for (int gi = 0; gi < 8; ++gi) { const int row = row0 + (gi >> 2) * HALF + (gi & 3) * 16; pp[gi][0] = *(const f32x4*)(SS + (size_t)row * 32 + fq * 8); pp[gi][1] = *(const f32x4*)(SS + (size_t)row * 32 + fq * 8 + 4); }
#pragma unroll
            for (int gi = 0; gi < 8; ++gi) { const f32x4 p0 = pp[gi][0], p1 = pp[gi][1];
                float q = ((p0[0] + p0[1]) + (p0[2] + p0[3])) + ((p1[0] + p1[1]) + (p1[2] + p1[3])); q += __shfl_xor(q, 16); q += __shfl_xor(q, 32); rsv[gi] = rsqrtf(q * (1.f / DM) + RMS_EPS); } }
#pragma unroll
        for (int ai = 0; ai < 2; ++ai)
#pragma unroll
            for (int m = 0; m < 4; ++m) { const int row = row0 + ai * HALF + m * 16; const float rs = rsv[ai * 4 + m];
                bf16* rowp = base + (size_t)row * XW + wc * 32 + 8 * fq;
#pragma unroll
                for (int bj = 0; bj < 2; ++bj) { const f32x4 v0 = acc[ai][bj][m][0] * rs, v1 = acc[ai][bj][m][1] * rs;
                    u32x4 w; w.x = cvt_pk_bf16(v0[0], v0[1]); w.y = cvt_pk_bf16(v0[2], v0[3]); w.z = cvt_pk_bf16(v1[0], v1[1]); w.w = cvt_pk_bf16(v1[2], v1[3]);
                    *(u32x4*)(rowp + bj * HALF) = w; } }
    }
};
struct MoeSched {
    const LAS int* tab; const char* A; const char* B; const int* TOKL; int G, c, npn; unsigned ldb; size_t erows;
    __device__ bool next(int i, GUnit& u) const {
        const int x = c & 7, j = c >> 3; const int T = npn == 16 ? i * 16 + 4 * (x >> 1) + (j & 3) : i * 32 + 4 * x + (j & 3); const int pnl = npn == 16 ? 8 * (x & 1) + (j >> 2) : (j >> 2);
        if (T >= tab[32]) return false;
        int e = 0;
#pragma unroll 1
        for (int j = 1; j < 32; ++j) e += (tab[j] <= T) ? 1 : 0;
        u.e = e; u.pm = T; u.pn = pnl; u.keep = 0; u.A = A; u.B = B + ((size_t)e * erows + (size_t)u.pn * 256) * ldb; return true; }
    __device__ int arow(const GUnit& u, int r) const { const int rank = (u.pm - tab[u.e]) * 256 + r; return rank < tab[40 + u.e] ? TOKL[(size_t)u.e * NTOK + rank] : 0; }
};
struct DownSched : MoeSched {
    unsigned lda;
    __device__ bool next(int i, GUnit& u) const { if (!MoeSched::next(i, u)) return false; u.A = A + (size_t)u.pm * 256 * lda; return true; }
};
struct EpiAct {
    static constexpr bool PERM = true;
    unsigned char* ws; const LAS int* tab; const float* bgu;
    __device__ __forceinline__ void operator()(f32x4 (&acc)[2][2][4][2], const GUnit& u, int wr, int wc, int fr, int fq) const {
        const int r0 = wr * 64 + fr, j0 = u.pn * 128 + wc * 32 + 8 * fq, rbase = (u.pm - tab[u.e]) * 256, cnt = tab[40 + u.e];
        const int* TOKL = (const int*)(ws + WS_TOKL) + (size_t)u.e * NTOK; const float* RS2 = (const float*)(ws + WS_RS2); unsigned char* HB = ws + WS_HB;
        const float* bg = bgu + (size_t)u.e * 2 * DFF + j0;
        const f32x4 bg0 = *(const f32x4*)bg, bg1 = *(const f32x4*)(bg + 4), bu0 = *(const f32x4*)(bg + DFF), bu1 = *(const f32x4*)(bg + DFF + 4);
        float rsv[8]; const float* RSL = (const float*)(ws + WS_RSL) + (size_t)u.e * NTOK;
#pragma unroll
        for (int gi = 0; gi < 8; ++gi) { const int rank = rbase + r0 + (gi >> 2) * HALF + (gi & 3) * 16; rsv[gi] = rank < cnt ? RSL[rank] : 0.f; }
#pragma unroll
        for (int ai = 0; ai < 2; ++ai)
#pragma unroll
            for (int m = 0; m < 4; ++m) { const int r = r0 + ai * HALF + m * 16; const float rs = rsv[ai * 4 + m] * W8_INV;
                float a[8];
#pragma unroll
                for (int n = 0; n < 2; ++n)
#pragma unroll
                    for (int p = 0; p < 2; ++p) { const f32x2 rs2 = (f32x2){rs, rs};
                        const f32x2 bg2 = n ? (f32x2){bg1[2 * p], bg1[2 * p + 1]} : (f32x2){bg0[2 * p], bg0[2 * p + 1]}, bu2 = n ? (f32x2){bu1[2 * p], bu1[2 * p + 1]} : (f32x2){bu0[2 * p], bu0[2 * p + 1]};
                        f32x2 g2 = (f32x2){acc[ai][0][m][n][2 * p], acc[ai][0][m][n][2 * p + 1]} * rs2 + bg2, u2 = (f32x2){acc[ai][1][m][n][2 * p], acc[ai][1][m][n][2 * p + 1]} * rs2 + bu2;
                        g2.x = fminf(g2.x, SW_LIMIT); g2.y = fminf(g2.y, SW_LIMIT); u2.x = __builtin_amdgcn_fmed3f(u2.x, -SW_LIMIT, SW_LIMIT); u2.y = __builtin_amdgcn_fmed3f(u2.y, -SW_LIMIT, SW_LIMIT);
                        const f32x2 y2 = g2 * (-1.4426950408889634f * SW_ALPHA); f32x2 e2; e2.x = __builtin_amdgcn_exp2f(y2.x); e2.y = __builtin_amdgcn_exp2f(y2.y);
                        const f32x2 d2 = e2 + 1.0f; f32x2 r2; r2.x = __builtin_amdgcn_rcpf(d2.x); r2.y = __builtin_amdgcn_rcpf(d2.y);
                        const f32x2 o2 = ((u2 + 1.0f) * g2) * r2; a[n * 4 + 2 * p] = o2.x; a[n * 4 + 2 * p + 1] = o2.y; }
                u32x2 w; w.x = pk4_fp8_nc(a[0], a[1], a[2], a[3]); w.y = pk4_fp8_nc(a[4], a[5], a[6], a[7]);
                *(u32x2*)(HB + (size_t)(u.pm * 256 + r) * DFF + j0) = w; }
    }
};
struct EpiDown {
    static constexpr bool PERM = true;
    unsigned char* ws; const LAS int* tab; const float* bd;
    __device__ __forceinline__ void operator()(f32x4 (&acc)[2][2][4][2], const GUnit& u, int wr, int wc, int fr, int fq) const {
        const int r0 = wr * 64 + fr, c0 = u.pn * 256 + wc * 32 + 8 * fq, rbase = (u.pm - tab[u.e]) * 256;
        const float* GWL = (const float*)(ws + WS_GWL) + (size_t)u.e * NTOK; unsigned char* YB = ws + WS_YB;
        const float* b = bd + (size_t)u.e * DM + c0;
        f32x4 bv[2][2];
#pragma unroll
        for (int bj = 0; bj < 2; ++bj) { bv[bj][0] = *(const f32x4*)(b + bj * HALF); bv[bj][1] = *(const f32x4*)(b + bj * HALF + 4); }
        float gwv[8];
#pragma unroll
        for (int gi = 0; gi < 8; ++gi) gwv[gi] = GWL[rbase + r0 + (gi >> 2) * HALF + (gi & 3) * 16];
#pragma unroll
        for (int ai = 0; ai < 2; ++ai)
#pragma unroll
            for (int m = 0; m < 4; ++m) { const int r = r0 + ai * HALF + m * 16; const float gw = gwv[ai * 4 + m];
#pragma unroll
                for (int bj = 0; bj < 2; ++bj) { const f32x4 v0 = (acc[ai][bj][m][0] * W8_INV + bv[bj][0]) * gw, v1 = (acc[ai][bj][m][1] * W8_INV + bv[bj][1]) * gw;
                    u32x2 w; w.x = pk4_fp8(v0[0], v0[1], v0[2], v0[3]); w.y = pk4_fp8(v1[0], v1[1], v1[2], v1[3]);
                    *(u32x2*)(YB + (size_t)(u.pm * 256 + r) * DM + c0 + bj * HALF) = w; } }
    }
};
}

struct KArgs { const float* in[25]; float* out; unsigned char* ws; int ph_lo, ph_hi, li, pad; };
struct Frame {
    LAS unsigned char* lds; volatile LAS unsigned* MISC; unsigned* ctl; unsigned char* ws;
    int tid, lane, wave, G, gw, NGW;
};

struct CvtDesc { const float* W; const float* g; bf16* dst0; size_t ldw, dld; int srccol, k0src, k0dst, f8; };
__device__ __forceinline__ void cvt_load(const CvtDesc& d, float (&v)[64], float& gv, int lane) {
    const float* rowp = d.W + (size_t)d.k0src * d.ldw;
    const unsigned col = (unsigned)d.srccol;
#pragma unroll
    for (int i = 0; i < 64; ++i) { v[i] = rowp[col]; rowp += d.ldw; }
    const float* gp = d.g ? d.g : d.W;
    const float gl = gp[d.k0src + lane]; gv = d.g ? gl : 1.f;
}
__device__ __forceinline__ void cvt_store(const CvtDesc& d, float (&v)[64], float gv, LAS unsigned char* tile, int lane) {
    if (d.f8) gv *= W8_SCALE;
#pragma unroll
    for (int i = 0; i < 64; ++i) v[i] *= __builtin_bit_cast(float, __builtin_amdgcn_readlane(__builtin_bit_cast(int, gv), i));
    if (d.f8) {
#pragma unroll
        for (int j = 0; j < 4; ++j) { u32x4 w; w.x = pk4_fp8(v[16 * j], v[16 * j + 1], v[16 * j + 2], v[16 * j + 3]); w.y = pk4_fp8(v[16 * j + 4], v[16 * j + 5], v[16 * j + 6], v[16 * j + 7]);
            w.z = pk4_fp8(v[16 * j + 8], v[16 * j + 9], v[16 * j + 10], v[16 * j + 11]); w.w = pk4_fp8(v[16 * j + 12], v[16 * j + 13], v[16 * j + 14], v[16 * j + 15]);
            *(LAS u32x4*)(tile + lane * 80 + j * 16) = w; }
        asm volatile("s_waitcnt lgkmcnt(0)" ::: "memory");
#pragma unroll
        for (int j = 0; j < 4; ++j) { const int r = 16 * j + (lane >> 2), c = lane & 3; const u32x4 w = *(const LAS u32x4*)(tile + r * 80 + c * 16);
            *(u32x4*)((unsigned char*)d.dst0 + (size_t)r * d.dld + d.k0dst + 16 * c) = w; }
        asm volatile("s_waitcnt lgkmcnt(0)" ::: "memory");
        return;
    }
#pragma unroll
    for (int j = 0; j < 8; ++j) { u32x4 w; w.x = cvt_pk_bf16(v[8 * j], v[8 * j + 1]); w.y = cvt_pk_bf16(v[8 * j + 2], v[8 * j + 3]); w.z = cvt_pk_bf16(v[8 * j + 4], v[8 * j + 5]); w.w = cvt_pk_bf16(v[8 * j + 6], v[8 * j + 7]);
        *(LAS u32x4*)(tile + lane * 144 + j * 16) = w; }
    asm volatile("s_waitcnt lgkmcnt(0)" ::: "memory");
#pragma unroll
    for (int j = 0; j < 8; ++j) { const int r = 8 * j + (lane >> 3), c = lane & 7; const u32x4 w = *(const LAS u32x4*)(tile + r * 144 + c * 16);
        *(u32x4*)(d.dst0 + (size_t)r * d.dld + d.k0dst + 8 * c) = w; }
    asm volatile("s_waitcnt lgkmcnt(0)" ::: "memory");
}
__device__ __forceinline__ int wp_srccol(int d) {
    if (d < 3072) return d;
    if (d < 5120) return d + 8;
    const int t = d - 5120, tile = t >> 8, r = t & 255, j = tile * 128 + (r & 127);
    return (r < 128 ? C_GA : C_GB) + j;
}
struct Cvt8Desc { const float* W; const float* g; unsigned char* dst; size_t ldw; int k0, col0a, col0b; };
__device__ __forceinline__ void cvt8_load(const Cvt8Desc& d, f32x4 (&v)[16], float& gv, int wave, int lane) {
    const float* rowp = d.W + (size_t)(d.k0 + 8 * wave) * d.ldw;
#pragma unroll
    for (int i = 0; i < 8; ++i) { v[2 * i] = __builtin_nontemporal_load((const f32x4*)(rowp + d.col0a)); v[2 * i + 1] = __builtin_nontemporal_load((const f32x4*)(rowp + d.col0b)); rowp += d.ldw; }
    const float* gp = d.g ? d.g : d.W; const float gl = gp[d.k0 + 8 * wave + (lane & 7)]; gv = d.g ? gl * W8_SCALE : W8_SCALE;
}
__device__ __forceinline__ void cvt8_pack(f32x4 (&v)[16], float gv, LAS unsigned char* lds, int sub, int wave, int lane) {
    float gs[8];
#pragma unroll
    for (int i = 0; i < 8; ++i) gs[i] = __builtin_bit_cast(float, __builtin_amdgcn_readlane(__builtin_bit_cast(int, gv), i));
#pragma unroll
    for (int hf = 0; hf < 2; ++hf) { u32x4 w[2];
#pragma unroll
        for (int j = 0; j < 4; ++j) { const unsigned lo = pk4_fp8(v[0 + hf][j] * gs[0], v[2 + hf][j] * gs[1], v[4 + hf][j] * gs[2], v[6 + hf][j] * gs[3]), hi = pk4_fp8(v[8 + hf][j] * gs[4], v[10 + hf][j] * gs[5], v[12 + hf][j] * gs[6], v[14 + hf][j] * gs[7]);
            if (j & 1) { w[j >> 1].z = lo; w[j >> 1].w = hi; } else { w[j >> 1].x = lo; w[j >> 1].y = hi; } }
        const int sw = 8 * sub + 2 * (wave >> 1);
        LAS unsigned char* p = lds + sub * 32768 + wave * 4096 + ((hf * 256 + 4 * lane) ^ (sw & 28)) * 8;
        *(LAS u32x4*)(p + 8 * (sw & 2)) = w[0]; *(LAS u32x4*)(p + 16 - 8 * (sw & 2)) = w[1]; }
}
__device__ __forceinline__ void cvt8_flush(unsigned char* dst, LAS unsigned char* lds, int tid) {
    asm volatile("s_waitcnt lgkmcnt(0)\n\ts_barrier" ::: "memory");
#pragma unroll 4
    for (int ps = 0; ps < 16; ++ps) { const int r = ps * 32 + (tid >> 4), p = tid & 15, j = p >> 2, pc = p & 3;
        const int rs = (r ^ (8 * j + 2 * pc)) * 8;
        const u32x2 a0 = *(const LAS u32x2*)(lds + j * 32768 + (2 * pc) * 4096 + rs), a1 = *(const LAS u32x2*)(lds + j * 32768 + (2 * pc + 1) * 4096 + rs);
        __builtin_nontemporal_store((u32x4){a0.x, a0.y, a1.x, a1.y}, (u32x4*)(dst + (size_t)r * DM + 16 * p)); }
    asm volatile("s_waitcnt lgkmcnt(0)\n\ts_barrier" ::: "memory");
}
constexpr int CVT8_SUPER = NE * 8 * 8 + NE * 8 * 4, CVT8_P1_SUPER = 1840;
__device__ __forceinline__ void cvt8_phase(const Frame& F, const KArgs& a, const int bit, const int nb, const int s_lo, const int s_hi) {
    unsigned char* ws = F.ws; const int lane = F.lane, wave = F.wave, tid = F.tid;
    constexpr int S_WGU = NE * 8 * 8;
    auto decode = [&](int s, int j) -> Cvt8Desc {
        Cvt8Desc D;
        if (s < S_WGU) { const int e = s / 64, rr = s % 64, kb4 = rr / 8, cb = rr % 8, kb = kb4 * 4 + j;
            const int da = 4 * lane, db = 256 + 4 * lane;
            D.W = a.in[20] + (size_t)e * DM * 2 * DFF; D.g = a.in[17]; D.ldw = 2 * DFF; D.k0 = kb * 64;
            D.col0a = ((da & 255) < 128 ? 0 : DFF) + (cb * 2 + (da >> 8)) * 128 + (da & 127); D.col0b = ((db & 255) < 128 ? 0 : DFF) + (cb * 2 + (db >> 8)) * 128 + (db & 127);
            D.dst = ws + WS_WGU + ((size_t)e * 2 * DFF + cb * 512) * DM + kb4 * 256; return D; }
        s -= S_WGU;
        { const int e = s / 32, rr = s % 32, kb4 = rr / 4, cb = rr % 4, kb = kb4 * 4 + j;
            D.W = a.in[22] + (size_t)e * DFF * DM; D.g = nullptr; D.ldw = DM; D.k0 = kb * 64; D.col0a = cb * 512 + 4 * lane; D.col0b = cb * 512 + 256 + 4 * lane;
            D.dst = ws + WS_WD + ((size_t)e * DM + cb * 512) * DFF + kb4 * 256; return D; }
    };
    f32x4 va[16], vb[16]; float ga = 1.f, gb = 1.f;
    int sidx = s_lo + bit;
    if (sidx < s_hi) { Cvt8Desc d0 = decode(sidx, 0); cvt8_load(d0, va, ga, wave, lane); }
    while (sidx < s_hi) {
        const int snext = sidx + nb; const bool more = snext < s_hi;
        { Cvt8Desc d1 = decode(sidx, 1); cvt8_load(d1, vb, gb, wave, lane); } cvt8_pack(va, ga, F.lds, 0, wave, lane);
        { Cvt8Desc d2 = decode(sidx, 2); cvt8_load(d2, va, ga, wave, lane); } cvt8_pack(vb, gb, F.lds, 1, wave, lane);
        { Cvt8Desc d3 = decode(sidx, 3); cvt8_load(d3, vb, gb, wave, lane); } cvt8_pack(va, ga, F.lds, 2, wave, lane);
        { Cvt8Desc dn = decode(more ? snext : sidx, 0); cvt8_load(dn, va, ga, wave, lane); } cvt8_pack(vb, gb, F.lds, 3, wave, lane);
        cvt8_flush(decode(sidx, 0).dst, F.lds, tid);
        sidx = snext;
    }
    asm volatile("s_waitcnt vmcnt(0)" ::: "memory"); __syncthreads();
}
template <int STAGE>
__device__ __forceinline__ void p0_prologue(const Frame& F, const KArgs& a, const int w0, const int nw) {
    unsigned char* ws = F.ws; const int lane = F.lane;
    constexpr int I_WP = (NPROJ / 64) * 32, I_WAB = 32 * 32, I_WO = 32 * 32, I_WXQ = 8 * 32, I_WXKV = 16 * 32, I_WXO = 32 * 8, I_WGU = NE * 64 * 32, I_WD = NE * 32 * 32;
    constexpr int NITEMS = I_WP + I_WAB + I_WO + I_WXQ + I_WXKV + I_WXO + I_WGU + I_WD;
    LAS float* wf = (LAS float*)F.lds;
    LAS unsigned char* tile = F.lds + F.wave * 9216;
    auto decode = [&](int it) -> CvtDesc {
        CvtDesc D; int r = it; D.g = nullptr; D.f8 = 0;
        if (r < I_WP) { const int kb = r / (NPROJ / 64), db = r % (NPROJ / 64), d = db * 64 + lane;
            D.W = a.in[3]; D.ldw = INC; D.srccol = wp_srccol(d); D.k0src = kb * 64; D.k0dst = kb * 64; D.dld = DM;
            if (db * 64 >= 5120) { D.f8 = 1; D.dst0 = (bf16*)(ws + WS_WPG + (size_t)(db * 64 - 5120) * DM); } else D.dst0 = (bf16*)(ws + WS_WP) + (size_t)db * 64 * DM;
            return D; } r -= I_WP;
        if (r < I_WAB) { const int kb = r / 32, db = r % 32, d = db * 64 + lane;
            D.W = kb < 16 ? a.in[9] : a.in[10]; D.ldw = DM; D.srccol = d; D.dst0 = (bf16*)(ws + WS_WAB) + (size_t)db * 64 * DM; D.dld = DM; D.k0src = (kb & 15) * 64; D.k0dst = kb * 64; return D; } r -= I_WAB;
        if (r < I_WO) { const int kb = r / 32, db = r % 32, d = db * 64 + lane;
            D.W = a.in[11]; D.ldw = DM; D.srccol = d; D.dst0 = (bf16*)(ws + WS_WO) + (size_t)db * 64 * DM; D.dld = DM; D.k0src = kb * 64; D.k0dst = kb * 64; return D; } r -= I_WO;
        if (r < I_WXQ) { const int kb = r / 8, db = r % 8, d = db * 64 + lane;
            D.W = a.in[14]; D.g = a.in[12]; D.ldw = XW; D.srccol = d; D.dst0 = (bf16*)(ws + WS_WXQ) + (size_t)db * 64 * DM; D.dld = DM; D.k0src = kb * 64; D.k0dst = kb * 64; return D; } r -= I_WXQ;
        if (r < I_WXKV) { const int kb = r / 16, db = r % 16, d = db * 64 + lane;
            D.W = a.in[15]; D.ldw = 2 * XW; D.srccol = d; D.dst0 = (bf16*)(ws + WS_WXKV) + (size_t)db * 64 * DM; D.dld = DM; D.k0src = kb * 64; D.k0dst = kb * 64; return D; } r -= I_WXKV;
        if (r < I_WXO) { const int kb = r / 32, db = r % 32, d = db * 64 + lane;
            D.W = a.in[16]; D.ldw = DM; D.srccol = d; D.dst0 = (bf16*)(ws + WS_WXO) + (size_t)db * 64 * XW; D.dld = XW; D.k0src = kb * 64; D.k0dst = kb * 64; return D; } r -= I_WXO;
        if (r < I_WGU) { const int e = r / (64 * 32), rr = r % (64 * 32), kb = rr / 64, db = rr % 64, d = db * 64 + lane;
            const int t256 = d >> 8, q = d & 255;
            D.W = a.in[20] + (size_t)e * DM * 2 * DFF; D.g = a.in[17]; D.ldw = 2 * DFF; D.srccol = (q < 128 ? 0 : DFF) + t256 * 128 + (q & 127); D.f8 = 1; D.dst0 = (bf16*)(ws + WS_WGU + ((size_t)e * 2 * DFF + db * 64) * DM); D.dld = DM; D.k0src = kb * 64; D.k0dst = kb * 64; return D; } r -= I_WGU;
        { const int e = r / (32 * 32), rr = r % (32 * 32), kb = rr / 32, db = rr % 32, d = db * 64 + lane;
            D.W = a.in[22] + (size_t)e * DFF * DM; D.ldw = DM; D.srccol = d; D.f8 = 1; D.dst0 = (bf16*)(ws + WS_WD + ((size_t)e * DM + db * 64) * DFF); D.dld = DFF; D.k0src = kb * 64; D.k0dst = kb * 64; return D; }
    };
    {
        float va[64], vb[64], ga = 1.f, gb = 1.f;
        constexpr int I_SMALL = I_WP + I_WAB + I_WO + I_WXQ + I_WXKV + I_WXO;
        const int IT_END = STAGE == 0 ? I_SMALL : NITEMS;
        int it = (STAGE == 0 ? 0 : I_SMALL) + w0;
        CvtDesc da = decode(it < IT_END ? it : 0), db_;
        cvt_load(da, va, ga, lane);
        while (it < IT_END) {
            const int it1 = it + nw, it2 = it + 2 * nw;
            db_ = decode(it1 < IT_END ? it1 : 0);
            cvt_load(db_, vb, gb, lane);
            cvt_store(da, va, ga, tile, lane);
            if (it1 >= IT_END) break;
            da = decode(it2 < IT_END ? it2 : 0);
            cvt_load(da, va, ga, lane);
            cvt_store(db_, vb, gb, tile, lane);
            it = it2;
        }
    }
    if constexpr (STAGE == 1) { asm volatile("s_waitcnt vmcnt(0)" ::: "memory"); __syncthreads(); return; }
    for (int i = F.gw * 64 + lane; i < DM * NE; i += F.NGW * 64) { const int k = i >> 5, e = i & 31; ((float*)(ws + WS_WRT))[(size_t)e * DM + k] = a.in[17][k] * a.in[18][i]; }
    __syncthreads();
    for (int i = F.tid; i < DM * 8; i += NTHREADS) wf[i] = a.in[3][(size_t)(i >> 3) * INC + C_F + (i & 7)];
    __syncthreads();
    for (int row = F.gw; row < NTOK + NMEM; row += F.NGW) {
        const bool ismem = row >= NTOK; const int r = ismem ? row - NTOK : row;
        const float* xr = (ismem ? a.in[1] : a.in[0]) + (size_t)r * DM; const float* g = ismem ? a.in[13] : a.in[2];
        bf16* orow = (bf16*)(ws + (ismem ? WS_HM : WS_H0)) + (size_t)r * DM;
        f32x4 v[8]; float s = 0.f;
#pragma unroll
        for (int j = 0; j < 8; ++j) { v[j] = ((const f32x4*)xr)[lane + 64 * j]; s += (v[j][0] * v[j][0] + v[j][1] * v[j][1]) + (v[j][2] * v[j][2] + v[j][3] * v[j][3]); }
        const float rstd = rsqrtf(wave_sum(s) * (1.f / DM) + RMS_EPS);
        float f[8];
#pragma unroll
        for (int j = 0; j < 8; ++j) f[j] = 0.f;
#pragma unroll
        for (int j = 0; j < 8; ++j) { const f32x4 gg = ((const f32x4*)g)[lane + 64 * j]; v[j] = v[j] * rstd * gg;
            u32x2 w; w.x = cvt_pk_bf16(v[j][0], v[j][1]); w.y = cvt_pk_bf16(v[j][2], v[j][3]); *(u32x2*)(orow + 4 * (lane + 64 * j)) = w;
            if (!ismem) { *(unsigned*)(ws + WS_H0Q + (size_t)r * DM + 4 * (lane + 64 * j)) = pk4_fp8(v[j][0], v[j][1], v[j][2], v[j][3]);
#pragma unroll
                for (int c = 0; c < 4; ++c) { const LAS f32x4* wk = (const LAS f32x4*)(wf + (4 * (lane + 64 * j) + c) * 8); const f32x4 w0 = wk[0], w1 = wk[1];
                    f[0] += v[j][c] * w0[0]; f[1] += v[j][c] * w0[1]; f[2] += v[j][c] * w0[2]; f[3] += v[j][c] * w0[3];
                    f[4] += v[j][c] * w1[0]; f[5] += v[j][c] * w1[1]; f[6] += v[j][c] * w1[2]; f[7] += v[j][c] * w1[3]; } } }
        if (!ismem) {
            float mine = 0.f;
#pragma unroll
            for (int j = 0; j < 8; ++j) { const float t = wave_sum(f[j]); if (lane == j) mine = t; }
            if (lane < 8) ((float*)(ws + WS_LOGF))[(size_t)r * 8 + lane] = log_sigmoid(mine + a.in[4][lane]);
        }
    }
}
__device__ __forceinline__ void cumsum_wave(const float* LOGF, float* CB, int bh, int lane) {
    const int b = bh / FH, h = bh % FH; float loc = 0.f;
    for (int i = 0; i < 64; ++i) loc += LOGF[(size_t)(b * SEQ + lane * 64 + i) * 8 + h];
    float inc = loc;
#pragma unroll
    for (int o = 1; o < 64; o <<= 1) { const float n = __shfl_up(inc, o); if (lane >= o) inc += n; }
    float run = inc - loc;
    for (int i = 0; i < 64; ++i) { run += LOGF[(size_t)(b * SEQ + lane * 64 + i) * 8 + h]; CB[(size_t)bh * SEQ + lane * 64 + i] = -run * 11.313708498984761f; }
}

namespace att {
constexpr int D = 128; constexpr float THR = 8.f; constexpr bool WSKIP = false;
constexpr float SCALE = 0.08838834764831845f;
constexpr int NW = 8, QBLK = 32, KVBLK = 64, QB = NW * QBLK;
constexpr int SHM_V = KVBLK * D * 2, SHM_K = KVBLK * D * 2;
constexpr int LDS_BYTES = 2 * SHM_V + 2 * SHM_K + NW * 64 * 4;
constexpr int BIAS_OFF = LDS_BYTES;

typedef short s16x4 __attribute__((ext_vector_type(4)));
typedef float f32x16 __attribute__((ext_vector_type(16)));
template <class A, class Bt> struct same_t { static constexpr bool v = false; };
template <class A> struct same_t<A, A> { static constexpr bool v = true; };

#define KSWZ(row, colB) ((row) * 256 + ((colB) ^ (((row) & 7) << 4)))
#define SBAR() __builtin_amdgcn_sched_barrier(0)
__device__ __forceinline__ int v_st(int k, int c) { const int kk = (k & ~0xC) | ((k & 4) << 1) | ((k & 8) >> 1); return ((kk >> 3) * 4 + (c >> 5)) * 512 + ((kk & 7) * 32 + (c & 31)) * 2; }
__device__ __forceinline__ int v_rd_base(int lane) { return ((lane & 3) << 3) | (((lane >> 2) & 3) << 6) | (((lane >> 4) & 1) << 5) | (((lane >> 5) & 1) << 8); }
constexpr int v_rd_off(int d0, int ks, int half) { return d0 * 512 + ks * 4096 + half * 2048; }
__device__ __forceinline__ int crow(int r, int hi) { return (r & 3) + 8 * (r >> 2) + 4 * hi; }
__device__ __forceinline__ unsigned cvtpk(float lo, float hi) {
    unsigned r; asm volatile("v_cvt_pk_bf16_f32 %0, %1, %2" : "=v"(r) : "v"(lo), "v"(hi)); return r;
}
__device__ __forceinline__ bf16x8 pack8(f32x4 a, f32x4 b) {
    u32x4 w = {cvtpk(a[0], a[1]), cvtpk(a[2], a[3]), cvtpk(b[0], b[1]), cvtpk(b[2], b[3])};
    return *reinterpret_cast<bf16x8*>(&w);
}
template <class T> __device__ __forceinline__ bf16x8 load8(const T* p) {
    if constexpr (same_t<T, float>::v) { return pack8(*(const f32x4*)p, *(const f32x4*)(p + 4)); }
    else { return *reinterpret_cast<const bf16x8*>(p); }
}
__device__ __forceinline__ void mask_tile(f32x16& p0, f32x16& p1, int dq, unsigned W) {
    const float NEG = -__builtin_inff();
#pragma unroll
    for (int r = 0; r < 16; ++r) {
        const int c = (r & 3) + 8 * (r >> 2);
        if ((unsigned)(dq - c) >= W) p0[r] = NEG;
        if ((unsigned)(dq - c - 32) >= W) p1[r] = NEG;
    }
}
__device__ __forceinline__ void partialSM(f32x16& p0, f32x16& p1, float& m_reg, float& mn, float& alpha) {
    float pmax = p0[0]; for (int r = 1; r < 16; ++r) pmax = fmaxf(pmax, p0[r]); for (int r = 0; r < 16; ++r) pmax = fmaxf(pmax, p1[r]);
    { auto rr = __builtin_amdgcn_permlane32_swap(__float_as_uint(pmax), __float_as_uint(pmax), false, false);
      pmax = fmaxf(__uint_as_float(rr[0]), __uint_as_float(rr[1])); }
    constexpr float C2 = 1.4426950408889634f * SCALE;
    if (__builtin_expect(__all((pmax - m_reg) * SCALE <= THR), 1)) { mn = m_reg; alpha = 1.f; }
    else { mn = fmaxf(m_reg, pmax); alpha = __builtin_amdgcn_exp2f((m_reg - mn) * C2); m_reg = mn; }
    const float mnL = -mn * C2;
    for (int r = 0; r < 16; ++r) p0[r] = fmaf(p0[r], C2, mnL); for (int r = 0; r < 16; ++r) p1[r] = fmaf(p1[r], C2, mnL);
    for (int r = 0; r < 16; ++r) p0[r] = __builtin_amdgcn_exp2f(p0[r]);
}
__device__ __forceinline__ void finishSM(f32x16& p0, f32x16& p1, float alpha, float& l_reg, bf16x8& pa0, bf16x8& pa1, bf16x8& pa2, bf16x8& pa3) {
    for (int r = 0; r < 16; ++r) p1[r] = __builtin_amdgcn_exp2f(p1[r]);
    float ps = 0; for (int r = 0; r < 16; ++r) ps += p0[r]; for (int r = 0; r < 16; ++r) ps += p1[r];
    { auto rr = __builtin_amdgcn_permlane32_swap(__float_as_uint(ps), __float_as_uint(ps), false, false);
      ps = __uint_as_float(rr[0]) + __uint_as_float(rr[1]); }
    l_reg = l_reg * alpha + ps;
#define PK4(P, B_, OUT) do { unsigned a0 = cvtpk(P[B_+0], P[B_+1]), a1 = cvtpk(P[B_+2], P[B_+3]);                          \
        unsigned b0 = cvtpk(P[B_+4], P[B_+5]), b1 = cvtpk(P[B_+6], P[B_+7]);                                             \
        auto r0 = __builtin_amdgcn_permlane32_swap(a0, b0, false, false); auto r1 = __builtin_amdgcn_permlane32_swap(a1, b1, false, false); \
        u32x4 w = {r0[0], r1[0], r0[1], r1[1]}; OUT = *reinterpret_cast<bf16x8*>(&w); } while (0)
    PK4(p0, 0, pa0); PK4(p0, 8, pa1); PK4(p1, 0, pa2); PK4(p1, 8, pa3);
#undef PK4
}
template <int KB, bool SK, bool BIAS>
__device__ __forceinline__ void qkt(f32x16& p0, f32x16& p1, const char* K_lds, int r32, int hi, const bf16x8* qr, bool act, const float* bl) {
    if (SK && !act) { const float NEG = -__builtin_inff();
#pragma unroll
        for (int r = 0; r < 16; ++r) { p0[r] = NEG; p1[r] = NEG; } return; }
    if constexpr (BIAS) {
#pragma unroll
        for (int g_ = 0; g_ < 4; ++g_) { const f32x4 t0 = *(const f32x4*)(bl + 8 * g_), t1 = *(const f32x4*)(bl + 32 + 8 * g_);
            p0[4 * g_] = t0[0]; p0[4 * g_ + 1] = t0[1]; p0[4 * g_ + 2] = t0[2]; p0[4 * g_ + 3] = t0[3]; p1[4 * g_] = t1[0]; p1[4 * g_ + 1] = t1[1]; p1[4 * g_ + 2] = t1[2]; p1[4 * g_ + 3] = t1[3]; }
    } else { p0 = f32x16{}; p1 = f32x16{}; }
    const char* kb[4];
#pragma unroll
    for (int dd = 0; dd < 4; ++dd) kb[dd] = K_lds + KB * SHM_K + KSWZ(r32, (dd * 16 + hi * 8) * 2);
#pragma unroll
    for (int d0 = 0; d0 < 8; ++d0) { const char* a = kb[d0 & 3] + (d0 >> 2) * 128;
        bf16x8 b0 = *reinterpret_cast<const bf16x8*>(a);
        bf16x8 b1 = *reinterpret_cast<const bf16x8*>(a + 32 * 256);
        p0 = __builtin_amdgcn_mfma_f32_32x32x16_bf16(b0, qr[d0], p0, 0, 0, 0);
        p1 = __builtin_amdgcn_mfma_f32_32x32x16_bf16(b1, qr[d0], p1, 0, 0, 0); }
}
template <int VB, bool SK>
__device__ __forceinline__ void pv_tile(f32x16* o, int vb0, bf16x8 pa0, bf16x8 pa1, bf16x8 pa2, bf16x8 pa3, bool act) {
    if (SK && !act) return;
#define TRRD(dst, off) asm volatile("ds_read_b64_tr_b16 %0, %1 offset:%2" : "=&v"(dst) : "v"(vb0), "i"(off) : "memory")
#define PV_D0(d0) do { s16x4 l0, l1, l2, l3, h0, h1, h2, h3; constexpr int b_ = VB * SHM_V + v_rd_off(d0, 0, 0);     \
        TRRD(l0, b_); TRRD(h0, b_ + 2048); TRRD(l1, b_ + 4096); TRRD(h1, b_ + 6144); TRRD(l2, b_ + 8192); TRRD(h2, b_ + 10240); TRRD(l3, b_ + 12288); TRRD(h3, b_ + 14336); \
        asm volatile("s_waitcnt lgkmcnt(0)" ::: "memory"); SBAR();                 \
        o[d0] = __builtin_amdgcn_mfma_f32_32x32x16_bf16(pa0, (bf16x8){l0[0], l0[1], l0[2], l0[3], h0[0], h0[1], h0[2], h0[3]}, o[d0], 0, 0, 0);   \
        o[d0] = __builtin_amdgcn_mfma_f32_32x32x16_bf16(pa1, (bf16x8){l1[0], l1[1], l1[2], l1[3], h1[0], h1[1], h1[2], h1[3]}, o[d0], 0, 0, 0);   \
        o[d0] = __builtin_amdgcn_mfma_f32_32x32x16_bf16(pa2, (bf16x8){l2[0], l2[1], l2[2], l2[3], h2[0], h2[1], h2[2], h2[3]}, o[d0], 0, 0, 0);   \
        o[d0] = __builtin_amdgcn_mfma_f32_32x32x16_bf16(pa3, (bf16x8){l3[0], l3[1], l3[2], l3[3], h3[0], h3[1], h3[2], h3[3]}, o[d0], 0, 0, 0); } while (0)
    PV_D0(0); PV_D0(1); PV_D0(2); PV_D0(3);
#undef PV_D0
#undef TRRD
}

template <class TIn, class TOut> struct BlockRef { const TIn* Q; const TIn* K; const TIn* V; TOut* O; int P0; };
template <class TIn> struct Seam {
    bf16x8 qr[8];
    bf16x8 st_v0, st_v1, st_k0, st_k1; f32x4 sf0, sf1, sf2, sf3;
    f32x4 tq[16];
};
__device__ __forceinline__ int swa_jlo(int P0, int W) { const int lowk = P0 - W + 1; return lowk > 0 ? lowk / KVBLK : 0; }
#define ROW(p, k0, rr) (((p) + (size_t)(k0) * KS) + (unsigned)((rr) * KS + sc))
#define VMW() asm volatile("s_waitcnt vmcnt(0)" ::: "memory")
#define VMWN(n) asm volatile("s_waitcnt vmcnt(%0)" :: "i"(n) : "memory")
#define SLOAD_H(Kp, Vp, k0) do { S.st_v0 = load8<TIn>(ROW(Vp, k0, sr)); S.st_v1 = load8<TIn>(ROW(Vp, k0, 32 + sr));              \
                         S.st_k0 = load8<TIn>(ROW(Kp, k0, sr)); S.st_k1 = load8<TIn>(ROW(Kp, k0, 32 + sr)); } while (0)
#define SWRITE_HK(bf) do { *(bf16x8*)(K_lds + (bf) * SHM_K + kws) = S.st_k0; *(bf16x8*)(K_lds + (bf) * SHM_K + kws + 32 * 256) = S.st_k1; } while (0)
#define SWRITE_HV(bf) do { *(bf16x8*)(V_lds + (bf) * SHM_V + vst0) = S.st_v0; *(bf16x8*)(V_lds + (bf) * SHM_V + vst1) = S.st_v1; } while (0)
#define SWRITE_H(bf) do { SWRITE_HV(bf); SWRITE_HK(bf); } while (0)
#define SLOAD_F(p, k0) do { S.sf0 = *(const f32x4*)ROW(p, k0, sr); S.sf1 = *(const f32x4*)(ROW(p, k0, sr) + 4);                \
                            S.sf2 = *(const f32x4*)ROW(p, k0, 32 + sr); S.sf3 = *(const f32x4*)(ROW(p, k0, 32 + sr) + 4); } while (0)
#define SWRITE_KF(bf) do { *(bf16x8*)(K_lds + (bf) * SHM_K + kws) = pack8(S.sf0, S.sf1); *(bf16x8*)(K_lds + (bf) * SHM_K + kws + 32 * 256) = pack8(S.sf2, S.sf3); } while (0)
#define SWRITE_VF(bf) do { *(bf16x8*)(V_lds + (bf) * SHM_V + vst0) = pack8(S.sf0, S.sf1); *(bf16x8*)(V_lds + (bf) * SHM_V + vst1) = pack8(S.sf2, S.sf3); } while (0)
template <class TIn, class TOut, int QS, int KS, int OS, bool BIAS>
__device__ __forceinline__ void causal_swa_prime(const BlockRef<TIn, TOut>& cur, int W, char* lds, Seam<TIn>& S) {
    constexpr bool F32 = same_t<TIn, float>::v;
    const int tid = threadIdx.x, wid = __builtin_amdgcn_readfirstlane(tid >> 6), lane = tid & 63, r32 = lane & 31, hi = lane >> 5;
    const int sr = tid >> 4, sc = (tid & 15) * 8, kws = KSWZ(sr, sc * 2); char* K_lds = lds + 2 * SHM_V;
    const int kb0 = swa_jlo(cur.P0, W) * KVBLK;
    for (int d0 = 0; d0 < 8; ++d0) S.qr[d0] = load8<TIn>(cur.Q + (size_t)(wid * QBLK + r32) * QS + d0 * 16 + hi * 8);
    if constexpr (F32) { SLOAD_F((const float*)cur.K, kb0); VMW(); SWRITE_KF(0); SBAR(); SLOAD_F((const float*)cur.V, kb0); }
    else { SLOAD_H(cur.K, cur.V, kb0); VMW(); SWRITE_HK(0); }
    __syncthreads();
}
template <class TIn, class TOut, int QS, int KS, int OS, bool BIAS, bool PREF = true>
__device__ __forceinline__ void causal_swa_block(const BlockRef<TIn, TOut>& cur, const BlockRef<TIn, TOut>& nxt, int skv, int W, char* lds, Seam<TIn>& S) {
    constexpr bool F32 = same_t<TIn, float>::v;
    const int tid = threadIdx.x, wid = __builtin_amdgcn_readfirstlane(tid >> 6), lane = tid & 63, r32 = lane & 31, hi = lane >> 5;
    const int j_lo = swa_jlo(cur.P0, W);
    int j_hi = (cur.P0 + QB - 1) / KVBLK + 1; if (j_hi > skv / KVBLK) j_hi = skv / KVBLK;
    const int NT = j_hi - j_lo;
    const int kbn = swa_jlo(nxt.P0, W) * KVBLK;
    const int qlo = cur.P0 + wid * QBLK, qm = qlo + r32 - 4 * hi;
    char* V_lds = lds; char* K_lds = lds + 2 * SHM_V;
    float* ws = (float*)(lds + 2 * SHM_V + 2 * SHM_K) + wid * 64; float* li_l = ws, * al_l = ws + 32;
    float m_reg = BIAS ? ((const float*)(lds + BIAS_OFF))[cur.P0 + wid * QBLK + r32] : -1e30f, l_reg = 0; f32x16 o[4] = {};
    const int sr = tid >> 4, sc = (tid & 15) * 8, vst0 = v_st(sr, sc), vst1 = v_st(32 + sr, sc), kws = KSWZ(sr, sc * 2);
    const int vb0 = (int)(uintptr_t)V_lds + v_rd_base(lane);
    const TIn* Kh = cur.K; const TIn* Vh = cur.V;
    const float* bias0 = (const float*)(lds + BIAS_OFF) + 4 * hi;
#define RESC(a) do { if (__any((a) < 1.f)) { if (hi == 0) al_l[r32] = (a); asm volatile("s_waitcnt lgkmcnt(0)" ::: "memory");              \
                     for (int d_ = 0; d_ < 4; ++d_) for (int r = 0; r < 16; ++r) o[d_][r] *= al_l[crow(r, hi)]; } } while (0)
#define KBASE(t) ((j_lo + (t)) * KVBLK)
#define BL(t) (bias0 + KBASE(t))
#define ACT(t) (KBASE(t) <= qlo + QBLK - 1 && KBASE(t) + KVBLK - 1 >= qlo - W + 1)
#define MASKT(P0_, P1_, t) do { const int kb_ = KBASE(t); if ((!SK || ACT(t)) && (kb_ + KVBLK - 1 > qlo || kb_ <= qlo + QBLK - 1 - W)) mask_tile(P0_, P1_, qm - kb_, (unsigned)W); } while (0)
    constexpr int NQL = F32 ? 16 : 8;
    constexpr bool SK = WSKIP && !F32;
#define SEAM_K0() do { VMWN(NQL); if constexpr (F32) { SWRITE_KF(0); SBAR(); SLOAD_F((const float*)nxt.V, kbn); } else { SWRITE_HK(0); } SBAR(); } while (0)
    f32x16 pA0, pA1, pB0, pB1; float mnA, mnB, alA, alB; bf16x8 pa0, pa1, pa2, pa3;
    if constexpr (F32) { VMW(); SWRITE_VF(0); SBAR(); } else { SWRITE_HV(0); SBAR(); }
    if (NT > 1) { if constexpr (F32) SLOAD_F((const float*)Kh, KBASE(1)); else SLOAD_H(Kh, Vh, KBASE(1)); }
    SBAR(); qkt<0, SK, BIAS>(pA0, pA1, K_lds, r32, hi, S.qr, ACT(0), BL(0));
    if constexpr (F32) { if (NT > 1) { VMW(); SWRITE_KF(1); SBAR(); SLOAD_F((const float*)Vh, KBASE(1)); } }
    MASKT(pA0, pA1, 0); partialSM(pA0, pA1, m_reg, mnA, alA);
    if (NT > 1) { VMW(); if constexpr (F32) { SWRITE_VF(1); SBAR(); if (NT > 2) SLOAD_F((const float*)Kh, KBASE(2)); } else SWRITE_H(1); }
    __syncthreads();
#define HALF_STEP(PX0, PX1, mnX, alX, PY0, PY1, alY, t, KB, VB, SB) do {                                                      \
        SBAR(); qkt<KB, SK, BIAS>(PX0, PX1, K_lds, r32, hi, S.qr, ACT(t), BL(t));                                             \
        finishSM(PY0, PY1, alY, l_reg, pa0, pa1, pa2, pa3); SBAR();                                                           \
        if ((t) + 1 < NT) { if constexpr (F32) { VMW(); SWRITE_KF(SB); SBAR(); SLOAD_F((const float*)Vh, KBASE((t) + 1)); }  \
                            else { SLOAD_H(Kh, Vh, KBASE((t) + 1)); } SBAR(); }                                               \
        pv_tile<VB, SK>(o, vb0, pa0, pa1, pa2, pa3, ACT((t) - 1)); MASKT(PX0, PX1, (t)); partialSM(PX0, PX1, m_reg, mnX, alX);                                        \
        __syncthreads();                                                                                                      \
        if ((t) + 1 < NT) { VMW(); if constexpr (F32) { SWRITE_VF(SB); SBAR(); if ((t) + 2 < NT) SLOAD_F((const float*)Kh, KBASE((t) + 2)); } \
                            else { SWRITE_H(SB); } }                                                                          \
        RESC(alX); __syncthreads(); } while (0)
    for (int t = 1; t + 1 < NT; t += 2) {
        HALF_STEP(pB0, pB1, mnB, alB, pA0, pA1, alA, t, 1, 0, 0);
        HALF_STEP(pA0, pA1, mnA, alA, pB0, pB1, alB, t + 1, 0, 1, 1);
    }
    const bool even = (NT & 1) == 0;
    if (even) { SBAR(); qkt<1, SK, BIAS>(pB0, pB1, K_lds, r32, hi, S.qr, ACT(NT - 1), BL(NT - 1)); SBAR(); }
#define QROW(e) (nxt.Q + (size_t)(wid * QBLK + r32) * QS + ((e) >> 1) * 16 + hi * 8 + ((e) & 1) * 4)
    if constexpr (F32) { SLOAD_F((const float*)nxt.K, kbn); SBAR();
#pragma unroll
        for (int e = 0; e < 8; ++e) S.tq[e] = *(const f32x4*)QROW(e); }
    else if constexpr (PREF) { SLOAD_H(nxt.K, nxt.V, kbn); SBAR();
#pragma unroll
        for (int d0 = 0; d0 < 8; ++d0) S.qr[d0] = load8<TIn>(nxt.Q + (size_t)(wid * QBLK + r32) * QS + d0 * 16 + hi * 8); }
    SBAR();
    finishSM(pA0, pA1, alA, l_reg, pa0, pa1, pa2, pa3); SBAR();
    if constexpr (F32) {
#pragma unroll
        for (int e = 8; e < 16; ++e) S.tq[e] = *(const f32x4*)QROW(e); SBAR(); }
#undef QROW
    pv_tile<0, SK>(o, vb0, pa0, pa1, pa2, pa3, ACT(even ? NT - 2 : NT - 1));
    if (even) { MASKT(pB0, pB1, NT - 1); partialSM(pB0, pB1, m_reg, mnB, alB); __syncthreads(); RESC(alB);
        finishSM(pB0, pB1, alB, l_reg, pa0, pa1, pa2, pa3); SBAR(); pv_tile<1, SK>(o, vb0, pa0, pa1, pa2, pa3, ACT(NT - 1)); }
    SBAR(); if constexpr (PREF) SEAM_K0();
    if (hi == 0) li_l[r32] = l_reg; asm volatile("s_waitcnt lgkmcnt(0)" ::: "memory");
    float rli[16];
#pragma unroll
    for (int r = 0; r < 16; ++r) rli[r] = __builtin_amdgcn_rcpf(li_l[crow(r, hi)]);
    TOut* Ow = cur.O + (size_t)(wid * QBLK) * OS;
#pragma unroll
    for (int r = 0; r < 16; ++r) { const int orow = crow(r, hi);
#pragma unroll
        for (int d0 = 0; d0 < 4; ++d0) { const float v = o[d0][r] * rli[r];
            if constexpr (same_t<TOut, float>::v) { Ow[(size_t)orow * OS + d0 * 32 + r32] = v; }
            else { const float vn = __shfl_xor(v, 1);
                   if ((r32 & 1) == 0) *(unsigned*)(Ow + (size_t)orow * OS + d0 * 32 + r32) = cvtpk(v, vn); } } }
    if constexpr (F32) {
#pragma unroll
        for (int d0 = 0; d0 < 8; ++d0) S.qr[d0] = pack8(S.tq[2 * d0], S.tq[2 * d0 + 1]); }
    __syncthreads();
#undef RESC
#undef KBASE
#undef BL
#undef ACT
#undef MASKT
#undef SEAM_K0
#undef HALF_STEP
}
#undef ROW
#undef VMW
#undef VMWN
#undef SLOAD_H
#undef SWRITE_HK
#undef SWRITE_HV
#undef SWRITE_H
#undef SLOAD_F
#undef SWRITE_KF
#undef SWRITE_VF

#undef KSWZ
#undef SBAR
}
__device__ __forceinline__ void sg_phase(const Frame& F, const KArgs& a, const int u_first, const int u_count) {
    unsigned char* ws = F.ws; const int tid = F.tid, lane = F.lane, w = F.wave, tl = lane & 15, kq = lane >> 4;
    LAS f32x2* st = (LAS f32x2*)F.lds;
    LAS unsigned short* vt = (LAS unsigned short*)(F.lds + 1024);
    const bf16* ZU = (const bf16*)(ws + WS_ZU); const bf16* ZV = (const bf16*)(ws + WS_ZV); const float* ZST = (const float*)(ws + WS_ZST); bf16* AS = (bf16*)(ws + WS_AS);
    const float* ln_g = a.in[5]; const float* ln_b = a.in[6]; const float* w_sp = a.in[7]; const float* b_sp = a.in[8];
    for (int uu = 0; uu < u_count; ++uu) { const int u = u_first + uu;
        const int chunk = u >> 3, g = u & 7, t0 = chunk * SGC;
        if (tid < 128) { const f32x4* p = (const f32x4*)(ZST + (size_t)(t0 + tid) * 32); float S = 0.f, Q = 0.f;
#pragma unroll
            for (int i = 0; i < 8; ++i) { const f32x4 v = p[i]; S += v[0] + v[2]; Q += v[1] + v[3]; }
            const float mu = S * (1.f / SGW), var = fmaxf(Q * (1.f / SGW) - mu * mu, 0.f); st[tid] = (f32x2){mu, rsqrtf(var + LN_EPS)}; }
        __syncthreads();
        { const int s = tid >> 2, c0 = (tid & 3) * 32; const f32x2 ms = st[s]; const bf16* src = ZV + (size_t)(t0 + s) * SGW + g * 128 + c0;
#pragma unroll
            for (int q = 0; q < 4; ++q) { const u32x4 raw = ((const u32x4*)src)[q]; const unsigned rw[4] = {raw.x, raw.y, raw.z, raw.w};
                const f32x4 g0 = *(const f32x4*)(ln_g + g * 128 + c0 + 8 * q), g1 = *(const f32x4*)(ln_g + g * 128 + c0 + 8 * q + 4), b0 = *(const f32x4*)(ln_b + g * 128 + c0 + 8 * q), b1 = *(const f32x4*)(ln_b + g * 128 + c0 + 8 * q + 4);
#pragma unroll
                for (int i = 0; i < 8; ++i) { const unsigned wd = rw[i >> 1]; const float v = __builtin_bit_cast(float, (i & 1) ? (wd & 0xffff0000u) : (wd << 16));
                    const float gg = (i < 4) ? g0[i & 3] : g1[i & 3], bb = (i < 4) ? b0[i & 3] : b1[i & 3];
                    vt[(c0 + 8 * q + i) * 136 + s] = (unsigned short)f2bf((v - ms[0]) * ms[1] * gg + bb); } } }
        __syncthreads();
        f32x4 acc[8];
#pragma unroll
        for (int j = 0; j < 8; ++j) acc[j] = (f32x4){0.f, 0.f, 0.f, 0.f};
        const int t = 16 * w + tl;
        f32x4 wraw[4][2];
#pragma unroll
        for (int ks = 0; ks < 4; ++ks) { const float* wp = w_sp + ((size_t)(g * 128 + t) * 128 + 32 * ks + 8 * kq); if (ks <= (w >> 1)) { wraw[ks][0] = *(const f32x4*)wp; wraw[ks][1] = *(const f32x4*)(wp + 4); } else { wraw[ks][0] = (f32x4){0.f, 0.f, 0.f, 0.f}; wraw[ks][1] = wraw[ks][0]; } }
        u32x2 uraw[8];
#pragma unroll
        for (int j = 0; j < 8; ++j) uraw[j] = *(const u32x2*)(ZU + (size_t)(t0 + t) * SGW + g * 128 + 16 * j + 4 * kq);
        const float bs = b_sp[g * 128 + t];
#pragma unroll
        for (int ks = 0; ks < 4; ++ks) { if (ks > (w >> 1)) continue;
            const f32x4 w0 = wraw[ks][0], w1 = wraw[ks][1];
            float wv[8] = {w0[0], w0[1], w0[2], w0[3], w1[0], w1[1], w1[2], w1[3]};
#pragma unroll
            for (int i = 0; i < 8; ++i) if (32 * ks + 8 * kq + i > t) wv[i] = 0.f;
            u32x4 pk; pk.x = cvt_pk_bf16(wv[0], wv[1]); pk.y = cvt_pk_bf16(wv[2], wv[3]); pk.z = cvt_pk_bf16(wv[4], wv[5]); pk.w = cvt_pk_bf16(wv[6], wv[7]);
            const bf16x8 wf = __builtin_bit_cast(bf16x8, pk);
#pragma unroll
            for (int j = 0; j < 8; ++j) { const bf16x8 vf = *(const LAS bf16x8*)(vt + (16 * j + tl) * 136 + 32 * ks + 8 * kq);
                acc[j] = __builtin_amdgcn_mfma_f32_16x16x32_bf16(vf, wf, acc[j], 0, 0, 0); }
        }
#pragma unroll
        for (int j = 0; j < 8; ++j) { const int ch = 16 * j + 4 * kq; const u32x2 uu = uraw[j];
            const float o0 = __builtin_bit_cast(float, uu.x << 16) * (acc[j][0] + bs), o1 = __builtin_bit_cast(float, uu.x & 0xffff0000u) * (acc[j][1] + bs);
            const float o2 = __builtin_bit_cast(float, uu.y << 16) * (acc[j][2] + bs), o3 = __builtin_bit_cast(float, uu.y & 0xffff0000u) * (acc[j][3] + bs);
            u32x2 o; o.x = cvt_pk_bf16(o0, o1); o.y = cvt_pk_bf16(o2, o3); *(u32x2*)(AS + (size_t)(t0 + t) * DM + FW + g * 128 + ch) = o; }
        __syncthreads();
    }
}
__device__ __forceinline__ void fox_phase(const Frame& F, char* lds, int& sg_first, int& sg_count) {
    sg_first = blockIdx.x * 4; sg_count = 4;
    typedef unsigned short T;
    unsigned char* ws = F.ws; const int G = F.G, c = blockIdx.x, vcu = (G % 8 == 0) ? (c % 8) * (G / 8) + c / 8 : c;
    const T* Qb = (const T*)(ws + WS_Q); const T* Kb = (const T*)(ws + WS_K); const T* Vb = (const T*)(ws + WS_V); T* Ob = (T*)(ws + WS_AS); const float* CB = (const float*)(ws + WS_CB);
    if (vcu < NB * FH * 8) {
        const int L = vcu; const int bh = L >> 3, x = L & 7, b = bh / FH, h = bh % FH;
        __syncthreads();
        { const f32x4* src = (const f32x4*)(CB + (size_t)bh * SEQ); f32x4* dst = (f32x4*)(lds + att::BIAS_OFF); dst[F.tid] = src[F.tid]; dst[F.tid + 512] = src[F.tid + 512]; }
        __syncthreads();
        int Wwin = SEQ;
        { const unsigned* NRM = F.ctl + CW_NRM; float q2 = 0.f, k2 = 0.f;
#pragma unroll
            for (int i = 0; i < 4; ++i) { q2 += __uint_as_float(__hip_atomic_load(NRM + ((0 * 4 + b) * 8 + h) * 4 + i, __ATOMIC_RELAXED, __HIP_MEMORY_SCOPE_AGENT)); k2 += __uint_as_float(__hip_atomic_load(NRM + ((1 * 4 + b) * 8 + h) * 4 + i, __ATOMIC_RELAXED, __HIP_MEMORY_SCOPE_AGENT)); }
            const float Bnd = sqrtf(q2 * k2) * 0.08838834764831845f * 1.02f;
            const float need = -(2.f * Bnd + 18.f) * 11.313708498984761f;
            const float* bl = (const float*)(lds + att::BIAS_OFF); float* red = (float*)(lds + att::BIAS_OFF + SEQ * 4);
            int lo = 1, hi = SEQ / 64;
            while (lo < hi) { const int mid = (lo + hi) >> 1, Wc = mid * 64; float mx = -3.0e38f;
                for (int t = Wc + F.tid; t < SEQ; t += NTHREADS) mx = fmaxf(mx, bl[t - Wc] - bl[t]);
#pragma unroll
                for (int o = 1; o < 64; o <<= 1) mx = fmaxf(mx, __shfl_xor(mx, o));
                __syncthreads(); if (F.lane == 0) red[F.wave] = mx; __syncthreads();
                float m8 = red[0];
#pragma unroll
                for (int i = 1; i < 8; ++i) m8 = fmaxf(m8, red[i]);
                if (m8 <= need) hi = mid; else lo = mid + 1; }
            Wwin = __builtin_amdgcn_readfirstlane(lo * 64); __syncthreads(); }
        att::BlockRef<T, T> cur, nxt;
        cur.K = Kb + (size_t)b * SEQ * FW + h * FD; cur.V = Vb + (size_t)b * SEQ * FW + h * FD; nxt = cur;
        cur.Q = Qb + ((size_t)b * SEQ + x * 256) * FW + h * FD; cur.O = Ob + ((size_t)b * SEQ + x * 256) * DM + h * FD; cur.P0 = x * 256;
        nxt.Q = Qb + ((size_t)b * SEQ + (15 - x) * 256) * FW + h * FD; nxt.O = Ob + ((size_t)b * SEQ + (15 - x) * 256) * DM + h * FD; nxt.P0 = (15 - x) * 256;
        att::Seam<T> S;
        att::causal_swa_prime<T, T, FW, FW, DM, true>(cur, Wwin, lds, S);
        att::causal_swa_block<T, T, FW, FW, DM, true>(cur, nxt, SEQ, Wwin, lds, S);
        att::causal_swa_block<T, T, FW, FW, DM, true, false>(nxt, nxt, SEQ, Wwin, lds, S);
        { const int wt = Wwin / 64 + 4; int load[8], cnt[8];
#pragma unroll
          for (int i = 0; i < 8; ++i) { const int f0 = 4 * (i + 1), f1 = 4 * (16 - i); load[i] = (f0 < wt ? f0 : wt) + (f1 < wt ? f1 : wt); cnt[i] = 0; }
          for (int k = 0; k < 32; ++k) { int bi = 0, bv = load[0];
#pragma unroll
              for (int i = 1; i < 8; ++i) if (load[i] < bv) { bv = load[i]; bi = i; }
#pragma unroll
              for (int i = 0; i < 8; ++i) if (i == bi) { load[i] += 4; cnt[i] += 1; } }
          int first = 0, mine = 0;
#pragma unroll
          for (int i = 0; i < 8; ++i) { if (i < x) first += cnt[i]; if (i == x) mine = cnt[i]; }
          sg_first = bh * 32 + first; sg_count = mine; }
    }
}
__device__ __forceinline__ void xattn_phase(const Frame& F, char* lds) {
    typedef unsigned short T;
    unsigned char* ws = F.ws;
    const T* Qb = (const T*)(ws + WS_QX); const T* Kb = (const T*)(ws + WS_KX); const T* Vb = (const T*)(ws + WS_VX); T* Ob = (T*)(ws + WS_OX);
    for (int L = blockIdx.x; L < NB * XH * 16; L += F.G) {
        const int b = L >> 6, h = (L >> 4) & 3, qb = L & 15;
        att::BlockRef<T, T> cur;
        cur.K = Kb + (size_t)b * MEML * XW + h * XD; cur.V = Vb + (size_t)b * MEML * XW + h * XD;
        cur.Q = Qb + ((size_t)b * SEQ + qb * 256) * XW + h * XD; cur.O = Ob + ((size_t)b * SEQ + qb * 256) * XW + h * XD; cur.P0 = MEML;
        att::Seam<T> S;
        att::causal_swa_prime<T, T, XW, XW, XW, false>(cur, 1 << 20, lds, S);
        att::causal_swa_block<T, T, XW, XW, XW, false, false>(cur, cur, MEML, 1 << 20, lds, S);
    }
}
__device__ __forceinline__ void moe_tables(const Frame& F) {
    LAS int* tab = (LAS int*)(F.lds + LDS_TAB);
    __syncthreads();
    if (F.tid == 0) { const unsigned* CNT = F.ctl + CW_CNT; int p = 0;
        for (int e = 0; e < NE; ++e) { const int c = (int)__hip_atomic_load(CNT + e, __ATOMIC_RELAXED, __HIP_MEMORY_SCOPE_AGENT); tab[e] = p; tab[40 + e] = c; p += (c + 255) >> 8; }
        tab[32] = p; }
    __syncthreads();
}
typedef float f32x16 __attribute__((ext_vector_type(16)));
__device__ __forceinline__ void p8_router(const Frame& F, const KArgs& a) {
    unsigned char* ws = F.ws; const int tid = F.tid, lane = F.lane, wave = F.wave, tl = lane & 31, hi = lane >> 5, grp = wave >> 2, kq = wave & 3;
    const float* X2 = (const float*)(ws + WS_X2); const float* WRT = (const float*)(ws + WS_WRT);
    constexpr int PITCH = 132;
    LAS float* xs = (LAS float*)F.lds;
    LAS float* wsm = xs + 2 * 64 * PITCH;
    LAS float* red = wsm + 2 * 32 * PITCH;
    LAS unsigned* lcnt = (LAS unsigned*)(F.lds + LDS_TAB + 512);
    for (int tp = blockIdx.x; tp < NTOK / 64; tp += F.G) {
        const int tok0 = tp * 64;
        f32x4 xa[4], wa[2], xb[4], wb[2];
#define P8_LOAD(X, W, c) do { _Pragma("unroll") for (int i = 0; i < 4; ++i) { const int p = tid + 512 * i; X[i] = *(const f32x4*)(X2 + (size_t)(tok0 + (p >> 5)) * DM + (c) * 128 + (p & 31) * 4); } \
        _Pragma("unroll") for (int i = 0; i < 2; ++i) { const int p = tid + 512 * i; W[i] = *(const f32x4*)(WRT + (size_t)(p >> 5) * DM + (c) * 128 + (p & 31) * 4); } } while (0)
#define P8_WRITE(X, W, b) do { _Pragma("unroll") for (int i = 0; i < 4; ++i) { const int p = tid + 512 * i; *(LAS f32x4*)(xs + ((b) * 64 + (p >> 5)) * PITCH + (p & 31) * 4) = X[i]; } \
        _Pragma("unroll") for (int i = 0; i < 2; ++i) { const int p = tid + 512 * i; *(LAS f32x4*)(wsm + ((b) * 32 + (p >> 5)) * PITCH + (p & 31) * 4) = W[i]; } } while (0)
#define P8_COMPUTE(b) do { const LAS float* xp = xs + ((b) * 64 + grp * 32 + tl) * PITCH + kq * 32 + 4 * hi; const LAS float* wp = wsm + ((b) * 32 + tl) * PITCH + kq * 32 + 4 * hi; \
        _Pragma("unroll") for (int s4 = 0; s4 < 4; ++s4) { const f32x4 xv = *(const LAS f32x4*)(xp + 8 * s4), wv = *(const LAS f32x4*)(wp + 8 * s4); \
            ss += (xv[0] * xv[0] + xv[1] * xv[1]) + (xv[2] * xv[2] + xv[3] * xv[3]); \
            _Pragma("unroll") for (int i = 0; i < 4; ++i) d = __builtin_amdgcn_mfma_f32_32x32x2f32(wv[i], xv[i], d, 0, 0, 0); } } while (0)
        __syncthreads();
        P8_LOAD(xa, wa, 0); P8_WRITE(xa, wa, 0); P8_LOAD(xa, wa, 1);
        f32x16 d = {}; float ss = 0.f;
        for (int c = 0; c < 16; c += 2) {
            if (c + 2 < 16) P8_LOAD(xb, wb, c + 2);
            asm volatile("s_waitcnt lgkmcnt(0)\n\ts_barrier" ::: "memory");
            P8_COMPUTE(0);
            P8_WRITE(xa, wa, 1);
            if (c + 3 < 16) P8_LOAD(xa, wa, c + 3);
            asm volatile("s_waitcnt lgkmcnt(0)\n\ts_barrier" ::: "memory");
            P8_COMPUTE(1);
            if (c + 2 < 16) P8_WRITE(xb, wb, 0);
        }
#undef P8_COMPUTE
#undef P8_LOAD
#undef P8_WRITE
        const int tok = tok0 + grp * 32 + tl;
        if (kq != 0) { LAS float* r = red + ((grp * 3 + (kq - 1)) * 17) * 64 + lane;
#pragma unroll
            for (int i = 0; i < 16; ++i) r[i * 64] = d[i];
            r[16 * 64] = ss; }
        __syncthreads();
        float wgt[4] = {0.f, 0.f, 0.f, 0.f}; int fe[4] = {0, 0, 0, 0}; unsigned lr[4] = {0u, 0u, 0u, 0u}; float rstd_t = 0.f;
        if (kq == 0) {
#pragma unroll
            for (int w = 0; w < 3; ++w) { const LAS float* r = red + ((grp * 3 + w) * 17) * 64 + lane;
#pragma unroll
                for (int i = 0; i < 16; ++i) d[i] += r[i * 64];
                ss += r[16 * 64]; }
            ss += __shfl_xor(ss, 32);
            const float rstd = rsqrtf(ss * (1.f / DM) + RMS_EPS);
            float l[16];
#pragma unroll
            for (int r = 0; r < 16; ++r) { const int e = (r & 3) + 8 * (r >> 2) + 4 * hi; l[r] = d[r] * rstd + a.in[19][e]; }
            float tv[8]; int ti[8];
#pragma unroll
            for (int k = 0; k < 4; ++k) { float bv = -INFINITY; int bi = 0;
#pragma unroll
                for (int r = 0; r < 16; ++r) { const int e = (r & 3) + 8 * (r >> 2) + 4 * hi; if (l[r] > bv || (l[r] == bv && e < bi)) { bv = l[r]; bi = e; } }
                tv[k] = bv; ti[k] = bi;
#pragma unroll
                for (int r = 0; r < 16; ++r) { const int e = (r & 3) + 8 * (r >> 2) + 4 * hi; if (e == bi) l[r] = -INFINITY; } }
#pragma unroll
            for (int k = 0; k < 4; ++k) { tv[4 + k] = __shfl_xor(tv[k], 32); ti[4 + k] = __shfl_xor(ti[k], 32); }
            float fv[4]; int fi[4];
#pragma unroll
            for (int k = 0; k < 4; ++k) { float bv = -INFINITY; int bi = 1 << 30;
#pragma unroll
                for (int j = 0; j < 8; ++j) if (tv[j] > bv || (tv[j] == bv && ti[j] < bi)) { bv = tv[j]; bi = ti[j]; }
                fv[k] = bv; fi[k] = bi;
#pragma unroll
                for (int j = 0; j < 8; ++j) if (ti[j] == bi) tv[j] = -INFINITY; }
            if (hi == 0) {
                float w[4], sm = 0.f;
#pragma unroll
                for (int k = 0; k < 4; ++k) { w[k] = __expf(fv[k] - fv[0]); sm += w[k]; }
                const float inv = 1.f / sm; rstd_t = rstd;
#pragma unroll
                for (int k = 0; k < 4; ++k) { fe[k] = fi[k]; wgt[k] = w[k] * inv; lr[k] = __hip_atomic_fetch_add(lcnt + fi[k], 1u, __ATOMIC_RELAXED, __HIP_MEMORY_SCOPE_WORKGROUP); }
            }
        }
        __syncthreads();
        if (tid < 32) { const unsigned cN = lcnt[tid]; lcnt[32 + tid] = cN ? atomicAdd(F.ctl + CW_CNT + tid, cN) : 0u; lcnt[tid] = 0u; }
        __syncthreads();
        if (kq == 0 && hi == 0) {
            ((float*)(ws + WS_RS2))[tok] = rstd_t;
#pragma unroll
            for (int k = 0; k < 4; ++k) { const int e = fe[k]; const float wk = wgt[k]; const unsigned rk = lcnt[32 + e] + lr[k];
                ((int*)(ws + WS_TOPE))[tok * 4 + k] = e; ((int*)(ws + WS_TOPR))[tok * 4 + k] = (int)rk; ((float*)(ws + WS_TOPW))[tok * 4 + k] = wk;
                ((int*)(ws + WS_TOKL))[(size_t)e * NTOK + rk] = tok; ((float*)(ws + WS_GWL))[(size_t)e * NTOK + rk] = wk; ((float*)(ws + WS_RSL))[(size_t)e * NTOK + rk] = rstd_t; }
        }
    }
}
__device__ __forceinline__ void p12_final(const Frame& F, const KArgs& a) {
    unsigned char* ws = F.ws; const int lane = F.lane; const LAS int* tab = (const LAS int*)(F.lds + LDS_TAB);
    const float* X2 = (const float*)(ws + WS_X2); const unsigned char* YB = ws + WS_YB; const int* TOPE = (const int*)(ws + WS_TOPE); const int* TOPR = (const int*)(ws + WS_TOPR);
    for (int row = F.gw; row < NTOK; row += F.NGW) {
        size_t so[4];
#pragma unroll
        for (int k = 0; k < 4; ++k) { const int e = TOPE[row * 4 + k], r = TOPR[row * 4 + k]; so[k] = (size_t)(tab[e] * 256 + r) * DM; }
        f32x4 v[8]; float q = 0.f;
#pragma unroll
        for (int j = 0; j < 8; ++j) { const int c = 4 * (lane + 64 * j); v[j] = *(const f32x4*)(X2 + (size_t)row * DM + c);
#pragma unroll
            for (int k = 0; k < 4; ++k) { const int y = *(const int*)(YB + so[k] + c);
                v[j][0] += __builtin_amdgcn_cvt_f32_fp8(y, 0); v[j][1] += __builtin_amdgcn_cvt_f32_fp8(y, 1); v[j][2] += __builtin_amdgcn_cvt_f32_fp8(y, 2); v[j][3] += __builtin_amdgcn_cvt_f32_fp8(y, 3); }
            q += (v[j][0] * v[j][0] + v[j][1] * v[j][1]) + (v[j][2] * v[j][2] + v[j][3] * v[j][3]); }
        const float rs = rsqrtf(wave_sum(q) * (1.f / DM) + RMS_EPS);
#pragma unroll
        for (int j = 0; j < 8; ++j) { const int c = 4 * (lane + 64 * j); const f32x4 g = *(const f32x4*)(a.in[24] + c); *(f32x4*)(a.out + (size_t)row * DM + c) = v[j] * rs * g; }
    }
}
__global__ void __launch_bounds__(NTHREADS, 2) mega_fwd(KArgs args) {
    extern __shared__ __attribute__((aligned(16))) unsigned char lds_raw[];
    Frame F;
    F.lds = (LAS unsigned char*)lds_raw; F.MISC = (volatile LAS unsigned*)(F.lds + LDS_MISC);
    F.tid = threadIdx.x; F.lane = F.tid & 63; F.wave = __builtin_amdgcn_readfirstlane(F.tid >> 6);
    F.G = gridDim.x; F.gw = blockIdx.x * NWAVES + F.wave; F.NGW = F.G * NWAVES;
    F.ws = args.ws; F.ctl = (unsigned*)(args.ws + WS_CTL);
    unsigned char* ws = args.ws;
    for (int u = F.tid; u < (LDS_BYTES - LDS_MISC) / 4; u += NTHREADS) ((LAS unsigned*)(F.lds + LDS_MISC))[u] = 0u;
    __syncthreads();
    XcdBarrier bar = xcd_barrier_post(F.ctl + CW_BAR + args.li * XCD_BAR_WORDS, F.MISC + 8);
    const int lo = args.ph_lo, hi = args.ph_hi;
#define IN(k) (lo <= (k) && (k) < hi)
#define BOTH(k) (IN(k) && IN((k) + 1))
    if (IN(0)) { p0_prologue<0>(F, args, F.gw, F.NGW); if (BOTH(0)) xcd_barrier(bar); }
    if (IN(1)) {
        if (blockIdx.x < NB * FH && F.wave == 0) cumsum_wave((const float*)(ws + WS_LOGF), (float*)(ws + WS_CB), blockIdx.x, F.lane);
        const int bx = blockIdx.x, oct = bx >> 3, conv = (oct & 7) < pg8::P1_CO ? 1 : 0;
        const int idx = (conv ? ((oct >> 3) * pg8::P1_CO + (oct & 7)) : ((oct >> 3) * (8 - pg8::P1_CO) + (oct & 7) - pg8::P1_CO)) * 8 + (bx & 7);
        if (conv) cvt8_phase(F, args, idx, pg8::P1_NC, 0, CVT8_P1_SUPER);
        {
            pg8::ProjSched S; S.T.init(NTOK / 256, pg8::P1_NBF, pg8::P1_NG, idx); S.A = (const char*)(ws + WS_H0); S.B = (const char*)(ws + WS_WP); S.lda = DM * 2; S.ldb = DM * 2; S.conv = conv; S.idx = idx;
            pg8::EpiProj E{ws, 0, -1.4426950408889634f};
            pg8::gemm_phase<false, false>(F.lds, DM / 64, DM * 2, DM * 2, S, E); }
        {
            constexpr int OFS = (pg8::P1_NG - ((NTOK / 256) * pg8::P1_NBF) % pg8::P1_NG) % pg8::P1_NG;
            pg8::ProjSched S; S.T.init(NTOK / 256, pg8::P1_NF8, pg8::P1_NG, (idx + OFS) % pg8::P1_NG); S.A = (const char*)(ws + WS_H0Q); S.B = (const char*)(ws + WS_WPG); S.lda = DM; S.ldb = DM; S.conv = conv; S.idx = (idx + OFS) % pg8::P1_NG;
            pg8::EpiProj E{ws, pg8::P1_NBF, -1.4426950408889634f * W8_INV};
            pg8::gemm_phase<false, true>(F.lds, DM / 128, DM, DM, S, E); }
        if (BOTH(1)) xcd_barrier(bar);
    }
    if (IN(2)) { int sg_first, sg_count; fox_phase(F, (char*)lds_raw, sg_first, sg_count); sg_phase(F, args, sg_first, sg_count); if (BOTH(2)) xcd_barrier(bar); }
    if (IN(3)) {
        pg8::MergeSched S; S.T.init(NTOK / 256, DM / 256, F.G, (int)blockIdx.x); S.A = (const char*)(ws + WS_AS); S.B = (const char*)(ws + WS_WAB); S.lda = DM * 2; S.ldb = DM * 2;
        pg8::EpiMerge E{ws};
        pg8::gemm_phase<false, false>(F.lds, FW / 64, DM * 2, DM * 2, S, E);
        if (BOTH(3)) xcd_barrier(bar);
    }
    if (IN(4)) {
        pg8::PlainSched S; S.T.init(NTOK / 256, DM / 256, F.G, (int)blockIdx.x); S.A = (const char*)(ws + WS_MG); S.B = (const char*)(ws + WS_WO); S.lda = DM * 2; S.ldb = DM * 2;
        pg8::EpiResid<false, false> E{args.in[0], nullptr, (bf16*)(ws + WS_X1B), (float*)(ws + WS_SS1), nullptr};
        pg8::gemm_phase<false, false>(F.lds, DM / 64, DM * 2, DM * 2, S, E);
        if (BOTH(4)) xcd_barrier(bar);
    }
    if (IN(5)) {
        if (blockIdx.x >= 144) cvt8_phase(F, args, (int)blockIdx.x - 144, 112, CVT8_P1_SUPER, CVT8_SUPER);
        pg8::QkvSched S{(const char*)(ws + WS_X1B), (const char*)(ws + WS_WXQ), (const char*)(ws + WS_HM), (const char*)(ws + WS_WXKV), (int)blockIdx.x};
        pg8::EpiQkv E{ws};
        pg8::gemm_phase<false, false>(F.lds, DM / 64, DM * 2, DM * 2, S, E);
        if (BOTH(5)) xcd_barrier(bar);
    }
    if (IN(6)) { xattn_phase(F, (char*)lds_raw); if (BOTH(6)) xcd_barrier(bar); }
    if (IN(7)) {
        pg8::PlainSched S; S.T.init(NTOK / 256, DM / 256, F.G, (int)blockIdx.x); S.A = (const char*)(ws + WS_OX); S.B = (const char*)(ws + WS_WXO); S.lda = XW * 2; S.ldb = XW * 2;
        pg8::EpiResid<true, true> E{(const void*)(ws + WS_X1B), (float*)(ws + WS_X2), nullptr, (float*)(ws + WS_SS2), ws + WS_X2Q};
        pg8::gemm_phase<false, false>(F.lds, XW / 64, XW * 2, XW * 2, S, E);
        if (BOTH(7)) xcd_barrier(bar);
    }
    if (IN(8)) { p8_router(F, args); if (BOTH(8)) xcd_barrier(bar); }
    if (IN(10)) {
        moe_tables(F);
        pg8::MoeSched S{(const LAS int*)(F.lds + LDS_TAB), (const char*)(ws + WS_X2Q), (const char*)(ws + WS_WGU), (const int*)(ws + WS_TOKL), F.G, (int)blockIdx.x, 16, (unsigned)DM, (size_t)(2 * DFF)};
        pg8::EpiAct E{ws, (const LAS int*)(F.lds + LDS_TAB), args.in[21]};
        pg8::gemm_phase<true, true>(F.lds, DM / 128, DM, DM, S, E);
        if (BOTH(10)) xcd_barrier(bar);
    }
    if (IN(11)) {
        moe_tables(F);
        pg8::DownSched S{{(const LAS int*)(F.lds + LDS_TAB), (const char*)(ws + WS_HB), (const char*)(ws + WS_WD), (const int*)(ws + WS_TOKL), F.G, (int)blockIdx.x, 8, (unsigned)DFF, (size_t)DM}, (unsigned)DFF};
        pg8::EpiDown E{ws, (const LAS int*)(F.lds + LDS_TAB), args.in[23]};
        pg8::gemm_phase<false, true>(F.lds, DFF / 128, DFF, DFF, S, E);
        if (BOTH(11)) xcd_barrier(bar);
    }
    if (IN(12)) { moe_tables(F); p12_final(F, args); }
#undef IN
#undef BOTH
}
#ifndef PROBE_PHASE
#define PROBE_PHASE -1
#endif
static int g_grid = 0;
static void mega_launch(hipStream_t st, void* const* d_in, void* d_out, void* d_ws, int lo, int hi, int li) {
    if (g_grid == 0) {
        int dev = 0, cus = 0;
        if (hipGetDevice(&dev) != hipSuccess || hipDeviceGetAttribute(&cus, hipDeviceAttributeMultiprocessorCount, dev) != hipSuccess || cus <= 0) cus = 256;
        if (hipFuncSetAttribute((const void*)mega_fwd, hipFuncAttributeMaxDynamicSharedMemorySize, LDS_BYTES) != hipSuccess) fprintf(stderr, "hipFuncSetAttribute failed\n");
        int per_cu = 0;
        if (hipOccupancyMaxActiveBlocksPerMultiprocessor(&per_cu, (const void*)mega_fwd, NTHREADS, LDS_BYTES) != hipSuccess || per_cu < 1) fprintf(stderr, "occupancy query: %d\n", per_cu);
        (void)hipGetLastError();
        g_grid = cus;
        if (cus != 256) fprintf(stderr, "kernel_launch: built for 256 CUs, device reports %d\n", cus);
    }
    KArgs a{};
    for (int i = 0; i < 25; ++i) a.in[i] = (const float*)d_in[i];
    a.out = (float*)d_out; a.ws = (unsigned char*)d_ws; a.ph_lo = lo; a.ph_hi = hi; a.li = li; a.pad = 0;
    hipLaunchKernelGGL(mega_fwd, dim3(g_grid), dim3(NTHREADS), LDS_BYTES, st, a);
}
extern "C" void kernel_launch(void* const* d_in, const int* in_sizes, int n_in, void* d_out, int out_size, void* d_ws, size_t ws_size, hipStream_t st) {
    if (n_in != 25 || ws_size < WS_END) { fprintf(stderr, "kernel_launch: unexpected n_in %d / ws %zu\n", n_in, ws_size); return; }
    (void)in_sizes; (void)out_size;
    char* ws = (char*)d_ws;
    (void)hipMemsetAsync(ws + WS_CTL, 0, CTL_BYTES, st);
    mega_launch(st, d_in, d_out, d_ws, 0, 13, 0);
#if PROBE_PHASE >= 0
    mega_launch(st, d_in, d_out, d_ws, PROBE_PHASE, PROBE_PHASE + 1, 1);
#endif
}
```

```cpp
#include <hip/hip_runtime.h>
#include <cstdio>
#include <cstdint>
#include <type_traits>

constexpr int DM = 2048, NB = 4, SEQ = 4096, NTOK = NB * SEQ, MEML = 256, NMEM = NB * MEML;
constexpr int FH = 8, FD = 128, FW = 1024, SGG = 8, SGD = 128, SGW = 1024, SGC = 128;
constexpr int XH = 4, XD = 128, XW = 512;
constexpr int NE = 32, TOPK = 4, DFF = 2048;
constexpr int INC = 3 * FW + FH + 2 * SGW + 2 * DM;
constexpr int C_Q = 0, C_K = 1024, C_V = 2048, C_F = 3072, C_Z = 3080, C_GA = 5128, C_GB = 7176;
constexpr float RMS_EPS = 1e-6f, LN_EPS = 1e-5f, SW_LIMIT = 7.0f, SW_ALPHA = 1.702f;
constexpr int MAXSLOT = NTOK * TOPK + NE * 256;

typedef unsigned short bf16;
__device__ __forceinline__ unsigned f2bf(float f) { unsigned u = __builtin_bit_cast(unsigned, f); return (u + 0x7fffu + ((u >> 16) & 1u)) >> 16; }
__device__ __forceinline__ float bf2f(bf16 h) { return __builtin_bit_cast(float, (unsigned)h << 16); }

constexpr size_t MiB = 1ull << 20;
constexpr size_t WS_CTL = 0;
constexpr size_t CTL_BYTES = 1 * MiB;
constexpr int CW_NRM = 12288;
constexpr int CW_FLG = 20480;
constexpr int CW_CNT = 8192;
constexpr size_t WS_H0   = 16 * MiB;
constexpr size_t WS_HM   = WS_H0 + 64 * MiB;
constexpr size_t WS_LOGF = WS_HM + 4 * MiB;
constexpr size_t WS_CB   = WS_LOGF + 1 * MiB;
constexpr size_t WS_Q    = WS_CB + 1 * MiB;
constexpr size_t WS_K    = WS_Q + 32 * MiB;
constexpr size_t WS_V    = WS_K + 32 * MiB;
constexpr size_t WS_ZU   = WS_V + 32 * MiB;
constexpr size_t WS_ZV   = WS_ZU + 32 * MiB;
constexpr size_t WS_ZST  = WS_ZV + 32 * MiB;
constexpr size_t WS_GR   = WS_ZST + 2 * MiB;
constexpr size_t WS_GS   = WS_GR + 64 * MiB;
constexpr size_t WS_AS   = WS_GS + 64 * MiB;
constexpr size_t WS_MG   = WS_AS + 64 * MiB;
constexpr size_t WS_X1   = WS_MG + 64 * MiB;
constexpr size_t WS_X1B  = WS_X1 + 128 * MiB;
constexpr size_t WS_SS1  = WS_X1B + 64 * MiB;
constexpr size_t WS_QX   = WS_SS1 + 2 * MiB;
constexpr size_t WS_KX   = WS_QX + 16 * MiB;
constexpr size_t WS_VX   = WS_KX + 1 * MiB;
constexpr size_t WS_OX   = WS_VX + 1 * MiB;
constexpr size_t WS_X2   = WS_OX + 16 * MiB;
constexpr size_t WS_X2B  = WS_X2 + 128 * MiB;
constexpr size_t WS_SS2  = WS_X2B + 64 * MiB;
constexpr size_t WS_TOPE = WS_SS2 + 2 * MiB;
constexpr size_t WS_TOPR = WS_TOPE + 1 * MiB;
constexpr size_t WS_TOPW = WS_TOPR + 1 * MiB;
constexpr size_t WS_TOKL = WS_TOPW + 1 * MiB;
constexpr size_t WS_GWL  = WS_TOKL + 2 * MiB;
constexpr size_t WS_HB   = WS_GWL + 2 * MiB;
constexpr size_t WS_YB   = WS_HB + 288 * MiB;
constexpr size_t WS_TMP  = WS_YB + 288 * MiB;
constexpr size_t WS_END_NAIVE = WS_TMP + 640 * MiB;

__device__ __forceinline__ float gelu_tanh(float x) {
    const float u = 0.7978845608028654f * (x + 0.044715f * x * x * x);
    const float e = __expf(2.f * u);
    const float t = 1.f - 2.f / (e + 1.f);
    return 0.5f * x * (1.f + t);
}
__device__ __forceinline__ float sigmoidf_(float x) { return 1.f / (1.f + __expf(-x)); }
__device__ __forceinline__ float log_sigmoid(float x) { return fminf(x, 0.f) - log1pf(__expf(-fabsf(x))); }

#ifdef REFERENCE_PIPELINE
__device__ __forceinline__ float block_sum_256(float v, float* red) {
#pragma unroll
    for (int o = 32; o > 0; o >>= 1) v += __shfl_xor(v, o);
    __syncthreads();
    if ((threadIdx.x & 63) == 0) red[threadIdx.x >> 6] = v;
    __syncthreads();
    return red[0] + red[1] + red[2] + red[3];
}
__global__ __launch_bounds__(256) void n_rms_rows(const float* X, const float* g, bf16* OUT, const float* w_in, const float* b_forget, float* LOGF) {
    __shared__ float red[4];
    const int row = blockIdx.x, t = threadIdx.x;
    const float* x = X + (size_t)row * DM;
    float v[8]; float s = 0.f;
#pragma unroll
    for (int i = 0; i < 8; ++i) { v[i] = x[t + 256 * i]; s += v[i] * v[i]; }
    const float tot = block_sum_256(s, red);
    const float rstd = rsqrtf(tot * (1.f / DM) + RMS_EPS);
    float f[8];
#pragma unroll
    for (int j = 0; j < 8; ++j) f[j] = 0.f;
#pragma unroll
    for (int i = 0; i < 8; ++i) {
        const int k = t + 256 * i; const float h = v[i] * rstd * g[k];
        OUT[(size_t)row * DM + k] = (bf16)f2bf(h);
        if (LOGF) {
#pragma unroll
            for (int j = 0; j < 8; ++j) f[j] += h * w_in[(size_t)k * INC + C_F + j];
        }
    }
    if (LOGF) {
#pragma unroll
        for (int j = 0; j < 8; ++j) { const float tj = block_sum_256(f[j], red); if (t == 0) LOGF[(size_t)row * 8 + j] = log_sigmoid(tj + b_forget[j]); }
    }
}
__global__ __launch_bounds__(64) void n_cumsum(const float* LOGF, float* CB) {
    const int bh = blockIdx.x, b = bh / FH, h = bh % FH, lane = threadIdx.x;
    float loc = 0.f;
    for (int i = 0; i < 64; ++i) loc += LOGF[(size_t)(b * SEQ + lane * 64 + i) * 8 + h];
    float inc = loc;
#pragma unroll
    for (int o = 1; o < 64; o <<= 1) { const float n = __shfl_up(inc, o); if (lane >= o) inc += n; }
    float run = inc - loc;
    for (int i = 0; i < 64; ++i) { run += LOGF[(size_t)(b * SEQ + lane * 64 + i) * 8 + h]; CB[(size_t)bh * SEQ + lane * 64 + i] = -run * 11.313708498984761f; }
}

template <bool DUAL, class FA, class FB, class FA2, class FB2, class FE>
__global__ __launch_bounds__(256) void n_gemm(int M, int N, int K, int padarg, const int* Mdev, FA fa, FB fb, FA2 fa2, FB2 fb2, FE fe) {
    __shared__ float As[16][68], Bs[16][68], As2[DUAL ? 16 : 1][68], Bs2[DUAL ? 16 : 1][68];
    const int z = blockIdx.z, m0 = blockIdx.y * 64, n0 = blockIdx.x * 64, t = threadIdx.x, tx = t & 15, ty = t >> 4;
    const int Mr = Mdev ? Mdev[z] : M;
    if (m0 >= Mr) return;
    float acc[4][4], acc2[4][4];
#pragma unroll
    for (int i = 0; i < 4; ++i)
#pragma unroll
        for (int j = 0; j < 4; ++j) { acc[i][j] = 0.f; acc2[i][j] = 0.f; }
    for (int k0 = 0; k0 < K; k0 += 16) {
#pragma unroll
        for (int i = 0; i < 4; ++i) {
            const int idx = t + i * 256;
            { const int r = idx >> 4, c = idx & 15; const bool ok = (m0 + r) < Mr; As[c][r] = ok ? fa(z, m0 + r, k0 + c) : 0.f; if (DUAL) As2[c][r] = ok ? fa2(z, m0 + r, k0 + c) : 0.f; }
            { const int r = idx >> 6, c = idx & 63; const bool ok = (n0 + c) < N; Bs[r][c] = ok ? fb(z, k0 + r, n0 + c) : 0.f; if (DUAL) Bs2[r][c] = ok ? fb2(z, k0 + r, n0 + c) : 0.f; }
        }
        __syncthreads();
#pragma unroll
        for (int kk = 0; kk < 16; ++kk) {
            float a[4], b[4], a2[4], b2[4];
#pragma unroll
            for (int i = 0; i < 4; ++i) { a[i] = As[kk][ty * 4 + i]; b[i] = Bs[kk][tx * 4 + i]; if (DUAL) { a2[i] = As2[kk][ty * 4 + i]; b2[i] = Bs2[kk][tx * 4 + i]; } }
#pragma unroll
            for (int i = 0; i < 4; ++i)
#pragma unroll
                for (int j = 0; j < 4; ++j) { acc[i][j] += a[i] * b[j]; if (DUAL) acc2[i][j] += a2[i] * b2[j]; }
        }
        __syncthreads();
    }
#pragma unroll
    for (int i = 0; i < 4; ++i)
#pragma unroll
        for (int j = 0; j < 4; ++j) { const int m = m0 + ty * 4 + i, n = n0 + tx * 4 + j; if (m < Mr && n < N) fe(z, m, n, acc[i][j], acc2[i][j]); }
}
struct FNone { long pad; __device__ float operator()(int, int, int) const { return 0.f; } };
template <bool DUAL, class FA, class FB, class FA2, class FB2, class FE>
static void run_gemm(hipStream_t st, int Z, int M, int N, int K, const int* Mdev, FA fa, FB fb, FA2 fa2, FB2 fb2, FE fe) {
    dim3 grid((N + 63) / 64, (M + 63) / 64, Z);
    hipLaunchKernelGGL((n_gemm<DUAL, FA, FB, FA2, FB2, FE>), grid, dim3(256), 0, st, M, N, K, 0, Mdev, fa, fb, fa2, fb2, fe);
}
template <class FA, class FB, class FE>
static void run_gemm1(hipStream_t st, int Z, int M, int N, int K, const int* Mdev, FA fa, FB fb, FE fe) { run_gemm<false>(st, Z, M, N, K, Mdev, fa, fb, FNone{}, FNone{}, fe); }

struct ABf { const bf16* p; int ld, pad; __device__ float operator()(int, int m, int k) const { return bf2f(p[(size_t)m * ld + k]); } };
struct AF32 { const float* p; int ld, pad; __device__ float operator()(int, int m, int k) const { return p[(size_t)m * ld + k]; } };
struct BF32 { const float* p; int ld, pad; __device__ float operator()(int, int k, int n) const { return p[(size_t)k * ld + n]; } };
struct BF32G { const float* p; const float* g; int ld, pad; __device__ float operator()(int, int k, int n) const { return g[k] * p[(size_t)k * ld + n]; } };

struct EProj { bf16 *Q, *K, *V, *ZU, *ZV; float *TGA, *TGB;
    __device__ void operator()(int, int m, int n, float v, float) const {
        if (n < C_K) Q[(size_t)m * FW + n] = (bf16)f2bf(v);
        else if (n < C_V) K[(size_t)m * FW + n - C_K] = (bf16)f2bf(v);
        else if (n < C_F) V[(size_t)m * FW + n - C_V] = (bf16)f2bf(v);
        else if (n < C_Z) {}
        else if (n < C_Z + SGW) ZU[(size_t)m * SGW + n - C_Z] = (bf16)f2bf(gelu_tanh(v));
        else if (n < C_GA) ZV[(size_t)m * SGW + n - C_Z - SGW] = (bf16)f2bf(gelu_tanh(v));
        else if (n < C_GB) TGA[(size_t)m * DM + n - C_GA] = sigmoidf_(v);
        else TGB[(size_t)m * DM + n - C_GB] = sigmoidf_(v);
    } };
__global__ __launch_bounds__(256) void n_gates(const float* TGA, const float* TGB, bf16* GR, bf16* GS) {
    const size_t i = (size_t)blockIdx.x * 256 + threadIdx.x; const float a = TGA[i], b = TGB[i]; GR[i] = (bf16)f2bf(a / b); GS[i] = (bf16)f2bf(b);
}
__global__ __launch_bounds__(256) void n_zstat(const bf16* ZV, float* ZST) {
    __shared__ float red[4];
    const int row = blockIdx.x, t = threadIdx.x; float s = 0.f, q = 0.f;
    for (int i = 0; i < 4; ++i) { const float v = bf2f(ZV[(size_t)row * SGW + t + 256 * i]); s += v; q += v * v; }
    const float S = block_sum_256(s, red); const float Q = block_sum_256(q, red);
    if (t < 32) ZST[(size_t)row * 32 + t] = (t == 0) ? S : (t == 1) ? Q : 0.f;
}
struct AQh { const bf16* p; int ld, b, rows, pad; __device__ float operator()(int z, int m, int k) const { return bf2f(p[(size_t)(b * rows + m) * ld + z * 128 + k]); } };
struct BKh { const bf16* p; int ld, b, rows, pad; __device__ float operator()(int z, int k, int n) const { return bf2f(p[(size_t)(b * rows + n) * ld + z * 128 + k]); } };
struct BVh { const bf16* p; int ld, b, rows, pad; __device__ float operator()(int z, int k, int n) const { return bf2f(p[(size_t)(b * rows + k) * ld + z * 128 + n]); } };
struct ES { float* S; const float* CB; int b, ncol, causal, pad; __device__ void operator()(int z, int m, int n, float v, float) const {
        float s = v; if (CB) s += CB[(size_t)(b * FH + z) * SEQ + n]; s *= 0.08838834764831845f; if (causal && n > m) s = -INFINITY; S[((size_t)z * SEQ + m) * ncol + n] = s; } };
__global__ __launch_bounds__(256) void n_softmax_rows(float* S, int ncol) {
    __shared__ float red[4];
    float* r = S + (size_t)blockIdx.x * ncol; const int t = threadIdx.x;
    float mx = -INFINITY; for (int i = t; i < ncol; i += 256) mx = fmaxf(mx, r[i]);
#pragma unroll
    for (int o = 32; o > 0; o >>= 1) mx = fmaxf(mx, __shfl_xor(mx, o));
    __syncthreads(); if ((t & 63) == 0) red[t >> 6] = mx; __syncthreads();
    mx = fmaxf(fmaxf(red[0], red[1]), fmaxf(red[2], red[3]));
    float s = 0.f; for (int i = t; i < ncol; i += 256) { const float e = __expf(r[i] - mx); r[i] = e; s += e; }
    const float tot = block_sum_256(s, red); const float inv = 1.f / tot;
    for (int i = t; i < ncol; i += 256) r[i] *= inv;
}
struct AS3 { const float* S; int ncol, pad; __device__ float operator()(int z, int m, int k) const { return S[((size_t)z * SEQ + m) * ncol + k]; } };
struct EO { bf16* O; int ld, b, coff, pad; __device__ void operator()(int z, int m, int n, float v, float) const { O[(size_t)(b * SEQ + m) * ld + coff + z * 128 + n] = (bf16)f2bf(v); } };
__global__ __launch_bounds__(128) void n_spatial(const bf16* ZU, const bf16* ZV, const float* ZST, const float* ln_g, const float* ln_b, const float* w_s, const float* b_s, bf16* AS) {
    __shared__ float vn[128][129];
    const int chunk = blockIdx.x, g = blockIdx.y, c = threadIdx.x, t0 = chunk * SGC;
    for (int s = 0; s < 128; ++s) {
        const float* st = ZST + (size_t)(t0 + s) * 32; float S = 0.f, Q = 0.f;
        for (int i = 0; i < 16; ++i) { S += st[2 * i]; Q += st[2 * i + 1]; }
        const float mu = S * (1.f / SGW), var = fmaxf(Q * (1.f / SGW) - mu * mu, 0.f), rs = rsqrtf(var + LN_EPS);
        const float v = bf2f(ZV[(size_t)(t0 + s) * SGW + g * 128 + c]);
        vn[s][c] = (v - mu) * rs * ln_g[g * 128 + c] + ln_b[g * 128 + c];
    }
    __syncthreads();
    for (int t = 0; t < 128; ++t) {
        float a = 0.f; const float* w = w_s + ((size_t)g * 128 + t) * 128;
        for (int s = 0; s <= t; ++s) a += w[s] * vn[s][c];
        a += b_s[g * 128 + t];
        const float u = bf2f(ZU[(size_t)(t0 + t) * SGW + g * 128 + c]);
        AS[(size_t)(t0 + t) * DM + FW + g * 128 + c] = (bf16)f2bf(u * a);
    }
}
struct BWab { const float* wa; const float* wb; int second, pad; __device__ float operator()(int, int k, int n) const { return second ? wb[(size_t)k * DM + n] : wa[(size_t)k * DM + n]; } };
struct AAs { const bf16* p; int off, pad; __device__ float operator()(int, int m, int k) const { return bf2f(p[(size_t)m * DM + off + k]); } };
struct EMerge { const bf16 *GR, *GS; bf16* MG; __device__ void operator()(int, int m, int n, float v, float v2) const { const size_t i = (size_t)m * DM + n; MG[i] = (bf16)f2bf((v * bf2f(GR[i]) + v2) * bf2f(GS[i])); } };
struct EResid { const float* Xi; float* Xo; bf16* Xb; __device__ void operator()(int, int m, int n, float v, float) const { const size_t i = (size_t)m * DM + n; const float o = Xi[i] + v; Xo[i] = o; Xb[i] = (bf16)f2bf(o); } };
__global__ __launch_bounds__(256) void n_sumsq(const float* X, float* SS) {
    __shared__ float red[4];
    const int row = blockIdx.x, t = threadIdx.x; float q = 0.f;
    for (int i = 0; i < 8; ++i) { const float v = X[(size_t)row * DM + t + 256 * i]; q += v * v; }
    const float Q = block_sum_256(q, red);
    if (t < 32) SS[(size_t)row * 32 + t] = (t == 0) ? Q : 0.f;
}
__device__ __forceinline__ float rstd_from(const float* SS, int m) { float q = 0.f; for (int i = 0; i < 32; ++i) q += SS[(size_t)m * 32 + i]; return rsqrtf(q * (1.f / DM) + RMS_EPS); }
struct EQx { const float* SS; bf16* QX; __device__ void operator()(int, int m, int n, float v, float) const { QX[(size_t)m * XW + n] = (bf16)f2bf(v * rstd_from(SS, m)); } };
struct EKVx { bf16 *KX, *VX; __device__ void operator()(int, int m, int n, float v, float) const { if (n < XW) KX[(size_t)m * XW + n] = (bf16)f2bf(v); else VX[(size_t)m * XW + n - XW] = (bf16)f2bf(v); } };
struct ELogit { const float* SS; const float* br; float* LG; __device__ void operator()(int, int m, int n, float v, float) const { LG[(size_t)m * NE + n] = v * rstd_from(SS, m) + br[n]; } };
__global__ __launch_bounds__(256) void n_topk(const float* LG, int* TOPE, int* TOPR, float* TOPW, int* TOKL, float* GWL, unsigned* CNT, const float* SS, float* RS2) {
    const int t = blockIdx.x * 256 + threadIdx.x; if (t >= NTOK) return;
    RS2[t] = rstd_from(SS, t);
    float l[NE];
#pragma unroll
    for (int e = 0; e < NE; ++e) l[e] = LG[(size_t)t * NE + e];
    float tv[4]; int ti[4];
#pragma unroll
    for (int k = 0; k < 4; ++k) { float bv = -INFINITY; int bi = 0;
#pragma unroll
        for (int e = 0; e < NE; ++e) { if (l[e] > bv) { bv = l[e]; bi = e; } }
        tv[k] = bv; ti[k] = bi;
#pragma unroll
        for (int e = 0; e < NE; ++e) if (e == bi) l[e] = -INFINITY; }
    float s = 0.f, w[4];
#pragma unroll
    for (int k = 0; k < 4; ++k) { w[k] = __expf(tv[k] - tv[0]); s += w[k]; }
#pragma unroll
    for (int k = 0; k < 4; ++k) { const float wk = w[k] / s; const int e = ti[k]; const unsigned r = atomicAdd(&CNT[e], 1u);
        TOPE[t * 4 + k] = e; TOPR[t * 4 + k] = (int)r; TOPW[t * 4 + k] = wk; TOKL[(size_t)e * NTOK + r] = t; GWL[(size_t)e * NTOK + r] = wk; }
}
__device__ __forceinline__ int expert_base(const unsigned* CNT, int e) { int b = 0; for (int i = 0; i < e; ++i) b += ((int)CNT[i] + 255) & ~255; return b; }
struct AGath { const bf16* X; const int* TOKL; __device__ float operator()(int z, int m, int k) const { return bf2f(X[(size_t)TOKL[(size_t)z * NTOK + m] * DM + k]); } };
struct BGu { const float* w; const float* g; int up, pad; __device__ float operator()(int z, int k, int n) const { return g[k] * w[((size_t)z * DM + k) * (2 * DFF) + up * DFF + n]; } };
struct EAct { const float* SS; const int* TOKL; const float* bgu; const unsigned* CNT; bf16* HB;
    __device__ void operator()(int z, int m, int n, float v, float v2) const {
        const float rs = rstd_from(SS, TOKL[(size_t)z * NTOK + m]);
        float gate = v * rs + bgu[(size_t)z * 2 * DFF + n], up = v2 * rs + bgu[(size_t)z * 2 * DFF + DFF + n];
        gate = fminf(gate, SW_LIMIT); up = fminf(fmaxf(up, -SW_LIMIT), SW_LIMIT);
        const float act = (up + 1.f) * gate * sigmoidf_(SW_ALPHA * gate);
        HB[(size_t)(expert_base(CNT, z) + m) * DFF + n] = (bf16)f2bf(act); } };
struct AHb { const bf16* HB; const unsigned* CNT; __device__ float operator()(int z, int m, int k) const { return bf2f(HB[(size_t)(expert_base(CNT, z) + m) * DFF + k]); } };
struct BDn { const float* w; __device__ float operator()(int z, int k, int n) const { return w[((size_t)z * DFF + k) * DM + n]; } };
struct EDn { const float* bd; const float* GWL; const unsigned* CNT; bf16* YB; __device__ void operator()(int z, int m, int n, float v, float) const {
        YB[(size_t)(expert_base(CNT, z) + m) * DM + n] = (bf16)f2bf((v + bd[(size_t)z * DM + n]) * GWL[(size_t)z * NTOK + m]); } };
__global__ __launch_bounds__(256) void n_final(const float* X2, const bf16* YB, const int* TOPE, const int* TOPR, const unsigned* CNT, const float* g, float* OUT) {
    __shared__ float red[4];
    const int row = blockIdx.x, t = threadIdx.x;
    int slot[4];
#pragma unroll
    for (int k = 0; k < 4; ++k) slot[k] = expert_base(CNT, TOPE[row * 4 + k]) + TOPR[row * 4 + k];
    float v[8]; float q = 0.f;
#pragma unroll
    for (int i = 0; i < 8; ++i) { const int c = t + 256 * i; float a = X2[(size_t)row * DM + c];
#pragma unroll
        for (int k = 0; k < 4; ++k) a += bf2f(YB[(size_t)slot[k] * DM + c]);
        v[i] = a; q += a * a; }
    const float Q = block_sum_256(q, red); const float rs = rsqrtf(Q * (1.f / DM) + RMS_EPS);
#pragma unroll
    for (int i = 0; i < 8; ++i) { const int c = t + 256 * i; OUT[(size_t)row * DM + c] = v[i] * rs * g[c]; }
}

#endif
#define LAS __attribute__((address_space(3)))
#define GAS __attribute__((address_space(1)))
typedef short bf16x8 __attribute__((ext_vector_type(8)));
typedef float f32x4 __attribute__((ext_vector_type(4)));
typedef float f32x2 __attribute__((ext_vector_type(2)));
typedef unsigned u32x4 __attribute__((ext_vector_type(4)));
typedef unsigned u32x2 __attribute__((ext_vector_type(2)));

constexpr int NPROJ = 9216;
constexpr size_t WS_WP   = WS_END_NAIVE;
constexpr size_t WS_WAB  = WS_WP + 36 * MiB;
constexpr size_t WS_WO   = WS_WAB + 8 * MiB;
constexpr size_t WS_WXQ  = WS_WO + 8 * MiB;
constexpr size_t WS_WXKV = WS_WXQ + 2 * MiB;
constexpr size_t WS_WXO  = WS_WXKV + 4 * MiB;
constexpr size_t WS_WGU  = WS_WXO + 2 * MiB;
constexpr size_t WS_WD   = WS_WGU + 512 * MiB;
constexpr size_t WS_WRT  = WS_WD + 256 * MiB;
constexpr size_t WS_RS2  = WS_WRT + 1 * MiB;
constexpr size_t WS_RSL  = WS_RS2 + 1 * MiB;
constexpr size_t WS_X2Q  = WS_RSL + 2 * MiB;
constexpr size_t WS_H0Q  = WS_X2Q + 32 * MiB;
constexpr size_t WS_WPG  = WS_H0Q + 32 * MiB;
constexpr size_t WS_END  = WS_WPG + 8 * MiB;

constexpr int NWAVES = 8, NTHREADS = 512;
constexpr int LDS_STAGE = 131072;
constexpr int LDS_MISC = LDS_STAGE;
constexpr int LDS_TAB = LDS_STAGE + 256;
constexpr int LDS_BYTES = 147456;
constexpr int CW_BAR = 65536;

__device__ __forceinline__ unsigned cvt_pk_bf16(float lo, float hi) { unsigned r; asm volatile("v_cvt_pk_bf16_f32 %0, %1, %2" : "=v"(r) : "v"(lo), "v"(hi)); return r; }
constexpr float W8_SCALE = 64.f, W8_INV = 1.f / 64.f;
__device__ __forceinline__ unsigned pk4_fp8(float a, float b, float c, float d) {
    a = __builtin_amdgcn_fmed3f(a, -448.f, 448.f); b = __builtin_amdgcn_fmed3f(b, -448.f, 448.f); c = __builtin_amdgcn_fmed3f(c, -448.f, 448.f); d = __builtin_amdgcn_fmed3f(d, -448.f, 448.f);
    int w = 0; w = __builtin_amdgcn_cvt_pk_fp8_f32(a, b, w, false); w = __builtin_amdgcn_cvt_pk_fp8_f32(c, d, w, true); return (unsigned)w; }
__device__ __forceinline__ unsigned pk4_fp8_nc(float a, float b, float c, float d) {
    int w = 0; w = __builtin_amdgcn_cvt_pk_fp8_f32(a, b, w, false); w = __builtin_amdgcn_cvt_pk_fp8_f32(c, d, w, true); return (unsigned)w; }
__device__ __forceinline__ float fast_sigmoid(float x) { return __builtin_amdgcn_rcpf(1.f + __builtin_amdgcn_exp2f(-1.4426950408889634f * x)); }
__device__ __forceinline__ float fast_gelu_tanh(float x) { const float u2 = 1.5957691216057308f * (x + 0.044715f * x * x * x); return x * __builtin_amdgcn_rcpf(1.f + __builtin_amdgcn_exp2f(-1.4426950408889634f * u2)); }
__device__ __forceinline__ f32x2 gelu_tanh2(f32x2 x) { const f32x2 u = (x * x * 0.044715f + 1.0f) * x * (-1.4426950408889634f * 1.5957691216057308f);
    f32x2 e; e.x = __builtin_amdgcn_exp2f(u.x); e.y = __builtin_amdgcn_exp2f(u.y); const f32x2 d = e + 1.0f; f32x2 r; r.x = __builtin_amdgcn_rcpf(d.x); r.y = __builtin_amdgcn_rcpf(d.y); return x * r; }
__device__ __forceinline__ float wave_sum(float v) {
#pragma unroll
    for (int o = 1; o < 64; o <<= 1) v += __shfl_xor(v, o);
    return v;
}

#define XB_TMO      128
#define XB_XCNT(j)  (256  + 64 * (j))
#define XB_XSUB(j)  (1280 + 64 * (j))
#define XB_XGEN(j)  (2304 + 64 * (j))
#define XB_TOP      3328
#define XB_TOPGEN   3392
#define XCD_BAR_WORDS 3456
#define XB_SPIN_CAP (1u << 18)
__device__ __forceinline__ unsigned xb_ld(unsigned* p)              { return __hip_atomic_load(p, __ATOMIC_RELAXED, __HIP_MEMORY_SCOPE_AGENT); }
__device__ __forceinline__ unsigned xb_add(unsigned* p, unsigned v) { return __hip_atomic_fetch_add(p, v, __ATOMIC_RELAXED, __HIP_MEMORY_SCOPE_AGENT); }
__device__ __forceinline__ unsigned xb_xcc_id() { return (unsigned)__builtin_amdgcn_s_getreg((3 << 11) | 20) & 0xFu; }
#define XB_SPIN(cond, bar) do { unsigned _sp = 0; while (cond) { __builtin_amdgcn_s_sleep(1); \
    if ((++_sp & 255u) == 0u) { if (xb_ld(&(bar)[XB_TMO])) break; if (_sp > XB_SPIN_CAP) { atomicAdd(&(bar)[XB_TMO], 1u); break; } } } } while (0)
struct XcdBarrier { unsigned* bar; unsigned x; volatile LAS unsigned* st; };
__device__ __forceinline__ XcdBarrier xcd_barrier_post(unsigned* bar, volatile LAS unsigned* st) {
    XcdBarrier b; b.bar = bar; b.x = xb_xcc_id(); b.st = st;
    if (threadIdx.x == 0) (void)xb_add(&bar[XB_XCNT(b.x)], 1u);
    return b;
}
__device__ __forceinline__ void xcd_barrier_complete(unsigned* bar, unsigned x, unsigned& nloc, unsigned& nx) {
    const unsigned G = gridDim.x * gridDim.y * gridDim.z;
    unsigned sum, cnt, mine, sp = 0u;
    for (;;) {
        sum = 0u; cnt = 0u; mine = 0u;
#pragma unroll
        for (unsigned j = 0; j < 16; ++j) { const unsigned c = xb_ld(&bar[XB_XCNT(j)]); sum += c; cnt += (c > 0u) ? 1u : 0u; mine = (j == x) ? c : mine; }
        if (sum == G) break;
        __builtin_amdgcn_s_sleep(1);
        if ((++sp & 255u) == 0u) { if (xb_ld(&bar[XB_TMO])) break; if (sp > XB_SPIN_CAP) { atomicAdd(&bar[XB_TMO], 1u); break; } }
    }
    nloc = mine > 0u ? mine : 1u; nx = cnt > 0u ? cnt : 1u;
}
__device__ __forceinline__ void xcd_barrier(const XcdBarrier& b) {
    asm volatile("s_waitcnt vmcnt(0)" ::: "memory");
    __syncthreads();
    if (threadIdx.x == 0) {
        unsigned* bar = b.bar;
        __builtin_amdgcn_s_waitcnt(0);
        unsigned nloc = b.st[0], nx = b.st[1];
        if (nloc == 0u) { xcd_barrier_complete(bar, b.x, nloc, nx); b.st[0] = nloc; b.st[1] = nx; }
        const unsigned old = xb_add(&bar[XB_XSUB(b.x)], 1u);
        const unsigned gen = old / nloc;
        if (old + 1u == (gen + 1u) * nloc) {
            __builtin_amdgcn_fence(__ATOMIC_RELEASE, "agent");
            asm volatile("s_waitcnt vmcnt(0)" ::: "memory");
            const unsigned og = xb_add(&bar[XB_TOP], 1u);
            const unsigned tg = og / nx;
            if (og + 1u == (tg + 1u) * nx) xb_add(&bar[XB_TOPGEN], 1u);
            else XB_SPIN(xb_ld(&bar[XB_TOPGEN]) == tg, bar);
            __builtin_amdgcn_fence(__ATOMIC_ACQUIRE, "agent");
            xb_add(&bar[XB_XGEN(b.x)], 1u);
            asm volatile("s_waitcnt vmcnt(0)" ::: "memory");
        } else {
            XB_SPIN(xb_ld(&bar[XB_XGEN(b.x)]) == gen, bar);
            __builtin_amdgcn_fence(__ATOMIC_ACQUIRE, "agent");
            asm volatile("s_waitcnt vmcnt(0)" ::: "memory");
        }
    }
    __syncthreads();
}

namespace pg8 {
typedef int v4i_t __attribute__((ext_vector_type(4)));
typedef int v8i_t __attribute__((ext_vector_type(8)));
constexpr int BM = 256, BK = 64, HALF = 128, HTB = HALF * BK * 2, STAGE_BYTES = 8 * HTB;
__host__ __device__ __forceinline__ int lds_byte(int r, int c) { const int st = (r >> 4) * 2 + (c >> 5), rr = r & 15, cc = c & 31, ob = rr * 64 + cc * 2; return st * 1024 + (ob ^ (((ob >> 9) & 1) << 5)); }
__host__ __device__ __forceinline__ void stage_rc(int b, int& R, int& C) { const int st = b / 1024, sb = b % 1024, swz = sb ^ (((sb >> 9) & 1) << 5); R = (st >> 1) * 16 + swz / 64; C = (st & 1) * 32 + (swz % 64) / 2; }
__host__ __device__ __forceinline__ int perm32(int rho) { const int n = rho >> 4, i = rho & 15; return 8 * (i >> 2) + 4 * n + (i & 3); }

struct GUnit { const char* A; const char* B; int pm, pn, e, keep; };

template <bool GATHER, bool F8, class Epi, class Sched>
__device__ __forceinline__ void gemm_phase(LAS unsigned char* lds, const int nt, const unsigned lda, const unsigned ldb, const Sched& S, const Epi& E) {
    const int tid = threadIdx.x, wid = __builtin_amdgcn_readfirstlane(tid >> 6), lane = tid & 63, wr = wid >> 2, wc = wid & 3, fr = lane & 15, fq = lane >> 4;
    unsigned voffA[2], voffB[2]; int RA[2]; unsigned CA2[2];
#pragma unroll
    for (int i = 0; i < 2; ++i) { int R, C; stage_rc(tid * 16 + i * 8192, R, C); const int Rb = Epi::PERM ? ((R & ~31) + perm32(R & 31)) : R;
        RA[i] = R; CA2[i] = (unsigned)C * 2u; voffA[i] = (unsigned)R * lda + (unsigned)C * 2u; voffB[i] = (unsigned)Rb * ldb + (unsigned)C * 2u; }
    const size_t kstep = (size_t)(BK * 2);
    const size_t hA = GATHER ? 0 : (size_t)HALF * lda, hB = (size_t)HALF * ldb;
    const unsigned ldsw = (unsigned)wid * 1024u;
    const int aoff = lds_byte(wr * 64 + fr, fq * 8), boff = lds_byte(wc * 32 + fr, fq * 8);
    LAS unsigned char* const ldsB = lds + 4 * HTB;
#define PG8_SA(b, h) (((b) * 2 + (h)) * HTB)
#define PG8_SB(b, h) ((4 + (b) * 2 + (h)) * HTB)
#define PG8_STAGE(bufoff, gbase, voff) do { _Pragma("unroll") for (int _i = 0; _i < 2; ++_i) \
        __builtin_amdgcn_global_load_lds((const unsigned*)((const char*)(gbase) + (voff)[_i]), (LAS unsigned*)(lds + (bufoff) + ldsw + _i * 8192), 16, 0, 0); } while (0)
#define PG8_SBR(b, h) (((b) * 2 + (h)) * HTB)
#define PG8_LD8(base, off) __builtin_shufflevector(*(const LAS v4i_t*)((base) + (off)), *(const LAS v4i_t*)((base) + (off) + 1024), 0, 1, 2, 3, 4, 5, 6, 7)
#define PG8_LDA(dst, b, h) do { if constexpr (F8) { _Pragma("unroll") for (int m = 0; m < 4; ++m) dst##8[m] = PG8_LD8(lds, PG8_SA(b, h) + aoff + m * 2048); } \
        else { _Pragma("unroll") for (int m = 0; m < 4; ++m) _Pragma("unroll") for (int k = 0; k < 2; ++k) dst[m][k] = *(const LAS bf16x8*)(lds + PG8_SA(b, h) + aoff + m * 2048 + k * 1024); } } while (0)
#define PG8_LDB(dst, b, h) do { if constexpr (F8) { _Pragma("unroll") for (int n = 0; n < 2; ++n) dst##8[n] = PG8_LD8(ldsB, PG8_SBR(b, h) + boff + n * 2048); } \
        else { _Pragma("unroll") for (int n = 0; n < 2; ++n) _Pragma("unroll") for (int k = 0; k < 2; ++k) dst[n][k] = *(const LAS bf16x8*)(ldsB + PG8_SBR(b, h) + boff + n * 2048 + k * 1024); } } while (0)
#define PG8_MMA(ai, bj, At, Bt) do { __builtin_amdgcn_s_setprio(1); \
        if constexpr (F8) { _Pragma("unroll") for (int m = 0; m < 4; ++m) _Pragma("unroll") for (int n = 0; n < 2; ++n) \
            asm volatile("v_mfma_scale_f32_16x16x128_f8f6f4 %0, %1, %2, %0, %3, %3 op_sel_hi:[0,0,0]" : "+v"(acc[ai][bj][m][n]) : "v"(Bt##8[n]), "v"(At##8[m]), "v"(sc8)); } \
        else { _Pragma("unroll") for (int m = 0; m < 4; ++m) _Pragma("unroll") for (int n = 0; n < 2; ++n) _Pragma("unroll") for (int k = 0; k < 2; ++k) \
            acc[ai][bj][m][n] = __builtin_amdgcn_mfma_f32_16x16x32_bf16(Bt[n][k], At[m][k], acc[ai][bj][m][n], 0, 0, 0); } \
        __builtin_amdgcn_s_setprio(0); } while (0)
#define PG8_WAIT_V(n) asm volatile("s_waitcnt vmcnt(" #n ")" ::: "memory")
#define PG8_WAIT_L(n) asm volatile("s_waitcnt lgkmcnt(" #n ")" ::: "memory")
#define PG8_BAR __builtin_amdgcn_s_barrier()
#define PG8_SCHED __builtin_amdgcn_sched_barrier(0)
    GUnit cur, nxt; int ui = 0;
    if (!S.next(0, cur)) return;
    f32x4 acc[2][2][4][2];
#pragma unroll
    for (int a = 0; a < 2; ++a)
#pragma unroll
        for (int b = 0; b < 2; ++b)
#pragma unroll
            for (int m = 0; m < 4; ++m)
#pragma unroll
                for (int n = 0; n < 2; ++n) acc[a][b][m][n] = (f32x4){0.f, 0.f, 0.f, 0.f};
    bf16x8 At[4][2], B0[2][2], B1[2][2]; v8i_t At8[4], B08[2], B18[2];
    const int sc8 = 0x7f7f7f7f;
    const char* cA = cur.A; const char* cB = cur.B;
    unsigned vA0[2], vA1[2], vN0[2], vN1[2];
    if constexpr (GATHER) {
#pragma unroll
        for (int i = 0; i < 2; ++i) { vA0[i] = (unsigned)S.arow(cur, RA[i]) * lda + CA2[i]; vA1[i] = (unsigned)S.arow(cur, HALF + RA[i]) * lda + CA2[i]; }
        asm volatile("" : "+v"(vA0[0]), "+v"(vA0[1]), "+v"(vA1[0]), "+v"(vA1[1]));
    } else {
#pragma unroll
        for (int i = 0; i < 2; ++i) { vA0[i] = voffA[i]; vA1[i] = voffA[i]; }
    }
    PG8_STAGE(PG8_SB(0, 0), cB, voffB); PG8_STAGE(PG8_SB(0, 1), cB + hB, voffB); PG8_STAGE(PG8_SA(0, 0), cA, vA0); PG8_STAGE(PG8_SA(0, 1), cA + hA, vA1);
    if (wr == 1) PG8_BAR;
    PG8_WAIT_V(2); PG8_BAR;
    PG8_STAGE(PG8_SB(1, 0), cB + kstep, voffB); PG8_STAGE(PG8_SA(1, 0), cA + kstep, vA0); PG8_STAGE(PG8_SB(1, 1), cB + hB + kstep, voffB);
    PG8_WAIT_V(6); PG8_BAR;
    for (;;) {
        const bool has_next = S.next(ui + 1, nxt);
        const char* nA = has_next ? nxt.A : cA; const char* nB = has_next ? nxt.B : cB;
        if constexpr (GATHER) {
            if (has_next) {
#pragma unroll
                for (int i = 0; i < 2; ++i) { vN0[i] = (unsigned)S.arow(nxt, RA[i]) * lda + CA2[i]; vN1[i] = (unsigned)S.arow(nxt, HALF + RA[i]) * lda + CA2[i]; }
            } else {
#pragma unroll
                for (int i = 0; i < 2; ++i) { vN0[i] = vA0[i]; vN1[i] = vA1[i]; }
            }
            asm volatile("" : "+v"(vN0[0]), "+v"(vN0[1]), "+v"(vN1[0]), "+v"(vN1[1]));
        }
        for (int t = 0; t < nt; t += 2) {
            const bool last = (t == nt - 2);
            const char* a1 = cA + (size_t)(t + 1) * kstep;
            const char* a2 = last ? nA : cA + (size_t)(t + 2) * kstep; const char* b2 = last ? nB : cB + (size_t)(t + 2) * kstep;
            const char* a3 = a2 + kstep; const char* b3 = b2 + kstep;
            unsigned w0[2], w1[2];
            if constexpr (GATHER) {
#pragma unroll
                for (int i = 0; i < 2; ++i) { w0[i] = last ? vN0[i] : vA0[i]; w1[i] = last ? vN1[i] : vA1[i]; }
            } else {
#pragma unroll
                for (int i = 0; i < 2; ++i) { w0[i] = voffA[i]; w1[i] = voffA[i]; }
            }
            PG8_LDB(B0, 0, 0); PG8_LDB(B1, 0, 1); PG8_SCHED; PG8_LDA(At, 0, 0); PG8_STAGE(PG8_SA(1, 1), a1 + hA, vA1);
            PG8_WAIT_V(8); PG8_WAIT_L(0); PG8_BAR; PG8_MMA(0, 0, At, B0); PG8_MMA(0, 1, At, B1); PG8_BAR; PG8_SCHED;
            PG8_LDA(At, 0, 1); PG8_STAGE(PG8_SB(0, 0), b2, voffB); PG8_STAGE(PG8_SB(0, 1), b2 + hB, voffB); PG8_STAGE(PG8_SA(0, 0), a2, w0);
            PG8_WAIT_V(8); PG8_WAIT_L(0); PG8_BAR; PG8_MMA(1, 0, At, B0); PG8_MMA(1, 1, At, B1); PG8_BAR; PG8_SCHED;
            PG8_LDB(B0, 1, 0); PG8_LDB(B1, 1, 1); PG8_SCHED; PG8_LDA(At, 1, 0); PG8_STAGE(PG8_SA(0, 1), a2 + hA, w1);
            PG8_WAIT_V(8); PG8_WAIT_L(0); PG8_BAR; PG8_MMA(0, 0, At, B0); PG8_MMA(0, 1, At, B1); PG8_BAR; PG8_SCHED;
            PG8_LDA(At, 1, 1); PG8_STAGE(PG8_SB(1, 0), b3, voffB); PG8_STAGE(PG8_SB(1, 1), b3 + hB, voffB); PG8_STAGE(PG8_SA(1, 0), a3, w0);
            PG8_WAIT_V(8); PG8_WAIT_L(0); PG8_BAR; PG8_MMA(1, 0, At, B0); PG8_MMA(1, 1, At, B1); PG8_BAR; PG8_SCHED;
        }
        if (wr == 0) PG8_BAR;
        E(acc, cur, wr, wc, fr, fq);
        if (!has_next) break;
        if (!cur.keep) {
#pragma unroll
            for (int a = 0; a < 2; ++a)
#pragma unroll
                for (int b = 0; b < 2; ++b)
#pragma unroll
                    for (int m = 0; m < 4; ++m)
#pragma unroll
                        for (int n = 0; n < 2; ++n) acc[a][b][m][n] = (f32x4){0.f, 0.f, 0.f, 0.f};
        }
        cur = nxt; cA = nA; cB = nB; ++ui;
        if constexpr (GATHER) {
#pragma unroll
            for (int i = 0; i < 2; ++i) { vA0[i] = vN0[i]; vA1[i] = vN1[i]; }
        }
        if (wr == 1) PG8_BAR;
    }
    PG8_WAIT_V(0);
    PG8_BAR;
#undef PG8_SA
#undef PG8_SB
#undef PG8_STAGE
#undef PG8_LDA
#undef PG8_LDB
#undef PG8_MMA
#undef PG8_LD8
#undef PG8_SBR
#undef PG8_WAIT_V
#undef PG8_WAIT_L
#undef PG8_BAR
#undef PG8_SCHED
}

struct TileOrder {
    int nM, nN, nwg, G, c;
    __device__ void init(int nM_, int nN_, int G_, int c_) { nM = nM_; nN = nN_; nwg = nM * nN; G = G_; c = c_; }
    __device__ bool tile(int i, int& pm, int& pn) const { return tileL((long)i * G + c, pm, pn); }
    __device__ bool tileL(long L, int& pm, int& pn) const {
        if (L < 0 || L >= nwg) return false;
        int wgid = (int)L; { const int q = nwg / 8, r = nwg % 8, xcd = wgid % 8, off = wgid / 8; wgid = (xcd < r ? xcd * (q + 1) : r * (q + 1) + (xcd - r) * q) + off; }
        const int nig = 4 * nN, gid = wgid / nig, fm = gid * 4, gsz = (nM - fm) < 4 ? (nM - fm) : 4;
        pm = fm + ((wgid % nig) % gsz); pn = (wgid % nig) / gsz; return true;
    }
};
constexpr int P1_CO = 2, P1_NC = P1_CO * 32, P1_NG = 256 - P1_NC, P1_UG = 12, P1_UC = 0, P1_NBF = 20, P1_NF8 = 16;
static_assert(P1_NG * P1_UG + P1_NC * P1_UC == (NTOK / 256) * (NPROJ / 256) && (P1_NBF + P1_NF8) * 256 == NPROJ, "P1 unit deal");
struct ProjSched {
    TileOrder T; const char* A; const char* B; unsigned lda, ldb; int conv, idx;
    __device__ bool next(int i, GUnit& u) const { const long L = conv ? -1 : (long)i * P1_NG + idx; int pm, pn; if (!T.tileL(L, pm, pn)) return false;
        u.pm = pm; u.pn = pn; u.e = 0; u.keep = 0; u.A = A + (size_t)pm * 256 * lda; u.B = B + (size_t)pn * 256 * ldb; return true; }
    __device__ int arow(const GUnit&, int) const { return 0; }
};
struct PlainSched {
    TileOrder T; const char* A; const char* B; unsigned lda, ldb;
    __device__ bool next(int i, GUnit& u) const { int pm, pn; if (!T.tile(i, pm, pn)) return false; u.pm = pm; u.pn = pn; u.e = 0; u.keep = 0;
        u.A = A + (size_t)pm * 256 * lda; u.B = B + (size_t)pn * 256 * ldb; return true; }
    __device__ int arow(const GUnit&, int) const { return 0; }
};

struct EpiProj {
    static constexpr bool PERM = true;
    unsigned char* ws; int pn0; float gsc;
    __device__ __forceinline__ void operator()(f32x4 (&acc)[2][2][4][2], const GUnit& u, int wr, int wc, int fr, int fq) const {
        const int row0 = u.pm * BM + wr * 64 + fr, pn = u.pn + pn0;
        if (pn < 12) {
            static_assert(WS_K - WS_Q == WS_V - WS_K, "q|k|v spacing"); bf16* base = (bf16*)(ws + WS_Q + (size_t)(pn >> 2) * (WS_K - WS_Q)); const int col0 = (pn & 3) * 256 + wc * 32 + 8 * fq;
            float nmax[2] = {0.f, 0.f};
#pragma unroll
            for (int ai = 0; ai < 2; ++ai)
#pragma unroll
                for (int m = 0; m < 4; ++m) { bf16* rowp = base + (size_t)(row0 + ai * HALF + m * 16) * FW + col0;
#pragma unroll
                    for (int bj = 0; bj < 2; ++bj) { const f32x4 v0 = acc[ai][bj][m][0], v1 = acc[ai][bj][m][1];
                        if (pn < 8) { float q2 = (v0[0] * v0[0] + v0[1] * v0[1]) + (v0[2] * v0[2] + v0[3] * v0[3]) + (v1[0] * v1[0] + v1[1] * v1[1]) + (v1[2] * v1[2] + v1[3] * v1[3]);
                            q2 += __shfl_xor(q2, 16); q2 += __shfl_xor(q2, 32); nmax[bj] = fmaxf(nmax[bj], q2); }
                        u32x4 w; w.x = cvt_pk_bf16(v0[0], v0[1]); w.y = cvt_pk_bf16(v0[2], v0[3]); w.z = cvt_pk_bf16(v1[0], v1[1]); w.w = cvt_pk_bf16(v1[2], v1[3]);
                        *(u32x4*)(rowp + bj * HALF) = w; } }
            if (pn < 8) {
#pragma unroll
                for (int bj = 0; bj < 2; ++bj) { float v = nmax[bj]; v = fmaxf(v, __shfl_xor(v, 1)); v = fmaxf(v, __shfl_xor(v, 2)); v = fmaxf(v, __shfl_xor(v, 4)); v = fmaxf(v, __shfl_xor(v, 8));
                    if (fr == 0 && fq == 0) atomicMax((unsigned*)(ws + WS_CTL) + CW_NRM + (((pn >> 2) * 4 + (u.pm >> 4)) * 8 + (pn & 3) * 2 + bj) * 4 + wc, __float_as_uint(v)); }
            }
        } else if (pn < 20) {
            const bool isv = pn >= 16; bf16* base = (bf16*)(ws + WS_ZU + (size_t)(isv ? 1 : 0) * (WS_ZV - WS_ZU)); float* ZST = (float*)(ws + WS_ZST); const int col0 = ((pn - 12) & 3) * 256 + wc * 32 + 8 * fq;
#pragma unroll
            for (int ai = 0; ai < 2; ++ai)
#pragma unroll
                for (int m = 0; m < 4; ++m) { const int row = row0 + ai * HALF + m * 16; bf16* rowp = base + (size_t)row * SGW + col0; float s = 0.f, q = 0.f;
#pragma unroll
                    for (int bj = 0; bj < 2; ++bj) { f32x4 v0 = acc[ai][bj][m][0], v1 = acc[ai][bj][m][1];
                        { const f32x2 a = gelu_tanh2((f32x2){v0[0], v0[1]}), b = gelu_tanh2((f32x2){v0[2], v0[3]}), c = gelu_tanh2((f32x2){v1[0], v1[1]}), d = gelu_tanh2((f32x2){v1[2], v1[3]});
                          v0 = (f32x4){a.x, a.y, b.x, b.y}; v1 = (f32x4){c.x, c.y, d.x, d.y};
                          if (isv) { const f32x2 s2 = (a + b) + (c + d), q2 = (a * a + b * b) + (c * c + d * d); s += s2.x + s2.y; q += q2.x + q2.y; } }
                        u32x4 w; w.x = cvt_pk_bf16(v0[0], v0[1]); w.y = cvt_pk_bf16(v0[2], v0[3]); w.z = cvt_pk_bf16(v1[0], v1[1]); w.w = cvt_pk_bf16(v1[2], v1[3]);
                        *(u32x4*)(rowp + bj * HALF) = w; }
                    if (isv) { s += __shfl_xor(s, 16); s += __shfl_xor(s, 32); q += __shfl_xor(q, 16); q += __shfl_xor(q, 32);
                        if (fq == 0) *(f32x2*)(ZST + (size_t)row * 32 + ((pn - 16) * 4 + wc) * 2) = (f32x2){s, q}; } }
        } else {
            const int col0 = (pn - 20) * 128 + wc * 32 + 8 * fq; bf16* GR = (bf16*)(ws + WS_GR); bf16* GS = (bf16*)(ws + WS_GS);
#pragma unroll
            for (int ai = 0; ai < 2; ++ai)
#pragma unroll
                for (int m = 0; m < 4; ++m) { const size_t off = (size_t)(row0 + ai * HALF + m * 16) * DM + col0; float r[8], sb[8];
#pragma unroll
                    for (int n = 0; n < 2; ++n)
#pragma unroll
                        for (int p = 0; p < 2; ++p) { const f32x2 ya = (f32x2){acc[ai][0][m][n][2 * p], acc[ai][0][m][n][2 * p + 1]} * gsc, yb = (f32x2){acc[ai][1][m][n][2 * p], acc[ai][1][m][n][2 * p + 1]} * gsc;
                            f32x2 ea, eb; ea.x = __builtin_amdgcn_exp2f(ya.x); ea.y = __builtin_amdgcn_exp2f(ya.y); eb.x = __builtin_amdgcn_exp2f(yb.x); eb.y = __builtin_amdgcn_exp2f(yb.y);
                            const f32x2 da = ea + 1.0f, db = eb + 1.0f; f32x2 ra, rb; ra.x = __builtin_amdgcn_rcpf(da.x); ra.y = __builtin_amdgcn_rcpf(da.y); rb.x = __builtin_amdgcn_rcpf(db.x); rb.y = __builtin_amdgcn_rcpf(db.y);
                            const f32x2 rr = db * ra; sb[n * 4 + 2 * p] = rb.x; sb[n * 4 + 2 * p + 1] = rb.y; r[n * 4 + 2 * p] = rr.x; r[n * 4 + 2 * p + 1] = rr.y; }
                    u32x4 w; w.x = cvt_pk_bf16(r[0], r[1]); w.y = cvt_pk_bf16(r[2], r[3]); w.z = cvt_pk_bf16(r[4], r[5]); w.w = cvt_pk_bf16(r[6], r[7]);
                    *(u32x4*)(GR + off) = w;
                    w.x = cvt_pk_bf16(sb[0], sb[1]); w.y = cvt_pk_bf16(sb[2], sb[3]); w.z = cvt_pk_bf16(sb[4], sb[5]); w.w = cvt_pk_bf16(sb[6], sb[7]);
                    *(u32x4*)(GS + off) = w; }
        }
    }
};
struct MergeSched {
    TileOrder T; const char* A; const char* B; unsigned lda, ldb;
    __device__ bool next(int i, GUnit& u) const { int pm, pn; if (!T.tile(i >> 1, pm, pn)) return false; const int half = i & 1; u.pm = pm; u.pn = pn; u.e = 0; u.keep = half ^ 1;
        u.A = A + (size_t)pm * 256 * lda + half * (FW * 2); u.B = B + (size_t)pn * 256 * ldb + half * (FW * 2); return true; }
    __device__ int arow(const GUnit&, int) const { return 0; }
};
struct EpiMerge {
    static constexpr bool PERM = true;
    unsigned char* ws;
    __device__ __forceinline__ void operator()(f32x4 (&acc)[2][2][4][2], const GUnit& u, int wr, int wc, int fr, int fq) const {
        const int row0 = u.pm * BM + wr * 64 + fr, col0 = u.pn * 256 + wc * 32 + 8 * fq;
        const bf16* G = (const bf16*)(ws + (u.keep ? WS_GR : WS_GS)); bf16* MG = (bf16*)(ws + WS_MG);
#pragma unroll
        for (int ai = 0; ai < 2; ++ai) {
            u32x4 gv[4][2];
#pragma unroll
            for (int m = 0; m < 4; ++m)
#pragma unroll
                for (int bj = 0; bj < 2; ++bj) gv[m][bj] = *(const u32x4*)(G + (size_t)(row0 + ai * HALF + m * 16) * DM + col0 + bj * HALF);
#pragma unroll
            for (int m = 0; m < 4; ++m) { const size_t off = (size_t)(row0 + ai * HALF + m * 16) * DM + col0;
#pragma unroll
                for (int bj = 0; bj < 2; ++bj) { const u32x4 g = gv[m][bj];
                    f32x4 v0 = acc[ai][bj][m][0], v1 = acc[ai][bj][m][1];
                    v0[0] *= __builtin_bit_cast(float, g.x << 16); v0[1] *= __builtin_bit_cast(float, g.x & 0xffff0000u); v0[2] *= __builtin_bit_cast(float, g.y << 16); v0[3] *= __builtin_bit_cast(float, g.y & 0xffff0000u);
                    v1[0] *= __builtin_bit_cast(float, g.z << 16); v1[1] *= __builtin_bit_cast(float, g.z & 0xffff0000u); v1[2] *= __builtin_bit_cast(float, g.w << 16); v1[3] *= __builtin_bit_cast(float, g.w & 0xffff0000u);
                    if (u.keep) { acc[ai][bj][m][0] = v0; acc[ai][bj][m][1] = v1; }
                    else { u32x4 w; w.x = cvt_pk_bf16(v0[0], v0[1]); w.y = cvt_pk_bf16(v0[2], v0[3]); w.z = cvt_pk_bf16(v1[0], v1[1]); w.w = cvt_pk_bf16(v1[2], v1[3]); *(u32x4*)(MG + off + bj * HALF) = w; } } } }
    }
};
template <bool RB, bool WF>
struct EpiResid {
    static constexpr bool PERM = true;
    const void* Xi; float* Xo; bf16* Xb; float* SS; unsigned char* Xq;
    __device__ __forceinline__ void operator()(f32x4 (&acc)[2][2][4][2], const GUnit& u, int wr, int wc, int fr, int fq) const {
        const int row0 = u.pm * BM + wr * 64 + fr, col0 = u.pn * 256 + wc * 32 + 8 * fq;
        typedef typename std::conditional<RB, u32x4, f32x4>::type rv_t;
        constexpr int NV = RB ? 1 : 2, GB = 4;
#pragma unroll
        for (int g0 = 0; g0 < 8; g0 += GB) {
            rv_t xr[GB][2][NV];
#pragma unroll
            for (int gg = 0; gg < GB; ++gg) { const int gi = g0 + gg; const size_t offl = (size_t)(row0 + (gi >> 2) * HALF + (gi & 3) * 16) * DM + col0;
#pragma unroll
                for (int bj = 0; bj < 2; ++bj) {
                    if constexpr (RB) xr[gg][bj][0] = *(const u32x4*)((const bf16*)Xi + offl + bj * HALF);
                    else { xr[gg][bj][0] = *(const f32x4*)((const float*)Xi + offl + bj * HALF); xr[gg][bj][NV - 1] = *(const f32x4*)((const float*)Xi + offl + bj * HALF + 4); } } }
#pragma unroll
            for (int gg = 0; gg < GB; ++gg) { const int gi = g0 + gg, ai = gi >> 2, m = gi & 3; const int row = row0 + ai * HALF + m * 16; const size_t off = (size_t)row * DM + col0; float q = 0.f;
#pragma unroll
                for (int bj = 0; bj < 2; ++bj) { const size_t o = off + bj * HALF; f32x4 r0, r1;
                    if constexpr (RB) { const u32x4 r = xr[gg][bj][0];
                        r0 = (f32x4){__builtin_bit_cast(float, r.x << 16), __builtin_bit_cast(float, r.x & 0xffff0000u), __builtin_bit_cast(float, r.y << 16), __builtin_bit_cast(float, r.y & 0xffff0000u)};
                        r1 = (f32x4){__builtin_bit_cast(float, r.z << 16), __builtin_bit_cast(float, r.z & 0xffff0000u), __builtin_bit_cast(float, r.w << 16), __builtin_bit_cast(float, r.w & 0xffff0000u)}; }
                    else { r0 = xr[gg][bj][0]; r1 = xr[gg][bj][NV - 1]; }
                    const f32x4 v0 = r0 + acc[ai][bj][m][0], v1 = r1 + acc[ai][bj][m][1];
                    if constexpr (WF) { *(f32x4*)(Xo + o) = v0; *(f32x4*)(Xo + o + 4) = v1; }
                    q += ((v0[0] * v0[0] + v0[1] * v0[1]) + (v0[2] * v0[2] + v0[3] * v0[3])) + ((v1[0] * v1[0] + v1[1] * v1[1]) + (v1[2] * v1[2] + v1[3] * v1[3]));
                    if (Xb) { u32x4 w; w.x = cvt_pk_bf16(v0[0], v0[1]); w.y = cvt_pk_bf16(v0[2], v0[3]); w.z = cvt_pk_bf16(v1[0], v1[1]); w.w = cvt_pk_bf16(v1[2], v1[3]); *(u32x4*)(Xb + o) = w; }
                    if (Xq) { u32x2 w8; w8.x = pk4_fp8(v0[0], v0[1], v0[2], v0[3]); w8.y = pk4_fp8(v1[0], v1[1], v1[2], v1[3]); *(u32x2*)(Xq + o) = w8; } }
                q += __shfl_xor(q, 16); q += __shfl_xor(q, 32);
                if (fq == 0) SS[(size_t)row * 32 + u.pn * 4 + wc] = q; }
        }
    }
};
struct QkvSched {
    const char* X1B; const char* WXQ; const char* HM; const char* WXKV; int c;
    __device__ bool next(int i, GUnit& u) const { if (i > 0 || c >= 144) return false; u.keep = 0;
        if (c < 128) { u.e = 0; u.pm = c >> 1; u.pn = c & 1; u.A = X1B + (size_t)u.pm * 256 * (DM * 2); u.B = WXQ + (size_t)u.pn * 256 * (DM * 2); }
        else { const int j = c - 128; u.e = 1; u.pm = j >> 2; u.pn = j & 3; u.A = HM + (size_t)u.pm * 256 * (DM * 2); u.B = WXKV + (size_t)u.pn * 256 * (DM * 2); }
        return true; }
    __device__ int arow(const GUnit&, int) const { return 0; }
};
struct EpiQkv {
    static constexpr bool PERM = true;
    unsigned char* ws;
    __device__ __forceinline__ void operator()(f32x4 (&acc)[2][2][4][2], const GUnit& u, int wr, int wc, int fr, int fq) const {
        const int row0 = u.pm * BM + wr * 64 + fr; const float* SS = (const float*)(ws + WS_SS1);
        bf16* base = u.e ? (bf16*)(ws + WS_KX + (size_t)(u.pn >> 1) * (WS_VX - WS_KX)) + (u.pn & 1) * 256 : (bf16*)(ws + WS_QX) + u.pn * 256;
        float rsv[8];
#pragma unroll
        for (int gi = 0; gi < 8; ++gi) rsv[gi] = 1.f;
        if (!u.e) { f32x4 pp[8][2];
#pragma unroll
            for (int gi = 0; gi < 8; ++gi) { const int row = row0 + (gi >> 2) * HALF + (gi & 3) * 16; pp[gi][0] = *(const f32x4*)(SS + (size_t)row * 32 + fq * 8); pp[gi][1] = *(const f32x4*)(SS + (size_t)row * 32 + fq * 8 + 4); }
#pragma unroll
            for (int gi = 0; gi < 8; ++gi) { const f32x4 p0 = pp[gi][0], p1 = pp[gi][1];
                float q = ((p0[0] + p0[1]) + (p0[2] + p0[3])) + ((p1[0] + p1[1]) + (p1[2] + p1[3])); q += __shfl_xor(q, 16); q += __shfl_xor(q, 32); rsv[gi] = rsqrtf(q * (1.f / DM) + RMS_EPS); } }
#pragma unroll
        for (int ai = 0; ai < 2; ++ai)
#pragma unroll
            for (int m = 0; m < 4; ++m) { const int row = row0 + ai * HALF + m * 16; const float rs = rsv[ai * 4 + m];
                bf16* rowp = base + (size_t)row * XW + wc * 32 + 8 * fq;
#pragma unroll
                for (int bj = 0; bj < 2; ++bj) { const f32x4 v0 = acc[ai][bj][m][0] * rs, v1 = acc[ai][bj][m][1] * rs;
                    u32x4 w; w.x = cvt_pk_bf16(v0[0], v0[1]); w.y = cvt_pk_bf16(v0[2], v0[3]); w.z = cvt_pk_bf16(v1[0], v1[1]); w.w = cvt_pk_bf16(v1[2], v1[3]);
                    *(u32x4*)(rowp + bj * HALF) = w; } }
    }
};
struct MoeSched {
    const LAS int* tab; const char* A; const char* B; const int* TOKL; int G, c, npn; unsigned ldb; size_t erows;
    __device__ bool next(int i, GUnit& u) const {
        const int x = c & 7, j = c >> 3; const int T = npn == 16 ? i * 16 + 4 * (x >> 1) + (j & 3) : i * 32 + 4 * x + (j & 3); const int pnl = npn == 16 ? 8 * (x & 1) + (j >> 2) : (j >> 2);
        if (T >= tab[32]) return false;
        int e = 0;
#pragma unroll 1
        for (int j = 1; j < 32; ++j) e += (tab[j] <= T) ? 1 : 0;
        u.e = e; u.pm = T; u.pn = pnl; u.keep = 0; u.A = A; u.B = B + ((size_t)e * erows + (size_t)u.pn * 256) * ldb; return true; }
    __device__ int arow(const GUnit& u, int r) const { const int rank = (u.pm - tab[u.e]) * 256 + r; return rank < tab[40 + u.e] ? TOKL[(size_t)u.e * NTOK + rank] : 0; }
};
struct DownSched : MoeSched {
    unsigned lda;
    __device__ bool next(int i, GUnit& u) const { if (!MoeSched::next(i, u)) return false; u.A = A + (size_t)u.pm * 256 * lda; return true; }
};
struct EpiAct {
    static constexpr bool PERM = true;
    unsigned char* ws; const LAS int* tab; const float* bgu;
    __device__ __forceinline__ void operator()(f32x4 (&acc)[2][2][4][2], const GUnit& u, int wr, int wc, int fr, int fq) const {
        const int r0 = wr * 64 + fr, j0 = u.pn * 128 + wc * 32 + 8 * fq, rbase = (u.pm - tab[u.e]) * 256, cnt = tab[40 + u.e];
        const int* TOKL = (const int*)(ws + WS_TOKL) + (size_t)u.e * NTOK; const float* RS2 = (const float*)(ws + WS_RS2); unsigned char* HB = ws + WS_HB;
        const float* bg = bgu + (size_t)u.e * 2 * DFF + j0;
        const f32x4 bg0 = *(const f32x4*)bg, bg1 = *(const f32x4*)(bg + 4), bu0 = *(const f32x4*)(bg + DFF), bu1 = *(const f32x4*)(bg + DFF + 4);
        float rsv[8]; const float* RSL = (const float*)(ws + WS_RSL) + (size_t)u.e * NTOK;
#pragma unroll
        for (int gi = 0; gi < 8; ++gi) { const int rank = rbase + r0 + (gi >> 2) * HALF + (gi & 3) * 16; rsv[gi] = rank < cnt ? RSL[rank] : 0.f; }
#pragma unroll
        for (int ai = 0; ai < 2; ++ai)
#pragma unroll
            for (int m = 0; m < 4; ++m) { const int r = r0 + ai * HALF + m * 16; const float rs = rsv[ai * 4 + m] * W8_INV;
                float a[8];
#pragma unroll
                for (int n = 0; n < 2; ++n)
#pragma unroll
                    for (int p = 0; p < 2; ++p) { const f32x2 rs2 = (f32x2){rs, rs};
                        const f32x2 bg2 = n ? (f32x2){bg1[2 * p], bg1[2 * p + 1]} : (f32x2){bg0[2 * p], bg0[2 * p + 1]}, bu2 = n ? (f32x2){bu1[2 * p], bu1[2 * p + 1]} : (f32x2){bu0[2 * p], bu0[2 * p + 1]};
                        f32x2 g2 = (f32x2){acc[ai][0][m][n][2 * p], acc[ai][0][m][n][2 * p + 1]} * rs2 + bg2, u2 = (f32x2){acc[ai][1][m][n][2 * p], acc[ai][1][m][n][2 * p + 1]} * rs2 + bu2;
                        g2.x = fminf(g2.x, SW_LIMIT); g2.y = fminf(g2.y, SW_LIMIT); u2.x = __builtin_amdgcn_fmed3f(u2.x, -SW_LIMIT, SW_LIMIT); u2.y = __builtin_amdgcn_fmed3f(u2.y, -SW_LIMIT, SW_LIMIT);
                        const f32x2 y2 = g2 * (-1.4426950408889634f * SW_ALPHA); f32x2 e2; e2.x = __builtin_amdgcn_exp2f(y2.x); e2.y = __builtin_amdgcn_exp2f(y2.y);
                        const f32x2 d2 = e2 + 1.0f; f32x2 r2; r2.x = __builtin_amdgcn_rcpf(d2.x); r2.y = __builtin_amdgcn_rcpf(d2.y);
                        const f32x2 o2 = ((u2 + 1.0f) * g2) * r2; a[n * 4 + 2 * p] = o2.x; a[n * 4 + 2 * p + 1] = o2.y; }
                u32x2 w; w.x = pk4_fp8_nc(a[0], a[1], a[2], a[3]); w.y = pk4_fp8_nc(a[4], a[5], a[6], a[7]);
                *(u32x2*)(HB + (size_t)(u.pm * 256 + r) * DFF + j0) = w; }
    }
};
struct EpiDown {
    static constexpr bool PERM = true;
    unsigned char* ws; const LAS int* tab; const float* bd;
    __device__ __forceinline__ void operator()(f32x4 (&acc)[2][2][4][2], const GUnit& u, int wr, int wc, int fr, int fq) const {
        const int r0 = wr * 64 + fr, c0 = u.pn * 256 + wc * 32 + 8 * fq, rbase = (u.pm - tab[u.e]) * 256;
        const float* GWL = (const float*)(ws + WS_GWL) + (size_t)u.e * NTOK; unsigned char* YB = ws + WS_YB;
        const float* b = bd + (size_t)u.e * DM + c0;
        f32x4 bv[2][2];
#pragma unroll
        for (int bj = 0; bj < 2; ++bj) { bv[bj][0] = *(const f32x4*)(b + bj * HALF); bv[bj][1] = *(const f32x4*)(b + bj * HALF + 4); }
        float gwv[8];
#pragma unroll
        for (int gi = 0; gi < 8; ++gi) gwv[gi] = GWL[rbase + r0 + (gi >> 2) * HALF + (gi & 3) * 16];
#pragma unroll
        for (int ai = 0; ai < 2; ++ai)
#pragma unroll
            for (int m = 0; m < 4; ++m) { const int r = r0 + ai * HALF + m * 16; const float gw = gwv[ai * 4 + m];
#pragma unroll
                for (int bj = 0; bj < 2; ++bj) { const f32x4 v0 = (acc[ai][bj][m][0] * W8_INV + bv[bj][0]) * gw, v1 = (acc[ai][bj][m][1] * W8_INV + bv[bj][1]) * gw;
                    u32x2 w; w.x = pk4_fp8(v0[0], v0[1], v0[2], v0[3]); w.y = pk4_fp8(v1[0], v1[1], v1[2], v1[3]);
                    *(u32x2*)(YB + (size_t)(u.pm * 256 + r) * DM + c0 + bj * HALF) = w; } }
    }
};
}

struct KArgs { const float* in[25]; float* out; unsigned char* ws; int ph_lo, ph_hi, li, pad; };
struct Frame {
    LAS unsigned char* lds; volatile LAS unsigned* MISC; unsigned* ctl; unsigned char* ws;
    int tid, lane, wave, G, gw, NGW;
};

struct CvtDesc { const float* W; const float* g; bf16* dst0; size_t ldw, dld; int srccol, k0src, k0dst, f8; };
__device__ __forceinline__ void cvt_load(const CvtDesc& d, float (&v)[64], float& gv, int lane) {
    const float* rowp = d.W + (size_t)d.k0src * d.ldw;
    const unsigned col = (unsigned)d.srccol;
#pragma unroll
    for (int i = 0; i < 64; ++i) { v[i] = rowp[col]; rowp += d.ldw; }
    const float* gp = d.g ? d.g : d.W;
    const float gl = gp[d.k0src + lane]; gv = d.g ? gl : 1.f;
}
__device__ __forceinline__ void cvt_store(const CvtDesc& d, float (&v)[64], float gv, LAS unsigned char* tile, int lane) {
    if (d.f8) gv *= W8_SCALE;
#pragma unroll
    for (int i = 0; i < 64; ++i) v[i] *= __builtin_bit_cast(float, __builtin_amdgcn_readlane(__builtin_bit_cast(int, gv), i));
    if (d.f8) {
#pragma unroll
        for (int j = 0; j < 4; ++j) { u32x4 w; w.x = pk4_fp8(v[16 * j], v[16 * j + 1], v[16 * j + 2], v[16 * j + 3]); w.y = pk4_fp8(v[16 * j + 4], v[16 * j + 5], v[16 * j + 6], v[16 * j + 7]);
            w.z = pk4_fp8(v[16 * j + 8], v[16 * j + 9], v[16 * j + 10], v[16 * j + 11]); w.w = pk4_fp8(v[16 * j + 12], v[16 * j + 13], v[16 * j + 14], v[16 * j + 15]);
            *(LAS u32x4*)(tile + lane * 80 + j * 16) = w; }
        asm volatile("s_waitcnt lgkmcnt(0)" ::: "memory");
#pragma unroll
        for (int j = 0; j < 4; ++j) { const int r = 16 * j + (lane >> 2), c = lane & 3; const u32x4 w = *(const LAS u32x4*)(tile + r * 80 + c * 16);
            *(u32x4*)((unsigned char*)d.dst0 + (size_t)r * d.dld + d.k0dst + 16 * c) = w; }
        asm volatile("s_waitcnt lgkmcnt(0)" ::: "memory");
        return;
    }
#pragma unroll
    for (int j = 0; j < 8; ++j) { u32x4 w; w.x = cvt_pk_bf16(v[8 * j], v[8 * j + 1]); w.y = cvt_pk_bf16(v[8 * j + 2], v[8 * j + 3]); w.z = cvt_pk_bf16(v[8 * j + 4], v[8 * j + 5]); w.w = cvt_pk_bf16(v[8 * j + 6], v[8 * j + 7]);
        *(LAS u32x4*)(tile + lane * 144 + j * 16) = w; }
    asm volatile("s_waitcnt lgkmcnt(0)" ::: "memory");
#pragma unroll
    for (int j = 0; j < 8; ++j) { const int r = 8 * j + (lane >> 3), c = lane & 7; const u32x4 w = *(const LAS u32x4*)(tile + r * 144 + c * 16);
        *(u32x4*)(d.dst0 + (size_t)r * d.dld + d.k0dst + 8 * c) = w; }
    asm volatile("s_waitcnt lgkmcnt(0)" ::: "memory");
}
__device__ __forceinline__ int wp_srccol(int d) {
    if (d < 3072) return d;
    if (d < 5120) return d + 8;
    const int t = d - 5120, tile = t >> 8, r = t & 255, j = tile * 128 + (r & 127);
    return (r < 128 ? C_GA : C_GB) + j;
}
struct Cvt8Desc { const float* W; const float* g; unsigned char* dst; size_t ldw; int k0, col0a, col0b; };
__device__ __forceinline__ void cvt8_load(const Cvt8Desc& d, f32x4 (&v)[16], float& gv, int wave, int lane) {
    const float* rowp = d.W + (size_t)(d.k0 + 8 * wave) * d.ldw;
#pragma unroll
    for (int i = 0; i < 8; ++i) { v[2 * i] = __builtin_nontemporal_load((const f32x4*)(rowp + d.col0a)); v[2 * i + 1] = __builtin_nontemporal_load((const f32x4*)(rowp + d.col0b)); rowp += d.ldw; }
    const float* gp = d.g ? d.g : d.W; const float gl = gp[d.k0 + 8 * wave + (lane & 7)]; gv = d.g ? gl * W8_SCALE : W8_SCALE;
}
__device__ __forceinline__ void cvt8_pack(f32x4 (&v)[16], float gv, LAS unsigned char* lds, int sub, int wave, int lane) {
    float gs[8];
#pragma unroll
    for (int i = 0; i < 8; ++i) gs[i] = __builtin_bit_cast(float, __builtin_amdgcn_readlane(__builtin_bit_cast(int, gv), i));
#pragma unroll
    for (int hf = 0; hf < 2; ++hf) { u32x4 w[2];
#pragma unroll
        for (int j = 0; j < 4; ++j) { const unsigned lo = pk4_fp8(v[0 + hf][j] * gs[0], v[2 + hf][j] * gs[1], v[4 + hf][j] * gs[2], v[6 + hf][j] * gs[3]), hi = pk4_fp8(v[8 + hf][j] * gs[4], v[10 + hf][j] * gs[5], v[12 + hf][j] * gs[6], v[14 + hf][j] * gs[7]);
            if (j & 1) { w[j >> 1].z = lo; w[j >> 1].w = hi; } else { w[j >> 1].x = lo; w[j >> 1].y = hi; } }
        const int sw = 8 * sub + 2 * (wave >> 1);
        LAS unsigned char* p = lds + sub * 32768 + wave * 4096 + ((hf * 256 + 4 * lane) ^ (sw & 28)) * 8;
        *(LAS u32x4*)(p + 8 * (sw & 2)) = w[0]; *(LAS u32x4*)(p + 16 - 8 * (sw & 2)) = w[1]; }
}
__device__ __forceinline__ void cvt8_flush(unsigned char* dst, LAS unsigned char* lds, int tid) {
    asm volatile("s_waitcnt lgkmcnt(0)\n\ts_barrier" ::: "memory");
#pragma unroll 4
    for (int ps = 0; ps < 16; ++ps) { const int r = ps * 32 + (tid >> 4), p = tid & 15, j = p >> 2, pc = p & 3;
        const int rs = (r ^ (8 * j + 2 * pc)) * 8;
        const u32x2 a0 = *(const LAS u32x2*)(lds + j * 32768 + (2 * pc) * 4096 + rs), a1 = *(const LAS u32x2*)(lds + j * 32768 + (2 * pc + 1) * 4096 + rs);
        __builtin_nontemporal_store((u32x4){a0.x, a0.y, a1.x, a1.y}, (u32x4*)(dst + (size_t)r * DM + 16 * p)); }
    asm volatile("s_waitcnt lgkmcnt(0)\n\ts_barrier" ::: "memory");
}
constexpr int CVT8_SUPER = NE * 8 * 8 + NE * 8 * 4, CVT8_P1_SUPER = 1840;
__device__ __forceinline__ void cvt8_phase(const Frame& F, const KArgs& a, const int bit, const int nb, const int s_lo, const int s_hi) {
    unsigned char* ws = F.ws; const int lane = F.lane, wave = F.wave, tid = F.tid;
    constexpr int S_WGU = NE * 8 * 8;
    auto decode = [&](int s, int j) -> Cvt8Desc {
        Cvt8Desc D;
        if (s < S_WGU) { const int e = s / 64, rr = s % 64, kb4 = rr / 8, cb = rr % 8, kb = kb4 * 4 + j;
            const int da = 4 * lane, db = 256 + 4 * lane;
            D.W = a.in[20] + (size_t)e * DM * 2 * DFF; D.g = a.in[17]; D.ldw = 2 * DFF; D.k0 = kb * 64;
            D.col0a = ((da & 255) < 128 ? 0 : DFF) + (cb * 2 + (da >> 8)) * 128 + (da & 127); D.col0b = ((db & 255) < 128 ? 0 : DFF) + (cb * 2 + (db >> 8)) * 128 + (db & 127);
            D.dst = ws + WS_WGU + ((size_t)e * 2 * DFF + cb * 512) * DM + kb4 * 256; return D; }
        s -= S_WGU;
        { const int e = s / 32, rr = s % 32, kb4 = rr / 4, cb = rr % 4, kb = kb4 * 4 + j;
            D.W = a.in[22] + (size_t)e * DFF * DM; D.g = nullptr; D.ldw = DM; D.k0 = kb * 64; D.col0a = cb * 512 + 4 * lane; D.col0b = cb * 512 + 256 + 4 * lane;
            D.dst = ws + WS_WD + ((size_t)e * DM + cb * 512) * DFF + kb4 * 256; return D; }
    };
    f32x4 va[16], vb[16]; float ga = 1.f, gb = 1.f;
    int sidx = s_lo + bit;
    if (sidx < s_hi) { Cvt8Desc d0 = decode(sidx, 0); cvt8_load(d0, va, ga, wave, lane); }
    while (sidx < s_hi) {
        const int snext = sidx + nb; const bool more = snext < s_hi;
        { Cvt8Desc d1 = decode(sidx, 1); cvt8_load(d1, vb, gb, wave, lane); } cvt8_pack(va, ga, F.lds, 0, wave, lane);
        { Cvt8Desc d2 = decode(sidx, 2); cvt8_load(d2, va, ga, wave, lane); } cvt8_pack(vb, gb, F.lds, 1, wave, lane);
        { Cvt8Desc d3 = decode(sidx, 3); cvt8_load(d3, vb, gb, wave, lane); } cvt8_pack(va, ga, F.lds, 2, wave, lane);
        { Cvt8Desc dn = decode(more ? snext : sidx, 0); cvt8_load(dn, va, ga, wave, lane); } cvt8_pack(vb, gb, F.lds, 3, wave, lane);
        cvt8_flush(decode(sidx, 0).dst, F.lds, tid);
        sidx = snext;
    }
    asm volatile("s_waitcnt vmcnt(0)" ::: "memory"); __syncthreads();
}
template <int STAGE>
__device__ __forceinline__ void p0_prologue(const Frame& F, const KArgs& a, const int w0, const int nw) {
    unsigned char* ws = F.ws; const int lane = F.lane;
    constexpr int I_WP = (NPROJ / 64) * 32, I_WAB = 32 * 32, I_WO = 32 * 32, I_WXQ = 8 * 32, I_WXKV = 16 * 32, I_WXO = 32 * 8, I_WGU = NE * 64 * 32, I_WD = NE * 32 * 32;
    constexpr int NITEMS = I_WP + I_WAB + I_WO + I_WXQ + I_WXKV + I_WXO + I_WGU + I_WD;
    LAS float* wf = (LAS float*)F.lds;
    LAS unsigned char* tile = F.lds + F.wave * 9216;
    auto decode = [&](int it) -> CvtDesc {
        CvtDesc D; int r = it; D.g = nullptr; D.f8 = 0;
        if (r < I_WP) { const int kb = r / (NPROJ / 64), db = r % (NPROJ / 64), d = db * 64 + lane;
            D.W = a.in[3]; D.ldw = INC; D.srccol = wp_srccol(d); D.k0src = kb * 64; D.k0dst = kb * 64; D.dld = DM;
            if (db * 64 >= 5120) { D.f8 = 1; D.dst0 = (bf16*)(ws + WS_WPG + (size_t)(db * 64 - 5120) * DM); } else D.dst0 = (bf16*)(ws + WS_WP) + (size_t)db * 64 * DM;
            return D; } r -= I_WP;
        if (r < I_WAB) { const int kb = r / 32, db = r % 32, d = db * 64 + lane;
            D.W = kb < 16 ? a.in[9] : a.in[10]; D.ldw = DM; D.srccol = d; D.dst0 = (bf16*)(ws + WS_WAB) + (size_t)db * 64 * DM; D.dld = DM; D.k0src = (kb & 15) * 64; D.k0dst = kb * 64; return D; } r -= I_WAB;
        if (r < I_WO) { const int kb = r / 32, db = r % 32, d = db * 64 + lane;
            D.W = a.in[11]; D.ldw = DM; D.srccol = d; D.dst0 = (bf16*)(ws + WS_WO) + (size_t)db * 64 * DM; D.dld = DM; D.k0src = kb * 64; D.k0dst = kb * 64; return D; } r -= I_WO;
        if (r < I_WXQ) { const int kb = r / 8, db = r % 8, d = db * 64 + lane;
            D.W = a.in[14]; D.g = a.in[12]; D.ldw = XW; D.srccol = d; D.dst0 = (bf16*)(ws + WS_WXQ) + (size_t)db * 64 * DM; D.dld = DM; D.k0src = kb * 64; D.k0dst = kb * 64; return D; } r -= I_WXQ;
        if (r < I_WXKV) { const int kb = r / 16, db = r % 16, d = db * 64 + lane;
            D.W = a.in[15]; D.ldw = 2 * XW; D.srccol = d; D.dst0 = (bf16*)(ws + WS_WXKV) + (size_t)db * 64 * DM; D.dld = DM; D.k0src = kb * 64; D.k0dst = kb * 64; return D; } r -= I_WXKV;
        if (r < I_WXO) { const int kb = r / 32, db = r % 32, d = db * 64 + lane;
            D.W = a.in[16]; D.ldw = DM; D.srccol = d; D.dst0 = (bf16*)(ws + WS_WXO) + (size_t)db * 64 * XW; D.dld = XW; D.k0src = kb * 64; D.k0dst = kb * 64; return D; } r -= I_WXO;
        if (r < I_WGU) { const int e = r / (64 * 32), rr = r % (64 * 32), kb = rr / 64, db = rr % 64, d = db * 64 + lane;
            const int t256 = d >> 8, q = d & 255;
            D.W = a.in[20] + (size_t)e * DM * 2 * DFF; D.g = a.in[17]; D.ldw = 2 * DFF; D.srccol = (q < 128 ? 0 : DFF) + t256 * 128 + (q & 127); D.f8 = 1; D.dst0 = (bf16*)(ws + WS_WGU + ((size_t)e * 2 * DFF + db * 64) * DM); D.dld = DM; D.k0src = kb * 64; D.k0dst = kb * 64; return D; } r -= I_WGU;
        { const int e = r / (32 * 32), rr = r % (32 * 32), kb = rr / 32, db = rr % 32, d = db * 64 + lane;
            D.W = a.in[22] + (size_t)e * DFF * DM; D.ldw = DM; D.srccol = d; D.f8 = 1; D.dst0 = (bf16*)(ws + WS_WD + ((size_t)e * DM + db * 64) * DFF); D.dld = DFF; D.k0src = kb * 64; D.k0dst = kb * 64; return D; }
    };
    {
        float va[64], vb[64], ga = 1.f, gb = 1.f;
        constexpr int I_SMALL = I_WP + I_WAB + I_WO + I_WXQ + I_WXKV + I_WXO;
        const int IT_END = STAGE == 0 ? I_SMALL : NITEMS;
        int it = (STAGE == 0 ? 0 : I_SMALL) + w0;
        CvtDesc da = decode(it < IT_END ? it : 0), db_;
        cvt_load(da, va, ga, lane);
        while (it < IT_END) {
            const int it1 = it + nw, it2 = it + 2 * nw;
            db_ = decode(it1 < IT_END ? it1 : 0);
            cvt_load(db_, vb, gb, lane);
            cvt_store(da, va, ga, tile, lane);
            if (it1 >= IT_END) break;
            da = decode(it2 < IT_END ? it2 : 0);
            cvt_load(da, va, ga, lane);
            cvt_store(db_, vb, gb, tile, lane);
            it = it2;
        }
    }
    if constexpr (STAGE == 1) { asm volatile("s_waitcnt vmcnt(0)" ::: "memory"); __syncthreads(); return; }
    for (int i = F.gw * 64 + lane; i < DM * NE; i += F.NGW * 64) { const int k = i >> 5, e = i & 31; ((float*)(ws + WS_WRT))[(size_t)e * DM + k] = a.in[17][k] * a.in[18][i]; }
    __syncthreads();
    for (int i = F.tid; i < DM * 8; i += NTHREADS) wf[i] = a.in[3][(size_t)(i >> 3) * INC + C_F + (i & 7)];
    __syncthreads();
    for (int row = F.gw; row < NTOK + NMEM; row += F.NGW) {
        const bool ismem = row >= NTOK; const int r = ismem ? row - NTOK : row;
        const float* xr = (ismem ? a.in[1] : a.in[0]) + (size_t)r * DM; const float* g = ismem ? a.in[13] : a.in[2];
        bf16* orow = (bf16*)(ws + (ismem ? WS_HM : WS_H0)) + (size_t)r * DM;
        f32x4 v[8]; float s = 0.f;
#pragma unroll
        for (int j = 0; j < 8; ++j) { v[j] = ((const f32x4*)xr)[lane + 64 * j]; s += (v[j][0] * v[j][0] + v[j][1] * v[j][1]) + (v[j][2] * v[j][2] + v[j][3] * v[j][3]); }
        const float rstd = rsqrtf(wave_sum(s) * (1.f / DM) + RMS_EPS);
        float f[8];
#pragma unroll
        for (int j = 0; j < 8; ++j) f[j] = 0.f;
#pragma unroll
        for (int j = 0; j < 8; ++j) { const f32x4 gg = ((const f32x4*)g)[lane + 64 * j]; v[j] = v[j] * rstd * gg;
            u32x2 w; w.x = cvt_pk_bf16(v[j][0], v[j][1]); w.y = cvt_pk_bf16(v[j][2], v[j][3]); *(u32x2*)(orow + 4 * (lane + 64 * j)) = w;
            if (!ismem) { *(unsigned*)(ws + WS_H0Q + (size_t)r * DM + 4 * (lane + 64 * j)) = pk4_fp8(v[j][0], v[j][1], v[j][2], v[j][3]);
#pragma unroll
                for (int c = 0; c < 4; ++c) { const LAS f32x4* wk = (const LAS f32x4*)(wf + (4 * (lane + 64 * j) + c) * 8); const f32x4 w0 = wk[0], w1 = wk[1];
                    f[0] += v[j][c] * w0[0]; f[1] += v[j][c] * w0[1]; f[2] += v[j][c] * w0[2]; f[3] += v[j][c] * w0[3];
                    f[4] += v[j][c] * w1[0]; f[5] += v[j][c] * w1[1]; f[6] += v[j][c] * w1[2]; f[7] += v[j][c] * w1[3]; } } }
        if (!ismem) {
            float mine = 0.f;
#pragma unroll
            for (int j = 0; j < 8; ++j) { const float t = wave_sum(f[j]); if (lane == j) mine = t; }
            if (lane < 8) ((float*)(ws + WS_LOGF))[(size_t)r * 8 + lane] = log_sigmoid(mine + a.in[4][lane]);
        }
    }
}
__device__ __forceinline__ void cumsum_wave(const float* LOGF, float* CB, int bh, int lane) {
    const int b = bh / FH, h = bh % FH; float loc = 0.f;
    for (int i = 0; i < 64; ++i) loc += LOGF[(size_t)(b * SEQ + lane * 64 + i) * 8 + h];
    float inc = loc;
#pragma unroll
    for (int o = 1; o < 64; o <<= 1) { const float n = __shfl_up(inc, o); if (lane >= o) inc += n; }
    float run = inc - loc;
    for (int i = 0; i < 64; ++i) { run += LOGF[(size_t)(b * SEQ + lane * 64 + i) * 8 + h]; CB[(size_t)bh * SEQ + lane * 64 + i] = -run * 11.313708498984761f; }
}

namespace att {
constexpr int D = 128; constexpr float THR = 8.f; constexpr bool WSKIP = false;
constexpr float SCALE = 0.08838834764831845f;
constexpr int NW = 8, QBLK = 32, KVBLK = 64, QB = NW * QBLK;
constexpr int SHM_V = KVBLK * D * 2, SHM_K = KVBLK * D * 2;
constexpr int LDS_BYTES = 2 * SHM_V + 2 * SHM_K + NW * 64 * 4;
constexpr int BIAS_OFF = LDS_BYTES;

typedef short s16x4 __attribute__((ext_vector_type(4)));
typedef float f32x16 __attribute__((ext_vector_type(16)));
template <class A, class Bt> struct same_t { static constexpr bool v = false; };
template <class A> struct same_t<A, A> { static constexpr bool v = true; };

#define KSWZ(row, colB) ((row) * 256 + ((colB) ^ (((row) & 7) << 4)))
#define SBAR() __builtin_amdgcn_sched_barrier(0)
__device__ __forceinline__ int v_st(int k, int c) { const int kk = (k & ~0xC) | ((k & 4) << 1) | ((k & 8) >> 1); return ((kk >> 3) * 4 + (c >> 5)) * 512 + ((kk & 7) * 32 + (c & 31)) * 2; }
__device__ __forceinline__ int v_rd_base(int lane) { return ((lane & 3) << 3) | (((lane >> 2) & 3) << 6) | (((lane >> 4) & 1) << 5) | (((lane >> 5) & 1) << 8); }
constexpr int v_rd_off(int d0, int ks, int half) { return d0 * 512 + ks * 4096 + half * 2048; }
__device__ __forceinline__ int crow(int r, int hi) { return (r & 3) + 8 * (r >> 2) + 4 * hi; }
__device__ __forceinline__ unsigned cvtpk(float lo, float hi) {
    unsigned r; asm volatile("v_cvt_pk_bf16_f32 %0, %1, %2" : "=v"(r) : "v"(lo), "v"(hi)); return r;
}
__device__ __forceinline__ bf16x8 pack8(f32x4 a, f32x4 b) {
    u32x4 w = {cvtpk(a[0], a[1]), cvtpk(a[2], a[3]), cvtpk(b[0], b[1]), cvtpk(b[2], b[3])};
    return *reinterpret_cast<bf16x8*>(&w);
}
template <class T> __device__ __forceinline__ bf16x8 load8(const T* p) {
    if constexpr (same_t<T, float>::v) { return pack8(*(const f32x4*)p, *(const f32x4*)(p + 4)); }
    else { return *reinterpret_cast<const bf16x8*>(p); }
}
__device__ __forceinline__ void mask_tile(f32x16& p0, f32x16& p1, int dq, unsigned W) {
    const float NEG = -__builtin_inff();
#pragma unroll
    for (int r = 0; r < 16; ++r) {
        const int c = (r & 3) + 8 * (r >> 2);
        if ((unsigned)(dq - c) >= W) p0[r] = NEG;
        if ((unsigned)(dq - c - 32) >= W) p1[r] = NEG;
    }
}
__device__ __forceinline__ void partialSM(f32x16& p0, f32x16& p1, float& m_reg, float& mn, float& alpha) {
    float pmax = p0[0]; for (int r = 1; r < 16; ++r) pmax = fmaxf(pmax, p0[r]); for (int r = 0; r < 16; ++r) pmax = fmaxf(pmax, p1[r]);
    { auto rr = __builtin_amdgcn_permlane32_swap(__float_as_uint(pmax), __float_as_uint(pmax), false, false);
      pmax = fmaxf(__uint_as_float(rr[0]), __uint_as_float(rr[1])); }
    constexpr float C2 = 1.4426950408889634f * SCALE;
    if (__builtin_expect(__all((pmax - m_reg) * SCALE <= THR), 1)) { mn = m_reg; alpha = 1.f; }
    else { mn = fmaxf(m_reg, pmax); alpha = __builtin_amdgcn_exp2f((m_reg - mn) * C2); m_reg = mn; }
    const float mnL = -mn * C2;
    for (int r = 0; r < 16; ++r) p0[r] = fmaf(p0[r], C2, mnL); for (int r = 0; r < 16; ++r) p1[r] = fmaf(p1[r], C2, mnL);
    for (int r = 0; r < 16; ++r) p0[r] = __builtin_amdgcn_exp2f(p0[r]);
}
__device__ __forceinline__ void finishSM(f32x16& p0, f32x16& p1, float alpha, float& l_reg, bf16x8& pa0, bf16x8& pa1, bf16x8& pa2, bf16x8& pa3) {
    for (int r = 0; r < 16; ++r) p1[r] = __builtin_amdgcn_exp2f(p1[r]);
    float ps = 0; for (int r = 0; r < 16; ++r) ps += p0[r]; for (int r = 0; r < 16; ++r) ps += p1[r];
    { auto rr = __builtin_amdgcn_permlane32_swap(__float_as_uint(ps), __float_as_uint(ps), false, false);
      ps = __uint_as_float(rr[0]) + __uint_as_float(rr[1]); }
    l_reg = l_reg * alpha + ps;
#define PK4(P, B_, OUT) do { unsigned a0 = cvtpk(P[B_+0], P[B_+1]), a1 = cvtpk(P[B_+2], P[B_+3]);                          \
        unsigned b0 = cvtpk(P[B_+4], P[B_+5]), b1 = cvtpk(P[B_+6], P[B_+7]);                                             \
        auto r0 = __builtin_amdgcn_permlane32_swap(a0, b0, false, false); auto r1 = __builtin_amdgcn_permlane32_swap(a1, b1, false, false); \
        u32x4 w = {r0[0], r1[0], r0[1], r1[1]}; OUT = *reinterpret_cast<bf16x8*>(&w); } while (0)
    PK4(p0, 0, pa0); PK4(p0, 8, pa1); PK4(p1, 0, pa2); PK4(p1, 8, pa3);
#undef PK4
}
template <int KB, bool SK, bool BIAS>
__device__ __forceinline__ void qkt(f32x16& p0, f32x16& p1, const char* K_lds, int r32, int hi, const bf16x8* qr, bool act, const float* bl) {
    if (SK && !act) { const float NEG = -__builtin_inff();
#pragma unroll
        for (int r = 0; r < 16; ++r) { p0[r] = NEG; p1[r] = NEG; } return; }
    if constexpr (BIAS) {
#pragma unroll
        for (int g_ = 0; g_ < 4; ++g_) { const f32x4 t0 = *(const f32x4*)(bl + 8 * g_), t1 = *(const f32x4*)(bl + 32 + 8 * g_);
            p0[4 * g_] = t0[0]; p0[4 * g_ + 1] = t0[1]; p0[4 * g_ + 2] = t0[2]; p0[4 * g_ + 3] = t0[3]; p1[4 * g_] = t1[0]; p1[4 * g_ + 1] = t1[1]; p1[4 * g_ + 2] = t1[2]; p1[4 * g_ + 3] = t1[3]; }
    } else { p0 = f32x16{}; p1 = f32x16{}; }
    const char* kb[4];
#pragma unroll
    for (int dd = 0; dd < 4; ++dd) kb[dd] = K_lds + KB * SHM_K + KSWZ(r32, (dd * 16 + hi * 8) * 2);
#pragma unroll
    for (int d0 = 0; d0 < 8; ++d0) { const char* a = kb[d0 & 3] + (d0 >> 2) * 128;
        bf16x8 b0 = *reinterpret_cast<const bf16x8*>(a);
        bf16x8 b1 = *reinterpret_cast<const bf16x8*>(a + 32 * 256);
        p0 = __builtin_amdgcn_mfma_f32_32x32x16_bf16(b0, qr[d0], p0, 0, 0, 0);
        p1 = __builtin_amdgcn_mfma_f32_32x32x16_bf16(b1, qr[d0], p1, 0, 0, 0); }
}
template <int VB, bool SK>
__device__ __forceinline__ void pv_tile(f32x16* o, int vb0, bf16x8 pa0, bf16x8 pa1, bf16x8 pa2, bf16x8 pa3, bool act) {
    if (SK && !act) return;
#define TRRD(dst, off) asm volatile("ds_read_b64_tr_b16 %0, %1 offset:%2" : "=&v"(dst) : "v"(vb0), "i"(off) : "memory")
#define PV_D0(d0) do { s16x4 l0, l1, l2, l3, h0, h1, h2, h3; constexpr int b_ = VB * SHM_V + v_rd_off(d0, 0, 0);     \
        TRRD(l0, b_); TRRD(h0, b_ + 2048); TRRD(l1, b_ + 4096); TRRD(h1, b_ + 6144); TRRD(l2, b_ + 8192); TRRD(h2, b_ + 10240); TRRD(l3, b_ + 12288); TRRD(h3, b_ + 14336); \
        asm volatile("s_waitcnt lgkmcnt(0)" ::: "memory"); SBAR();                 \
        o[d0] = __builtin_amdgcn_mfma_f32_32x32x16_bf16(pa0, (bf16x8){l0[0], l0[1], l0[2], l0[3], h0[0], h0[1], h0[2], h0[3]}, o[d0], 0, 0, 0);   \
        o[d0] = __builtin_amdgcn_mfma_f32_32x32x16_bf16(pa1, (bf16x8){l1[0], l1[1], l1[2], l1[3], h1[0], h1[1], h1[2], h1[3]}, o[d0], 0, 0, 0);   \
        o[d0] = __builtin_amdgcn_mfma_f32_32x32x16_bf16(pa2, (bf16x8){l2[0], l2[1], l2[2], l2[3], h2[0], h2[1], h2[2], h2[3]}, o[d0], 0, 0, 0);   \
        o[d0] = __builtin_amdgcn_mfma_f32_32x32x16_bf16(pa3, (bf16x8){l3[0], l3[1], l3[2], l3[3], h3[0], h3[1], h3[2], h3[3]}, o[d0], 0, 0, 0); } while (0)
    PV_D0(0); PV_D0(1); PV_D0(2); PV_D0(3);
#undef PV_D0
#undef TRRD
}

template <class TIn, class TOut> struct BlockRef { const TIn* Q; const TIn* K; const TIn* V; TOut* O; int P0; };
template <class TIn> struct Seam {
    bf16x8 qr[8];
    bf16x8 st_v0, st_v1, st_k0, st_k1; f32x4 sf0, sf1, sf2, sf3;
    f32x4 tq[16];
};
__device__ __forceinline__ int swa_jlo(int P0, int W) { const int lowk = P0 - W + 1; return lowk > 0 ? lowk / KVBLK : 0; }
#define ROW(p, k0, rr) (((p) + (size_t)(k0) * KS) + (unsigned)((rr) * KS + sc))
#define VMW() asm volatile("s_waitcnt vmcnt(0)" ::: "memory")
#define VMWN(n) asm volatile("s_waitcnt vmcnt(%0)" :: "i"(n) : "memory")
#define SLOAD_H(Kp, Vp, k0) do { S.st_v0 = load8<TIn>(ROW(Vp, k0, sr)); S.st_v1 = load8<TIn>(ROW(Vp, k0, 32 + sr));              \
                         S.st_k0 = load8<TIn>(ROW(Kp, k0, sr)); S.st_k1 = load8<TIn>(ROW(Kp, k0, 32 + sr)); } while (0)
#define SWRITE_HK(bf) do { *(bf16x8*)(K_lds + (bf) * SHM_K + kws) = S.st_k0; *(bf16x8*)(K_lds + (bf) * SHM_K + kws + 32 * 256) = S.st_k1; } while (0)
#define SWRITE_HV(bf) do { *(bf16x8*)(V_lds + (bf) * SHM_V + vst0) = S.st_v0; *(bf16x8*)(V_lds + (bf) * SHM_V + vst1) = S.st_v1; } while (0)
#define SWRITE_H(bf) do { SWRITE_HV(bf); SWRITE_HK(bf); } while (0)
#define SLOAD_F(p, k0) do { S.sf0 = *(const f32x4*)ROW(p, k0, sr); S.sf1 = *(const f32x4*)(ROW(p, k0, sr) + 4);                \
                            S.sf2 = *(const f32x4*)ROW(p, k0, 32 + sr); S.sf3 = *(const f32x4*)(ROW(p, k0, 32 + sr) + 4); } while (0)
#define SWRITE_KF(bf) do { *(bf16x8*)(K_lds + (bf) * SHM_K + kws) = pack8(S.sf0, S.sf1); *(bf16x8*)(K_lds + (bf) * SHM_K + kws + 32 * 256) = pack8(S.sf2, S.sf3); } while (0)
#define SWRITE_VF(bf) do { *(bf16x8*)(V_lds + (bf) * SHM_V + vst0) = pack8(S.sf0, S.sf1); *(bf16x8*)(V_lds + (bf) * SHM_V + vst1) = pack8(S.sf2, S.sf3); } while (0)
template <class TIn, class TOut, int QS, int KS, int OS, bool BIAS>
__device__ __forceinline__ void causal_swa_prime(const BlockRef<TIn, TOut>& cur, int W, char* lds, Seam<TIn>& S) {
    constexpr bool F32 = same_t<TIn, float>::v;
    const int tid = threadIdx.x, wid = __builtin_amdgcn_readfirstlane(tid >> 6), lane = tid & 63, r32 = lane & 31, hi = lane >> 5;
    const int sr = tid >> 4, sc = (tid & 15) * 8, kws = KSWZ(sr, sc * 2); char* K_lds = lds + 2 * SHM_V;
    const int kb0 = swa_jlo(cur.P0, W) * KVBLK;
    for (int d0 = 0; d0 < 8; ++d0) S.qr[d0] = load8<TIn>(cur.Q + (size_t)(wid * QBLK + r32) * QS + d0 * 16 + hi * 8);
    if constexpr (F32) { SLOAD_F((const float*)cur.K, kb0); VMW(); SWRITE_KF(0); SBAR(); SLOAD_F((const float*)cur.V, kb0); }
    else { SLOAD_H(cur.K, cur.V, kb0); VMW(); SWRITE_HK(0); }
    __syncthreads();
}
template <class TIn, class TOut, int QS, int KS, int OS, bool BIAS, bool PREF = true>
__device__ __forceinline__ void causal_swa_block(const BlockRef<TIn, TOut>& cur, const BlockRef<TIn, TOut>& nxt, int skv, int W, char* lds, Seam<TIn>& S) {
    constexpr bool F32 = same_t<TIn, float>::v;
    const int tid = threadIdx.x, wid = __builtin_amdgcn_readfirstlane(tid >> 6), lane = tid & 63, r32 = lane & 31, hi = lane >> 5;
    const int j_lo = swa_jlo(cur.P0, W);
    int j_hi = (cur.P0 + QB - 1) / KVBLK + 1; if (j_hi > skv / KVBLK) j_hi = skv / KVBLK;
    const int NT = j_hi - j_lo;
    const int kbn = swa_jlo(nxt.P0, W) * KVBLK;
    const int qlo = cur.P0 + wid * QBLK, qm = qlo + r32 - 4 * hi;
    char* V_lds = lds; char* K_lds = lds + 2 * SHM_V;
    float* ws = (float*)(lds + 2 * SHM_V + 2 * SHM_K) + wid * 64; float* li_l = ws, * al_l = ws + 32;
    float m_reg = BIAS ? ((const float*)(lds + BIAS_OFF))[cur.P0 + wid * QBLK + r32] : -1e30f, l_reg = 0; f32x16 o[4] = {};
    const int sr = tid >> 4, sc = (tid & 15) * 8, vst0 = v_st(sr, sc), vst1 = v_st(32 + sr, sc), kws = KSWZ(sr, sc * 2);
    const int vb0 = (int)(uintptr_t)V_lds + v_rd_base(lane);
    const TIn* Kh = cur.K; const TIn* Vh = cur.V;
    const float* bias0 = (const float*)(lds + BIAS_OFF) + 4 * hi;
#define RESC(a) do { if (__any((a) < 1.f)) { if (hi == 0) al_l[r32] = (a); asm volatile("s_waitcnt lgkmcnt(0)" ::: "memory");              \
                     for (int d_ = 0; d_ < 4; ++d_) for (int r = 0; r < 16; ++r) o[d_][r] *= al_l[crow(r, hi)]; } } while (0)
#define KBASE(t) ((j_lo + (t)) * KVBLK)
#define BL(t) (bias0 + KBASE(t))
#define ACT(t) (KBASE(t) <= qlo + QBLK - 1 && KBASE(t) + KVBLK - 1 >= qlo - W + 1)
#define MASKT(P0_, P1_, t) do { const int kb_ = KBASE(t); if ((!SK || ACT(t)) && (kb_ + KVBLK - 1 > qlo || kb_ <= qlo + QBLK - 1 - W)) mask_tile(P0_, P1_, qm - kb_, (unsigned)W); } while (0)
    constexpr int NQL = F32 ? 16 : 8;
    constexpr bool SK = WSKIP && !F32;
#define SEAM_K0() do { VMWN(NQL); if constexpr (F32) { SWRITE_KF(0); SBAR(); SLOAD_F((const float*)nxt.V, kbn); } else { SWRITE_HK(0); } SBAR(); } while (0)
    f32x16 pA0, pA1, pB0, pB1; float mnA, mnB, alA, alB; bf16x8 pa0, pa1, pa2, pa3;
    if constexpr (F32) { VMW(); SWRITE_VF(0); SBAR(); } else { SWRITE_HV(0); SBAR(); }
    if (NT > 1) { if constexpr (F32) SLOAD_F((const float*)Kh, KBASE(1)); else SLOAD_H(Kh, Vh, KBASE(1)); }
    SBAR(); qkt<0, SK, BIAS>(pA0, pA1, K_lds, r32, hi, S.qr, ACT(0), BL(0));
    if constexpr (F32) { if (NT > 1) { VMW(); SWRITE_KF(1); SBAR(); SLOAD_F((const float*)Vh, KBASE(1)); } }
    MASKT(pA0, pA1, 0); partialSM(pA0, pA1, m_reg, mnA, alA);
    if (NT > 1) { VMW(); if constexpr (F32) { SWRITE_VF(1); SBAR(); if (NT > 2) SLOAD_F((const float*)Kh, KBASE(2)); } else SWRITE_H(1); }
    __syncthreads();
#define HALF_STEP(PX0, PX1, mnX, alX, PY0, PY1, alY, t, KB, VB, SB) do {                                                      \
        SBAR(); qkt<KB, SK, BIAS>(PX0, PX1, K_lds, r32, hi, S.qr, ACT(t), BL(t));                                             \
        finishSM(PY0, PY1, alY, l_reg, pa0, pa1, pa2, pa3); SBAR();                                                           \
        if ((t) + 1 < NT) { if constexpr (F32) { VMW(); SWRITE_KF(SB); SBAR(); SLOAD_F((const float*)Vh, KBASE((t) + 1)); }  \
                            else { SLOAD_H(Kh, Vh, KBASE((t) + 1)); } SBAR(); }                                               \
        pv_tile<VB, SK>(o, vb0, pa0, pa1, pa2, pa3, ACT((t) - 1)); MASKT(PX0, PX1, (t)); partialSM(PX0, PX1, m_reg, mnX, alX);                                        \
        __syncthreads();                                                                                                      \
        if ((t) + 1 < NT) { VMW(); if constexpr (F32) { SWRITE_VF(SB); SBAR(); if ((t) + 2 < NT) SLOAD_F((const float*)Kh, KBASE((t) + 2)); } \
                            else { SWRITE_H(SB); } }                                                                          \
        RESC(alX); __syncthreads(); } while (0)
    for (int t = 1; t + 1 < NT; t += 2) {
        HALF_STEP(pB0, pB1, mnB, alB, pA0, pA1, alA, t, 1, 0, 0);
        HALF_STEP(pA0, pA1, mnA, alA, pB0, pB1, alB, t + 1, 0, 1, 1);
    }
    const bool even = (NT & 1) == 0;
    if (even) { SBAR(); qkt<1, SK, BIAS>(pB0, pB1, K_lds, r32, hi, S.qr, ACT(NT - 1), BL(NT - 1)); SBAR(); }
#define QROW(e) (nxt.Q + (size_t)(wid * QBLK + r32) * QS + ((e) >> 1) * 16 + hi * 8 + ((e) & 1) * 4)
    if constexpr (F32) { SLOAD_F((const float*)nxt.K, kbn); SBAR();
#pragma unroll
        for (int e = 0; e < 8; ++e) S.tq[e] = *(const f32x4*)QROW(e); }
    else if constexpr (PREF) { SLOAD_H(nxt.K, nxt.V, kbn); SBAR();
#pragma unroll
        for (int d0 = 0; d0 < 8; ++d0) S.qr[d0] = load8<TIn>(nxt.Q + (size_t)(wid * QBLK + r32) * QS + d0 * 16 + hi * 8); }
    SBAR();
    finishSM(pA0, pA1, alA, l_reg, pa0, pa1, pa2, pa3); SBAR();
    if constexpr (F32) {
#pragma unroll
        for (int e = 8; e < 16; ++e) S.tq[e] = *(const f32x4*)QROW(e); SBAR(); }
#undef QROW
    pv_tile<0, SK>(o, vb0, pa0, pa1, pa2, pa3, ACT(even ? NT - 2 : NT - 1));
    if (even) { MASKT(pB0, pB1, NT - 1); partialSM(pB0, pB1, m_reg, mnB, alB); __syncthreads(); RESC(alB);
        finishSM(pB0, pB1, alB, l_reg, pa0, pa1, pa2, pa3); SBAR(); pv_tile<1, SK>(o, vb0, pa0, pa1, pa2, pa3, ACT(NT - 1)); }
    SBAR(); if constexpr (PREF) SEAM_K0();
    if (hi == 0) li_l[r32] = l_reg; asm volatile("s_waitcnt lgkmcnt(0)" ::: "memory");
    float rli[16];
#pragma unroll
    for (int r = 0; r < 16; ++r) rli[r] = __builtin_amdgcn_rcpf(li_l[crow(r, hi)]);
    TOut* Ow = cur.O + (size_t)(wid * QBLK) * OS;
#pragma unroll
    for (int r = 0; r < 16; ++r) { const int orow = crow(r, hi);
#pragma unroll
        for (int d0 = 0; d0 < 4; ++d0) { const float v = o[d0][r] * rli[r];
            if constexpr (same_t<TOut, float>::v) { Ow[(size_t)orow * OS + d0 * 32 + r32] = v; }
            else { const float vn = __shfl_xor(v, 1);
                   if ((r32 & 1) == 0) *(unsigned*)(Ow + (size_t)orow * OS + d0 * 32 + r32) = cvtpk(v, vn); } } }
    if constexpr (F32) {
#pragma unroll
        for (int d0 = 0; d0 < 8; ++d0) S.qr[d0] = pack8(S.tq[2 * d0], S.tq[2 * d0 + 1]); }
    __syncthreads();
#undef RESC
#undef KBASE
#undef BL
#undef ACT
#undef MASKT
#undef SEAM_K0
#undef HALF_STEP
}
#undef ROW
#undef VMW
#undef VMWN
#undef SLOAD_H
#undef SWRITE_HK
#undef SWRITE_HV
#undef SWRITE_H
#undef SLOAD_F
#undef SWRITE_KF
#undef SWRITE_VF

#undef KSWZ
#undef SBAR
}
__device__ __forceinline__ void sg_phase(const Frame& F, const KArgs& a, const int u_first, const int u_count) {
    unsigned char* ws = F.ws; const int tid = F.tid, lane = F.lane, w = F.wave, tl = lane & 15, kq = lane >> 4;
    LAS f32x2* st = (LAS f32x2*)F.lds;
    LAS unsigned short* vt = (LAS unsigned short*)(F.lds + 1024);
    const bf16* ZU = (const bf16*)(ws + WS_ZU); const bf16* ZV = (const bf16*)(ws + WS_ZV); const float* ZST = (const float*)(ws + WS_ZST); bf16* AS = (bf16*)(ws + WS_AS);
    const float* ln_g = a.in[5]; const float* ln_b = a.in[6]; const float* w_sp = a.in[7]; const float* b_sp = a.in[8];
    for (int uu = 0; uu < u_count; ++uu) { const int u = u_first + uu;
        const int chunk = u >> 3, g = u & 7, t0 = chunk * SGC;
        if (tid < 128) { const f32x4* p = (const f32x4*)(ZST + (size_t)(t0 + tid) * 32); float S = 0.f, Q = 0.f;
#pragma unroll
            for (int i = 0; i < 8; ++i) { const f32x4 v = p[i]; S += v[0] + v[2]; Q += v[1] + v[3]; }
            const float mu = S * (1.f / SGW), var = fmaxf(Q * (1.f / SGW) - mu * mu, 0.f); st[tid] = (f32x2){mu, rsqrtf(var + LN_EPS)}; }
        __syncthreads();
        { const int s = tid >> 2, c0 = (tid & 3) * 32; const f32x2 ms = st[s]; const bf16* src = ZV + (size_t)(t0 + s) * SGW + g * 128 + c0;
#pragma unroll
            for (int q = 0; q < 4; ++q) { const u32x4 raw = ((const u32x4*)src)[q]; const unsigned rw[4] = {raw.x, raw.y, raw.z, raw.w};
                const f32x4 g0 = *(const f32x4*)(ln_g + g * 128 + c0 + 8 * q), g1 = *(const f32x4*)(ln_g + g * 128 + c0 + 8 * q + 4), b0 = *(const f32x4*)(ln_b + g * 128 + c0 + 8 * q), b1 = *(const f32x4*)(ln_b + g * 128 + c0 + 8 * q + 4);
#pragma unroll
                for (int i = 0; i < 8; ++i) { const unsigned wd = rw[i >> 1]; const float v = __builtin_bit_cast(float, (i & 1) ? (wd & 0xffff0000u) : (wd << 16));
                    const float gg = (i < 4) ? g0[i & 3] : g1[i & 3], bb = (i < 4) ? b0[i & 3] : b1[i & 3];
                    vt[(c0 + 8 * q + i) * 136 + s] = (unsigned short)f2bf((v - ms[0]) * ms[1] * gg + bb); } } }
        __syncthreads();
        f32x4 acc[8];
#pragma unroll
        for (int j = 0; j < 8; ++j) acc[j] = (f32x4){0.f, 0.f, 0.f, 0.f};
        const int t = 16 * w + tl;
        f32x4 wraw[4][2];
#pragma unroll
        for (int ks = 0; ks < 4; ++ks) { const float* wp = w_sp + ((size_t)(g * 128 + t) * 128 + 32 * ks + 8 * kq); if (ks <= (w >> 1)) { wraw[ks][0] = *(const f32x4*)wp; wraw[ks][1] = *(const f32x4*)(wp + 4); } else { wraw[ks][0] = (f32x4){0.f, 0.f, 0.f, 0.f}; wraw[ks][1] = wraw[ks][0]; } }
        u32x2 uraw[8];
#pragma unroll
        for (int j = 0; j < 8; ++j) uraw[j] = *(const u32x2*)(ZU + (size_t)(t0 + t) * SGW + g * 128 + 16 * j + 4 * kq);
        const float bs = b_sp[g * 128 + t];
#pragma unroll
        for (int ks = 0; ks < 4; ++ks) { if (ks > (w >> 1)) continue;
            const f32x4 w0 = wraw[ks][0], w1 = wraw[ks][1];
            float wv[8] = {w0[0], w0[1], w0[2], w0[3], w1[0], w1[1], w1[2], w1[3]};
#pragma unroll
            for (int i = 0; i < 8; ++i) if (32 * ks + 8 * kq + i > t) wv[i] = 0.f;
            u32x4 pk; pk.x = cvt_pk_bf16(wv[0], wv[1]); pk.y = cvt_pk_bf16(wv[2], wv[3]); pk.z = cvt_pk_bf16(wv[4], wv[5]); pk.w = cvt_pk_bf16(wv[6], wv[7]);
            const bf16x8 wf = __builtin_bit_cast(bf16x8, pk);
#pragma unroll
            for (int j = 0; j < 8; ++j) { const bf16x8 vf = *(const LAS bf16x8*)(vt + (16 * j + tl) * 136 + 32 * ks + 8 * kq);
                acc[j] = __builtin_amdgcn_mfma_f32_16x16x32_bf16(vf, wf, acc[j], 0, 0, 0); }
        }
#pragma unroll
        for (int j = 0; j < 8; ++j) { const int ch = 16 * j + 4 * kq; const u32x2 uu = uraw[j];
            const float o0 = __builtin_bit_cast(float, uu.x << 16) * (acc[j][0] + bs), o1 = __builtin_bit_cast(float, uu.x & 0xffff0000u) * (acc[j][1] + bs);
            const float o2 = __builtin_bit_cast(float, uu.y << 16) * (acc[j][2] + bs), o3 = __builtin_bit_cast(float, uu.y & 0xffff0000u) * (acc[j][3] + bs);
            u32x2 o; o.x = cvt_pk_bf16(o0, o1); o.y = cvt_pk_bf16(o2, o3); *(u32x2*)(AS + (size_t)(t0 + t) * DM + FW + g * 128 + ch) = o; }
        __syncthreads();
    }
}
__device__ __forceinline__ void fox_phase(const Frame& F, char* lds, int& sg_first, int& sg_count) {
    sg_first = blockIdx.x * 4; sg_count = 4;
    typedef unsigned short T;
    unsigned char* ws = F.ws; const int G = F.G, c = blockIdx.x, vcu = (G % 8 == 0) ? (c % 8) * (G / 8) + c / 8 : c;
    const T* Qb = (const T*)(ws + WS_Q); const T* Kb = (const T*)(ws + WS_K); const T* Vb = (const T*)(ws + WS_V); T* Ob = (T*)(ws + WS_AS); const float* CB = (const float*)(ws + WS_CB);
    if (vcu < NB * FH * 8) {
        const int L = vcu; const int bh = L >> 3, x = L & 7, b = bh / FH, h = bh % FH;
        __syncthreads();
        { const f32x4* src = (const f32x4*)(CB + (size_t)bh * SEQ); f32x4* dst = (f32x4*)(lds + att::BIAS_OFF); dst[F.tid] = src[F.tid]; dst[F.tid + 512] = src[F.tid + 512]; }
        __syncthreads();
        int Wwin = SEQ;
        { const unsigned* NRM = F.ctl + CW_NRM; float q2 = 0.f, k2 = 0.f;
#pragma unroll
            for (int i = 0; i < 4; ++i) { q2 += __uint_as_float(__hip_atomic_load(NRM + ((0 * 4 + b) * 8 + h) * 4 + i, __ATOMIC_RELAXED, __HIP_MEMORY_SCOPE_AGENT)); k2 += __uint_as_float(__hip_atomic_load(NRM + ((1 * 4 + b) * 8 + h) * 4 + i, __ATOMIC_RELAXED, __HIP_MEMORY_SCOPE_AGENT)); }
            const float Bnd = sqrtf(q2 * k2) * 0.08838834764831845f * 1.02f;
            const float need = -(2.f * Bnd + 18.f) * 11.313708498984761f;
            const float* bl = (const float*)(lds + att::BIAS_OFF); float* red = (float*)(lds + att::BIAS_OFF + SEQ * 4);
            int lo = 1, hi = SEQ / 64;
            while (lo < hi) { const int mid = (lo + hi) >> 1, Wc = mid * 64; float mx = -3.0e38f;
                for (int t = Wc + F.tid; t < SEQ; t += NTHREADS) mx = fmaxf(mx, bl[t - Wc] - bl[t]);
#pragma unroll
                for (int o = 1; o < 64; o <<= 1) mx = fmaxf(mx, __shfl_xor(mx, o));
                __syncthreads(); if (F.lane == 0) red[F.wave] = mx; __syncthreads();
                float m8 = red[0];
#pragma unroll
                for (int i = 1; i < 8; ++i) m8 = fmaxf(m8, red[i]);
                if (m8 <= need) hi = mid; else lo = mid + 1; }
            Wwin = __builtin_amdgcn_readfirstlane(lo * 64); __syncthreads(); }
        att::BlockRef<T, T> cur, nxt;
        cur.K = Kb + (size_t)b * SEQ * FW + h * FD; cur.V = Vb + (size_t)b * SEQ * FW + h * FD; nxt = cur;
        cur.Q = Qb + ((size_t)b * SEQ + x * 256) * FW + h * FD; cur.O = Ob + ((size_t)b * SEQ + x * 256) * DM + h * FD; cur.P0 = x * 256;
        nxt.Q = Qb + ((size_t)b * SEQ + (15 - x) * 256) * FW + h * FD; nxt.O = Ob + ((size_t)b * SEQ + (15 - x) * 256) * DM + h * FD; nxt.P0 = (15 - x) * 256;
        att::Seam<T> S;
        att::causal_swa_prime<T, T, FW, FW, DM, true>(cur, Wwin, lds, S);
        att::causal_swa_block<T, T, FW, FW, DM, true>(cur, nxt, SEQ, Wwin, lds, S);
        att::causal_swa_block<T, T, FW, FW, DM, true, false>(nxt, nxt, SEQ, Wwin, lds, S);
        { const int wt = Wwin / 64 + 4; int load[8], cnt[8];
#pragma unroll
          for (int i = 0; i < 8; ++i) { const int f0 = 4 * (i + 1), f1 = 4 * (16 - i); load[i] = (f0 < wt ? f0 : wt) + (f1 < wt ? f1 : wt); cnt[i] = 0; }
          for (int k = 0; k < 32; ++k) { int bi = 0, bv = load[0];
#pragma unroll
              for (int i = 1; i < 8; ++i) if (load[i] < bv) { bv = load[i]; bi = i; }
#pragma unroll
              for (int i = 0; i < 8; ++i) if (i == bi) { load[i] += 4; cnt[i] += 1; } }
          int first = 0, mine = 0;
#pragma unroll
          for (int i = 0; i < 8; ++i) { if (i < x) first += cnt[i]; if (i == x) mine = cnt[i]; }
          sg_first = bh * 32 + first; sg_count = mine; }
    }
}
__device__ __forceinline__ void xattn_phase(const Frame& F, char* lds, unsigned* bar) {
    typedef unsigned short T;
    unsigned char* ws = F.ws; unsigned* FLG = F.ctl + CW_FLG;
    const T* Qb = (const T*)(ws + WS_QX); const T* Kb = (const T*)(ws + WS_KX); const T* Vb = (const T*)(ws + WS_VX); T* Ob = (T*)(ws + WS_OX);
    for (int L = blockIdx.x; L < NB * XH * 16; L += 144) {
        const int b = L >> 6, h = (L >> 4) & 3, qb = L & 15;
        __syncthreads();
        if (F.tid == 0) {
            unsigned* fq_ = FLG + ((b * 16 + qb) * 2 + (h >> 1)) * 32; unsigned* fk_ = FLG + (128 + 4 * b + (h >> 1)) * 32; unsigned* fv_ = FLG + (130 + 4 * b + (h >> 1)) * 32;
            XB_SPIN(xb_ld(fq_) == 0u, bar); XB_SPIN(xb_ld(fk_) == 0u, bar); XB_SPIN(xb_ld(fv_) == 0u, bar);
            __builtin_amdgcn_fence(__ATOMIC_ACQUIRE, "agent");
            asm volatile("s_waitcnt vmcnt(0)" ::: "memory");
        }
        __syncthreads();
        att::BlockRef<T, T> cur;
        cur.K = Kb + (size_t)b * MEML * XW + h * XD; cur.V = Vb + (size_t)b * MEML * XW + h * XD;
        cur.Q = Qb + ((size_t)b * SEQ + qb * 256) * XW + h * XD; cur.O = Ob + ((size_t)b * SEQ + qb * 256) * XW + h * XD; cur.P0 = MEML;
        att::Seam<T> S;
        att::causal_swa_prime<T, T, XW, XW, XW, false>(cur, 1 << 20, lds, S);
        att::causal_swa_block<T, T, XW, XW, XW, false, false>(cur, cur, MEML, 1 << 20, lds, S);
    }
}
__device__ __forceinline__ void moe_tables(const Frame& F) {
    LAS int* tab = (LAS int*)(F.lds + LDS_TAB);
    __syncthreads();
    if (F.tid == 0) { const unsigned* CNT = F.ctl + CW_CNT; int p = 0;
        for (int e = 0; e < NE; ++e) { const int c = (int)__hip_atomic_load(CNT + e, __ATOMIC_RELAXED, __HIP_MEMORY_SCOPE_AGENT); tab[e] = p; tab[40 + e] = c; p += (c + 255) >> 8; }
        tab[32] = p; }
    __syncthreads();
}
typedef float f32x16 __attribute__((ext_vector_type(16)));
__device__ __forceinline__ void p8_router(const Frame& F, const KArgs& a) {
    unsigned char* ws = F.ws; const int tid = F.tid, lane = F.lane, wave = F.wave, tl = lane & 31, hi = lane >> 5, grp = wave >> 2, kq = wave & 3;
    const float* X2 = (const float*)(ws + WS_X2); const float* WRT = (const float*)(ws + WS_WRT);
    constexpr int PITCH = 132;
    LAS float* xs = (LAS float*)F.lds;
    LAS float* wsm = xs + 2 * 64 * PITCH;
    LAS float* red = wsm + 2 * 32 * PITCH;
    LAS unsigned* lcnt = (LAS unsigned*)(F.lds + LDS_TAB + 512);
    for (int tp = blockIdx.x; tp < NTOK / 64; tp += F.G) {
        const int tok0 = tp * 64;
        f32x4 xa[4], wa[2], xb[4], wb[2];
#define P8_LOAD(X, W, c) do { _Pragma("unroll") for (int i = 0; i < 4; ++i) { const int p = tid + 512 * i; X[i] = *(const f32x4*)(X2 + (size_t)(tok0 + (p >> 5)) * DM + (c) * 128 + (p & 31) * 4); } \
        _Pragma("unroll") for (int i = 0; i < 2; ++i) { const int p = tid + 512 * i; W[i] = *(const f32x4*)(WRT + (size_t)(p >> 5) * DM + (c) * 128 + (p & 31) * 4); } } while (0)
#define P8_WRITE(X, W, b) do { _Pragma("unroll") for (int i = 0; i < 4; ++i) { const int p = tid + 512 * i; *(LAS f32x4*)(xs + ((b) * 64 + (p >> 5)) * PITCH + (p & 31) * 4) = X[i]; } \
        _Pragma("unroll") for (int i = 0; i < 2; ++i) { const int p = tid + 512 * i; *(LAS f32x4*)(wsm + ((b) * 32 + (p >> 5)) * PITCH + (p & 31) * 4) = W[i]; } } while (0)
#define P8_COMPUTE(b) do { const LAS float* xp = xs + ((b) * 64 + grp * 32 + tl) * PITCH + kq * 32 + 4 * hi; const LAS float* wp = wsm + ((b) * 32 + tl) * PITCH + kq * 32 + 4 * hi; \
        _Pragma("unroll") for (int s4 = 0; s4 < 4; ++s4) { const f32x4 xv = *(const LAS f32x4*)(xp + 8 * s4), wv = *(const LAS f32x4*)(wp + 8 * s4); \
            ss += (xv[0] * xv[0] + xv[1] * xv[1]) + (xv[2] * xv[2] + xv[3] * xv[3]); \
            _Pragma("unroll") for (int i = 0; i < 4; ++i) d = __builtin_amdgcn_mfma_f32_32x32x2f32(wv[i], xv[i], d, 0, 0, 0); } } while (0)
        __syncthreads();
        P8_LOAD(xa, wa, 0); P8_WRITE(xa, wa, 0); P8_LOAD(xa, wa, 1);
        f32x16 d = {}; float ss = 0.f;
        for (int c = 0; c < 16; c += 2) {
            if (c + 2 < 16) P8_LOAD(xb, wb, c + 2);
            asm volatile("s_waitcnt lgkmcnt(0)\n\ts_barrier" ::: "memory");
            P8_COMPUTE(0);
            P8_WRITE(xa, wa, 1);
            if (c + 3 < 16) P8_LOAD(xa, wa, c + 3);
            asm volatile("s_waitcnt lgkmcnt(0)\n\ts_barrier" ::: "memory");
            P8_COMPUTE(1);
            if (c + 2 < 16) P8_WRITE(xb, wb, 0);
        }
#undef P8_COMPUTE
#undef P8_LOAD
#undef P8_WRITE
        const int tok = tok0 + grp * 32 + tl;
        if (kq != 0) { LAS float* r = red + ((grp * 3 + (kq - 1)) * 17) * 64 + lane;
#pragma unroll
            for (int i = 0; i < 16; ++i) r[i * 64] = d[i];
            r[16 * 64] = ss; }
        __syncthreads();
        float wgt[4] = {0.f, 0.f, 0.f, 0.f}; int fe[4] = {0, 0, 0, 0}; unsigned lr[4] = {0u, 0u, 0u, 0u}; float rstd_t = 0.f;
        if (kq == 0) {
#pragma unroll
            for (int w = 0; w < 3; ++w) { const LAS float* r = red + ((grp * 3 + w) * 17) * 64 + lane;
#pragma unroll
                for (int i = 0; i < 16; ++i) d[i] += r[i * 64];
                ss += r[16 * 64]; }
            ss += __shfl_xor(ss, 32);
            const float rstd = rsqrtf(ss * (1.f / DM) + RMS_EPS);
            float l[16];
#pragma unroll
            for (int r = 0; r < 16; ++r) { const int e = (r & 3) + 8 * (r >> 2) + 4 * hi; l[r] = d[r] * rstd + a.in[19][e]; }
            float tv[8]; int ti[8];
#pragma unroll
            for (int k = 0; k < 4; ++k) { float bv = -INFINITY; int bi = 0;
#pragma unroll
                for (int r = 0; r < 16; ++r) { const int e = (r & 3) + 8 * (r >> 2) + 4 * hi; if (l[r] > bv || (l[r] == bv && e < bi)) { bv = l[r]; bi = e; } }
                tv[k] = bv; ti[k] = bi;
#pragma unroll
                for (int r = 0; r < 16; ++r) { const int e = (r & 3) + 8 * (r >> 2) + 4 * hi; if (e == bi) l[r] = -INFINITY; } }
#pragma unroll
            for (int k = 0; k < 4; ++k) { tv[4 + k] = __shfl_xor(tv[k], 32); ti[4 + k] = __shfl_xor(ti[k], 32); }
            float fv[4]; int fi[4];
#pragma unroll
            for (int k = 0; k < 4; ++k) { float bv = -INFINITY; int bi = 1 << 30;
#pragma unroll
                for (int j = 0; j < 8; ++j) if (tv[j] > bv || (tv[j] == bv && ti[j] < bi)) { bv = tv[j]; bi = ti[j]; }
                fv[k] = bv; fi[k] = bi;
#pragma unroll
                for (int j = 0; j < 8; ++j) if (ti[j] == bi) tv[j] = -INFINITY; }
            if (hi == 0) {
                float w[4], sm = 0.f;
#pragma unroll
                for (int k = 0; k < 4; ++k) { w[k] = __expf(fv[k] - fv[0]); sm += w[k]; }
                const float inv = 1.f / sm; rstd_t = rstd;
#pragma unroll
                for (int k = 0; k < 4; ++k) { fe[k] = fi[k]; wgt[k] = w[k] * inv; lr[k] = __hip_atomic_fetch_add(lcnt + fi[k], 1u, __ATOMIC_RELAXED, __HIP_MEMORY_SCOPE_WORKGROUP); }
            }
        }
        __syncthreads();
        if (tid < 32) { const unsigned cN = lcnt[tid]; lcnt[32 + tid] = cN ? atomicAdd(F.ctl + CW_CNT + tid, cN) : 0u; lcnt[tid] = 0u; }
        __syncthreads();
        if (kq == 0 && hi == 0) {
            ((float*)(ws + WS_RS2))[tok] = rstd_t;
#pragma unroll
            for (int k = 0; k < 4; ++k) { const int e = fe[k]; const float wk = wgt[k]; const unsigned rk = lcnt[32 + e] + lr[k];
                ((int*)(ws + WS_TOPE))[tok * 4 + k] = e; ((int*)(ws + WS_TOPR))[tok * 4 + k] = (int)rk; ((float*)(ws + WS_TOPW))[tok * 4 + k] = wk;
                ((int*)(ws + WS_TOKL))[(size_t)e * NTOK + rk] = tok; ((float*)(ws + WS_GWL))[(size_t)e * NTOK + rk] = wk; ((float*)(ws + WS_RSL))[(size_t)e * NTOK + rk] = rstd_t; }
        }
    }
}
__device__ __forceinline__ void p12_final(const Frame& F, const KArgs& a) {
    unsigned char* ws = F.ws; const int lane = F.lane; const LAS int* tab = (const LAS int*)(F.lds + LDS_TAB);
    const float* X2 = (const float*)(ws + WS_X2); const unsigned char* YB = ws + WS_YB; const int* TOPE = (const int*)(ws + WS_TOPE); const int* TOPR = (const int*)(ws + WS_TOPR);
    for (int row = F.gw; row < NTOK; row += F.NGW) {
        size_t so[4];
#pragma unroll
        for (int k = 0; k < 4; ++k) { const int e = TOPE[row * 4 + k], r = TOPR[row * 4 + k]; so[k] = (size_t)(tab[e] * 256 + r) * DM; }
        f32x4 v[8]; float q = 0.f;
#pragma unroll
        for (int j = 0; j < 8; ++j) { const int c = 4 * (lane + 64 * j); v[j] = *(const f32x4*)(X2 + (size_t)row * DM + c);
#pragma unroll
            for (int k = 0; k < 4; ++k) { const int y = *(const int*)(YB + so[k] + c);
                v[j][0] += __builtin_amdgcn_cvt_f32_fp8(y, 0); v[j][1] += __builtin_amdgcn_cvt_f32_fp8(y, 1); v[j][2] += __builtin_amdgcn_cvt_f32_fp8(y, 2); v[j][3] += __builtin_amdgcn_cvt_f32_fp8(y, 3); }
            q += (v[j][0] * v[j][0] + v[j][1] * v[j][1]) + (v[j][2] * v[j][2] + v[j][3] * v[j][3]); }
        const float rs = rsqrtf(wave_sum(q) * (1.f / DM) + RMS_EPS);
#pragma unroll
        for (int j = 0; j < 8; ++j) { const int c = 4 * (lane + 64 * j); const f32x4 g = *(const f32x4*)(a.in[24] + c); *(f32x4*)(a.out + (size_t)row * DM + c) = v[j] * rs * g; }
    }
}
__global__ void __launch_bounds__(NTHREADS, 2) mega_fwd(KArgs args) {
    extern __shared__ __attribute__((aligned(16))) unsigned char lds_raw[];
    Frame F;
    F.lds = (LAS unsigned char*)lds_raw; F.MISC = (volatile LAS unsigned*)(F.lds + LDS_MISC);
    F.tid = threadIdx.x; F.lane = F.tid & 63; F.wave = __builtin_amdgcn_readfirstlane(F.tid >> 6);
    F.G = gridDim.x; F.gw = blockIdx.x * NWAVES + F.wave; F.NGW = F.G * NWAVES;
    F.ws = args.ws; F.ctl = (unsigned*)(args.ws + WS_CTL);
    unsigned char* ws = args.ws;
    for (int u = F.tid; u < (LDS_BYTES - LDS_MISC) / 4; u += NTHREADS) ((LAS unsigned*)(F.lds + LDS_MISC))[u] = 0u;
    __syncthreads();
    XcdBarrier bar = xcd_barrier_post(F.ctl + CW_BAR + args.li * XCD_BAR_WORDS, F.MISC + 8);
    const int lo = args.ph_lo, hi = args.ph_hi;
#define IN(k) (lo <= (k) && (k) < hi)
#define BOTH(k) (IN(k) && IN((k) + 1))
    if (IN(0)) { p0_prologue<0>(F, args, F.gw, F.NGW); if (BOTH(0)) xcd_barrier(bar); }
    if (IN(1)) {
        if (blockIdx.x < NB * FH && F.wave == 0) cumsum_wave((const float*)(ws + WS_LOGF), (float*)(ws + WS_CB), blockIdx.x, F.lane);
        const int bx = blockIdx.x, oct = bx >> 3, conv = (oct & 7) < pg8::P1_CO ? 1 : 0;
        const int idx = (conv ? ((oct >> 3) * pg8::P1_CO + (oct & 7)) : ((oct >> 3) * (8 - pg8::P1_CO) + (oct & 7) - pg8::P1_CO)) * 8 + (bx & 7);
        if (conv) cvt8_phase(F, args, idx, pg8::P1_NC, 0, CVT8_P1_SUPER);
        {
            pg8::ProjSched S; S.T.init(NTOK / 256, pg8::P1_NBF, pg8::P1_NG, idx); S.A = (const char*)(ws + WS_H0); S.B = (const char*)(ws + WS_WP); S.lda = DM * 2; S.ldb = DM * 2; S.conv = conv; S.idx = idx;
            pg8::EpiProj E{ws, 0, -1.4426950408889634f};
            pg8::gemm_phase<false, false>(F.lds, DM / 64, DM * 2, DM * 2, S, E); }
        {
            constexpr int OFS = (pg8::P1_NG - ((NTOK / 256) * pg8::P1_NBF) % pg8::P1_NG) % pg8::P1_NG;
            pg8::ProjSched S; S.T.init(NTOK / 256, pg8::P1_NF8, pg8::P1_NG, (idx + OFS) % pg8::P1_NG); S.A = (const char*)(ws + WS_H0Q); S.B = (const char*)(ws + WS_WPG); S.lda = DM; S.ldb = DM; S.conv = conv; S.idx = (idx + OFS) % pg8::P1_NG;
            pg8::EpiProj E{ws, pg8::P1_NBF, -1.4426950408889634f * W8_INV};
            pg8::gemm_phase<false, true>(F.lds, DM / 128, DM, DM, S, E); }
        if (BOTH(1)) xcd_barrier(bar);
    }
    if (IN(2)) { int sg_first, sg_count; fox_phase(F, (char*)lds_raw, sg_first, sg_count); sg_phase(F, args, sg_first, sg_count); if (BOTH(2)) xcd_barrier(bar); }
    if (IN(3)) {
        pg8::MergeSched S; S.T.init(NTOK / 256, DM / 256, F.G, (int)blockIdx.x); S.A = (const char*)(ws + WS_AS); S.B = (const char*)(ws + WS_WAB); S.lda = DM * 2; S.ldb = DM * 2;
        pg8::EpiMerge E{ws};
        pg8::gemm_phase<false, false>(F.lds, FW / 64, DM * 2, DM * 2, S, E);
        if (BOTH(3)) xcd_barrier(bar);
    }
    if (IN(4)) {
        pg8::PlainSched S; S.T.init(NTOK / 256, DM / 256, F.G, (int)blockIdx.x); S.A = (const char*)(ws + WS_MG); S.B = (const char*)(ws + WS_WO); S.lda = DM * 2; S.ldb = DM * 2;
        pg8::EpiResid<false, false> E{args.in[0], nullptr, (bf16*)(ws + WS_X1B), (float*)(ws + WS_SS1), nullptr};
        pg8::gemm_phase<false, false>(F.lds, DM / 64, DM * 2, DM * 2, S, E);
        if (BOTH(4)) xcd_barrier(bar);
    }
    if (IN(5)) {
        if (blockIdx.x >= 144) cvt8_phase(F, args, (int)blockIdx.x - 144, 112, CVT8_P1_SUPER, CVT8_SUPER);
        pg8::QkvSched S{(const char*)(ws + WS_X1B), (const char*)(ws + WS_WXQ), (const char*)(ws + WS_HM), (const char*)(ws + WS_WXKV), (int)blockIdx.x};
        pg8::EpiQkv E{ws};
        pg8::gemm_phase<false, false>(F.lds, DM / 64, DM * 2, DM * 2, S, E);
        if (blockIdx.x < 144) {
            asm volatile("s_waitcnt vmcnt(0)" ::: "memory"); __syncthreads();
            if (F.tid == 0) { __builtin_amdgcn_fence(__ATOMIC_RELEASE, "agent"); asm volatile("s_waitcnt vmcnt(0)" ::: "memory"); (void)xb_add(F.ctl + CW_FLG + (int)blockIdx.x * 32, 1u); }
            xattn_phase(F, (char*)lds_raw, bar.bar);
        }
        if (BOTH(5)) xcd_barrier(bar);
    }
    if (IN(7)) {
        pg8::PlainSched S; S.T.init(NTOK / 256, DM / 256, F.G, (int)blockIdx.x); S.A = (const char*)(ws + WS_OX); S.B = (const char*)(ws + WS_WXO); S.lda = XW * 2; S.ldb = XW * 2;
        pg8::EpiResid<true, true> E{(const void*)(ws + WS_X1B), (float*)(ws + WS_X2), nullptr, (float*)(ws + WS_SS2), ws + WS_X2Q};
        pg8::gemm_phase<false, false>(F.lds, XW / 64, XW * 2, XW * 2, S, E);
        if (BOTH(7)) xcd_barrier(bar);
    }
    if (IN(8)) { p8_router(F, args); if (BOTH(8)) xcd_barrier(bar); }
    if (IN(10)) {
        moe_tables(F);
        pg8::MoeSched S{(const LAS int*)(F.lds + LDS_TAB), (const char*)(ws + WS_X2Q), (const char*)(ws + WS_WGU), (const int*)(ws + WS_TOKL), F.G, (int)blockIdx.x, 16, (unsigned)DM, (size_t)(2 * DFF)};
        pg8::EpiAct E{ws, (const LAS int*)(F.lds + LDS_TAB), args.in[21]};
        pg8::gemm_phase<true, true>(F.lds, DM / 128, DM, DM, S, E);
        if (BOTH(10)) xcd_barrier(bar);
    }
    if (IN(11)) {
        moe_tables(F);
        pg8::DownSched S{{(const LAS int*)(F.lds + LDS_TAB), (const char*)(ws + WS_HB), (const char*)(ws + WS_WD), (const int*)(ws + WS_TOKL), F.G, (int)blockIdx.x, 8, (unsigned)DFF, (size_t)DM}, (unsigned)DFF};
        pg8::EpiDown E{ws, (const LAS int*)(F.lds + LDS_TAB), args.in[23]};
        pg8::gemm_phase<false, true>(F.lds, DFF / 128, DFF, DFF, S, E);
        if (BOTH(11)) xcd_barrier(bar);
    }
    if (IN(12)) { moe_tables(F); p12_final(F, args); }
#undef IN
#undef BOTH
}
#ifndef PROBE_PHASE
#define PROBE_PHASE -1
#endif
static int g_grid = 0;
static void mega_launch(hipStream_t st, void* const* d_in, void* d_out, void* d_ws, int lo, int hi, int li) {
    if (g_grid == 0) {
        int dev = 0, cus = 0;
        if (hipGetDevice(&dev) != hipSuccess || hipDeviceGetAttribute(&cus, hipDeviceAttributeMultiprocessorCount, dev) != hipSuccess || cus <= 0) cus = 256;
        if (hipFuncSetAttribute((const void*)mega_fwd, hipFuncAttributeMaxDynamicSharedMemorySize, LDS_BYTES) != hipSuccess) fprintf(stderr, "hipFuncSetAttribute failed\n");
        int per_cu = 0;
        if (hipOccupancyMaxActiveBlocksPerMultiprocessor(&per_cu, (const void*)mega_fwd, NTHREADS, LDS_BYTES) != hipSuccess || per_cu < 1) fprintf(stderr, "occupancy query: %d\n", per_cu);
        (void)hipGetLastError();
        g_grid = cus;
        if (cus != 256) fprintf(stderr, "kernel_launch: built for 256 CUs, device reports %d\n", cus);
    }
    KArgs a{};
    for (int i = 0; i < 25; ++i) a.in[i] = (const float*)d_in[i];
    a.out = (float*)d_out; a.ws = (unsigned char*)d_ws; a.ph_lo = lo; a.ph_hi = hi; a.li = li; a.pad = 0;
    hipLaunchKernelGGL(mega_fwd, dim3(g_grid), dim3(NTHREADS), LDS_BYTES, st, a);
}
extern "C" void kernel_launch(void* const* d_in, const int* in_sizes, int n_in, void* d_out, int out_size, void* d_ws, size_t ws_size, hipStream_t st) {
    if (n_in != 25 || ws_size < WS_END) { fprintf(stderr, "kernel_launch: unexpected n_in %d / ws %zu\n", n_in, ws_size); return; }
    (void)in_sizes; (void)out_size;
    char* ws = (char*)d_ws;
    (void)hipMemsetAsync(ws + WS_CTL, 0, CTL_BYTES, st);
    mega_launch(st, d_in, d_out, d_ws, 0, 13, 0);
#if PROBE_PHASE >= 0
    mega_launch(st, d_in, d_out, d_ws, PROBE_PHASE, PROBE_PHASE + 1, 1);
#endif
}
```

```cpp
#include <hip/hip_runtime.h>
#include <cstdio>
#include <cstdint>
#include <type_traits>

constexpr int DM = 2048, NB = 4, SEQ = 4096, NTOK = NB * SEQ, MEML = 256, NMEM = NB * MEML;
constexpr int FH = 8, FD = 128, FW = 1024, SGG = 8, SGD = 128, SGW = 1024, SGC = 128;
constexpr int XH = 4, XD = 128, XW = 512;
constexpr int NE = 32, TOPK = 4, DFF = 2048;
constexpr int INC = 3 * FW + FH + 2 * SGW + 2 * DM;
constexpr int C_Q = 0, C_K = 1024, C_V = 2048, C_F = 3072, C_Z = 3080, C_GA = 5128, C_GB = 7176;
constexpr float RMS_EPS = 1e-6f, LN_EPS = 1e-5f, SW_LIMIT = 7.0f, SW_ALPHA = 1.702f;
constexpr int MAXSLOT = NTOK * TOPK + NE * 256;

typedef unsigned short bf16;
__device__ __forceinline__ unsigned f2bf(float f) { unsigned u = __builtin_bit_cast(unsigned, f); return (u + 0x7fffu + ((u >> 16) & 1u)) >> 16; }
__device__ __forceinline__ float bf2f(bf16 h) { return __builtin_bit_cast(float, (unsigned)h << 16); }

constexpr size_t MiB = 1ull << 20;
constexpr size_t WS_CTL = 0;
constexpr size_t CTL_BYTES = 1 * MiB;
constexpr int CW_NRM = 12288;
constexpr int CW_FLG = 20480;
constexpr int CW_CNT = 8192;
constexpr size_t WS_H0   = 16 * MiB;
constexpr size_t WS_HM   = WS_H0 + 64 * MiB;
constexpr size_t WS_LOGF = WS_HM + 4 * MiB;
constexpr size_t WS_CB   = WS_LOGF + 1 * MiB;
constexpr size_t WS_Q    = WS_CB + 1 * MiB;
constexpr size_t WS_K    = WS_Q + 32 * MiB;
constexpr size_t WS_V    = WS_K + 32 * MiB;
constexpr size_t WS_ZU   = WS_V + 32 * MiB;
constexpr size_t WS_ZV   = WS_ZU + 32 * MiB;
constexpr size_t WS_ZST  = WS_ZV + 32 * MiB;
constexpr size_t WS_GR   = WS_ZST + 2 * MiB;
constexpr size_t WS_GS   = WS_GR + 64 * MiB;
constexpr size_t WS_AS   = WS_GS + 64 * MiB;
constexpr size_t WS_MG   = WS_AS + 64 * MiB;
constexpr size_t WS_X1   = WS_MG + 64 * MiB;
constexpr size_t WS_X1B  = WS_X1 + 128 * MiB;
constexpr size_t WS_SS1  = WS_X1B + 64 * MiB;
constexpr size_t WS_QX   = WS_SS1 + 2 * MiB;
constexpr size_t WS_KX   = WS_QX + 16 * MiB;
constexpr size_t WS_VX   = WS_KX + 1 * MiB;
constexpr size_t WS_OX   = WS_VX + 1 * MiB;
constexpr size_t WS_X2   = WS_OX + 16 * MiB;
constexpr size_t WS_X2B  = WS_X2 + 128 * MiB;
constexpr size_t WS_SS2  = WS_X2B + 64 * MiB;
constexpr size_t WS_TOPE = WS_SS2 + 2 * MiB;
constexpr size_t WS_TOPR = WS_TOPE + 1 * MiB;
constexpr size_t WS_TOPW = WS_TOPR + 1 * MiB;
constexpr size_t WS_TOKL = WS_TOPW + 1 * MiB;
constexpr size_t WS_GWL  = WS_TOKL + 2 * MiB;
constexpr size_t WS_HB   = WS_GWL + 2 * MiB;
constexpr size_t WS_YB   = WS_HB + 288 * MiB;
constexpr size_t WS_TMP  = WS_YB + 288 * MiB;
constexpr size_t WS_END_NAIVE = WS_TMP + 640 * MiB;

__device__ __forceinline__ float gelu_tanh(float x) {
    const float u = 0.7978845608028654f * (x + 0.044715f * x * x * x);
    const float e = __expf(2.f * u);
    const float t = 1.f - 2.f / (e + 1.f);
    return 0.5f * x * (1.f + t);
}
__device__ __forceinline__ float sigmoidf_(float x) { return 1.f / (1.f + __expf(-x)); }
__device__ __forceinline__ float log_sigmoid(float x) { return fminf(x, 0.f) - log1pf(__expf(-fabsf(x))); }

#ifdef REFERENCE_PIPELINE
__device__ __forceinline__ float block_sum_256(float v, float* red) {
#pragma unroll
    for (int o = 32; o > 0; o >>= 1) v += __shfl_xor(v, o);
    __syncthreads();
    if ((threadIdx.x & 63) == 0) red[threadIdx.x >> 6] = v;
    __syncthreads();
    return red[0] + red[1] + red[2] + red[3];
}
__global__ __launch_bounds__(256) void n_rms_rows(const float* X, const float* g, bf16* OUT, const float* w_in, const float* b_forget, float* LOGF) {
    __shared__ float red[4];
    const int row = blockIdx.x, t = threadIdx.x;
    const float* x = X + (size_t)row * DM;
    float v[8]; float s = 0.f;
#pragma unroll
    for (int i = 0; i < 8; ++i) { v[i] = x[t + 256 * i]; s += v[i] * v[i]; }
    const float tot = block_sum_256(s, red);
    const float rstd = rsqrtf(tot * (1.f / DM) + RMS_EPS);
    float f[8];
#pragma unroll
    for (int j = 0; j < 8; ++j) f[j] = 0.f;
#pragma unroll
    for (int i = 0; i < 8; ++i) {
        const int k = t + 256 * i; const float h = v[i] * rstd * g[k];
        OUT[(size_t)row * DM + k] = (bf16)f2bf(h);
        if (LOGF) {
#pragma unroll
            for (int j = 0; j < 8; ++j) f[j] += h * w_in[(size_t)k * INC + C_F + j];
        }
    }
    if (LOGF) {
#pragma unroll
        for (int j = 0; j < 8; ++j) { const float tj = block_sum_256(f[j], red); if (t == 0) LOGF[(size_t)row * 8 + j] = log_sigmoid(tj + b_forget[j]); }
    }
}
__global__ __launch_bounds__(64) void n_cumsum(const float* LOGF, float* CB) {
    const int bh = blockIdx.x, b = bh / FH, h = bh % FH, lane = threadIdx.x;
    float loc = 0.f;
    for (int i = 0; i < 64; ++i) loc += LOGF[(size_t)(b * SEQ + lane * 64 + i) * 8 + h];
    float inc = loc;
#pragma unroll
    for (int o = 1; o < 64; o <<= 1) { const float n = __shfl_up(inc, o); if (lane >= o) inc += n; }
    float run = inc - loc;
    for (int i = 0; i < 64; ++i) { run += LOGF[(size_t)(b * SEQ + lane * 64 + i) * 8 + h]; CB[(size_t)bh * SEQ + lane * 64 + i] = -run * 11.313708498984761f; }
}

template <bool DUAL, class FA, class FB, class FA2, class FB2, class FE>
__global__ __launch_bounds__(256) void n_gemm(int M, int N, int K, int padarg, const int* Mdev, FA fa, FB fb, FA2 fa2, FB2 fb2, FE fe) {
    __shared__ float As[16][68], Bs[16][68], As2[DUAL ? 16 : 1][68], Bs2[DUAL ? 16 : 1][68];
    const int z = blockIdx.z, m0 = blockIdx.y * 64, n0 = blockIdx.x * 64, t = threadIdx.x, tx = t & 15, ty = t >> 4;
    const int Mr = Mdev ? Mdev[z] : M;
    if (m0 >= Mr) return;
    float acc[4][4], acc2[4][4];
#pragma unroll
    for (int i = 0; i < 4; ++i)
#pragma unroll
        for (int j = 0; j < 4; ++j) { acc[i][j] = 0.f; acc2[i][j] = 0.f; }
    for (int k0 = 0; k0 < K; k0 += 16) {
#pragma unroll
        for (int i = 0; i < 4; ++i) {
            const int idx = t + i * 256;
            { const int r = idx >> 4, c = idx & 15; const bool ok = (m0 + r) < Mr; As[c][r] = ok ? fa(z, m0 + r, k0 + c) : 0.f; if (DUAL) As2[c][r] = ok ? fa2(z, m0 + r, k0 + c) : 0.f; }
            { const int r = idx >> 6, c = idx & 63; const bool ok = (n0 + c) < N; Bs[r][c] = ok ? fb(z, k0 + r, n0 + c) : 0.f; if (DUAL) Bs2[r][c] = ok ? fb2(z, k0 + r, n0 + c) : 0.f; }
        }
        __syncthreads();
#pragma unroll
        for (int kk = 0; kk < 16; ++kk) {
            float a[4], b[4], a2[4], b2[4];
#pragma unroll
            for (int i = 0; i < 4; ++i) { a[i] = As[kk][ty * 4 + i]; b[i] = Bs[kk][tx * 4 + i]; if (DUAL) { a2[i] = As2[kk][ty * 4 + i]; b2[i] = Bs2[kk][tx * 4 + i]; } }
#pragma unroll
            for (int i = 0; i < 4; ++i)
#pragma unroll
                for (int j = 0; j < 4; ++j) { acc[i][j] += a[i] * b[j]; if (DUAL) acc2[i][j] += a2[i] * b2[j]; }
        }
        __syncthreads();
    }
#pragma unroll
    for (int i = 0; i < 4; ++i)
#pragma unroll
        for (int j = 0; j < 4; ++j) { const int m = m0 + ty * 4 + i, n = n0 + tx * 4 + j; if (m < Mr && n < N) fe(z, m, n, acc[i][j], acc2[i][j]); }
}
struct FNone { long pad; __device__ float operator()(int, int, int) const { return 0.f; } };
template <bool DUAL, class FA, class FB, class FA2, class FB2, class FE>
static void run_gemm(hipStream_t st, int Z, int M, int N, int K, const int* Mdev, FA fa, FB fb, FA2 fa2, FB2 fb2, FE fe) {
    dim3 grid((N + 63) / 64, (M + 63) / 64, Z);
    hipLaunchKernelGGL((n_gemm<DUAL, FA, FB, FA2, FB2, FE>), grid, dim3(256), 0, st, M, N, K, 0, Mdev, fa, fb, fa2, fb2, fe);
}
template <class FA, class FB, class FE>
static void run_gemm1(hipStream_t st, int Z, int M, int N, int K, const int* Mdev, FA fa, FB fb, FE fe) { run_gemm<false>(st, Z, M, N, K, Mdev, fa, fb, FNone{}, FNone{}, fe); }

struct ABf { const bf16* p; int ld, pad; __device__ float operator()(int, int m, int k) const { return bf2f(p[(size_t)m * ld + k]); } };
struct AF32 { const float* p; int ld, pad; __device__ float operator()(int, int m, int k) const { return p[(size_t)m * ld + k]; } };
struct BF32 { const float* p; int ld, pad; __device__ float operator()(int, int k, int n) const { return p[(size_t)k * ld + n]; } };
struct BF32G { const float* p; const float* g; int ld, pad; __device__ float operator()(int, int k, int n) const { return g[k] * p[(size_t)k * ld + n]; } };

struct EProj { bf16 *Q, *K, *V, *ZU, *ZV; float *TGA, *TGB;
    __device__ void operator()(int, int m, int n, float v, float) const {
        if (n < C_K) Q[(size_t)m * FW + n] = (bf16)f2bf(v);
        else if (n < C_V) K[(size_t)m * FW + n - C_K] = (bf16)f2bf(v);
        else if (n < C_F) V[(size_t)m * FW + n - C_V] = (bf16)f2bf(v);
        else if (n < C_Z) {}
        else if (n < C_Z + SGW) ZU[(size_t)m * SGW + n - C_Z] = (bf16)f2bf(gelu_tanh(v));
        else if (n < C_GA) ZV[(size_t)m * SGW + n - C_Z - SGW] = (bf16)f2bf(gelu_tanh(v));
        else if (n < C_GB) TGA[(size_t)m * DM + n - C_GA] = sigmoidf_(v);
        else TGB[(size_t)m * DM + n - C_GB] = sigmoidf_(v);
    } };
__global__ __launch_bounds__(256) void n_gates(const float* TGA, const float* TGB, bf16* GR, bf16* GS) {
    const size_t i = (size_t)blockIdx.x * 256 + threadIdx.x; const float a = TGA[i], b = TGB[i]; GR[i] = (bf16)f2bf(a / b); GS[i] = (bf16)f2bf(b);
}
__global__ __launch_bounds__(256) void n_zstat(const bf16* ZV, float* ZST) {
    __shared__ float red[4];
    const int row = blockIdx.x, t = threadIdx.x; float s = 0.f, q = 0.f;
    for (int i = 0; i < 4; ++i) { const float v = bf2f(ZV[(size_t)row * SGW + t + 256 * i]); s += v; q += v * v; }
    const float S = block_sum_256(s, red); const float Q = block_sum_256(q, red);
    if (t < 32) ZST[(size_t)row * 32 + t] = (t == 0) ? S : (t == 1) ? Q : 0.f;
}
struct AQh { const bf16* p; int ld, b, rows, pad; __device__ float operator()(int z, int m, int k) const { return bf2f(p[(size_t)(b * rows + m) * ld + z * 128 + k]); } };
struct BKh { const bf16* p; int ld, b, rows, pad; __device__ float operator()(int z, int k, int n) const { return bf2f(p[(size_t)(b * rows + n) * ld + z * 128 + k]); } };
struct BVh { const bf16* p; int ld, b, rows, pad; __device__ float operator()(int z, int k, int n) const { return bf2f(p[(size_t)(b * rows + k) * ld + z * 128 + n]); } };
struct ES { float* S; const float* CB; int b, ncol, causal, pad; __device__ void operator()(int z, int m, int n, float v, float) const {
        float s = v; if (CB) s += CB[(size_t)(b * FH + z) * SEQ + n]; s *= 0.08838834764831845f; if (causal && n > m) s = -INFINITY; S[((size_t)z * SEQ + m) * ncol + n] = s; } };
__global__ __launch_bounds__(256) void n_softmax_rows(float* S, int ncol) {
    __shared__ float red[4];
    float* r = S + (size_t)blockIdx.x * ncol; const int t = threadIdx.x;
    float mx = -INFINITY; for (int i = t; i < ncol; i += 256) mx = fmaxf(mx, r[i]);
#pragma unroll
    for (int o = 32; o > 0; o >>= 1) mx = fmaxf(mx, __shfl_xor(mx, o));
    __syncthreads(); if ((t & 63) == 0) red[t >> 6] = mx; __syncthreads();
    mx = fmaxf(fmaxf(red[0], red[1]), fmaxf(red[2], red[3]));
    float s = 0.f; for (int i = t; i < ncol; i += 256) { const float e = __expf(r[i] - mx); r[i] = e; s += e; }
    const float tot = block_sum_256(s, red); const float inv = 1.f / tot;
    for (int i = t; i < ncol; i += 256) r[i] *= inv;
}
struct AS3 { const float* S; int ncol, pad; __device__ float operator()(int z, int m, int k) const { return S[((size_t)z * SEQ + m) * ncol + k]; } };
struct EO { bf16* O; int ld, b, coff, pad; __device__ void operator()(int z, int m, int n, float v, float) const { O[(size_t)(b * SEQ + m) * ld + coff + z * 128 + n] = (bf16)f2bf(v); } };
__global__ __launch_bounds__(128) void n_spatial(const bf16* ZU, const bf16* ZV, const float* ZST, const float* ln_g, const float* ln_b, const float* w_s, const float* b_s, bf16* AS) {
    __shared__ float vn[128][129];
    const int chunk = blockIdx.x, g = blockIdx.y, c = threadIdx.x, t0 = chunk * SGC;
    for (int s = 0; s < 128; ++s) {
        const float* st = ZST + (size_t)(t0 + s) * 32; float S = 0.f, Q = 0.f;
        for (int i = 0; i < 16; ++i) { S += st[2 * i]; Q += st[2 * i + 1]; }
        const float mu = S * (1.f / SGW), var = fmaxf(Q * (1.f / SGW) - mu * mu, 0.f), rs = rsqrtf(var + LN_EPS);
        const float v = bf2f(ZV[(size_t)(t0 + s) * SGW + g * 128 + c]);
        vn[s][c] = (v - mu) * rs * ln_g[g * 128 + c] + ln_b[g * 128 + c];
    }
    __syncthreads();
    for (int t = 0; t < 128; ++t) {
        float a = 0.f; const float* w = w_s + ((size_t)g * 128 + t) * 128;
        for (int s = 0; s <= t; ++s) a += w[s] * vn[s][c];
        a += b_s[g * 128 + t];
        const float u = bf2f(ZU[(size_t)(t0 + t) * SGW + g * 128 + c]);
        AS[(size_t)(t0 + t) * DM + FW + g * 128 + c] = (bf16)f2bf(u * a);
    }
}
struct BWab { const float* wa; const float* wb; int second, pad; __device__ float operator()(int, int k, int n) const { return second ? wb[(size_t)k * DM + n] : wa[(size_t)k * DM + n]; } };
struct AAs { const bf16* p; int off, pad; __device__ float operator()(int, int m, int k) const { return bf2f(p[(size_t)m * DM + off + k]); } };
struct EMerge { const bf16 *GR, *GS; bf16* MG; __device__ void operator()(int, int m, int n, float v, float v2) const { const size_t i = (size_t)m * DM + n; MG[i] = (bf16)f2bf((v * bf2f(GR[i]) + v2) * bf2f(GS[i])); } };
struct EResid { const float* Xi; float* Xo; bf16* Xb; __device__ void operator()(int, int m, int n, float v, float) const { const size_t i = (size_t)m * DM + n; const float o = Xi[i] + v; Xo[i] = o; Xb[i] = (bf16)f2bf(o); } };
__global__ __launch_bounds__(256) void n_sumsq(const float* X, float* SS) {
    __shared__ float red[4];
    const int row = blockIdx.x, t = threadIdx.x; float q = 0.f;
    for (int i = 0; i < 8; ++i) { const float v = X[(size_t)row * DM + t + 256 * i]; q += v * v; }
    const float Q = block_sum_256(q, red);
    if (t < 32) SS[(size_t)row * 32 + t] = (t == 0) ? Q : 0.f;
}
__device__ __forceinline__ float rstd_from(const float* SS, int m) { float q = 0.f; for (int i = 0; i < 32; ++i) q += SS[(size_t)m * 32 + i]; return rsqrtf(q * (1.f / DM) + RMS_EPS); }
struct EQx { const float* SS; bf16* QX; __device__ void operator()(int, int m, int n, float v, float) const { QX[(size_t)m * XW + n] = (bf16)f2bf(v * rstd_from(SS, m)); } };
struct EKVx { bf16 *KX, *VX; __device__ void operator()(int, int m, int n, float v, float) const { if (n < XW) KX[(size_t)m * XW + n] = (bf16)f2bf(v); else VX[(size_t)m * XW + n - XW] = (bf16)f2bf(v); } };
struct ELogit { const float* SS; const float* br; float* LG; __device__ void operator()(int, int m, int n, float v, float) const { LG[(size_t)m * NE + n] = v * rstd_from(SS, m) + br[n]; } };
__global__ __launch_bounds__(256) void n_topk(const float* LG, int* TOPE, int* TOPR, float* TOPW, int* TOKL, float* GWL, unsigned* CNT, const float* SS, float* RS2) {
    const int t = blockIdx.x * 256 + threadIdx.x; if (t >= NTOK) return;
    RS2[t] = rstd_from(SS, t);
    float l[NE];
#pragma unroll
    for (int e = 0; e < NE; ++e) l[e] = LG[(size_t)t * NE + e];
    float tv[4]; int ti[4];
#pragma unroll
    for (int k = 0; k < 4; ++k) { float bv = -INFINITY; int bi = 0;
#pragma unroll
        for (int e = 0; e < NE; ++e) { if (l[e] > bv) { bv = l[e]; bi = e; } }
        tv[k] = bv; ti[k] = bi;
#pragma unroll
        for (int e = 0; e < NE; ++e) if (e == bi) l[e] = -INFINITY; }
    float s = 0.f, w[4];
#pragma unroll
    for (int k = 0; k < 4; ++k) { w[k] = __expf(tv[k] - tv[0]); s += w[k]; }
#pragma unroll
    for (int k = 0; k < 4; ++k) { const float wk = w[k] / s; const int e = ti[k]; const unsigned r = atomicAdd(&CNT[e], 1u);
        TOPE[t * 4 + k] = e; TOPR[t * 4 + k] = (int)r; TOPW[t * 4 + k] = wk; TOKL[(size_t)e * NTOK + r] = t; GWL[(size_t)e * NTOK + r] = wk; }
}
__device__ __forceinline__ int expert_base(const unsigned* CNT, int e) { int b = 0; for (int i = 0; i < e; ++i) b += ((int)CNT[i] + 255) & ~255; return b; }
struct AGath { const bf16* X; const int* TOKL; __device__ float operator()(int z, int m, int k) const { return bf2f(X[(size_t)TOKL[(size_t)z * NTOK + m] * DM + k]); } };
struct BGu { const float* w; const float* g; int up, pad; __device__ float operator()(int z, int k, int n) const { return g[k] * w[((size_t)z * DM + k) * (2 * DFF) + up * DFF + n]; } };
struct EAct { const float* SS; const int* TOKL; const float* bgu; const unsigned* CNT; bf16* HB;
    __device__ void operator()(int z, int m, int n, float v, float v2) const {
        const float rs = rstd_from(SS, TOKL[(size_t)z * NTOK + m]);
        float gate = v * rs + bgu[(size_t)z * 2 * DFF + n], up = v2 * rs + bgu[(size_t)z * 2 * DFF + DFF + n];
        gate = fminf(gate, SW_LIMIT); up = fminf(fmaxf(up, -SW_LIMIT), SW_LIMIT);
        const float act = (up + 1.f) * gate * sigmoidf_(SW_ALPHA * gate);
        HB[(size_t)(expert_base(CNT, z) + m) * DFF + n] = (bf16)f2bf(act); } };
struct AHb { const bf16* HB; const unsigned* CNT; __device__ float operator()(int z, int m, int k) const { return bf2f(HB[(size_t)(expert_base(CNT, z) + m) * DFF + k]); } };
struct BDn { const float* w; __device__ float operator()(int z, int k, int n) const { return w[((size_t)z * DFF + k) * DM + n]; } };
struct EDn { const float* bd; const float* GWL; const unsigned* CNT; bf16* YB; __device__ void operator()(int z, int m, int n, float v, float) const {
        YB[(size_t)(expert_base(CNT, z) + m) * DM + n] = (bf16)f2bf((v + bd[(size_t)z * DM + n]) * GWL[(size_t)z * NTOK + m]); } };
__global__ __launch_bounds__(256) void n_final(const float* X2, const bf16* YB, const int* TOPE, const int* TOPR, const unsigned* CNT, const float* g, float* OUT) {
    __shared__ float red[4];
    const int row = blockIdx.x, t = threadIdx.x;
    int slot[4];
#pragma unroll
    for (int k = 0; k < 4; ++k) slot[k] = expert_base(CNT, TOPE[row * 4 + k]) + TOPR[row * 4 + k];
    float v[8]; float q = 0.f;
#pragma unroll
    for (int i = 0; i < 8; ++i) { const int c = t + 256 * i; float a = X2[(size_t)row * DM + c];
#pragma unroll
        for (int k = 0; k < 4; ++k) a += bf2f(YB[(size_t)slot[k] * DM + c]);
        v[i] = a; q += a * a; }
    const float Q = block_sum_256(q, red); const float rs = rsqrtf(Q * (1.f / DM) + RMS_EPS);
#pragma unroll
    for (int i = 0; i < 8; ++i) { const int c = t + 256 * i; OUT[(size_t)row * DM + c] = v[i] * rs * g[c]; }
}

#endif
#define LAS __attribute__((address_space(3)))
#define GAS __attribute__((address_space(1)))
typedef short bf16x8 __attribute__((ext_vector_type(8)));
typedef float f32x4 __attribute__((ext_vector_type(4)));
typedef float f32x2 __attribute__((ext_vector_type(2)));
typedef unsigned u32x4 __attribute__((ext_vector_type(4)));
typedef unsigned u32x2 __attribute__((ext_vector_type(2)));

constexpr int NPROJ = 9216;
constexpr size_t WS_WP   = WS_END_NAIVE;
constexpr size_t WS_WAB  = WS_WP + 36 * MiB;
constexpr size_t WS_WO   = WS_WAB + 8 * MiB;
constexpr size_t WS_WXQ  = WS_WO + 8 * MiB;
constexpr size_t WS_WXKV = WS_WXQ + 2 * MiB;
constexpr size_t WS_WXO  = WS_WXKV + 4 * MiB;
constexpr size_t WS_WGU  = WS_WXO + 2 * MiB;
constexpr size_t WS_WD   = WS_WGU + 512 * MiB;
constexpr size_t WS_WRT  = WS_WD + 256 * MiB;
constexpr size_t WS_RS2  = WS_WRT + 1 * MiB;
constexpr size_t WS_RSL  = WS_RS2 + 1 * MiB;
constexpr size_t WS_X2Q  = WS_RSL + 2 * MiB;
constexpr size_t WS_H0Q  = WS_X2Q + 32 * MiB;
constexpr size_t WS_WPG  = WS_H0Q + 32 * MiB;
constexpr size_t WS_END  = WS_WPG + 8 * MiB;

constexpr int NWAVES = 8, NTHREADS = 512;
constexpr int LDS_STAGE = 131072;
constexpr int LDS_MISC = LDS_STAGE;
constexpr int LDS_TAB = LDS_STAGE + 256;
constexpr int LDS_BYTES = 147456;
constexpr int CW_BAR = 65536;

__device__ __forceinline__ unsigned cvt_pk_bf16(float lo, float hi) { unsigned r; asm volatile("v_cvt_pk_bf16_f32 %0, %1, %2" : "=v"(r) : "v"(lo), "v"(hi)); return r; }
constexpr float W8_SCALE = 64.f, W8_INV = 1.f / 64.f;
__device__ __forceinline__ unsigned pk4_fp8(float a, float b, float c, float d) {
    a = __builtin_amdgcn_fmed3f(a, -448.f, 448.f); b = __builtin_amdgcn_fmed3f(b, -448.f, 448.f); c = __builtin_amdgcn_fmed3f(c, -448.f, 448.f); d = __builtin_amdgcn_fmed3f(d, -448.f, 448.f);
    int w = 0; w = __builtin_amdgcn_cvt_pk_fp8_f32(a, b, w, false); w = __builtin_amdgcn_cvt_pk_fp8_f32(c, d, w, true); return (unsigned)w; }
__device__ __forceinline__ unsigned pk4_fp8_nc(float a, float b, float c, float d) {
    int w = 0; w = __builtin_amdgcn_cvt_pk_fp8_f32(a, b, w, false); w = __builtin_amdgcn_cvt_pk_fp8_f32(c, d, w, true); return (unsigned)w; }
__device__ __forceinline__ float fast_sigmoid(float x) { return __builtin_amdgcn_rcpf(1.f + __builtin_amdgcn_exp2f(-1.4426950408889634f * x)); }
__device__ __forceinline__ float fast_gelu_tanh(float x) { const float u2 = 1.5957691216057308f * (x + 0.044715f * x * x * x); return x * __builtin_amdgcn_rcpf(1.f + __builtin_amdgcn_exp2f(-1.4426950408889634f * u2)); }
__device__ __forceinline__ f32x2 gelu_tanh2(f32x2 x) { const f32x2 u = (x * x * 0.044715f + 1.0f) * x * (-1.4426950408889634f * 1.5957691216057308f);
    f32x2 e; e.x = __builtin_amdgcn_exp2f(u.x); e.y = __builtin_amdgcn_exp2f(u.y); const f32x2 d = e + 1.0f; f32x2 r; r.x = __builtin_amdgcn_rcpf(d.x); r.y = __builtin_amdgcn_rcpf(d.y); return x * r; }
__device__ __forceinline__ float wave_sum(float v) {
#pragma unroll
    for (int o = 1; o < 64; o <<= 1) v += __shfl_xor(v, o);
    return v;
}

#define XB_TMO      128
#define XB_XCNT(j)  (256  + 64 * (j))
#define XB_XSUB(j)  (1280 + 64 * (j))
#define XB_XGEN(j)  (2304 + 64 * (j))
#define XB_TOP      3328
#define XB_TOPGEN   3392
#define XCD_BAR_WORDS 3456
#define XB_SPIN_CAP (1u << 18)
__device__ __forceinline__ unsigned xb_ld(unsigned* p)              { return __hip_atomic_load(p, __ATOMIC_RELAXED, __HIP_MEMORY_SCOPE_AGENT); }
__device__ __forceinline__ unsigned xb_add(unsigned* p, unsigned v) { return __hip_atomic_fetch_add(p, v, __ATOMIC_RELAXED, __HIP_MEMORY_SCOPE_AGENT); }
__device__ __forceinline__ unsigned xb_xcc_id() { return (unsigned)__builtin_amdgcn_s_getreg((3 << 11) | 20) & 0xFu; }
#define XB_SPIN(cond, bar) do { unsigned _sp = 0; while (cond) { __builtin_amdgcn_s_sleep(1); \
    if ((++_sp & 255u) == 0u) { if (xb_ld(&(bar)[XB_TMO])) break; if (_sp > XB_SPIN_CAP) { atomicAdd(&(bar)[XB_TMO], 1u); break; } } } } while (0)
struct XcdBarrier { unsigned* bar; unsigned x; volatile LAS unsigned* st; };
__device__ __forceinline__ XcdBarrier xcd_barrier_post(unsigned* bar, volatile LAS unsigned* st) {
    XcdBarrier b; b.bar = bar; b.x = xb_xcc_id(); b.st = st;
    if (threadIdx.x == 0) (void)xb_add(&bar[XB_XCNT(b.x)], 1u);
    return b;
}
__device__ __forceinline__ void xcd_barrier_complete(unsigned* bar, unsigned x, unsigned& nloc, unsigned& nx) {
    const unsigned G = gridDim.x * gridDim.y * gridDim.z;
    unsigned sum, cnt, mine, sp = 0u;
    for (;;) {
        sum = 0u; cnt = 0u; mine = 0u;
#pragma unroll
        for (unsigned j = 0; j < 16; ++j) { const unsigned c = xb_ld(&bar[XB_XCNT(j)]); sum += c; cnt += (c > 0u) ? 1u : 0u; mine = (j == x) ? c : mine; }
        if (sum == G) break;
        __builtin_amdgcn_s_sleep(1);
        if ((++sp & 255u) == 0u) { if (xb_ld(&bar[XB_TMO])) break; if (sp > XB_SPIN_CAP) { atomicAdd(&bar[XB_TMO], 1u); break; } }
    }
    nloc = mine > 0u ? mine : 1u; nx = cnt > 0u ? cnt : 1u;
}
__device__ __forceinline__ void xcd_barrier(const XcdBarrier& b) {
    asm volatile("s_waitcnt vmcnt(0)" ::: "memory");
    __syncthreads();
    if (threadIdx.x == 0) {
        unsigned* bar = b.bar;
        __builtin_amdgcn_s_waitcnt(0);
        unsigned nloc = b.st[0], nx = b.st[1];
        if (nloc == 0u) { xcd_barrier_complete(bar, b.x, nloc, nx); b.st[0] = nloc; b.st[1] = nx; }
        const unsigned old = xb_add(&bar[XB_XSUB(b.x)], 1u);
        const unsigned gen = old / nloc;
        if (old + 1u == (gen + 1u) * nloc) {
            __builtin_amdgcn_fence(__ATOMIC_RELEASE, "agent");
            asm volatile("s_waitcnt vmcnt(0)" ::: "memory");
            const unsigned og = xb_add(&bar[XB_TOP], 1u);
            const unsigned tg = og / nx;
            if (og + 1u == (tg + 1u) * nx) xb_add(&bar[XB_TOPGEN], 1u);
            else XB_SPIN(xb_ld(&bar[XB_TOPGEN]) == tg, bar);
            __builtin_amdgcn_fence(__ATOMIC_ACQUIRE, "agent");
            xb_add(&bar[XB_XGEN(b.x)], 1u);
            asm volatile("s_waitcnt vmcnt(0)" ::: "memory");
        } else {
            XB_SPIN(xb_ld(&bar[XB_XGEN(b.x)]) == gen, bar);
            __builtin_amdgcn_fence(__ATOMIC_ACQUIRE, "agent");
            asm volatile("s_waitcnt vmcnt(0)" ::: "memory");
        }
    }
    __syncthreads();
}

namespace pg8 {
typedef int v4i_t __attribute__((ext_vector_type(4)));
typedef int v8i_t __attribute__((ext_vector_type(8)));
constexpr int BM = 256, BK = 64, HALF = 128, HTB = HALF * BK * 2, STAGE_BYTES = 8 * HTB;
__host__ __device__ __forceinline__ int lds_byte(int r, int c) { const int st = (r >> 4) * 2 + (c >> 5), rr = r & 15, cc = c & 31, ob = rr * 64 + cc * 2; return st * 1024 + (ob ^ (((ob >> 9) & 1) << 5)); }
__host__ __device__ __forceinline__ void stage_rc(int b, int& R, int& C) { const int st = b / 1024, sb = b % 1024, swz = sb ^ (((sb >> 9) & 1) << 5); R = (st >> 1) * 16 + swz / 64; C = (st & 1) * 32 + (swz % 64) / 2; }
__host__ __device__ __forceinline__ int perm32(int rho) { const int n = rho >> 4, i = rho & 15; return 8 * (i >> 2) + 4 * n + (i & 3); }

struct GUnit { const char* A; const char* B; int pm, pn, e, keep; };

template <bool GATHER, bool F8, class Epi, class Sched>
__device__ __forceinline__ void gemm_phase(LAS unsigned char* lds, const int nt, const unsigned lda, const unsigned ldb, const Sched& S, const Epi& E) {
    const int tid = threadIdx.x, wid = __builtin_amdgcn_readfirstlane(tid >> 6), lane = tid & 63, wr = wid >> 2, wc = wid & 3, fr = lane & 15, fq = lane >> 4;
    unsigned voffA[2], voffB[2]; int RA[2]; unsigned CA2[2];
#pragma unroll
    for (int i = 0; i < 2; ++i) { int R, C; stage_rc(tid * 16 + i * 8192, R, C); const int Rb = Epi::PERM ? ((R & ~31) + perm32(R & 31)) : R;
        RA[i] = R; CA2[i] = (unsigned)C * 2u; voffA[i] = (unsigned)R * lda + (unsigned)C * 2u; voffB[i] = (unsigned)Rb * ldb + (unsigned)C * 2u; }
    const size_t kstep = (size_t)(BK * 2);
    const size_t hA = GATHER ? 0 : (size_t)HALF * lda, hB = (size_t)HALF * ldb;
    const unsigned ldsw = (unsigned)wid * 1024u;
    const int aoff = lds_byte(wr * 64 + fr, fq * 8), boff = lds_byte(wc * 32 + fr, fq * 8);
    LAS unsigned char* const ldsB = lds + 4 * HTB;
#define PG8_SA(b, h) (((b) * 2 + (h)) * HTB)
#define PG8_SB(b, h) ((4 + (b) * 2 + (h)) * HTB)
#define PG8_STAGE(bufoff, gbase, voff) do { _Pragma("unroll") for (int _i = 0; _i < 2; ++_i) \
        __builtin_amdgcn_global_load_lds((const unsigned*)((const char*)(gbase) + (voff)[_i]), (LAS unsigned*)(lds + (bufoff) + ldsw + _i * 8192), 16, 0, 0); } while (0)
#define PG8_SBR(b, h) (((b) * 2 + (h)) * HTB)
#define PG8_LD8(base, off) __builtin_shufflevector(*(const LAS v4i_t*)((base) + (off)), *(const LAS v4i_t*)((base) + (off) + 1024), 0, 1, 2, 3, 4, 5, 6, 7)
#define PG8_LDA(dst, b, h) do { if constexpr (F8) { _Pragma("unroll") for (int m = 0; m < 4; ++m) dst##8[m] = PG8_LD8(lds, PG8_SA(b, h) + aoff + m * 2048); } \
        else { _Pragma("unroll") for (int m = 0; m < 4; ++m) _Pragma("unroll") for (int k = 0; k < 2; ++k) dst[m][k] = *(const LAS bf16x8*)(lds + PG8_SA(b, h) + aoff + m * 2048 + k * 1024); } } while (0)
#define PG8_LDB(dst, b, h) do { if constexpr (F8) { _Pragma("unroll") for (int n = 0; n < 2; ++n) dst##8[n] = PG8_LD8(ldsB, PG8_SBR(b, h) + boff + n * 2048); } \
        else { _Pragma("unroll") for (int n = 0; n < 2; ++n) _Pragma("unroll") for (int k = 0; k < 2; ++k) dst[n][k] = *(const LAS bf16x8*)(ldsB + PG8_SBR(b, h) + boff + n * 2048 + k * 1024); } } while (0)
#define PG8_MMA(ai, bj, At, Bt) do { __builtin_amdgcn_s_setprio(1); \
        if constexpr (F8) { _Pragma("unroll") for (int m = 0; m < 4; ++m) _Pragma("unroll") for (int n = 0; n < 2; ++n) \
            asm volatile("v_mfma_scale_f32_16x16x128_f8f6f4 %0, %1, %2, %0, %3, %3 op_sel_hi:[0,0,0]" : "+v"(acc[ai][bj][m][n]) : "v"(Bt##8[n]), "v"(At##8[m]), "v"(sc8)); } \
        else { _Pragma("unroll") for (int m = 0; m < 4; ++m) _Pragma("unroll") for (int n = 0; n < 2; ++n) _Pragma("unroll") for (int k = 0; k < 2; ++k) \
            acc[ai][bj][m][n] = __builtin_amdgcn_mfma_f32_16x16x32_bf16(Bt[n][k], At[m][k], acc[ai][bj][m][n], 0, 0, 0); } \
        __builtin_amdgcn_s_setprio(0); } while (0)
#define PG8_WAIT_V(n) asm volatile("s_waitcnt vmcnt(" #n ")" ::: "memory")
#define PG8_WAIT_L(n) asm volatile("s_waitcnt lgkmcnt(" #n ")" ::: "memory")
#define PG8_BAR __builtin_amdgcn_s_barrier()
#define PG8_SCHED __builtin_amdgcn_sched_barrier(0)
    GUnit cur, nxt; int ui = 0;
    if (!S.next(0, cur)) return;
    f32x4 acc[2][2][4][2];
#pragma unroll
    for (int a = 0; a < 2; ++a)
#pragma unroll
        for (int b = 0; b < 2; ++b)
#pragma unroll
            for (int m = 0; m < 4; ++m)
#pragma unroll
                for (int n = 0; n < 2; ++n) acc[a][b][m][n] = (f32x4){0.f, 0.f, 0.f, 0.f};
    bf16x8 At[4][2], B0[2][2], B1[2][2]; v8i_t At8[4], B08[2], B18[2];
    const int sc8 = 0x7f7f7f7f;
    const char* cA = cur.A; const char* cB = cur.B;
    unsigned vA0[2], vA1[2], vN0[2], vN1[2];
    if constexpr (GATHER) {
#pragma unroll
        for (int i = 0; i < 2; ++i) { vA0[i] = (unsigned)S.arow(cur, RA[i]) * lda + CA2[i]; vA1[i] = (unsigned)S.arow(cur, HALF + RA[i]) * lda + CA2[i]; }
        asm volatile("" : "+v"(vA0[0]), "+v"(vA0[1]), "+v"(vA1[0]), "+v"(vA1[1]));
    } else {
#pragma unroll
        for (int i = 0; i < 2; ++i) { vA0[i] = voffA[i]; vA1[i] = voffA[i]; }
    }
    PG8_STAGE(PG8_SB(0, 0), cB, voffB); PG8_STAGE(PG8_SB(0, 1), cB + hB, voffB); PG8_STAGE(PG8_SA(0, 0), cA, vA0); PG8_STAGE(PG8_SA(0, 1), cA + hA, vA1);
    if (wr == 1) PG8_BAR;
    PG8_WAIT_V(2); PG8_BAR;
    PG8_STAGE(PG8_SB(1, 0), cB + kstep, voffB); PG8_STAGE(PG8_SA(1, 0), cA + kstep, vA0); PG8_STAGE(PG8_SB(1, 1), cB + hB + kstep, voffB);
    PG8_WAIT_V(6); PG8_BAR;
    for (;;) {
        const bool has_next = S.next(ui + 1, nxt);
        const char* nA = has_next ? nxt.A : cA; const char* nB = has_next ? nxt.B : cB;
        if constexpr (GATHER) {
            if (has_next) {
#pragma unroll
                for (int i = 0; i < 2; ++i) { vN0[i] = (unsigned)S.arow(nxt, RA[i]) * lda + CA2[i]; vN1[i] = (unsigned)S.arow(nxt, HALF + RA[i]) * lda + CA2[i]; }
            } else {
#pragma unroll
                for (int i = 0; i < 2; ++i) { vN0[i] = vA0[i]; vN1[i] = vA1[i]; }
            }
            asm volatile("" : "+v"(vN0[0]), "+v"(vN0[1]), "+v"(vN1[0]), "+v"(vN1[1]));
        }
        for (int t = 0; t < nt; t += 2) {
            const bool last = (t == nt - 2);
            const char* a1 = cA + (size_t)(t + 1) * kstep;
            const char* a2 = last ? nA : cA + (size_t)(t + 2) * kstep; const char* b2 = last ? nB : cB + (size_t)(t + 2) * kstep;
            const char* a3 = a2 + kstep; const char* b3 = b2 + kstep;
            unsigned w0[2], w1[2];
            if constexpr (GATHER) {
#pragma unroll
                for (int i = 0; i < 2; ++i) { w0[i] = last ? vN0[i] : vA0[i]; w1[i] = last ? vN1[i] : vA1[i]; }
            } else {
#pragma unroll
                for (int i = 0; i < 2; ++i) { w0[i] = voffA[i]; w1[i] = voffA[i]; }
            }
            PG8_LDB(B0, 0, 0); PG8_LDB(B1, 0, 1); PG8_SCHED; PG8_LDA(At, 0, 0); PG8_STAGE(PG8_SA(1, 1), a1 + hA, vA1);
            PG8_WAIT_V(8); PG8_WAIT_L(0); PG8_BAR; PG8_MMA(0, 0, At, B0); PG8_MMA(0, 1, At, B1); PG8_BAR; PG8_SCHED;
            PG8_LDA(At, 0, 1); PG8_STAGE(PG8_SB(0, 0), b2, voffB); PG8_STAGE(PG8_SB(0, 1), b2 + hB, voffB); PG8_STAGE(PG8_SA(0, 0), a2, w0);
            PG8_WAIT_V(8); PG8_WAIT_L(0); PG8_BAR; PG8_MMA(1, 0, At, B0); PG8_MMA(1, 1, At, B1); PG8_BAR; PG8_SCHED;
            PG8_LDB(B0, 1, 0); PG8_LDB(B1, 1, 1); PG8_SCHED; PG8_LDA(At, 1, 0); PG8_STAGE(PG8_SA(0, 1), a2 + hA, w1);
            PG8_WAIT_V(8); PG8_WAIT_L(0); PG8_BAR; PG8_MMA(0, 0, At, B0); PG8_MMA(0, 1, At, B1); PG8_BAR; PG8_SCHED;
            PG8_LDA(At, 1, 1); PG8_STAGE(PG8_SB(1, 0), b3, voffB); PG8_STAGE(PG8_SB(1, 1), b3 + hB, voffB); PG8_STAGE(PG8_SA(1, 0), a3, w0);
            PG8_WAIT_V(8); PG8_WAIT_L(0); PG8_BAR; PG8_MMA(1, 0, At, B0); PG8_MMA(1, 1, At, B1); PG8_BAR; PG8_SCHED;
        }
        if (wr == 0) PG8_BAR;
        E(acc, cur, wr, wc, fr, fq);
        if (!has_next) break;
        if (!cur.keep) {
#pragma unroll
            for (int a = 0; a < 2; ++a)
#pragma unroll
                for (int b = 0; b < 2; ++b)
#pragma unroll
                    for (int m = 0; m < 4; ++m)
#pragma unroll
                        for (int n = 0; n < 2; ++n) acc[a][b][m][n] = (f32x4){0.f, 0.f, 0.f, 0.f};
        }
        cur = nxt; cA = nA; cB = nB; ++ui;
        if constexpr (GATHER) {
#pragma unroll
            for (int i = 0; i < 2; ++i) { vA0[i] = vN0[i]; vA1[i] = vN1[i]; }
        }
        if (wr == 1) PG8_BAR;
    }
    PG8_WAIT_V(0);
    PG8_BAR;
#undef PG8_SA
#undef PG8_SB
#undef PG8_STAGE
#undef PG8_LDA
#undef PG8_LDB
#undef PG8_MMA
#undef PG8_LD8
#undef PG8_SBR
#undef PG8_WAIT_V
#undef PG8_WAIT_L
#undef PG8_BAR
#undef PG8_SCHED
}

struct TileOrder {
    int nM, nN, nwg, G, c;
    __device__ void init(int nM_, int nN_, int G_, int c_) { nM = nM_; nN = nN_; nwg = nM * nN; G = G_; c = c_; }
    __device__ bool tile(int i, int& pm, int& pn) const { return tileL((long)i * G + c, pm, pn); }
    __device__ bool tileL(long L, int& pm, int& pn) const {
        if (L < 0 || L >= nwg) return false;
        int wgid = (int)L; { const int q = nwg / 8, r = nwg % 8, xcd = wgid % 8, off = wgid / 8; wgid = (xcd < r ? xcd * (q + 1) : r * (q + 1) + (xcd - r) * q) + off; }
        const int nig = 4 * nN, gid = wgid / nig, fm = gid * 4, gsz = (nM - fm) < 4 ? (nM - fm) : 4;
        pm = fm + ((wgid % nig) % gsz); pn = (wgid % nig) / gsz; return true;
    }
};
constexpr int P1_CO = 2, P1_NC = P1_CO * 32, P1_NG = 256 - P1_NC, P1_UG = 12, P1_UC = 0, P1_NBF = 20, P1_NF8 = 16;
static_assert(P1_NG * P1_UG + P1_NC * P1_UC == (NTOK / 256) * (NPROJ / 256) && (P1_NBF + P1_NF8) * 256 == NPROJ, "P1 unit deal");
struct ProjSched {
    TileOrder T; const char* A; const char* B; unsigned lda, ldb; int conv, idx;
    __device__ bool next(int i, GUnit& u) const { const long L = conv ? -1 : (long)i * P1_NG + idx; int pm, pn; if (!T.tileL(L, pm, pn)) return false;
        u.pm = pm; u.pn = pn; u.e = 0; u.keep = 0; u.A = A + (size_t)pm * 256 * lda; u.B = B + (size_t)pn * 256 * ldb; return true; }
    __device__ int arow(const GUnit&, int) const { return 0; }
};
struct PlainSched {
    TileOrder T; const char* A; const char* B; unsigned lda, ldb;
    __device__ bool next(int i, GUnit& u) const { int pm, pn; if (!T.tile(i, pm, pn)) return false; u.pm = pm; u.pn = pn; u.e = 0; u.keep = 0;
        u.A = A + (size_t)pm * 256 * lda; u.B = B + (size_t)pn * 256 * ldb; return true; }
    __device__ int arow(const GUnit&, int) const { return 0; }
};

struct EpiProj {
    static constexpr bool PERM = true;
    unsigned char* ws; int pn0; float gsc;
    __device__ __forceinline__ void operator()(f32x4 (&acc)[2][2][4][2], const GUnit& u, int wr, int wc, int fr, int fq) const {
        const int row0 = u.pm * BM + wr * 64 + fr, pn = u.pn + pn0;
        if (pn < 12) {
            static_assert(WS_K - WS_Q == WS_V - WS_K, "q|k|v spacing"); bf16* base = (bf16*)(ws + WS_Q + (size_t)(pn >> 2) * (WS_K - WS_Q)); const int col0 = (pn & 3) * 256 + wc * 32 + 8 * fq;
            float nmax[2] = {0.f, 0.f};
#pragma unroll
            for (int ai = 0; ai < 2; ++ai)
#pragma unroll
                for (int m = 0; m < 4; ++m) { bf16* rowp = base + (size_t)(row0 + ai * HALF + m * 16) * FW + col0;
#pragma unroll
                    for (int bj = 0; bj < 2; ++bj) { const f32x4 v0 = acc[ai][bj][m][0], v1 = acc[ai][bj][m][1];
                        if (pn < 8) { float q2 = (v0[0] * v0[0] + v0[1] * v0[1]) + (v0[2] * v0[2] + v0[3] * v0[3]) + (v1[0] * v1[0] + v1[1] * v1[1]) + (v1[2] * v1[2] + v1[3] * v1[3]);
                            q2 += __shfl_xor(q2, 16); q2 += __shfl_xor(q2, 32); nmax[bj] = fmaxf(nmax[bj], q2); }
                        u32x4 w; w.x = cvt_pk_bf16(v0[0], v0[1]); w.y = cvt_pk_bf16(v0[2], v0[3]); w.z = cvt_pk_bf16(v1[0], v1[1]); w.w = cvt_pk_bf16(v1[2], v1[3]);
                        *(u32x4*)(rowp + bj * HALF) = w; } }
            if (pn < 8) {
#pragma unroll
                for (int bj = 0; bj < 2; ++bj) { float v = nmax[bj]; v = fmaxf(v, __shfl_xor(v, 1)); v = fmaxf(v, __shfl_xor(v, 2)); v = fmaxf(v, __shfl_xor(v, 4)); v = fmaxf(v, __shfl_xor(v, 8));
                    if (fr == 0 && fq == 0) atomicMax((unsigned*)(ws + WS_CTL) + CW_NRM + (((pn >> 2) * 4 + (u.pm >> 4)) * 8 + (pn & 3) * 2 + bj) * 4 + wc, __float_as_uint(v)); }
            }
        } else if (pn < 20) {
            const bool isv = pn >= 16; bf16* base = (bf16*)(ws + WS_ZU + (size_t)(isv ? 1 : 0) * (WS_ZV - WS_ZU)); float* ZST = (float*)(ws + WS_ZST); const int col0 = ((pn - 12) & 3) * 256 + wc * 32 + 8 * fq;
#pragma unroll
            for (int ai = 0; ai < 2; ++ai)
#pragma unroll
                for (int m = 0; m < 4; ++m) { const int row = row0 + ai * HALF + m * 16; bf16* rowp = base + (size_t)row * SGW + col0; float s = 0.f, q = 0.f;
#pragma unroll
                    for (int bj = 0; bj < 2; ++bj) { f32x4 v0 = acc[ai][bj][m][0], v1 = acc[ai][bj][m][1];
                        { const f32x2 a = gelu_tanh2((f32x2){v0[0], v0[1]}), b = gelu_tanh2((f32x2){v0[2], v0[3]}), c = gelu_tanh2((f32x2){v1[0], v1[1]}), d = gelu_tanh2((f32x2){v1[2], v1[3]});
                          v0 = (f32x4){a.x, a.y, b.x, b.y}; v1 = (f32x4){c.x, c.y, d.x, d.y};
                          if (isv) { const f32x2 s2 = (a + b) + (c + d), q2 = (a * a + b * b) + (c * c + d * d); s += s2.x + s2.y; q += q2.x + q2.y; } }
                        u32x4 w; w.x = cvt_pk_bf16(v0[0], v0[1]); w.y = cvt_pk_bf16(v0[2], v0[3]); w.z = cvt_pk_bf16(v1[0], v1[1]); w.w = cvt_pk_bf16(v1[2], v1[3]);
                        *(u32x4*)(rowp + bj * HALF) = w; }
                    if (isv) { s += __shfl_xor(s, 16); s += __shfl_xor(s, 32); q += __shfl_xor(q, 16); q += __shfl_xor(q, 32);
                        if (fq == 0) *(f32x2*)(ZST + (size_t)row * 32 + ((pn - 16) * 4 + wc) * 2) = (f32x2){s, q}; } }
        } else {
            const int col0 = (pn - 20) * 128 + wc * 32 + 8 * fq; bf16* GR = (bf16*)(ws + WS_GR); bf16* GS = (bf16*)(ws + WS_GS);
#pragma unroll
            for (int ai = 0; ai < 2; ++ai)
#pragma unroll
                for (int m = 0; m < 4; ++m) { const size_t off = (size_t)(row0 + ai * HALF + m * 16) * DM + col0; float r[8], sb[8];
#pragma unroll
                    for (int n = 0; n < 2; ++n)
#pragma unroll
                        for (int p = 0; p < 2; ++p) { const f32x2 ya = (f32x2){acc[ai][0][m][n][2 * p], acc[ai][0][m][n][2 * p + 1]} * gsc, yb = (f32x2){acc[ai][1][m][n][2 * p], acc[ai][1][m][n][2 * p + 1]} * gsc;
                            f32x2 ea, eb; ea.x = __builtin_amdgcn_exp2f(ya.x); ea.y = __builtin_amdgcn_exp2f(ya.y); eb.x = __builtin_amdgcn_exp2f(yb.x); eb.y = __builtin_amdgcn_exp2f(yb.y);
                            const f32x2 da = ea + 1.0f, db = eb + 1.0f; f32x2 ra, rb; ra.x = __builtin_amdgcn_rcpf(da.x); ra.y = __builtin_amdgcn_rcpf(da.y); rb.x = __builtin_amdgcn_rcpf(db.x); rb.y = __builtin_amdgcn_rcpf(db.y);
                            const f32x2 rr = db * ra; sb[n * 4 + 2 * p] = rb.x; sb[n * 4 + 2 * p + 1] = rb.y; r[n * 4 + 2 * p] = rr.x; r[n * 4 + 2 * p + 1] = rr.y; }
                    u32x4 w; w.x = cvt_pk_bf16(r[0], r[1]); w.y = cvt_pk_bf16(r[2], r[3]); w.z = cvt_pk_bf16(r[4], r[5]); w.w = cvt_pk_bf16(r[6], r[7]);
                    *(u32x4*)(GR + off) = w;
                    w.x = cvt_pk_bf16(sb[0], sb[1]); w.y = cvt_pk_bf16(sb[2], sb[3]); w.z = cvt_pk_bf16(sb[4], sb[5]); w.w = cvt_pk_bf16(sb[6], sb[7]);
                    *(u32x4*)(GS + off) = w; }
        }
    }
};
struct MergeSched {
    TileOrder T; const char* A; const char* B; unsigned lda, ldb;
    __device__ bool next(int i, GUnit& u) const { int pm, pn; if (!T.tile(i >> 1, pm, pn)) return false; const int half = i & 1; u.pm = pm; u.pn = pn; u.e = 0; u.keep = half ^ 1;
        u.A = A + (size_t)pm * 256 * lda + half * (FW * 2); u.B = B + (size_t)pn * 256 * ldb + half * (FW * 2); return true; }
    __device__ int arow(const GUnit&, int) const { return 0; }
};
struct EpiMerge {
    static constexpr bool PERM = true;
    unsigned char* ws;
    __device__ __forceinline__ void operator()(f32x4 (&acc)[2][2][4][2], const GUnit& u, int wr, int wc, int fr, int fq) const {
        const int row0 = u.pm * BM + wr * 64 + fr, col0 = u.pn * 256 + wc * 32 + 8 * fq;
        const bf16* G = (const bf16*)(ws + (u.keep ? WS_GR : WS_GS)); bf16* MG = (bf16*)(ws + WS_MG);
#pragma unroll
        for (int ai = 0; ai < 2; ++ai) {
            u32x4 gv[4][2];
#pragma unroll
            for (int m = 0; m < 4; ++m)
#pragma unroll
                for (int bj = 0; bj < 2; ++bj) gv[m][bj] = *(const u32x4*)(G + (size_t)(row0 + ai * HALF + m * 16) * DM + col0 + bj * HALF);
#pragma unroll
            for (int m = 0; m < 4; ++m) { const size_t off = (size_t)(row0 + ai * HALF + m * 16) * DM + col0;
#pragma unroll
                for (int bj = 0; bj < 2; ++bj) { const u32x4 g = gv[m][bj];
                    f32x4 v0 = acc[ai][bj][m][0], v1 = acc[ai][bj][m][1];
                    v0[0] *= __builtin_bit_cast(float, g.x << 16); v0[1] *= __builtin_bit_cast(float, g.x & 0xffff0000u); v0[2] *= __builtin_bit_cast(float, g.y << 16); v0[3] *= __builtin_bit_cast(float, g.y & 0xffff0000u);
                    v1[0] *= __builtin_bit_cast(float, g.z << 16); v1[1] *= __builtin_bit_cast(float, g.z & 0xffff0000u); v1[2] *= __builtin_bit_cast(float, g.w << 16); v1[3] *= __builtin_bit_cast(float, g.w & 0xffff0000u);
                    if (u.keep) { acc[ai][bj][m][0] = v0; acc[ai][bj][m][1] = v1; }
                    else { u32x4 w; w.x = cvt_pk_bf16(v0[0], v0[1]); w.y = cvt_pk_bf16(v0[2], v0[3]); w.z = cvt_pk_bf16(v1[0], v1[1]); w.w = cvt_pk_bf16(v1[2], v1[3]); *(u32x4*)(MG + off + bj * HALF) = w; } } } }
    }
};
template <bool RB, bool WF>
struct EpiResid {
    static constexpr bool PERM = true;
    const void* Xi; float* Xo; bf16* Xb; float* SS; unsigned char* Xq;
    __device__ __forceinline__ void operator()(f32x4 (&acc)[2][2][4][2], const GUnit& u, int wr, int wc, int fr, int fq) const {
        const int row0 = u.pm * BM + wr * 64 + fr, col0 = u.pn * 256 + wc * 32 + 8 * fq;
        typedef typename std::conditional<RB, u32x4, f32x4>::type rv_t;
        constexpr int NV = RB ? 1 : 2, GB = 4;
#pragma unroll
        for (int g0 = 0; g0 < 8; g0 += GB) {
            rv_t xr[GB][2][NV];
#pragma unroll
            for (int gg = 0; gg < GB; ++gg) { const int gi = g0 + gg; const size_t offl = (size_t)(row0 + (gi >> 2) * HALF + (gi & 3) * 16) * DM + col0;
#pragma unroll
                for (int bj = 0; bj < 2; ++bj) {
                    if constexpr (RB) xr[gg][bj][0] = *(const u32x4*)((const bf16*)Xi + offl + bj * HALF);
                    else { xr[gg][bj][0] = *(const f32x4*)((const float*)Xi + offl + bj * HALF); xr[gg][bj][NV - 1] = *(const f32x4*)((const float*)Xi + offl + bj * HALF + 4); } } }
#pragma unroll
            for (int gg = 0; gg < GB; ++gg) { const int gi = g0 + gg, ai = gi >> 2, m = gi & 3; const int row = row0 + ai * HALF + m * 16; const size_t off = (size_t)row * DM + col0; float q = 0.f;
#pragma unroll
                for (int bj = 0; bj < 2; ++bj) { const size_t o = off + bj * HALF; f32x4 r0, r1;
                    if constexpr (RB) { const u32x4 r = xr[gg][bj][0];
                        r0 = (f32x4){__builtin_bit_cast(float, r.x << 16), __builtin_bit_cast(float, r.x & 0xffff0000u), __builtin_bit_cast(float, r.y << 16), __builtin_bit_cast(float, r.y & 0xffff0000u)};
                        r1 = (f32x4){__builtin_bit_cast(float, r.z << 16), __builtin_bit_cast(float, r.z & 0xffff0000u), __builtin_bit_cast(float, r.w << 16), __builtin_bit_cast(float, r.w & 0xffff0000u)}; }
                    else { r0 = xr[gg][bj][0]; r1 = xr[gg][bj][NV - 1]; }
                    const f32x4 v0 = r0 + acc[ai][bj][m][0], v1 = r1 + acc[ai][bj][m][1];
                    if constexpr (WF) { *(f32x4*)(Xo + o) = v0; *(f32x4*)(Xo + o + 4) = v1; }
                    q += ((v0[0] * v0[0] + v0[1] * v0[1]) + (v0[2] * v0[2] + v0[3] * v0[3])) + ((v1[0] * v1[0] + v1[1] * v1[1]) + (v1[2] * v1[2] + v1[3] * v1[3]));
                    if (Xb) { u32x4 w; w.x = cvt_pk_bf16(v0[0], v0[1]); w.y = cvt_pk_bf16(v0[2], v0[3]); w.z = cvt_pk_bf16(v1[0], v1[1]); w.w = cvt_pk_bf16(v1[2], v1[3]); *(u32x4*)(Xb + o) = w; }
                    if (Xq) { u32x2 w8; w8.x = pk4_fp8(v0[0], v0[1], v0[2], v0[3]); w8.y = pk4_fp8(v1[0], v1[1], v1[2], v1[3]); *(u32x2*)(Xq + o) = w8; } }
                q += __shfl_xor(q, 16); q += __shfl_xor(q, 32);
                if (fq == 0) SS[(size_t)row * 32 + u.pn * 4 + wc] = q; }
        }
    }
};
struct QkvSched {
    const char* X1B; const char* WXQ; const char* HM; const char* WXKV; int c;
    __device__ bool next(int i, GUnit& u) const { if (i > 0 || c >= 144) return false; u.keep = 0;
        if (c < 128) { u.e = 0; u.pm = c >> 1; u.pn = c & 1; u.A = X1B + (size_t)u.pm * 256 * (DM * 2); u.B = WXQ + (size_t)u.pn * 256 * (DM * 2); }
        else { const int j = c - 128; u.e = 1; u.pm = j >> 2; u.pn = j & 3; u.A = HM + (size_t)u.pm * 256 * (DM * 2); u.B = WXKV + (size_t)u.pn * 256 * (DM * 2); }
        return true; }
    __device__ int arow(const GUnit&, int) const { return 0; }
};
struct EpiQkv {
    static constexpr bool PERM = true;
    unsigned char* ws;
    __device__ __forceinline__ void operator()(f32x4 (&acc)[2][2][4][2], const GUnit& u, int wr, int wc, int fr, int fq) const {
        const int row0 = u.pm * BM + wr * 64 + fr; const float* SS = (const float*)(ws + WS_SS1);
        bf16* base = u.e ? (bf16*)(ws + WS_KX + (size_t)(u.pn >> 1) * (WS_VX - WS_KX)) + (u.pn & 1) * 256 : (bf16*)(ws + WS_QX) + u.pn * 256;
        float rsv[8];
#pragma unroll
        for (int gi = 0; gi < 8; ++gi) rsv[gi] = 1.f;
        if (!u.e) { f32x4 pp[8][2];
#pragma unroll
            for (int gi = 0; gi < 8; ++gi) { const int row = row0 + (gi >> 2) * HALF + (gi & 3) * 16; pp[gi][0] = *(const f32x4*)(SS + (size_t)row * 32 + fq * 8); pp[gi][1] = *(const f32x4*)(SS + (size_t)row * 32 + fq * 8 + 4); }
#pragma unroll
            for (int gi = 0; gi < 8; ++gi) { const f32x4 p0 = pp[gi][0], p1 = pp[gi][1];
                float q = ((p0[0] + p0[1]) + (p0[2] + p0[3])) + ((p1[0] + p1[1]) + (p1[2] + p1[3])); q += __shfl_xor(q, 16); q += __shfl_xor(q, 32); rsv[gi] = rsqrtf(q * (1.f / DM) + RMS_EPS); } }
#pragma unroll
        for (int ai = 0; ai < 2; ++ai)
#pragma unroll
            for (int m = 0; m < 4; ++m) { const int row = row0 + ai * HALF + m * 16; const float rs = rsv[ai * 4 + m];
                bf16* rowp = base + (size_t)row * XW + wc * 32 + 8 * fq;
#pragma unroll
                for (int bj = 0; bj < 2; ++bj) { const f32x4 v0 = acc[ai][bj][m][0] * rs, v1 = acc[ai][bj][m][1] * rs;
                    u32x4 w; w.x = cvt_pk_bf16(v0[0], v0[1]); w.y = cvt_pk_bf16(v0[2], v0[3]); w.z = cvt_pk_bf16(v1[0], v1[1]); w.w = cvt_pk_bf16(v1[2], v1[3]);
                    *(u32x4*)(rowp + bj * HALF) = w; } }
    }
};
struct MoeSched {
    const LAS int* tab; const char* A; const char* B; const int* TOKL; int G, c, npn; unsigned ldb; size_t erows;
    __device__ bool next(int i, GUnit& u) const {
        const int x = c & 7, j = c >> 3; const int T = npn == 16 ? i * 16 + 4 * (x >> 1) + (j & 3) : i * 32 + 4 * x + (j & 3); const int pnl = npn == 16 ? 8 * (x & 1) + (j >> 2) : (j >> 2);
        if (T >= tab[32]) return false;
        int e = 0;
#pragma unroll 1
        for (int j = 1; j < 32; ++j) e += (tab[j] <= T) ? 1 : 0;
        u.e = e; u.pm = T; u.pn = pnl; u.keep = 0; u.A = A; u.B = B + ((size_t)e * erows + (size_t)u.pn * 256) * ldb; return true; }
    __device__ int arow(const GUnit& u, int r) const { const int rank = (u.pm - tab[u.e]) * 256 + r; return rank < tab[40 + u.e] ? TOKL[(size_t)u.e * NTOK + rank] : 0; }
};
struct DownSched : MoeSched {
    unsigned lda;
    __device__ bool next(int i, GUnit& u) const { if (!MoeSched::next(i, u)) return false; u.A = A + (size_t)u.pm * 256 * lda; return true; }
};
struct EpiAct {
    static constexpr bool PERM = true;
    unsigned char* ws; const LAS int* tab; const float* bgu;
    __device__ __forceinline__ void operator()(f32x4 (&acc)[2][2][4][2], const GUnit& u, int wr, int wc, int fr, int fq) const {
        const int r0 = wr * 64 + fr, j0 = u.pn * 128 + wc * 32 + 8 * fq, rbase = (u.pm - tab[u.e]) * 256, cnt = tab[40 + u.e];
        const int* TOKL = (const int*)(ws + WS_TOKL) + (size_t)u.e * NTOK; const float* RS2 = (const float*)(ws + WS_RS2); unsigned char* HB = ws + WS_HB;
        const float* bg = bgu + (size_t)u.e * 2 * DFF + j0;
        const f32x4 bg0 = *(const f32x4*)bg, bg1 = *(const f32x4*)(bg + 4), bu0 = *(const f32x4*)(bg + DFF), bu1 = *(const f32x4*)(bg + DFF + 4);
        float rsv[8]; const float* RSL = (const float*)(ws + WS_RSL) + (size_t)u.e * NTOK;
#pragma unroll
        for (int gi = 0; gi < 8; ++gi) { const int rank = rbase + r0 + (gi >> 2) * HALF + (gi & 3) * 16; rsv[gi] = rank < cnt ? RSL[rank] : 0.f; }
#pragma unroll
        for (int ai = 0; ai < 2; ++ai)
#pragma unroll
            for (int m = 0; m < 4; ++m) { const int r = r0 + ai * HALF + m * 16; const float rs = rsv[ai * 4 + m] * W8_INV;
                float a[8];
#pragma unroll
                for (int n = 0; n < 2; ++n)
#pragma unroll
                    for (int p = 0; p < 2; ++p) { const f32x2 rs2 = (f32x2){rs, rs};
                        const f32x2 bg2 = n ? (f32x2){bg1[2 * p], bg1[2 * p + 1]} : (f32x2){bg0[2 * p], bg0[2 * p + 1]}, bu2 = n ? (f32x2){bu1[2 * p], bu1[2 * p + 1]} : (f32x2){bu0[2 * p], bu0[2 * p + 1]};
                        f32x2 g2 = (f32x2){acc[ai][0][m][n][2 * p], acc[ai][0][m][n][2 * p + 1]} * rs2 + bg2, u2 = (f32x2){acc[ai][1][m][n][2 * p], acc[ai][1][m][n][2 * p + 1]} * rs2 + bu2;
                        g2.x = fminf(g2.x, SW_LIMIT); g2.y = fminf(g2.y, SW_LIMIT); u2.x = __builtin_amdgcn_fmed3f(u2.x, -SW_LIMIT, SW_LIMIT); u2.y = __builtin_amdgcn_fmed3f(u2.y, -SW_LIMIT, SW_LIMIT);
                        const f32x2 y2 = g2 * (-1.4426950408889634f * SW_ALPHA); f32x2 e2; e2.x = __builtin_amdgcn_exp2f(y2.x); e2.y = __builtin_amdgcn_exp2f(y2.y);
                        const f32x2 d2 = e2 + 1.0f; f32x2 r2; r2.x = __builtin_amdgcn_rcpf(d2.x); r2.y = __builtin_amdgcn_rcpf(d2.y);
                        const f32x2 o2 = ((u2 + 1.0f) * g2) * r2; a[n * 4 + 2 * p] = o2.x; a[n * 4 + 2 * p + 1] = o2.y; }
                u32x2 w; w.x = pk4_fp8_nc(a[0], a[1], a[2], a[3]); w.y = pk4_fp8_nc(a[4], a[5], a[6], a[7]);
                *(u32x2*)(HB + (size_t)(u.pm * 256 + r) * DFF + j0) = w; }
    }
};
struct EpiDown {
    static constexpr bool PERM = true;
    unsigned char* ws; const LAS int* tab; const float* bd;
    __device__ __forceinline__ void operator()(f32x4 (&acc)[2][2][4][2], const GUnit& u, int wr, int wc, int fr, int fq) const {
        const int r0 = wr * 64 + fr, c0 = u.pn * 256 + wc * 32 + 8 * fq, rbase = (u.pm - tab[u.e]) * 256;
        const float* GWL = (const float*)(ws + WS_GWL) + (size_t)u.e * NTOK; unsigned char* YB = ws + WS_YB;
        const float* b = bd + (size_t)u.e * DM + c0;
        f32x4 bv[2][2];
#pragma unroll
        for (int bj = 0; bj < 2; ++bj) { bv[bj][0] = *(const f32x4*)(b + bj * HALF); bv[bj][1] = *(const f32x4*)(b + bj * HALF + 4); }
        float gwv[8];
#pragma unroll
        for (int gi = 0; gi < 8; ++gi) gwv[gi] = GWL[rbase + r0 + (gi >> 2) * HALF + (gi & 3) * 16];
#pragma unroll
        for (int ai = 0; ai < 2; ++ai)
#pragma unroll
            for (int m = 0; m < 4; ++m) { const int r = r0 + ai * HALF + m * 16; const float gw = gwv[ai * 4 + m];
#pragma unroll
                for (int bj = 0; bj < 2; ++bj) { const f32x4 v0 = (acc[ai][bj][m][0] * W8_INV + bv[bj][0]) * gw, v1 = (acc[ai][bj][m][1] * W8_INV + bv[bj][1]) * gw;
                    u32x2 w; w.x = pk4_fp8(v0[0], v0[1], v0[2], v0[3]); w.y = pk4_fp8(v1[0], v1[1], v1[2], v1[3]);
                    *(u32x2*)(YB + (size_t)(u.pm * 256 + r) * DM + c0 + bj * HALF) = w; } }
    }
};
}

struct KArgs { const float* in[25]; float* out; unsigned char* ws; int ph_lo, ph_hi, li, pad; };
struct Frame {
    LAS unsigned char* lds; volatile LAS unsigned* MISC; unsigned* ctl; unsigned char* ws;
    int tid, lane, wave, G, gw, NGW;
};

struct CvtDesc { const float* W; const float* g; bf16* dst0; size_t ldw, dld; int srccol, k0src, k0dst, f8; };
__device__ __forceinline__ void cvt_load(const CvtDesc& d, float (&v)[64], float& gv, int lane) {
    const float* rowp = d.W + (size_t)d.k0src * d.ldw;
    const unsigned col = (unsigned)d.srccol;
#pragma unroll
    for (int i = 0; i < 64; ++i) { v[i] = rowp[col]; rowp += d.ldw; }
    const float* gp = d.g ? d.g : d.W;
    const float gl = gp[d.k0src + lane]; gv = d.g ? gl : 1.f;
}
__device__ __forceinline__ void cvt_store(const CvtDesc& d, float (&v)[64], float gv, LAS unsigned char* tile, int lane) {
    if (d.f8) gv *= W8_SCALE;
#pragma unroll
    for (int i = 0; i < 64; ++i) v[i] *= __builtin_bit_cast(float, __builtin_amdgcn_readlane(__builtin_bit_cast(int, gv), i));
    if (d.f8) {
#pragma unroll
        for (int j = 0; j < 4; ++j) { u32x4 w; w.x = pk4_fp8(v[16 * j], v[16 * j + 1], v[16 * j + 2], v[16 * j + 3]); w.y = pk4_fp8(v[16 * j + 4], v[16 * j + 5], v[16 * j + 6], v[16 * j + 7]);
            w.z = pk4_fp8(v[16 * j + 8], v[16 * j + 9], v[16 * j + 10], v[16 * j + 11]); w.w = pk4_fp8(v[16 * j + 12], v[16 * j + 13], v[16 * j + 14], v[16 * j + 15]);
            *(LAS u32x4*)(tile + lane * 80 + j * 16) = w; }
        asm volatile("s_waitcnt lgkmcnt(0)" ::: "memory");
#pragma unroll
        for (int j = 0; j < 4; ++j) { const int r = 16 * j + (lane >> 2), c = lane & 3; const u32x4 w = *(const LAS u32x4*)(tile + r * 80 + c * 16);
            *(u32x4*)((unsigned char*)d.dst0 + (size_t)r * d.dld + d.k0dst + 16 * c) = w; }
        asm volatile("s_waitcnt lgkmcnt(0)" ::: "memory");
        return;
    }
#pragma unroll
    for (int j = 0; j < 8; ++j) { u32x4 w; w.x = cvt_pk_bf16(v[8 * j], v[8 * j + 1]); w.y = cvt_pk_bf16(v[8 * j + 2], v[8 * j + 3]); w.z = cvt_pk_bf16(v[8 * j + 4], v[8 * j + 5]); w.w = cvt_pk_bf16(v[8 * j + 6], v[8 * j + 7]);
        *(LAS u32x4*)(tile + lane * 144 + j * 16) = w; }
    asm volatile("s_waitcnt lgkmcnt(0)" ::: "memory");
#pragma unroll
    for (int j = 0; j < 8; ++j) { const int r = 8 * j + (lane >> 3), c = lane & 7; const u32x4 w = *(const LAS u32x4*)(tile + r * 144 + c * 16);
        *(u32x4*)(d.dst0 + (size_t)r * d.dld + d.k0dst + 8 * c) = w; }
    asm volatile("s_waitcnt lgkmcnt(0)" ::: "memory");
}
__device__ __forceinline__ int wp_srccol(int d) {
    if (d < 3072) return d;
    if (d < 5120) return d + 8;
    const int t = d - 5120, tile = t >> 8, r = t & 255, j = tile * 128 + (r & 127);
    return (r < 128 ? C_GA : C_GB) + j;
}
struct Cvt8Desc { const float* W; const float* g; unsigned char* dst; size_t ldw; int k0, col0a, col0b; };
__device__ __forceinline__ void cvt8_load(const Cvt8Desc& d, f32x4 (&v)[16], float& gv, int wave, int lane) {
    const float* rowp = d.W + (size_t)(d.k0 + 8 * wave) * d.ldw;
#pragma unroll
    for (int i = 0; i < 8; ++i) { v[2 * i] = __builtin_nontemporal_load((const f32x4*)(rowp + d.col0a)); v[2 * i + 1] = __builtin_nontemporal_load((const f32x4*)(rowp + d.col0b)); rowp += d.ldw; }
    const float* gp = d.g ? d.g : d.W; const float gl = gp[d.k0 + 8 * wave + (lane & 7)]; gv = d.g ? gl * W8_SCALE : W8_SCALE;
}
__device__ __forceinline__ void cvt8_pack(f32x4 (&v)[16], float gv, LAS unsigned char* lds, int sub, int wave, int lane) {
    float gs[8];
#pragma unroll
    for (int i = 0; i < 8; ++i) gs[i] = __builtin_bit_cast(float, __builtin_amdgcn_readlane(__builtin_bit_cast(int, gv), i));
#pragma unroll
    for (int hf = 0; hf < 2; ++hf) { u32x4 w[2];
#pragma unroll
        for (int j = 0; j < 4; ++j) { const unsigned lo = pk4_fp8(v[0 + hf][j] * gs[0], v[2 + hf][j] * gs[1], v[4 + hf][j] * gs[2], v[6 + hf][j] * gs[3]), hi = pk4_fp8(v[8 + hf][j] * gs[4], v[10 + hf][j] * gs[5], v[12 + hf][j] * gs[6], v[14 + hf][j] * gs[7]);
            if (j & 1) { w[j >> 1].z = lo; w[j >> 1].w = hi; } else { w[j >> 1].x = lo; w[j >> 1].y = hi; } }
        const int sw = 8 * sub + 2 * (wave >> 1);
        LAS unsigned char* p = lds + sub * 32768 + wave * 4096 + ((hf * 256 + 4 * lane) ^ (sw & 28)) * 8;
        *(LAS u32x4*)(p + 8 * (sw & 2)) = w[0]; *(LAS u32x4*)(p + 16 - 8 * (sw & 2)) = w[1]; }
}
__device__ __forceinline__ void cvt8_flush(unsigned char* dst, LAS unsigned char* lds, int tid) {
    asm volatile("s_waitcnt lgkmcnt(0)\n\ts_barrier" ::: "memory");
#pragma unroll 4
    for (int ps = 0; ps < 16; ++ps) { const int r = ps * 32 + (tid >> 4), p = tid & 15, j = p >> 2, pc = p & 3;
        const int rs = (r ^ (8 * j + 2 * pc)) * 8;
        const u32x2 a0 = *(const LAS u32x2*)(lds + j * 32768 + (2 * pc) * 4096 + rs), a1 = *(const LAS u32x2*)(lds + j * 32768 + (2 * pc + 1) * 4096 + rs);
        __builtin_nontemporal_store((u32x4){a0.x, a0.y, a1.x, a1.y}, (u32x4*)(dst + (size_t)r * DM + 16 * p)); }
    asm volatile("s_waitcnt lgkmcnt(0)\n\ts_barrier" ::: "memory");
}
constexpr int CVT8_SUPER = NE * 8 * 8 + NE * 8 * 4, CVT8_P1_SUPER = 1840;
__device__ __forceinline__ void cvt8_phase(const Frame& F, const KArgs& a, const int bit, const int nb, const int s_lo, const int s_hi) {
    unsigned char* ws = F.ws; const int lane = F.lane, wave = F.wave, tid = F.tid;
    constexpr int S_WGU = NE * 8 * 8;
    auto decode = [&](int s, int j) -> Cvt8Desc {
        Cvt8Desc D;
        if (s < S_WGU) { const int e = s / 64, rr = s % 64, kb4 = rr / 8, cb = rr % 8, kb = kb4 * 4 + j;
            const int da = 4 * lane, db = 256 + 4 * lane;
            D.W = a.in[20] + (size_t)e * DM * 2 * DFF; D.g = a.in[17]; D.ldw = 2 * DFF; D.k0 = kb * 64;
            D.col0a = ((da & 255) < 128 ? 0 : DFF) + (cb * 2 + (da >> 8)) * 128 + (da & 127); D.col0b = ((db & 255) < 128 ? 0 : DFF) + (cb * 2 + (db >> 8)) * 128 + (db & 127);
            D.dst = ws + WS_WGU + ((size_t)e * 2 * DFF + cb * 512) * DM + kb4 * 256; return D; }
        s -= S_WGU;
        { const int e = s / 32, rr = s % 32, kb4 = rr / 4, cb = rr % 4, kb = kb4 * 4 + j;
            D.W = a.in[22] + (size_t)e * DFF * DM; D.g = nullptr; D.ldw = DM; D.k0 = kb * 64; D.col0a = cb * 512 + 4 * lane; D.col0b = cb * 512 + 256 + 4 * lane;
            D.dst = ws + WS_WD + ((size_t)e * DM + cb * 512) * DFF + kb4 * 256; return D; }
    };
    f32x4 va[16], vb[16]; float ga = 1.f, gb = 1.f;
    int sidx = s_lo + bit;
    if (sidx < s_hi) { Cvt8Desc d0 = decode(sidx, 0); cvt8_load(d0, va, ga, wave, lane); }
    while (sidx < s_hi) {
        const int snext = sidx + nb; const bool more = snext < s_hi;
        { Cvt8Desc d1 = decode(sidx, 1); cvt8_load(d1, vb, gb, wave, lane); } cvt8_pack(va, ga, F.lds, 0, wave, lane);
        { Cvt8Desc d2 = decode(sidx, 2); cvt8_load(d2, va, ga, wave, lane); } cvt8_pack(vb, gb, F.lds, 1, wave, lane);
        { Cvt8Desc d3 = decode(sidx, 3); cvt8_load(d3, vb, gb, wave, lane); } cvt8_pack(va, ga, F.lds, 2, wave, lane);
        { Cvt8Desc dn = decode(more ? snext : sidx, 0); cvt8_load(dn, va, ga, wave, lane); } cvt8_pack(vb, gb, F.lds, 3, wave, lane);
        cvt8_flush(decode(sidx, 0).dst, F.lds, tid);
        sidx = snext;
    }
    asm volatile("s_waitcnt vmcnt(0)" ::: "memory"); __syncthreads();
}
template <int STAGE>
__device__ __forceinline__ void p0_prologue(const Frame& F, const KArgs& a, const int w0, const int nw) {
    unsigned char* ws = F.ws; const int lane = F.lane;
    constexpr int I_WP = (NPROJ / 64) * 32, I_WAB = 32 * 32, I_WO = 32 * 32, I_WXQ = 8 * 32, I_WXKV = 16 * 32, I_WXO = 32 * 8, I_WGU = NE * 64 * 32, I_WD = NE * 32 * 32;
    constexpr int NITEMS = I_WP + I_WAB + I_WO + I_WXQ + I_WXKV + I_WXO + I_WGU + I_WD;
    LAS float* wf = (LAS float*)F.lds;
    LAS unsigned char* tile = F.lds + F.wave * 9216;
    auto decode = [&](int it) -> CvtDesc {
        CvtDesc D; int r = it; D.g = nullptr; D.f8 = 0;
        if (r < I_WP) { const int kb = r / (NPROJ / 64), db = r % (NPROJ / 64), d = db * 64 + lane;
            D.W = a.in[3]; D.ldw = INC; D.srccol = wp_srccol(d); D.k0src = kb * 64; D.k0dst = kb * 64; D.dld = DM;
            if (db * 64 >= 5120) { D.f8 = 1; D.dst0 = (bf16*)(ws + WS_WPG + (size_t)(db * 64 - 5120) * DM); } else D.dst0 = (bf16*)(ws + WS_WP) + (size_t)db * 64 * DM;
            return D; } r -= I_WP;
        if (r < I_WAB) { const int kb = r / 32, db = r % 32, d = db * 64 + lane;
            D.W = kb < 16 ? a.in[9] : a.in[10]; D.ldw = DM; D.srccol = d; D.dst0 = (bf16*)(ws + WS_WAB) + (size_t)db * 64 * DM; D.dld = DM; D.k0src = (kb & 15) * 64; D.k0dst = kb * 64; return D; } r -= I_WAB;
        if (r < I_WO) { const int kb = r / 32, db = r % 32, d = db * 64 + lane;
            D.W = a.in[11]; D.ldw = DM; D.srccol = d; D.dst0 = (bf16*)(ws + WS_WO) + (size_t)db * 64 * DM; D.dld = DM; D.k0src = kb * 64; D.k0dst = kb * 64; return D; } r -= I_WO;
        if (r < I_WXQ) { const int kb = r / 8, db = r % 8, d = db * 64 + lane;
            D.W = a.in[14]; D.g = a.in[12]; D.ldw = XW; D.srccol = d; D.dst0 = (bf16*)(ws + WS_WXQ) + (size_t)db * 64 * DM; D.dld = DM; D.k0src = kb * 64; D.k0dst = kb * 64; return D; } r -= I_WXQ;
        if (r < I_WXKV) { const int kb = r / 16, db = r % 16, d = db * 64 + lane;
            D.W = a.in[15]; D.ldw = 2 * XW; D.srccol = d; D.dst0 = (bf16*)(ws + WS_WXKV) + (size_t)db * 64 * DM; D.dld = DM; D.k0src = kb * 64; D.k0dst = kb * 64; return D; } r -= I_WXKV;
        if (r < I_WXO) { const int kb = r / 32, db = r % 32, d = db * 64 + lane;
            D.W = a.in[16]; D.ldw = DM; D.srccol = d; D.dst0 = (bf16*)(ws + WS_WXO) + (size_t)db * 64 * XW; D.dld = XW; D.k0src = kb * 64; D.k0dst = kb * 64; return D; } r -= I_WXO;
        if (r < I_WGU) { const int e = r / (64 * 32), rr = r % (64 * 32), kb = rr / 64, db = rr % 64, d = db * 64 + lane;
            const int t256 = d >> 8, q = d & 255;
            D.W = a.in[20] + (size_t)e * DM * 2 * DFF; D.g = a.in[17]; D.ldw = 2 * DFF; D.srccol = (q < 128 ? 0 : DFF) + t256 * 128 + (q & 127); D.f8 = 1; D.dst0 = (bf16*)(ws + WS_WGU + ((size_t)e * 2 * DFF + db * 64) * DM); D.dld = DM; D.k0src = kb * 64; D.k0dst = kb * 64; return D; } r -= I_WGU;
        { const int e = r / (32 * 32), rr = r % (32 * 32), kb = rr / 32, db = rr % 32, d = db * 64 + lane;
            D.W = a.in[22] + (size_t)e * DFF * DM; D.ldw = DM; D.srccol = d; D.f8 = 1; D.dst0 = (bf16*)(ws + WS_WD + ((size_t)e * DM + db * 64) * DFF); D.dld = DFF; D.k0src = kb * 64; D.k0dst = kb * 64; return D; }
    };
    {
        float va[64], vb[64], ga = 1.f, gb = 1.f;
        constexpr int I_SMALL = I_WP + I_WAB + I_WO + I_WXQ + I_WXKV + I_WXO;
        const int IT_END = STAGE == 0 ? I_SMALL : NITEMS;
        int it = (STAGE == 0 ? 0 : I_SMALL) + w0;
        CvtDesc da = decode(it < IT_END ? it : 0), db_;
        cvt_load(da, va, ga, lane);
        while (it < IT_END) {
            const int it1 = it + nw, it2 = it + 2 * nw;
            db_ = decode(it1 < IT_END ? it1 : 0);
            cvt_load(db_, vb, gb, lane);
            cvt_store(da, va, ga, tile, lane);
            if (it1 >= IT_END) break;
            da = decode(it2 < IT_END ? it2 : 0);
            cvt_load(da, va, ga, lane);
            cvt_store(db_, vb, gb, tile, lane);
            it = it2;
        }
    }
    if constexpr (STAGE == 1) { asm volatile("s_waitcnt vmcnt(0)" ::: "memory"); __syncthreads(); return; }
    for (int i = F.gw * 64 + lane; i < DM * NE; i += F.NGW * 64) { const int k = i >> 5, e = i & 31; ((float*)(ws + WS_WRT))[(size_t)e * DM + k] = a.in[17][k] * a.in[18][i]; }
    __syncthreads();
    for (int i = F.tid; i < DM * 8; i += NTHREADS) wf[i] = a.in[3][(size_t)(i >> 3) * INC + C_F + (i & 7)];
    __syncthreads();
    for (int row = F.gw; row < NTOK + NMEM; row += F.NGW) {
        const bool ismem = row >= NTOK; const int r = ismem ? row - NTOK : row;
        const float* xr = (ismem ? a.in[1] : a.in[0]) + (size_t)r * DM; const float* g = ismem ? a.in[13] : a.in[2];
        bf16* orow = (bf16*)(ws + (ismem ? WS_HM : WS_H0)) + (size_t)r * DM;
        f32x4 v[8]; float s = 0.f;
#pragma unroll
        for (int j = 0; j < 8; ++j) { v[j] = ((const f32x4*)xr)[lane + 64 * j]; s += (v[j][0] * v[j][0] + v[j][1] * v[j][1]) + (v[j][2] * v[j][2] + v[j][3] * v[j][3]); }
        const float rstd = rsqrtf(wave_sum(s) * (1.f / DM) + RMS_EPS);
        float f[8];
#pragma unroll
        for (int j = 0; j < 8; ++j) f[j] = 0.f;
#pragma unroll
        for (int j = 0; j < 8; ++j) { const f32x4 gg = ((const f32x4*)g)[lane + 64 * j]; v[j] = v[j] * rstd * gg;
            u32x2 w; w.x = cvt_pk_bf16(v[j][0], v[j][1]); w.y = cvt_pk_bf16(v[j][2], v[j][3]); *(u32x2*)(orow + 4 * (lane + 64 * j)) = w;
            if (!ismem) { *(unsigned*)(ws + WS_H0Q + (size_t)r * DM + 4 * (lane + 64 * j)) = pk4_fp8(v[j][0], v[j][1], v[j][2], v[j][3]);
#pragma unroll
                for (int c = 0; c < 4; ++c) { const LAS f32x4* wk = (const LAS f32x4*)(wf + (4 * (lane + 64 * j) + c) * 8); const f32x4 w0 = wk[0], w1 = wk[1];
                    f[0] += v[j][c] * w0[0]; f[1] += v[j][c] * w0[1]; f[2] += v[j][c] * w0[2]; f[3] += v[j][c] * w0[3];
                    f[4] += v[j][c] * w1[0]; f[5] += v[j][c] * w1[1]; f[6] += v[j][c] * w1[2]; f[7] += v[j][c] * w1[3]; } } }
        if (!ismem) {
            float mine = 0.f;
#pragma unroll
            for (int j = 0; j < 8; ++j) { const float t = wave_sum(f[j]); if (lane == j) mine = t; }
            if (lane < 8) ((float*)(ws + WS_LOGF))[(size_t)r * 8 + lane] = log_sigmoid(mine + a.in[4][lane]);
        }
    }
}
__device__ __forceinline__ void cumsum_wave(const float* LOGF, float* CB, int bh, int lane) {
    const int b = bh / FH, h = bh % FH; float loc = 0.f;
    for (int i = 0; i < 64; ++i) loc += LOGF[(size_t)(b * SEQ + lane * 64 + i) * 8 + h];
    float inc = loc;
#pragma unroll
    for (int o = 1; o < 64; o <<= 1) { const float n = __shfl_up(inc, o); if (lane >= o) inc += n; }
    float run = inc - loc;
    for (int i = 0; i < 64; ++i) { run += LOGF[(size_t)(b * SEQ + lane * 64 + i) * 8 + h]; CB[(size_t)bh * SEQ + lane * 64 + i] = -run * 11.313708498984761f; }
}

namespace att {
constexpr int D = 128; constexpr float THR = 8.f; constexpr bool WSKIP = false;
constexpr float SCALE = 0.08838834764831845f;
constexpr int NW = 8, QBLK = 32, KVBLK = 64, QB = NW * QBLK;
constexpr int SHM_V = KVBLK * D * 2, SHM_K = KVBLK * D * 2;
constexpr int LDS_BYTES = 2 * SHM_V + 2 * SHM_K + NW * 64 * 4;
constexpr int BIAS_OFF = LDS_BYTES;

typedef short s16x4 __attribute__((ext_vector_type(4)));
typedef float f32x16 __attribute__((ext_vector_type(16)));
template <class A, class Bt> struct same_t { static constexpr bool v = false; };
template <class A> struct same_t<A, A> { static constexpr bool v = true; };

#define KSWZ(row, colB) ((row) * 256 + ((colB) ^ (((row) & 7) << 4)))
#define SBAR() __builtin_amdgcn_sched_barrier(0)
__device__ __forceinline__ int v_st(int k, int c) { const int kk = (k & ~0xC) | ((k & 4) << 1) | ((k & 8) >> 1); return ((kk >> 3) * 4 + (c >> 5)) * 512 + ((kk & 7) * 32 + (c & 31)) * 2; }
__device__ __forceinline__ int v_rd_base(int lane) { return ((lane & 3) << 3) | (((lane >> 2) & 3) << 6) | (((lane >> 4) & 1) << 5) | (((lane >> 5) & 1) << 8); }
constexpr int v_rd_off(int d0, int ks, int half) { return d0 * 512 + ks * 4096 + half * 2048; }
__device__ __forceinline__ int crow(int r, int hi) { return (r & 3) + 8 * (r >> 2) + 4 * hi; }
__device__ __forceinline__ unsigned cvtpk(float lo, float hi) {
    unsigned r; asm volatile("v_cvt_pk_bf16_f32 %0, %1, %2" : "=v"(r) : "v"(lo), "v"(hi)); return r;
}
__device__ __forceinline__ bf16x8 pack8(f32x4 a, f32x4 b) {
    u32x4 w = {cvtpk(a[0], a[1]), cvtpk(a[2], a[3]), cvtpk(b[0], b[1]), cvtpk(b[2], b[3])};
    return *reinterpret_cast<bf16x8*>(&w);
}
template <class T> __device__ __forceinline__ bf16x8 load8(const T* p) {
    if constexpr (same_t<T, float>::v) { return pack8(*(const f32x4*)p, *(const f32x4*)(p + 4)); }
    else { return *reinterpret_cast<const bf16x8*>(p); }
}
__device__ __forceinline__ void mask_tile(f32x16& p0, f32x16& p1, int dq, unsigned W) {
    const float NEG = -__builtin_inff();
#pragma unroll
    for (int r = 0; r < 16; ++r) {
        const int c = (r & 3) + 8 * (r >> 2);
        if ((unsigned)(dq - c) >= W) p0[r] = NEG;
        if ((unsigned)(dq - c - 32) >= W) p1[r] = NEG;
    }
}
__device__ __forceinline__ void partialSM(f32x16& p0, f32x16& p1, float& m_reg, float& mn, float& alpha) {
    float pmax = p0[0]; for (int r = 1; r < 16; ++r) pmax = fmaxf(pmax, p0[r]); for (int r = 0; r < 16; ++r) pmax = fmaxf(pmax, p1[r]);
    { auto rr = __builtin_amdgcn_permlane32_swap(__float_as_uint(pmax), __float_as_uint(pmax), false, false);
      pmax = fmaxf(__uint_as_float(rr[0]), __uint_as_float(rr[1])); }
    constexpr float C2 = 1.4426950408889634f * SCALE;
    if (__builtin_expect(__all((pmax - m_reg) * SCALE <= THR), 1)) { mn = m_reg; alpha = 1.f; }
    else { mn = fmaxf(m_reg, pmax); alpha = __builtin_amdgcn_exp2f((m_reg - mn) * C2); m_reg = mn; }
    const float mnL = -mn * C2;
    for (int r = 0; r < 16; ++r) p0[r] = fmaf(p0[r], C2, mnL); for (int r = 0; r < 16; ++r) p1[r] = fmaf(p1[r], C2, mnL);
    for (int r = 0; r < 16; ++r) p0[r] = __builtin_amdgcn_exp2f(p0[r]);
}
__device__ __forceinline__ void finishSM(f32x16& p0, f32x16& p1, float alpha, float& l_reg, bf16x8& pa0, bf16x8& pa1, bf16x8& pa2, bf16x8& pa3) {
    for (int r = 0; r < 16; ++r) p1[r] = __builtin_amdgcn_exp2f(p1[r]);
    float ps = 0; for (int r = 0; r < 16; ++r) ps += p0[r]; for (int r = 0; r < 16; ++r) ps += p1[r];
    { auto rr = __builtin_amdgcn_permlane32_swap(__float_as_uint(ps), __float_as_uint(ps), false, false);
      ps = __uint_as_float(rr[0]) + __uint_as_float(rr[1]); }
    l_reg = l_reg * alpha + ps;
#define PK4(P, B_, OUT) do { unsigned a0 = cvtpk(P[B_+0], P[B_+1]), a1 = cvtpk(P[B_+2], P[B_+3]);                          \
        unsigned b0 = cvtpk(P[B_+4], P[B_+5]), b1 = cvtpk(P[B_+6], P[B_+7]);                                             \
        auto r0 = __builtin_amdgcn_permlane32_swap(a0, b0, false, false); auto r1 = __builtin_amdgcn_permlane32_swap(a1, b1, false, false); \
        u32x4 w = {r0[0], r1[0], r0[1], r1[1]}; OUT = *reinterpret_cast<bf16x8*>(&w); } while (0)
    PK4(p0, 0, pa0); PK4(p0, 8, pa1); PK4(p1, 0, pa2); PK4(p1, 8, pa3);
#undef PK4
}
template <int KB, bool SK, bool BIAS>
__device__ __forceinline__ void qkt(f32x16& p0, f32x16& p1, const char* K_lds, int r32, int hi, const bf16x8* qr, bool act, const float* bl) {
    if (SK && !act) { const float NEG = -__builtin_inff();
#pragma unroll
        for (int r = 0; r < 16; ++r) { p0[r] = NEG; p1[r] = NEG; } return; }
    if constexpr (BIAS) {
#pragma unroll
        for (int g_ = 0; g_ < 4; ++g_) { const f32x4 t0 = *(const f32x4*)(bl + 8 * g_), t1 = *(const f32x4*)(bl + 32 + 8 * g_);
            p0[4 * g_] = t0[0]; p0[4 * g_ + 1] = t0[1]; p0[4 * g_ + 2] = t0[2]; p0[4 * g_ + 3] = t0[3]; p1[4 * g_] = t1[0]; p1[4 * g_ + 1] = t1[1]; p1[4 * g_ + 2] = t1[2]; p1[4 * g_ + 3] = t1[3]; }
    } else { p0 = f32x16{}; p1 = f32x16{}; }
    const char* kb[4];
#pragma unroll
    for (int dd = 0; dd < 4; ++dd) kb[dd] = K_lds + KB * SHM_K + KSWZ(r32, (dd * 16 + hi * 8) * 2);
#pragma unroll
    for (int d0 = 0; d0 < 8; ++d0) { const char* a = kb[d0 & 3] + (d0 >> 2) * 128;
        bf16x8 b0 = *reinterpret_cast<const bf16x8*>(a);
        bf16x8 b1 = *reinterpret_cast<const bf16x8*>(a + 32 * 256);
        p0 = __builtin_amdgcn_mfma_f32_32x32x16_bf16(b0, qr[d0], p0, 0, 0, 0);
        p1 = __builtin_amdgcn_mfma_f32_32x32x16_bf16(b1, qr[d0], p1, 0, 0, 0); }
}
template <int VB, bool SK>
__device__ __forceinline__ void pv_tile(f32x16* o, int vb0, bf16x8 pa0, bf16x8 pa1, bf16x8 pa2, bf16x8 pa3, bool act) {
    if (SK && !act) return;
#define TRRD(dst, off) asm volatile("ds_read_b64_tr_b16 %0, %1 offset:%2" : "=&v"(dst) : "v"(vb0), "i"(off) : "memory")
#define PV_D0(d0) do { s16x4 l0, l1, l2, l3, h0, h1, h2, h3; constexpr int b_ = VB * SHM_V + v_rd_off(d0, 0, 0);     \
        TRRD(l0, b_); TRRD(h0, b_ + 2048); TRRD(l1, b_ + 4096); TRRD(h1, b_ + 6144); TRRD(l2, b_ + 8192); TRRD(h2, b_ + 10240); TRRD(l3, b_ + 12288); TRRD(h3, b_ + 14336); \
        asm volatile("s_waitcnt lgkmcnt(0)" ::: "memory"); SBAR();                 \
        o[d0] = __builtin_amdgcn_mfma_f32_32x32x16_bf16(pa0, (bf16x8){l0[0], l0[1], l0[2], l0[3], h0[0], h0[1], h0[2], h0[3]}, o[d0], 0, 0, 0);   \
        o[d0] = __builtin_amdgcn_mfma_f32_32x32x16_bf16(pa1, (bf16x8){l1[0], l1[1], l1[2], l1[3], h1[0], h1[1], h1[2], h1[3]}, o[d0], 0, 0, 0);   \
        o[d0] = __builtin_amdgcn_mfma_f32_32x32x16_bf16(pa2, (bf16x8){l2[0], l2[1], l2[2], l2[3], h2[0], h2[1], h2[2], h2[3]}, o[d0], 0, 0, 0);   \
        o[d0] = __builtin_amdgcn_mfma_f32_32x32x16_bf16(pa3, (bf16x8){l3[0], l3[1], l3[2], l3[3], h3[0], h3[1], h3[2], h3[3]}, o[d0], 0, 0, 0); } while (0)
    PV_D0(0); PV_D0(1); PV_D0(2); PV_D0(3);
#undef PV_D0
#undef TRRD
}

template <class TIn, class TOut> struct BlockRef { const TIn* Q; const TIn* K; const TIn* V; TOut* O; int P0; };
template <class TIn> struct Seam {
    bf16x8 qr[8];
    bf16x8 st_v0, st_v1, st_k0, st_k1; f32x4 sf0, sf1, sf2, sf3;
    f32x4 tq[16];
};
__device__ __forceinline__ int swa_jlo(int P0, int W) { const int lowk = P0 - W + 1; return lowk > 0 ? lowk / KVBLK : 0; }
#define ROW(p, k0, rr) (((p) + (size_t)(k0) * KS) + (unsigned)((rr) * KS + sc))
#define VMW() asm volatile("s_waitcnt vmcnt(0)" ::: "memory")
#define VMWN(n) asm volatile("s_waitcnt vmcnt(%0)" :: "i"(n) : "memory")
#define SLOAD_H(Kp, Vp, k0) do { S.st_v0 = load8<TIn>(ROW(Vp, k0, sr)); S.st_v1 = load8<TIn>(ROW(Vp, k0, 32 + sr));              \
                         S.st_k0 = load8<TIn>(ROW(Kp, k0, sr)); S.st_k1 = load8<TIn>(ROW(Kp, k0, 32 + sr)); } while (0)
#define SWRITE_HK(bf) do { *(bf16x8*)(K_lds + (bf) * SHM_K + kws) = S.st_k0; *(bf16x8*)(K_lds + (bf) * SHM_K + kws + 32 * 256) = S.st_k1; } while (0)
#define SWRITE_HV(bf) do { *(bf16x8*)(V_lds + (bf) * SHM_V + vst0) = S.st_v0; *(bf16x8*)(V_lds + (bf) * SHM_V + vst1) = S.st_v1; } while (0)
#define SWRITE_H(bf) do { SWRITE_HV(bf); SWRITE_HK(bf); } while (0)
#define SLOAD_F(p, k0) do { S.sf0 = *(const f32x4*)ROW(p, k0, sr); S.sf1 = *(const f32x4*)(ROW(p, k0, sr) + 4);                \
                            S.sf2 = *(const f32x4*)ROW(p, k0, 32 + sr); S.sf3 = *(const f32x4*)(ROW(p, k0, 32 + sr) + 4); } while (0)
#define SWRITE_KF(bf) do { *(bf16x8*)(K_lds + (bf) * SHM_K + kws) = pack8(S.sf0, S.sf1); *(bf16x8*)(K_lds + (bf) * SHM_K + kws + 32 * 256) = pack8(S.sf2, S.sf3); } while (0)
#define SWRITE_VF(bf) do { *(bf16x8*)(V_lds + (bf) * SHM_V + vst0) = pack8(S.sf0, S.sf1); *(bf16x8*)(V_lds + (bf) * SHM_V + vst1) = pack8(S.sf2, S.sf3); } while (0)
template <class TIn, class TOut, int QS, int KS, int OS, bool BIAS>
__device__ __forceinline__ void causal_swa_prime(const BlockRef<TIn, TOut>& cur, int W, char* lds, Seam<TIn>& S) {
    constexpr bool F32 = same_t<TIn, float>::v;
    const int tid = threadIdx.x, wid = __builtin_amdgcn_readfirstlane(tid >> 6), lane = tid & 63, r32 = lane & 31, hi = lane >> 5;
    const int sr = tid >> 4, sc = (tid & 15) * 8, kws = KSWZ(sr, sc * 2); char* K_lds = lds + 2 * SHM_V;
    const int kb0 = swa_jlo(cur.P0, W) * KVBLK;
    for (int d0 = 0; d0 < 8; ++d0) S.qr[d0] = load8<TIn>(cur.Q + (size_t)(wid * QBLK + r32) * QS + d0 * 16 + hi * 8);
    if constexpr (F32) { SLOAD_F((const float*)cur.K, kb0); VMW(); SWRITE_KF(0); SBAR(); SLOAD_F((const float*)cur.V, kb0); }
    else { SLOAD_H(cur.K, cur.V, kb0); VMW(); SWRITE_HK(0); }
    __syncthreads();
}
template <class TIn, class TOut, int QS, int KS, int OS, bool BIAS, bool PREF = true>
__device__ __forceinline__ void causal_swa_block(const BlockRef<TIn, TOut>& cur, const BlockRef<TIn, TOut>& nxt, int skv, int W, char* lds, Seam<TIn>& S) {
    constexpr bool F32 = same_t<TIn, float>::v;
    const int tid = threadIdx.x, wid = __builtin_amdgcn_readfirstlane(tid >> 6), lane = tid & 63, r32 = lane & 31, hi = lane >> 5;
    const int j_lo = swa_jlo(cur.P0, W);
    int j_hi = (cur.P0 + QB - 1) / KVBLK + 1; if (j_hi > skv / KVBLK) j_hi = skv / KVBLK;
    const int NT = j_hi - j_lo;
    const int kbn = swa_jlo(nxt.P0, W) * KVBLK;
    const int qlo = cur.P0 + wid * QBLK, qm = qlo + r32 - 4 * hi;
    char* V_lds = lds; char* K_lds = lds + 2 * SHM_V;
    float* ws = (float*)(lds + 2 * SHM_V + 2 * SHM_K) + wid * 64; float* li_l = ws, * al_l = ws + 32;
    float m_reg = BIAS ? ((const float*)(lds + BIAS_OFF))[cur.P0 + wid * QBLK + r32] : -1e30f, l_reg = 0; f32x16 o[4] = {};
    const int sr = tid >> 4, sc = (tid & 15) * 8, vst0 = v_st(sr, sc), vst1 = v_st(32 + sr, sc), kws = KSWZ(sr, sc * 2);
    const int vb0 = (int)(uintptr_t)V_lds + v_rd_base(lane);
    const TIn* Kh = cur.K; const TIn* Vh = cur.V;
    const float* bias0 = (const float*)(lds + BIAS_OFF) + 4 * hi;
#define RESC(a) do { if (__any((a) < 1.f)) { if (hi == 0) al_l[r32] = (a); asm volatile("s_waitcnt lgkmcnt(0)" ::: "memory");              \
                     for (int d_ = 0; d_ < 4; ++d_) for (int r = 0; r < 16; ++r) o[d_][r] *= al_l[crow(r, hi)]; } } while (0)
#define KBASE(t) ((j_lo + (t)) * KVBLK)
#define BL(t) (bias0 + KBASE(t))
#define ACT(t) (KBASE(t) <= qlo + QBLK - 1 && KBASE(t) + KVBLK - 1 >= qlo - W + 1)
#define MASKT(P0_, P1_, t) do { const int kb_ = KBASE(t); if ((!SK || ACT(t)) && (kb_ + KVBLK - 1 > qlo || kb_ <= qlo + QBLK - 1 - W)) mask_tile(P0_, P1_, qm - kb_, (unsigned)W); } while (0)
    constexpr int NQL = F32 ? 16 : 8;
    constexpr bool SK = WSKIP && !F32;
#define SEAM_K0() do { VMWN(NQL); if constexpr (F32) { SWRITE_KF(0); SBAR(); SLOAD_F((const float*)nxt.V, kbn); } else { SWRITE_HK(0); } SBAR(); } while (0)
    f32x16 pA0, pA1, pB0, pB1; float mnA, mnB, alA, alB; bf16x8 pa0, pa1, pa2, pa3;
    if constexpr (F32) { VMW(); SWRITE_VF(0); SBAR(); } else { SWRITE_HV(0); SBAR(); }
    if (NT > 1) { if constexpr (F32) SLOAD_F((const float*)Kh, KBASE(1)); else SLOAD_H(Kh, Vh, KBASE(1)); }
    SBAR(); qkt<0, SK, BIAS>(pA0, pA1, K_lds, r32, hi, S.qr, ACT(0), BL(0));
    if constexpr (F32) { if (NT > 1) { VMW(); SWRITE_KF(1); SBAR(); SLOAD_F((const float*)Vh, KBASE(1)); } }
    MASKT(pA0, pA1, 0); partialSM(pA0, pA1, m_reg, mnA, alA);
    if (NT > 1) { VMW(); if constexpr (F32) { SWRITE_VF(1); SBAR(); if (NT > 2) SLOAD_F((const float*)Kh, KBASE(2)); } else SWRITE_H(1); }
    __syncthreads();
#define HALF_STEP(PX0, PX1, mnX, alX, PY0, PY1, alY, t, KB, VB, SB) do {                                                      \
        SBAR(); qkt<KB, SK, BIAS>(PX0, PX1, K_lds, r32, hi, S.qr, ACT(t), BL(t));                                             \
        finishSM(PY0, PY1, alY, l_reg, pa0, pa1, pa2, pa3); SBAR();                                                           \
        if ((t) + 1 < NT) { if constexpr (F32) { VMW(); SWRITE_KF(SB); SBAR(); SLOAD_F((const float*)Vh, KBASE((t) + 1)); }  \
                            else { SLOAD_H(Kh, Vh, KBASE((t) + 1)); } SBAR(); }                                               \
        pv_tile<VB, SK>(o, vb0, pa0, pa1, pa2, pa3, ACT((t) - 1)); MASKT(PX0, PX1, (t)); partialSM(PX0, PX1, m_reg, mnX, alX);                                        \
        __syncthreads();                                                                                                      \
        if ((t) + 1 < NT) { VMW(); if constexpr (F32) { SWRITE_VF(SB); SBAR(); if ((t) + 2 < NT) SLOAD_F((const float*)Kh, KBASE((t) + 2)); } \
                            else { SWRITE_H(SB); } }                                                                          \
        RESC(alX); __syncthreads(); } while (0)
    for (int t = 1; t + 1 < NT; t += 2) {
        HALF_STEP(pB0, pB1, mnB, alB, pA0, pA1, alA, t, 1, 0, 0);
        HALF_STEP(pA0, pA1, mnA, alA, pB0, pB1, alB, t + 1, 0, 1, 1);
    }
    const bool even = (NT & 1) == 0;
    if (even) { SBAR(); qkt<1, SK, BIAS>(pB0, pB1, K_lds, r32, hi, S.qr, ACT(NT - 1), BL(NT - 1)); SBAR(); }
#define QROW(e) (nxt.Q + (size_t)(wid * QBLK + r32) * QS + ((e) >> 1) * 16 + hi * 8 + ((e) & 1) * 4)
    if constexpr (F32) { SLOAD_F((const float*)nxt.K, kbn); SBAR();
#pragma unroll
        for (int e = 0; e < 8; ++e) S.tq[e] = *(const f32x4*)QROW(e); }
    else if constexpr (PREF) { SLOAD_H(nxt.K, nxt.V, kbn); SBAR();
#pragma unroll
        for (int d0 = 0; d0 < 8; ++d0) S.qr[d0] = load8<TIn>(nxt.Q + (size_t)(wid * QBLK + r32) * QS + d0 * 16 + hi * 8); }
    SBAR();
    finishSM(pA0, pA1, alA, l_reg, pa0, pa1, pa2, pa3); SBAR();
    if constexpr (F32) {
#pragma unroll
        for (int e = 8; e < 16; ++e) S.tq[e] = *(const f32x4*)QROW(e); SBAR(); }
#undef QROW
    pv_tile<0, SK>(o, vb0, pa0, pa1, pa2, pa3, ACT(even ? NT - 2 : NT - 1));
    if (even) { MASKT(pB0, pB1, NT - 1); partialSM(pB0, pB1, m_reg, mnB, alB); __syncthreads(); RESC(alB);
        finishSM(pB0, pB1, alB, l_reg, pa0, pa1, pa2, pa3); SBAR(); pv_tile<1, SK>(o, vb0, pa0, pa1, pa2, pa3, ACT(NT - 1)); }
    SBAR(); if constexpr (PREF) SEAM_K0();
    if (hi == 0) li_l[r32] = l_reg; asm volatile("s_waitcnt lgkmcnt(0)" ::: "memory");
    float rli[16];
#pragma unroll
    for (int r = 0; r < 16; ++r) rli[r] = __builtin_amdgcn_rcpf(li_l[crow(r, hi)]);
    TOut* Ow = cur.O + (size_t)(wid * QBLK) * OS;
#pragma unroll
    for (int r = 0; r < 16; ++r) { const int orow = crow(r, hi);
#pragma unroll
        for (int d0 = 0; d0 < 4; ++d0) { const float v = o[d0][r] * rli[r];
            if constexpr (same_t<TOut, float>::v) { Ow[(size_t)orow * OS + d0 * 32 + r32] = v; }
            else { const float vn = __shfl_xor(v, 1);
                   if ((r32 & 1) == 0) *(unsigned*)(Ow + (size_t)orow * OS + d0 * 32 + r32) = cvtpk(v, vn); } } }
    if constexpr (F32) {
#pragma unroll
        for (int d0 = 0; d0 < 8; ++d0) S.qr[d0] = pack8(S.tq[2 * d0], S.tq[2 * d0 + 1]); }
    __syncthreads();
#undef RESC
#undef KBASE
#undef BL
#undef ACT
#undef MASKT
#undef SEAM_K0
#undef HALF_STEP
}
#undef ROW
#undef VMW
#undef VMWN
#undef SLOAD_H
#undef SWRITE_HK
#undef SWRITE_HV
#undef SWRITE_H
#undef SLOAD_F
#undef SWRITE_KF
#undef SWRITE_VF

#undef KSWZ
#undef SBAR
}
__device__ __forceinline__ void sg_phase(const Frame& F, const KArgs& a, const int u_first, const int u_count) {
    unsigned char* ws = F.ws; const int tid = F.tid, lane = F.lane, w = F.wave, tl = lane & 15, kq = lane >> 4;
    LAS f32x2* st = (LAS f32x2*)F.lds;
    LAS unsigned short* vt = (LAS unsigned short*)(F.lds + 1024);
    const bf16* ZU = (const bf16*)(ws + WS_ZU); const bf16* ZV = (const bf16*)(ws + WS_ZV); const float* ZST = (const float*)(ws + WS_ZST); bf16* AS = (bf16*)(ws + WS_AS);
    const float* ln_g = a.in[5]; const float* ln_b = a.in[6]; const float* w_sp = a.in[7]; const float* b_sp = a.in[8];
    for (int uu = 0; uu < u_count; ++uu) { const int u = u_first + uu;
        const int chunk = u >> 3, g = u & 7, t0 = chunk * SGC;
        if (tid < 128) { const f32x4* p = (const f32x4*)(ZST + (size_t)(t0 + tid) * 32); float S = 0.f, Q = 0.f;
#pragma unroll
            for (int i = 0; i < 8; ++i) { const f32x4 v = p[i]; S += v[0] + v[2]; Q += v[1] + v[3]; }
            const float mu = S * (1.f / SGW), var = fmaxf(Q * (1.f / SGW) - mu * mu, 0.f); st[tid] = (f32x2){mu, rsqrtf(var + LN_EPS)}; }
        __syncthreads();
        { const int s = tid >> 2, c0 = (tid & 3) * 32; const f32x2 ms = st[s]; const bf16* src = ZV + (size_t)(t0 + s) * SGW + g * 128 + c0;
#pragma unroll
            for (int q = 0; q < 4; ++q) { const u32x4 raw = ((const u32x4*)src)[q]; const unsigned rw[4] = {raw.x, raw.y, raw.z, raw.w};
                const f32x4 g0 = *(const f32x4*)(ln_g + g * 128 + c0 + 8 * q), g1 = *(const f32x4*)(ln_g + g * 128 + c0 + 8 * q + 4), b0 = *(const f32x4*)(ln_b + g * 128 + c0 + 8 * q), b1 = *(const f32x4*)(ln_b + g * 128 + c0 + 8 * q + 4);
#pragma unroll
                for (int i = 0; i < 8; ++i) { const unsigned wd = rw[i >> 1]; const float v = __builtin_bit_cast(float, (i & 1) ? (wd & 0xffff0000u) : (wd << 16));
                    const float gg = (i < 4) ? g0[i & 3] : g1[i & 3], bb = (i < 4) ? b0[i & 3] : b1[i & 3];
                    vt[(c0 + 8 * q + i) * 136 + s] = (unsigned short)f2bf((v - ms[0]) * ms[1] * gg + bb); } } }
        __syncthreads();
        f32x4 acc[8];
#pragma unroll
        for (int j = 0; j < 8; ++j) acc[j] = (f32x4){0.f, 0.f, 0.f, 0.f};
        const int t = 16 * w + tl;
        f32x4 wraw[4][2];
#pragma unroll
        for (int ks = 0; ks < 4; ++ks) { const float* wp = w_sp + ((size_t)(g * 128 + t) * 128 + 32 * ks + 8 * kq); if (ks <= (w >> 1)) { wraw[ks][0] = *(const f32x4*)wp; wraw[ks][1] = *(const f32x4*)(wp + 4); } else { wraw[ks][0] = (f32x4){0.f, 0.f, 0.f, 0.f}; wraw[ks][1] = wraw[ks][0]; } }
        u32x2 uraw[8];
#pragma unroll
        for (int j = 0; j < 8; ++j) uraw[j] = *(const u32x2*)(ZU + (size_t)(t0 + t) * SGW + g * 128 + 16 * j + 4 * kq);
        const float bs = b_sp[g * 128 + t];
#pragma unroll
        for (int ks = 0; ks < 4; ++ks) { if (ks > (w >> 1)) continue;
            const f32x4 w0 = wraw[ks][0], w1 = wraw[ks][1];
            float wv[8] = {w0[0], w0[1], w0[2], w0[3], w1[0], w1[1], w1[2], w1[3]};
#pragma unroll
            for (int i = 0; i < 8; ++i) if (32 * ks + 8 * kq + i > t) wv[i] = 0.f;
            u32x4 pk; pk.x = cvt_pk_bf16(wv[0], wv[1]); pk.y = cvt_pk_bf16(wv[2], wv[3]); pk.z = cvt_pk_bf16(wv[4], wv[5]); pk.w = cvt_pk_bf16(wv[6], wv[7]);
            const bf16x8 wf = __builtin_bit_cast(bf16x8, pk);
#pragma unroll
            for (int j = 0; j < 8; ++j) { const bf16x8 vf = *(const LAS bf16x8*)(vt + (16 * j + tl) * 136 + 32 * ks + 8 * kq);
                acc[j] = __builtin_amdgcn_mfma_f32_16x16x32_bf16(vf, wf, acc[j], 0, 0, 0); }
        }
#pragma unroll
        for (int j = 0; j < 8; ++j) { const int ch = 16 * j + 4 * kq; const u32x2 uu = uraw[j];
            const float o0 = __builtin_bit_cast(float, uu.x << 16) * (acc[j][0] + bs), o1 = __builtin_bit_cast(float, uu.x & 0xffff0000u) * (acc[j][1] + bs);
            const float o2 = __builtin_bit_cast(float, uu.y << 16) * (acc[j][2] + bs), o3 = __builtin_bit_cast(float, uu.y & 0xffff0000u) * (acc[j][3] + bs);
            u32x2 o; o.x = cvt_pk_bf16(o0, o1); o.y = cvt_pk_bf16(o2, o3); *(u32x2*)(AS + (size_t)(t0 + t) * DM + FW + g * 128 + ch) = o; }
        __syncthreads();
    }
}
__device__ __forceinline__ void fox_phase(const Frame& F, char* lds, int& sg_first, int& sg_count) {
    sg_first = blockIdx.x * 4; sg_count = 4;
    typedef unsigned short T;
    unsigned char* ws = F.ws; const int G = F.G, c = blockIdx.x, vcu = (G % 8 == 0) ? (c % 8) * (G / 8) + c / 8 : c;
    const T* Qb = (const T*)(ws + WS_Q); const T* Kb = (const T*)(ws + WS_K); const T* Vb = (const T*)(ws + WS_V); T* Ob = (T*)(ws + WS_AS); const float* CB = (const float*)(ws + WS_CB);
    if (vcu < NB * FH * 8) {
        const int L = vcu; const int bh = L >> 3, x = L & 7, b = bh / FH, h = bh % FH;
        __syncthreads();
        { const f32x4* src = (const f32x4*)(CB + (size_t)bh * SEQ); f32x4* dst = (f32x4*)(lds + att::BIAS_OFF); dst[F.tid] = src[F.tid]; dst[F.tid + 512] = src[F.tid + 512]; }
        __syncthreads();
        int Wwin = SEQ;
        { const unsigned* NRM = F.ctl + CW_NRM; float q2 = 0.f, k2 = 0.f;
#pragma unroll
            for (int i = 0; i < 4; ++i) { q2 += __uint_as_float(__hip_atomic_load(NRM + ((0 * 4 + b) * 8 + h) * 4 + i, __ATOMIC_RELAXED, __HIP_MEMORY_SCOPE_AGENT)); k2 += __uint_as_float(__hip_atomic_load(NRM + ((1 * 4 + b) * 8 + h) * 4 + i, __ATOMIC_RELAXED, __HIP_MEMORY_SCOPE_AGENT)); }
            const float Bnd = sqrtf(q2 * k2) * 0.08838834764831845f * 1.02f;
            const float need = -(2.f * Bnd + 18.f) * 11.313708498984761f;
            const float* bl = (const float*)(lds + att::BIAS_OFF); float* red = (float*)(lds + att::BIAS_OFF + SEQ * 4);
            int lo = 1, hi = SEQ / 64;
            while (lo < hi) { const int mid = (lo + hi) >> 1, Wc = mid * 64; float mx = -3.0e38f;
                for (int t = Wc + F.tid; t < SEQ; t += NTHREADS) mx = fmaxf(mx, bl[t - Wc] - bl[t]);
#pragma unroll
                for (int o = 1; o < 64; o <<= 1) mx = fmaxf(mx, __shfl_xor(mx, o));
                __syncthreads(); if (F.lane == 0) red[F.wave] = mx; __syncthreads();
                float m8 = red[0];
#pragma unroll
                for (int i = 1; i < 8; ++i) m8 = fmaxf(m8, red[i]);
                if (m8 <= need) hi = mid; else lo = mid + 1; }
            Wwin = __builtin_amdgcn_readfirstlane(lo * 64); __syncthreads(); }
        att::BlockRef<T, T> cur, nxt;
        cur.K = Kb + (size_t)b * SEQ * FW + h * FD; cur.V = Vb + (size_t)b * SEQ * FW + h * FD; nxt = cur;
        cur.Q = Qb + ((size_t)b * SEQ + x * 256) * FW + h * FD; cur.O = Ob + ((size_t)b * SEQ + x * 256) * DM + h * FD; cur.P0 = x * 256;
        nxt.Q = Qb + ((size_t)b * SEQ + (15 - x) * 256) * FW + h * FD; nxt.O = Ob + ((size_t)b * SEQ + (15 - x) * 256) * DM + h * FD; nxt.P0 = (15 - x) * 256;
        att::Seam<T> S;
        att::causal_swa_prime<T, T, FW, FW, DM, true>(cur, Wwin, lds, S);
        att::causal_swa_block<T, T, FW, FW, DM, true>(cur, nxt, SEQ, Wwin, lds, S);
        att::causal_swa_block<T, T, FW, FW, DM, true, false>(nxt, nxt, SEQ, Wwin, lds, S);
        { const int wt = Wwin / 64 + 4; int load[8], cnt[8];
#pragma unroll
          for (int i = 0; i < 8; ++i) { const int f0 = 4 * (i + 1), f1 = 4 * (16 - i); load[i] = (f0 < wt ? f0 : wt) + (f1 < wt ? f1 : wt); cnt[i] = 0; }
          for (int k = 0; k < 32; ++k) { int bi = 0, bv = load[0];
#pragma unroll
              for (int i = 1; i < 8; ++i) if (load[i] < bv) { bv = load[i]; bi = i; }
#pragma unroll
              for (int i = 0; i < 8; ++i) if (i == bi) { load[i] += 4; cnt[i] += 1; } }
          int first = 0, mine = 0;
#pragma unroll
          for (int i = 0; i < 8; ++i) { if (i < x) first += cnt[i]; if (i == x) mine = cnt[i]; }
          sg_first = bh * 32 + first; sg_count = mine; }
    }
}
__device__ __forceinline__ void xattn_phase(const Frame& F, char* lds, unsigned* bar) {
    typedef unsigned short T;
    unsigned char* ws = F.ws; unsigned* FLG = F.ctl + CW_FLG;
    const T* Qb = (const T*)(ws + WS_QX); const T* Kb = (const T*)(ws + WS_KX); const T* Vb = (const T*)(ws + WS_VX); T* Ob = (T*)(ws + WS_OX);
    for (int L = blockIdx.x; L < NB * XH * 16; L += 144) {
        const int b = L >> 6, h = (L >> 4) & 3, qb = L & 15;
        __syncthreads();
        if (F.tid == 0) {
            unsigned* fq_ = FLG + ((b * 16 + qb) * 2 + (h >> 1)) * 32; unsigned* fk_ = FLG + (128 + 4 * b + (h >> 1)) * 32; unsigned* fv_ = FLG + (130 + 4 * b + (h >> 1)) * 32;
            XB_SPIN(xb_ld(fq_) == 0u, bar); XB_SPIN(xb_ld(fk_) == 0u, bar); XB_SPIN(xb_ld(fv_) == 0u, bar);
            __builtin_amdgcn_fence(__ATOMIC_ACQUIRE, "agent");
            asm volatile("s_waitcnt vmcnt(0)" ::: "memory");
        }
        __syncthreads();
        att::BlockRef<T, T> cur;
        cur.K = Kb + (size_t)b * MEML * XW + h * XD; cur.V = Vb + (size_t)b * MEML * XW + h * XD;
        cur.Q = Qb + ((size_t)b * SEQ + qb * 256) * XW + h * XD; cur.O = Ob + ((size_t)b * SEQ + qb * 256) * XW + h * XD; cur.P0 = MEML;
        att::Seam<T> S;
        att::causal_swa_prime<T, T, XW, XW, XW, false>(cur, 1 << 20, lds, S);
        att::causal_swa_block<T, T, XW, XW, XW, false, false>(cur, cur, MEML, 1 << 20, lds, S);
    }
}
__device__ __forceinline__ void moe_tables(const Frame& F) {
    LAS int* tab = (LAS int*)(F.lds + LDS_TAB);
    __syncthreads();
    if (F.tid == 0) { const unsigned* CNT = F.ctl + CW_CNT; int p = 0;
        for (int e = 0; e < NE; ++e) { const int c = (int)__hip_atomic_load(CNT + e, __ATOMIC_RELAXED, __HIP_MEMORY_SCOPE_AGENT); tab[e] = p; tab[40 + e] = c; p += (c + 255) >> 8; }
        tab[32] = p; }
    __syncthreads();
}
typedef float f32x16 __attribute__((ext_vector_type(16)));
__device__ __forceinline__ void p8_router(const Frame& F, const KArgs& a) {
    unsigned char* ws = F.ws; const int tid = F.tid, lane = F.lane, wave = F.wave, tl = lane & 31, hi = lane >> 5, grp = wave >> 2, kq = wave & 3;
    const unsigned short* X2 = (const unsigned short*)(ws + WS_X2B); const float* WRT = (const float*)(ws + WS_WRT);
    constexpr int PITCH = 132;
    LAS float* xs = (LAS float*)F.lds;
    LAS float* wsm = xs + 2 * 64 * PITCH;
    LAS float* red = wsm + 2 * 32 * PITCH;
    LAS unsigned* lcnt = (LAS unsigned*)(F.lds + LDS_TAB + 512);
    for (int tp = blockIdx.x; tp < NTOK / 64; tp += F.G) {
        const int tok0 = tp * 64;
        u32x4 xa[2], xb[2]; f32x4 wa[2], wb[2];
#define P8_LOAD(X, W, c) do { _Pragma("unroll") for (int i = 0; i < 2; ++i) { const int p = tid + 512 * i; X[i] = *(const u32x4*)(X2 + (size_t)(tok0 + (p >> 4)) * DM + (c) * 128 + (p & 15) * 8); } \
        _Pragma("unroll") for (int i = 0; i < 2; ++i) { const int p = tid + 512 * i; W[i] = *(const f32x4*)(WRT + (size_t)(p >> 5) * DM + (c) * 128 + (p & 31) * 4); } } while (0)
#define P8_WRITE(X, W, b) do { _Pragma("unroll") for (int i = 0; i < 2; ++i) { const int p = tid + 512 * i; LAS float* xd = xs + ((b) * 64 + (p >> 4)) * PITCH + (p & 15) * 8; const u32x4 r = X[i]; \
            *(LAS f32x4*)xd = (f32x4){__builtin_bit_cast(float, r.x << 16), __builtin_bit_cast(float, r.x & 0xffff0000u), __builtin_bit_cast(float, r.y << 16), __builtin_bit_cast(float, r.y & 0xffff0000u)}; \
            *(LAS f32x4*)(xd + 4) = (f32x4){__builtin_bit_cast(float, r.z << 16), __builtin_bit_cast(float, r.z & 0xffff0000u), __builtin_bit_cast(float, r.w << 16), __builtin_bit_cast(float, r.w & 0xffff0000u)}; } \
        _Pragma("unroll") for (int i = 0; i < 2; ++i) { const int p = tid + 512 * i; *(LAS f32x4*)(wsm + ((b) * 32 + (p >> 5)) * PITCH + (p & 31) * 4) = W[i]; } } while (0)
#define P8_COMPUTE(b) do { const LAS float* xp = xs + ((b) * 64 + grp * 32 + tl) * PITCH + kq * 32 + 4 * hi; const LAS float* wp = wsm + ((b) * 32 + tl) * PITCH + kq * 32 + 4 * hi; \
        _Pragma("unroll") for (int s4 = 0; s4 < 4; ++s4) { const f32x4 xv = *(const LAS f32x4*)(xp + 8 * s4), wv = *(const LAS f32x4*)(wp + 8 * s4); \
            ss += (xv[0] * xv[0] + xv[1] * xv[1]) + (xv[2] * xv[2] + xv[3] * xv[3]); \
            _Pragma("unroll") for (int i = 0; i < 4; ++i) d = __builtin_amdgcn_mfma_f32_32x32x2f32(wv[i], xv[i], d, 0, 0, 0); } } while (0)
        __syncthreads();
        P8_LOAD(xa, wa, 0); P8_WRITE(xa, wa, 0); P8_LOAD(xa, wa, 1);
        f32x16 d = {}; float ss = 0.f;
        for (int c = 0; c < 16; c += 2) {
            if (c + 2 < 16) P8_LOAD(xb, wb, c + 2);
            asm volatile("s_waitcnt lgkmcnt(0)\n\ts_barrier" ::: "memory");
            P8_COMPUTE(0);
            P8_WRITE(xa, wa, 1);
            if (c + 3 < 16) P8_LOAD(xa, wa, c + 3);
            asm volatile("s_waitcnt lgkmcnt(0)\n\ts_barrier" ::: "memory");
            P8_COMPUTE(1);
            if (c + 2 < 16) P8_WRITE(xb, wb, 0);
        }
#undef P8_COMPUTE
#undef P8_LOAD
#undef P8_WRITE
        const int tok = tok0 + grp * 32 + tl;
        if (kq != 0) { LAS float* r = red + ((grp * 3 + (kq - 1)) * 17) * 64 + lane;
#pragma unroll
            for (int i = 0; i < 16; ++i) r[i * 64] = d[i];
            r[16 * 64] = ss; }
        __syncthreads();
        float wgt[4] = {0.f, 0.f, 0.f, 0.f}; int fe[4] = {0, 0, 0, 0}; unsigned lr[4] = {0u, 0u, 0u, 0u}; float rstd_t = 0.f;
        if (kq == 0) {
#pragma unroll
            for (int w = 0; w < 3; ++w) { const LAS float* r = red + ((grp * 3 + w) * 17) * 64 + lane;
#pragma unroll
                for (int i = 0; i < 16; ++i) d[i] += r[i * 64];
                ss += r[16 * 64]; }
            ss += __shfl_xor(ss, 32);
            const float rstd = rsqrtf(ss * (1.f / DM) + RMS_EPS);
            float l[16];
#pragma unroll
            for (int r = 0; r < 16; ++r) { const int e = (r & 3) + 8 * (r >> 2) + 4 * hi; l[r] = d[r] * rstd + a.in[19][e]; }
            float tv[8]; int ti[8];
#pragma unroll
            for (int k = 0; k < 4; ++k) { float bv = -INFINITY; int bi = 0;
#pragma unroll
                for (int r = 0; r < 16; ++r) { const int e = (r & 3) + 8 * (r >> 2) + 4 * hi; if (l[r] > bv || (l[r] == bv && e < bi)) { bv = l[r]; bi = e; } }
                tv[k] = bv; ti[k] = bi;
#pragma unroll
                for (int r = 0; r < 16; ++r) { const int e = (r & 3) + 8 * (r >> 2) + 4 * hi; if (e == bi) l[r] = -INFINITY; } }
#pragma unroll
            for (int k = 0; k < 4; ++k) { tv[4 + k] = __shfl_xor(tv[k], 32); ti[4 + k] = __shfl_xor(ti[k], 32); }
            float fv[4]; int fi[4];
#pragma unroll
            for (int k = 0; k < 4; ++k) { float bv = -INFINITY; int bi = 1 << 30;
#pragma unroll
                for (int j = 0; j < 8; ++j) if (tv[j] > bv || (tv[j] == bv && ti[j] < bi)) { bv = tv[j]; bi = ti[j]; }
                fv[k] = bv; fi[k] = bi;
#pragma unroll
                for (int j = 0; j < 8; ++j) if (ti[j] == bi) tv[j] = -INFINITY; }
            if (hi == 0) {
                float w[4], sm = 0.f;
#pragma unroll
                for (int k = 0; k < 4; ++k) { w[k] = __expf(fv[k] - fv[0]); sm += w[k]; }
                const float inv = 1.f / sm; rstd_t = rstd;
#pragma unroll
                for (int k = 0; k < 4; ++k) { fe[k] = fi[k]; wgt[k] = w[k] * inv; lr[k] = __hip_atomic_fetch_add(lcnt + fi[k], 1u, __ATOMIC_RELAXED, __HIP_MEMORY_SCOPE_WORKGROUP); }
            }
        }
        __syncthreads();
        if (tid < 32) { const unsigned cN = lcnt[tid]; lcnt[32 + tid] = cN ? atomicAdd(F.ctl + CW_CNT + tid, cN) : 0u; lcnt[tid] = 0u; }
        __syncthreads();
        if (kq == 0 && hi == 0) {
            ((float*)(ws + WS_RS2))[tok] = rstd_t;
#pragma unroll
            for (int k = 0; k < 4; ++k) { const int e = fe[k]; const float wk = wgt[k]; const unsigned rk = lcnt[32 + e] + lr[k];
                ((int*)(ws + WS_TOPE))[tok * 4 + k] = e; ((int*)(ws + WS_TOPR))[tok * 4 + k] = (int)rk; ((float*)(ws + WS_TOPW))[tok * 4 + k] = wk;
                ((int*)(ws + WS_TOKL))[(size_t)e * NTOK + rk] = tok; ((float*)(ws + WS_GWL))[(size_t)e * NTOK + rk] = wk; ((float*)(ws + WS_RSL))[(size_t)e * NTOK + rk] = rstd_t; }
        }
    }
}
__device__ __forceinline__ void p12_final(const Frame& F, const KArgs& a) {
    unsigned char* ws = F.ws; const int lane = F.lane; const LAS int* tab = (const LAS int*)(F.lds + LDS_TAB);
    const unsigned short* X2 = (const unsigned short*)(ws + WS_X2B); const unsigned char* YB = ws + WS_YB; const int* TOPE = (const int*)(ws + WS_TOPE); const int* TOPR = (const int*)(ws + WS_TOPR);
    for (int row = F.gw; row < NTOK; row += F.NGW) {
        size_t so[4];
#pragma unroll
        for (int k = 0; k < 4; ++k) { const int e = TOPE[row * 4 + k], r = TOPR[row * 4 + k]; so[k] = (size_t)(tab[e] * 256 + r) * DM; }
        f32x4 v[8]; float q = 0.f;
#pragma unroll
        for (int j = 0; j < 8; ++j) { const int c = 4 * (lane + 64 * j); { const u32x2 xr = *(const u32x2*)(X2 + (size_t)row * DM + c); v[j] = (f32x4){__builtin_bit_cast(float, xr.x << 16), __builtin_bit_cast(float, xr.x & 0xffff0000u), __builtin_bit_cast(float, xr.y << 16), __builtin_bit_cast(float, xr.y & 0xffff0000u)}; }
#pragma unroll
            for (int k = 0; k < 4; ++k) { const int y = *(const int*)(YB + so[k] + c);
                v[j][0] += __builtin_amdgcn_cvt_f32_fp8(y, 0); v[j][1] += __builtin_amdgcn_cvt_f32_fp8(y, 1); v[j][2] += __builtin_amdgcn_cvt_f32_fp8(y, 2); v[j][3] += __builtin_amdgcn_cvt_f32_fp8(y, 3); }
            q += (v[j][0] * v[j][0] + v[j][1] * v[j][1]) + (v[j][2] * v[j][2] + v[j][3] * v[j][3]); }
        const float rs = rsqrtf(wave_sum(q) * (1.f / DM) + RMS_EPS);
#pragma unroll
        for (int j = 0; j < 8; ++j) { const int c = 4 * (lane + 64 * j); const f32x4 g = *(const f32x4*)(a.in[24] + c); *(f32x4*)(a.out + (size_t)row * DM + c) = v[j] * rs * g; }
    }
}
__global__ void __launch_bounds__(NTHREADS, 2) mega_fwd(KArgs args) {
    extern __shared__ __attribute__((aligned(16))) unsigned char lds_raw[];
    Frame F;
    F.lds = (LAS unsigned char*)lds_raw; F.MISC = (volatile LAS unsigned*)(F.lds + LDS_MISC);
    F.tid = threadIdx.x; F.lane = F.tid & 63; F.wave = __builtin_amdgcn_readfirstlane(F.tid >> 6);
    F.G = gridDim.x; F.gw = blockIdx.x * NWAVES + F.wave; F.NGW = F.G * NWAVES;
    F.ws = args.ws; F.ctl = (unsigned*)(args.ws + WS_CTL);
    unsigned char* ws = args.ws;
    for (int u = F.tid; u < (LDS_BYTES - LDS_MISC) / 4; u += NTHREADS) ((LAS unsigned*)(F.lds + LDS_MISC))[u] = 0u;
    __syncthreads();
    XcdBarrier bar = xcd_barrier_post(F.ctl + CW_BAR + args.li * XCD_BAR_WORDS, F.MISC + 8);
    const int lo = args.ph_lo, hi = args.ph_hi;
#define IN(k) (lo <= (k) && (k) < hi)
#define BOTH(k) (IN(k) && IN((k) + 1))
    if (IN(0)) { p0_prologue<0>(F, args, F.gw, F.NGW); if (BOTH(0)) xcd_barrier(bar); }
    if (IN(1)) {
        if (blockIdx.x < NB * FH && F.wave == 0) cumsum_wave((const float*)(ws + WS_LOGF), (float*)(ws + WS_CB), blockIdx.x, F.lane);
        const int bx = blockIdx.x, oct = bx >> 3, conv = (oct & 7) < pg8::P1_CO ? 1 : 0;
        const int idx = (conv ? ((oct >> 3) * pg8::P1_CO + (oct & 7)) : ((oct >> 3) * (8 - pg8::P1_CO) + (oct & 7) - pg8::P1_CO)) * 8 + (bx & 7);
        if (conv) cvt8_phase(F, args, idx, pg8::P1_NC, 0, CVT8_P1_SUPER);
        {
            pg8::ProjSched S; S.T.init(NTOK / 256, pg8::P1_NBF, pg8::P1_NG, idx); S.A = (const char*)(ws + WS_H0); S.B = (const char*)(ws + WS_WP); S.lda = DM * 2; S.ldb = DM * 2; S.conv = conv; S.idx = idx;
            pg8::EpiProj E{ws, 0, -1.4426950408889634f};
            pg8::gemm_phase<false, false>(F.lds, DM / 64, DM * 2, DM * 2, S, E); }
        {
            constexpr int OFS = (pg8::P1_NG - ((NTOK / 256) * pg8::P1_NBF) % pg8::P1_NG) % pg8::P1_NG;
            pg8::ProjSched S; S.T.init(NTOK / 256, pg8::P1_NF8, pg8::P1_NG, (idx + OFS) % pg8::P1_NG); S.A = (const char*)(ws + WS_H0Q); S.B = (const char*)(ws + WS_WPG); S.lda = DM; S.ldb = DM; S.conv = conv; S.idx = (idx + OFS) % pg8::P1_NG;
            pg8::EpiProj E{ws, pg8::P1_NBF, -1.4426950408889634f * W8_INV};
            pg8::gemm_phase<false, true>(F.lds, DM / 128, DM, DM, S, E); }
        if (BOTH(1)) xcd_barrier(bar);
    }
    if (IN(2)) { int sg_first, sg_count; fox_phase(F, (char*)lds_raw, sg_first, sg_count); sg_phase(F, args, sg_first, sg_count); if (BOTH(2)) xcd_barrier(bar); }
    if (IN(3)) {
        pg8::MergeSched S; S.T.init(NTOK / 256, DM / 256, F.G, (int)blockIdx.x); S.A = (const char*)(ws + WS_AS); S.B = (const char*)(ws + WS_WAB); S.lda = DM * 2; S.ldb = DM * 2;
        pg8::EpiMerge E{ws};
        pg8::gemm_phase<false, false>(F.lds, FW / 64, DM * 2, DM * 2, S, E);
        if (BOTH(3)) xcd_barrier(bar);
    }
    if (IN(4)) {
        pg8::PlainSched S; S.T.init(NTOK / 256, DM / 256, F.G, (int)blockIdx.x); S.A = (const char*)(ws + WS_MG); S.B = (const char*)(ws + WS_WO); S.lda = DM * 2; S.ldb = DM * 2;
        pg8::EpiResid<false, false> E{args.in[0], nullptr, (bf16*)(ws + WS_X1B), (float*)(ws + WS_SS1), nullptr};
        pg8::gemm_phase<false, false>(F.lds, DM / 64, DM * 2, DM * 2, S, E);
        if (BOTH(4)) xcd_barrier(bar);
    }
    if (IN(5)) {
        if (blockIdx.x >= 144) cvt8_phase(F, args, (int)blockIdx.x - 144, 112, CVT8_P1_SUPER, CVT8_SUPER);
        pg8::QkvSched S{(const char*)(ws + WS_X1B), (const char*)(ws + WS_WXQ), (const char*)(ws + WS_HM), (const char*)(ws + WS_WXKV), (int)blockIdx.x};
        pg8::EpiQkv E{ws};
        pg8::gemm_phase<false, false>(F.lds, DM / 64, DM * 2, DM * 2, S, E);
        if (blockIdx.x < 144) {
            asm volatile("s_waitcnt vmcnt(0)" ::: "memory"); __syncthreads();
            if (F.tid == 0) { __builtin_amdgcn_fence(__ATOMIC_RELEASE, "agent"); asm volatile("s_waitcnt vmcnt(0)" ::: "memory"); (void)xb_add(F.ctl + CW_FLG + (int)blockIdx.x * 32, 1u); }
            xattn_phase(F, (char*)lds_raw, bar.bar);
        }
        if (BOTH(5)) xcd_barrier(bar);
    }
    if (IN(7)) {
        pg8::PlainSched S; S.T.init(NTOK / 256, DM / 256, F.G, (int)blockIdx.x); S.A = (const char*)(ws + WS_OX); S.B = (const char*)(ws + WS_WXO); S.lda = XW * 2; S.ldb = XW * 2;
        pg8::EpiResid<true, false> E{(const void*)(ws + WS_X1B), nullptr, (bf16*)(ws + WS_X2B), (float*)(ws + WS_SS2), ws + WS_X2Q};
        pg8::gemm_phase<false, false>(F.lds, XW / 64, XW * 2, XW * 2, S, E);
        if (BOTH(7)) xcd_barrier(bar);
    }
    if (IN(8)) { p8_router(F, args); if (BOTH(8)) xcd_barrier(bar); }
    if (IN(10)) {
        moe_tables(F);
        pg8::MoeSched S{(const LAS int*)(F.lds + LDS_TAB), (const char*)(ws + WS_X2Q), (const char*)(ws + WS_WGU), (const int*)(ws + WS_TOKL), F.G, (int)blockIdx.x, 16, (unsigned)DM, (size_t)(2 * DFF)};
        pg8::EpiAct E{ws, (const LAS int*)(F.lds + LDS_TAB), args.in[21]};
        pg8::gemm_phase<true, true>(F.lds, DM / 128, DM, DM, S, E);
        if (BOTH(10)) xcd_barrier(bar);
    }
    if (IN(11)) {
        moe_tables(F);
        pg8::DownSched S{{(const LAS int*)(F.lds + LDS_TAB), (const char*)(ws + WS_HB), (const char*)(ws + WS_WD), (const int*)(ws + WS_TOKL), F.G, (int)blockIdx.x, 8, (unsigned)DFF, (size_t)DM}, (unsigned)DFF};
        pg8::EpiDown E{ws, (const LAS int*)(F.lds + LDS_TAB), args.in[23]};
        pg8::gemm_phase<false, true>(F.lds, DFF / 128, DFF, DFF, S, E);
        if (BOTH(11)) xcd_barrier(bar);
    }
    if (IN(12)) { moe_tables(F); p12_final(F, args); }
#undef IN
#undef BOTH
}
#ifndef PROBE_PHASE
#define PROBE_PHASE -1
#endif
static int g_grid = 0;
static void mega_launch(hipStream_t st, void* const* d_in, void* d_out, void* d_ws, int lo, int hi, int li) {
    if (g_grid == 0) {
        int dev = 0, cus = 0;
        if (hipGetDevice(&dev) != hipSuccess || hipDeviceGetAttribute(&cus, hipDeviceAttributeMultiprocessorCount, dev) != hipSuccess || cus <= 0) cus = 256;
        if (hipFuncSetAttribute((const void*)mega_fwd, hipFuncAttributeMaxDynamicSharedMemorySize, LDS_BYTES) != hipSuccess) fprintf(stderr, "hipFuncSetAttribute failed\n");
        int per_cu = 0;
        if (hipOccupancyMaxActiveBlocksPerMultiprocessor(&per_cu, (const void*)mega_fwd, NTHREADS, LDS_BYTES) != hipSuccess || per_cu < 1) fprintf(stderr, "occupancy query: %d\n", per_cu);
        (void)hipGetLastError();
        g_grid = cus;
        if (cus != 256) fprintf(stderr, "kernel_launch: built for 256 CUs, device reports %d\n", cus);
    }
    KArgs a{};
    for (int i = 0; i < 25; ++i) a.in[i] = (const float*)d_in[i];
    a.out = (float*)d_out; a.ws = (unsigned char*)d_ws; a.ph_lo = lo; a.ph_hi = hi; a.li = li; a.pad = 0;
    hipLaunchKernelGGL(mega_fwd, dim3(g_grid), dim3(NTHREADS), LDS_BYTES, st, a);
}
extern "C" void kernel_launch(void* const* d_in, const int* in_sizes, int n_in, void* d_out, int out_size, void* d_ws, size_t ws_size, hipStream_t st) {
    if (n_in != 25 || ws_size < WS_END) { fprintf(stderr, "kernel_launch: unexpected n_in %d / ws %zu\n", n_in, ws_size); return; }
    (void)in_sizes; (void)out_size;
    char* ws = (char*)d_ws;
    (void)hipMemsetAsync(ws + WS_CTL, 0, CTL_BYTES, st);
    mega_launch(st, d_in, d_out, d_ws, 0, 13, 0);
#if PROBE_PHASE >= 0
    mega_launch(st, d_in, d_out, d_ws, PROBE_PHASE, PROBE_PHASE + 1, 1);
#endif
}
```
